# Optimizing an MI355X kernel written in HIP

```python
import jax, jax.numpy as jnp
from jax import lax
import numpy as np

D_MODEL = 1024
BATCH = 2
SEQ = 8192
DEPTH = 1

GLA_HEADS = 4
GLA_DK = 128
GLA_DV = 256
GLA_RANK = 16
GLA_TAU = 16.0
GLA_CHUNK = 64
GLA_QK = GLA_HEADS * GLA_DK
GLA_V = GLA_HEADS * GLA_DV
SGU_GROUPS = 8
SGU_CH = D_MODEL // SGU_GROUPS
SGU_W = SGU_GROUPS * SGU_CH
SGU_CHUNK = 128
PEER_HEADS = 8
PEER_NKEYS = 128
PEER_NEXP = PEER_NKEYS * PEER_NKEYS
PEER_DQ = 256
PEER_TOPK = 16
PEER_BLOCK = 128
EPS = 1e-6

IN_SIZES = (GLA_QK, GLA_QK, GLA_V, GLA_V, GLA_RANK, SGU_W, SGU_W, D_MODEL, D_MODEL)
IN_WIDTH = sum(IN_SIZES)
IN_SPLITS = [int(s) for s in np.cumsum(IN_SIZES)[:-1]]

kernel_name = 'hybrid_gla_gmlp_peer_adaln'


def rms_norm(x, w):
    xf = x.astype(jnp.float32)
    y = xf * lax.rsqrt(jnp.mean(xf * xf, axis=-1, keepdims=True) + EPS)
    return (y * w.astype(jnp.float32)).astype(x.dtype)


def layer_norm(x, w, b):
    xf = x.astype(jnp.float32)
    mu = jnp.mean(xf, axis=-1, keepdims=True)
    xc = xf - mu
    y = xc * lax.rsqrt(jnp.mean(xc * xc, axis=-1, keepdims=True) + EPS)
    return (y * w.astype(jnp.float32) + b.astype(jnp.float32)).astype(x.dtype)


def modulate(h, shift, scale):
    return h * (1 + scale[:, None, :]) + shift[:, None, :]


def gla_chunked(q, k, v, log_a):
    B, T, H, dk = q.shape
    dv = v.shape[-1]
    C = GLA_CHUNK
    N = T // C
    f32 = jnp.float32

    def to_chunks(t):
        return t.astype(f32).reshape(B, N, C, H, t.shape[-1]).transpose(1, 0, 3, 2, 4)

    qc, kc, vc, lac = to_chunks(q) * dk ** -0.5, to_chunks(k), to_chunks(v), to_chunks(log_a)
    G = jnp.cumsum(lac, axis=-2)
    G_last = G[..., -1:, :]
    q_dec = qc * jnp.exp(G)
    k_inv = kc * jnp.exp(-G)
    k_tail = kc * jnp.exp(G_last - G)
    mask = jnp.tril(jnp.ones((C, C), dtype=bool))
    A = jnp.where(mask, jnp.einsum('nbhik,nbhjk->nbhij', q_dec, k_inv), 0.0)
    o_intra = jnp.einsum('nbhij,nbhjv->nbhiv', A, vc)

    def step(S, inp):
        qd, kt, vv, gl = inp
        o = jnp.einsum('bhik,bhkv->bhiv', qd, S)
        S = S * jnp.exp(gl)[..., 0, :, None] + jnp.einsum('bhjk,bhjv->bhkv', kt, vv)
        return S, o

    S0 = jnp.zeros((B, H, dk, dv), f32)
    _, o_inter = lax.scan(step, S0, (q_dec, k_tail, vc, G_last))
    o = o_intra + o_inter
    return o.transpose(1, 0, 3, 2, 4).reshape(B, T, H, dv).astype(q.dtype)


def spatial_gating(u, v, w_s, b_s, ln_w, ln_b):
    B, T, _ = v.shape
    N = T // SGU_CHUNK
    v = layer_norm(v, ln_w, ln_b)
    vg = v.reshape(B, N, SGU_CHUNK, SGU_GROUPS, SGU_CH)
    mask = jnp.tril(jnp.ones((SGU_CHUNK, SGU_CHUNK), dtype=bool))
    w = jnp.where(mask[None], w_s, 0)
    s = jnp.einsum('gij,bnjgc->bnigc', w, vg) + b_s.T[None, None, :, :, None]
    return u * s.reshape(B, T, SGU_W)


def peer(h, w_q, keys1, keys2, expert_down, expert_up):
    B, T, D = h.shape
    H, K = PEER_HEADS, PEER_TOPK
    q = jnp.einsum('btd,dq->btq', h, w_q).reshape(B, T, H, 2, PEER_DQ // 2)
    s1 = jnp.einsum('bthc,kc->bthk', q[..., 0, :], keys1).astype(jnp.float32)
    s2 = jnp.einsum('bthc,kc->bthk', q[..., 1, :], keys2).astype(jnp.float32)
    v1, i1 = lax.top_k(s1, K)
    v2, i2 = lax.top_k(s2, K)
    cand = (v1[..., :, None] + v2[..., None, :]).reshape(B, T, H, K * K)
    cidx = (i1[..., :, None] * PEER_NKEYS + i2[..., None, :]).reshape(B, T, H, K * K)
    top_s, pos = lax.top_k(cand, K)
    idx = jnp.take_along_axis(cidx, pos, axis=-1)
    g = jax.nn.softmax(top_s, axis=-1).astype(h.dtype)
    nb = (B * T) // PEER_BLOCK
    xb = h.reshape(nb, PEER_BLOCK, D)
    ib = idx.reshape(nb, PEER_BLOCK, H * K)
    gb = g.reshape(nb, PEER_BLOCK, H * K)

    def block(args):
        xx, ii, gg = args
        u = expert_down[ii]
        a = jax.nn.gelu(jnp.einsum('pd,ped->pe', xx, u), approximate=False)
        vv = expert_up[ii]
        return jnp.einsum('pe,ped->pd', gg * a, vv)

    return lax.map(block, (xb, ib, gb)).reshape(B, T, D)


def setup_inputs(seed: int = 0) -> dict:
    key = jax.random.key(seed)
    ks = jax.random.split(key, 24)
    f32 = jnp.float32
    L, D = DEPTH, D_MODEL

    def nrm(k, shape, scale):
        return jax.random.normal(k, shape, f32) * scale

    return {
        'x': nrm(ks[0], (BATCH, SEQ, D), 1.0),
        'c': nrm(ks[1], (BATCH, D), 1.0),
        'w_ada': nrm(ks[2], (L, D, 6 * D), 0.5 * D ** -0.5),
        'b_ada': nrm(ks[3], (L, 6 * D), 0.02),
        'norm1_w': 1.0 + nrm(ks[4], (L, D), 0.02),
        'w_in': nrm(ks[5], (L, D, IN_WIDTH), D ** -0.5),
        'w_alpha_up': nrm(ks[6], (L, GLA_RANK, GLA_QK), GLA_RANK ** -0.5),
        'b_alpha': nrm(ks[7], (L, GLA_QK), 0.1),
        'gla_norm_w': 1.0 + nrm(ks[8], (L, GLA_V), 0.02),
        'sgu_ln_w': 1.0 + nrm(ks[9], (L, SGU_W), 0.02),
        'sgu_ln_b': nrm(ks[10], (L, SGU_W), 0.02),
        'sgu_w': nrm(ks[11], (L, SGU_GROUPS, SGU_CHUNK, SGU_CHUNK), 0.5 * SGU_CHUNK ** -0.5),
        'sgu_b': 1.0 + nrm(ks[12], (L, SGU_GROUPS, SGU_CHUNK), 0.02),
        'w_out': nrm(ks[13], (L, D, D), D ** -0.5),
        'norm2_w': 1.0 + nrm(ks[14], (L, D), 0.02),
        'peer_w_q': nrm(ks[15], (L, D, PEER_HEADS * PEER_DQ), D ** -0.5),
        'peer_keys1': nrm(ks[16], (L, PEER_NKEYS, PEER_DQ // 2), (PEER_DQ // 2) ** -0.5),
        'peer_keys2': nrm(ks[17], (L, PEER_NKEYS, PEER_DQ // 2), (PEER_DQ // 2) ** -0.5),
        'peer_down': nrm(ks[18], (L, PEER_NEXP, D), D ** -0.5),
        'peer_up': nrm(ks[19], (L, PEER_NEXP, D), D ** -0.5),
        'final_norm_w': 1.0 + nrm(ks[20], (D,), 0.02),
    }


def reference(x, c, w_ada, b_ada, norm1_w, w_in, w_alpha_up, b_alpha, gla_norm_w,
              sgu_ln_w, sgu_ln_b, sgu_w, sgu_b, w_out, norm2_w, peer_w_q, peer_keys1,
              peer_keys2, peer_down, peer_up, final_norm_w):
    B, T, D = x.shape
    silu_c = jax.nn.silu(c)
    for l in range(DEPTH):
        mod = jnp.einsum('bd,de->be', silu_c, w_ada[l]) + b_ada[l]
        shift1, scale1, gate1, shift2, scale2, gate2 = jnp.split(mod, 6, axis=-1)

        h = modulate(rms_norm(x, norm1_w[l]), shift1, scale1)
        proj = jnp.einsum('btd,de->bte', h, w_in[l])
        q, k, v, r, a_lr, su, sv, g_a, g_b = jnp.split(proj, IN_SPLITS, axis=-1)

        z = jnp.einsum('btr,rk->btk', a_lr, w_alpha_up[l]) + b_alpha[l]
        log_a = jax.nn.log_sigmoid(z.astype(jnp.float32)) / GLA_TAU
        o = gla_chunked(q.reshape(B, T, GLA_HEADS, GLA_DK), k.reshape(B, T, GLA_HEADS, GLA_DK),
                        v.reshape(B, T, GLA_HEADS, GLA_DV), log_a.reshape(B, T, GLA_HEADS, GLA_DK))
        o = rms_norm(o, gla_norm_w[l].reshape(GLA_HEADS, GLA_DV)).reshape(B, T, GLA_V)
        o_gla = o * jax.nn.silu(r)

        o_sgu = spatial_gating(jax.nn.gelu(su, approximate=False), jax.nn.gelu(sv, approximate=False),
                               sgu_w[l], sgu_b[l], sgu_ln_w[l], sgu_ln_b[l])

        merged = jax.nn.sigmoid(g_a) * o_gla + jax.nn.sigmoid(g_b) * o_sgu
        y = jnp.einsum('bte,ed->btd', merged, w_out[l])
        x = x + gate1[:, None, :] * y

        h2 = modulate(rms_norm(x, norm2_w[l]), shift2, scale2)
        y2 = peer(h2, peer_w_q[l], peer_keys1[l], peer_keys2[l], peer_down[l], peer_up[l])
        x = x + gate2[:, None, :] * y2
    return rms_norm(x, final_norm_w)
```

```cpp
#include <hip/hip_runtime.h>
#include <hip/hip_cooperative_groups.h>
#include <cstdio>
namespace cg = cooperative_groups;

#define LAS __attribute__((address_space(3)))
typedef unsigned short bf16_t;
typedef short bf16x8 __attribute__((ext_vector_type(8)));
typedef float f32x2 __attribute__((ext_vector_type(2)));
typedef float f32x4 __attribute__((ext_vector_type(4)));
typedef float f32x16 __attribute__((ext_vector_type(16)));
typedef unsigned u32x2 __attribute__((ext_vector_type(2)));
typedef unsigned u32x4 __attribute__((ext_vector_type(4)));
typedef __bf16 bf16x2_t __attribute__((ext_vector_type(2)));

constexpr int NTOK = 16384, DM = 1024, SEQ = 8192, INW = 7184, PW = 5120;
constexpr float EPS = 1e-6f;
constexpr size_t MiB = 1024 * 1024;
constexpr size_t OFF_PROJ = 0;
constexpr size_t OFF_DOWN = 0;
constexpr size_t OFF_UP = 32 * MiB;
constexpr size_t OFF_H2 = 64 * MiB;
constexpr size_t OFF_QP = 96 * MiB;
constexpr size_t OFF_HB = 160 * MiB;
constexpr size_t OFF_WINT = 192 * MiB;
constexpr size_t OFF_WOUTT = 206 * MiB;
constexpr size_t OFF_WQT = 208 * MiB;
constexpr size_t OFF_KEYS = 212 * MiB;
constexpr size_t OFF_MOD = OFF_KEYS + 65536;
constexpr size_t OFF_ALR = OFF_MOD + 65536;
constexpr size_t OFF_STATS = OFF_ALR + MiB;
constexpr size_t OFF_DECAY = OFF_STATS + 131072;
constexpr size_t OFF_IDX = 214 * MiB;
constexpr size_t OFF_G = 222 * MiB;
constexpr size_t WS_END = 230 * MiB;
constexpr int LDS_BYTES = 135168;

struct Params {
    const float *x, *c, *w_ada, *b_ada, *norm1_w, *w_in, *w_alpha_up, *b_alpha, *gla_norm_w, *sgu_ln_w, *sgu_ln_b, *sgu_w, *sgu_b, *w_out, *norm2_w, *w_q, *keys1, *keys2, *down, *up, *final_w;
    float* out; unsigned char* ws;
};

__device__ __forceinline__ unsigned cvt_pk_bf16_asm(float lo, float hi) { unsigned r; asm volatile("v_cvt_pk_bf16_f32 %0, %1, %2" : "=v"(r) : "v"(lo), "v"(hi)); return r; }
__device__ __forceinline__ unsigned cvt_pk_bf16(float lo, float hi) { f32x2 v = {lo, hi}; bf16x2_t b = __builtin_convertvector(v, bf16x2_t); return __builtin_bit_cast(unsigned, b); }
__device__ __forceinline__ float bflo(unsigned w) { return __uint_as_float(w << 16); }
__device__ __forceinline__ float bfhi(unsigned w) { return __uint_as_float(w & 0xffff0000u); }
__device__ __forceinline__ float wave_sum(float v) {
#pragma unroll
    for (int o = 32; o; o >>= 1) v += __shfl_xor(v, o);
    return v;
}
__device__ __forceinline__ float sigmoidf_(float x) { return __builtin_amdgcn_rcpf(1.0f + __expf(-x)); }
__device__ __forceinline__ f32x2 gelu_pk(f32x2 v) {
    const f32x2 av = __builtin_elementwise_abs(v), d = av * 0.2316418882f + 1.0f;
    f32x2 t; t.x = __builtin_amdgcn_rcpf(d.x); t.y = __builtin_amdgcn_rcpf(d.y);
    f32x2 q = t * 0.5307027145f + (-0.7265760135f); q = q * t + 0.7107068705f; q = q * t + (-0.142248368f); q = q * t + 0.127414796f; q = q * t;
    const f32x2 s = (v * v) * (-0.72134752044f);
    f32x2 e; e.x = __builtin_amdgcn_exp2f(s.x); e.y = __builtin_amdgcn_exp2f(s.y);
    const f32x2 m = v * (q * e), r = v - m;
    f32x2 o; o.x = v.x < 0.f ? m.x : r.x; o.y = v.y < 0.f ? m.y : r.y; return o;
}
__device__ __forceinline__ float gelu1(float v) { f32x2 r = gelu_pk((f32x2){v, v}); return r.x; }
__device__ __forceinline__ f32x16 zero16() { f32x16 z;
#pragma unroll
    for (int i = 0; i < 16; ++i) z[i] = 0.f;
    return z; }
__device__ __forceinline__ float dot2bf(unsigned a, unsigned b, float c) { return __builtin_amdgcn_fdot2_f32_bf16(__builtin_bit_cast(bf16x2_t, a), __builtin_bit_cast(bf16x2_t, b), c, false); }
#define MFMA32(a, b, c) __builtin_amdgcn_mfma_f32_32x32x16_bf16((a), (b), (c), 0, 0, 0)

namespace pg8 {
constexpr int BM = 256, BK = 64, HALF = 128, HTB = HALF * BK * 2, STAGE_BYTES = 8 * HTB, NXCD = 8, WGM = 8;
__host__ __device__ __forceinline__ int lds_byte(int r, int c) { const int st = (r >> 4) * 2 + (c >> 5), rr = r & 15, cc = c & 31, ob = rr * 64 + cc * 2; return st * 1024 + (ob ^ (((ob >> 9) & 1) << 5)); }
__host__ __device__ __forceinline__ void stage_rc(int b, int& R, int& C) { const int st = b / 1024, sb = b % 1024, swz = sb ^ (((sb >> 9) & 1) << 5); R = (st >> 1) * 16 + swz / 64; C = (st & 1) * 32 + (swz % 64) / 2; }
__host__ __device__ __forceinline__ int perm32(int rho) { const int n = rho >> 4, i = rho & 15; return 8 * (i >> 2) + 4 * n + (i & 3); }
struct Unit { int pm, pn; };
struct Gemm { const bf16_t* A; const bf16_t* Bt; int M, N, K; };
struct StaticOrder {
    int nM, nN, nwg, G, c;
    __device__ void init(int M, int N, int G_, int c_) { nM = M / BM; nN = N / BM; nwg = nM * nN; G = G_; c = c_; }
    __device__ bool next(int i, Unit& u) const {
        const long L = (long)i * G + c; if (L >= nwg) return false;
        int wgid = (int)L; { const int q = nwg / NXCD, r = nwg % NXCD, xcd = wgid % NXCD, off = wgid / NXCD; wgid = (xcd < r ? xcd * (q + 1) : r * (q + 1) + (xcd - r) * q) + off; }
        const int nig = WGM * nN, gid = wgid / nig, fm = gid * WGM, gsz = (nM - fm) < WGM ? (nM - fm) : WGM;
        u.pm = fm + ((wgid % nig) % gsz); u.pn = (wgid % nig) / gsz; return true;
    }
    __device__ __forceinline__ void a_ready(const Unit&) const {}
    __device__ __forceinline__ void done(const Unit&) const {}
};

template <class Epi, class Sched>
__device__ __forceinline__ void gemm_phase(LAS unsigned char* lds, const Gemm g, const Sched& S, const Epi& E) {
    const int tid = threadIdx.x, wid = __builtin_amdgcn_readfirstlane(tid >> 6), lane = tid & 63, wr = wid >> 2, wc = wid & 3, fr = lane & 15, fq = lane >> 4;
    const int K = g.K, nt = K / BK;
    unsigned voffA[2], voffB[2];
#pragma unroll
    for (int i = 0; i < 2; ++i) { int R, C; stage_rc(tid * 16 + i * 8192, R, C); const int Rb = Epi::PERM ? ((R & ~31) + perm32(R & 31)) : R;
        voffA[i] = (unsigned)(R * K + C) * 2u; voffB[i] = (unsigned)(Rb * K + C) * 2u; }
    const size_t kstep = (size_t)(BK * 2);
    const size_t hstep = (size_t)HALF * K * 2;
    const size_t tstep = 2 * hstep;
    const unsigned ldsw = (unsigned)wid * 1024u;
    const int aoff = lds_byte(wr * 64 + fr, fq * 8), boff = lds_byte(wc * 32 + fr, fq * 8);
#define PG8_SA(b, h) (((b) * 2 + (h)) * HTB)
#define PG8_SB(b, h) ((4 + (b) * 2 + (h)) * HTB)
#define PG8_STAGE(bufoff, gbase, voff) do { _Pragma("unroll") for (int _i = 0; _i < 2; ++_i) \
        __builtin_amdgcn_global_load_lds((const unsigned*)((const char*)(gbase) + (voff)[_i]), (LAS unsigned*)(lds + (bufoff) + ldsw + _i * 8192), 16, 0, 0); } while (0)
#define PG8_LDA(dst, b, h) do { _Pragma("unroll") for (int m = 0; m < 4; ++m) _Pragma("unroll") for (int k = 0; k < 2; ++k) dst[m][k] = *(const LAS bf16x8*)(lds + PG8_SA(b, h) + aoff + m * 2048 + k * 1024); } while (0)
#define PG8_LDB(dst, b, h) do { _Pragma("unroll") for (int n = 0; n < 2; ++n) _Pragma("unroll") for (int k = 0; k < 2; ++k) dst[n][k] = *(const LAS bf16x8*)(lds + PG8_SB(b, h) + boff + n * 2048 + k * 1024); } while (0)
#define PG8_MMA(ai, bj, At, Bt) do { __builtin_amdgcn_s_setprio(1); _Pragma("unroll") for (int m = 0; m < 4; ++m) _Pragma("unroll") for (int n = 0; n < 2; ++n) _Pragma("unroll") for (int k = 0; k < 2; ++k) \
        acc[ai][bj][m][n] = __builtin_amdgcn_mfma_f32_16x16x32_bf16(Bt[n][k], At[m][k], acc[ai][bj][m][n], 0, 0, 0); __builtin_amdgcn_s_setprio(0); } while (0)
#define PG8_WAIT_V(n) asm volatile("s_waitcnt vmcnt(" #n ")" ::: "memory")
#define PG8_WAIT_L(n) asm volatile("s_waitcnt lgkmcnt(" #n ")" ::: "memory")
#define PG8_BAR __builtin_amdgcn_s_barrier()
#define PG8_SCHED __builtin_amdgcn_sched_barrier(0)
    Unit cur, nxt; int ui = 0;
    if (!S.next(0, cur)) return;
    f32x4 acc[2][2][4][2];
#pragma unroll
    for (int a = 0; a < 2; ++a)
#pragma unroll
        for (int b = 0; b < 2; ++b)
#pragma unroll
            for (int m = 0; m < 4; ++m)
#pragma unroll
                for (int n = 0; n < 2; ++n) acc[a][b][m][n] = (f32x4){0.f, 0.f, 0.f, 0.f};
    bf16x8 At[4][2], B0[2][2], B1[2][2];
    const char* cA = (const char*)g.A + (size_t)cur.pm * tstep; const char* cB = (const char*)g.Bt + (size_t)cur.pn * tstep;
    S.a_ready(cur);
    PG8_STAGE(PG8_SB(0, 0), cB, voffB); PG8_STAGE(PG8_SA(0, 0), cA, voffA); PG8_STAGE(PG8_SB(0, 1), cB + hstep, voffB); PG8_STAGE(PG8_SA(0, 1), cA + hstep, voffA);
    if (wr == 1) PG8_BAR;
    PG8_WAIT_V(4); PG8_BAR;
    PG8_STAGE(PG8_SB(1, 0), cB + kstep, voffB); PG8_STAGE(PG8_SA(1, 0), cA + kstep, voffA); PG8_STAGE(PG8_SB(1, 1), cB + hstep + kstep, voffB);
    PG8_WAIT_V(6); PG8_BAR;
    for (;;) {
        const bool has_next = S.next(ui + 1, nxt);
        const char* nA = has_next ? (const char*)g.A + (size_t)nxt.pm * tstep : cA; const char* nB = has_next ? (const char*)g.Bt + (size_t)nxt.pn * tstep : cB;
        for (int t = 0; t < nt; t += 2) {
            const bool last = (t == nt - 2);
            const char* a1 = cA + (size_t)(t + 1) * kstep;
            const char* a2 = last ? nA : cA + (size_t)(t + 2) * kstep; const char* b2 = last ? nB : cB + (size_t)(t + 2) * kstep;
            const char* a3 = a2 + kstep; const char* b3 = b2 + kstep;
            if (last && has_next) S.a_ready(nxt);
            PG8_LDB(B0, 0, 0); PG8_SCHED; PG8_LDA(At, 0, 0); PG8_STAGE(PG8_SA(1, 1), a1 + hstep, voffA);
            PG8_WAIT_L(8); PG8_BAR; PG8_WAIT_L(0); PG8_MMA(0, 0, At, B0); PG8_BAR; PG8_SCHED;
            PG8_LDB(B1, 0, 1); PG8_STAGE(PG8_SB(0, 0), b2, voffB);
            PG8_BAR; PG8_WAIT_L(0); PG8_MMA(0, 1, At, B1); PG8_BAR;
            PG8_LDA(At, 0, 1); PG8_STAGE(PG8_SA(0, 0), a2, voffA);
            PG8_BAR; PG8_WAIT_L(0); PG8_MMA(1, 0, At, B0); PG8_BAR; PG8_SCHED;
            PG8_STAGE(PG8_SB(0, 1), b2 + hstep, voffB);
            PG8_WAIT_V(6); PG8_BAR; PG8_MMA(1, 1, At, B1); PG8_BAR;
            PG8_LDB(B0, 1, 0); PG8_SCHED; PG8_LDA(At, 1, 0); PG8_STAGE(PG8_SA(0, 1), a2 + hstep, voffA);
            PG8_WAIT_L(8); PG8_BAR; PG8_WAIT_L(0); PG8_MMA(0, 0, At, B0); PG8_BAR; PG8_SCHED;
            PG8_LDB(B1, 1, 1); PG8_STAGE(PG8_SB(1, 0), b3, voffB);
            PG8_BAR; PG8_WAIT_L(0); PG8_MMA(0, 1, At, B1); PG8_BAR;
            PG8_LDA(At, 1, 1); PG8_STAGE(PG8_SA(1, 0), a3, voffA);
            PG8_BAR; PG8_WAIT_L(0); PG8_MMA(1, 0, At, B0); PG8_BAR; PG8_SCHED;
            PG8_STAGE(PG8_SB(1, 1), b3 + hstep, voffB);
            PG8_WAIT_V(6); PG8_BAR; PG8_MMA(1, 1, At, B1); PG8_BAR;
        }
        E(acc, cur, wr, wc, fr, fq); S.done(cur);
        if (!has_next) break;
#pragma unroll
        for (int a = 0; a < 2; ++a)
#pragma unroll
            for (int b = 0; b < 2; ++b)
#pragma unroll
                for (int m = 0; m < 4; ++m)
#pragma unroll
                    for (int n = 0; n < 2; ++n) acc[a][b][m][n] = (f32x4){0.f, 0.f, 0.f, 0.f};
        cur = nxt; cA = nA; cB = nB; ++ui;
    }
    PG8_WAIT_V(0);
    if (wr == 0) PG8_BAR;
    PG8_BAR;
#undef PG8_SA
#undef PG8_SB
#undef PG8_STAGE
#undef PG8_LDA
#undef PG8_LDB
#undef PG8_MMA
#undef PG8_WAIT_V
#undef PG8_WAIT_L
#undef PG8_BAR
#undef PG8_SCHED
}
}
using pg8::Unit;

struct EpiProj {
    static constexpr bool PERM = true;
    bf16_t* P;
    __device__ __forceinline__ void operator()(const f32x4 (&acc)[2][2][4][2], const Unit& u, int wr, int wc, int fr, int fq) const {
        const int row0 = u.pm * 256 + wr * 64 + fr; const int pn = u.pn;
        if (pn < 8 || pn >= 24) {
            const bool act = pn >= 24;
            const int col0 = (act ? 4096 + (pn - 24) * 256 : pn * 256) + wc * 32 + 8 * fq;
#pragma unroll
            for (int ai = 0; ai < 2; ++ai)
#pragma unroll
                for (int m = 0; m < 4; ++m) { bf16_t* rowp = P + (size_t)(row0 + ai * 128 + m * 16) * PW + col0;
#pragma unroll
                    for (int bj = 0; bj < 2; ++bj) { f32x4 v0 = acc[ai][bj][m][0], v1 = acc[ai][bj][m][1];
                        if (act) { f32x2 a = gelu_pk((f32x2){v0[0], v0[1]}), b = gelu_pk((f32x2){v0[2], v0[3]}), c = gelu_pk((f32x2){v1[0], v1[1]}), d = gelu_pk((f32x2){v1[2], v1[3]});
                            v0 = (f32x4){a.x, a.y, b.x, b.y}; v1 = (f32x4){c.x, c.y, d.x, d.y}; }
                        u32x4 w; w.x = cvt_pk_bf16_asm(v0[0], v0[1]); w.y = cvt_pk_bf16_asm(v0[2], v0[3]); w.z = cvt_pk_bf16_asm(v1[0], v1[1]); w.w = cvt_pk_bf16_asm(v1[2], v1[3]);
                        *(u32x4*)(rowp + bj * 128) = w; } }
        } else {
            const bool isrg = pn < 16;
            const int col0 = (isrg ? 2048 + (pn - 8) * 128 : 3072 + (pn - 16) * 128) + wc * 32 + 8 * fq;
#pragma unroll
            for (int ai = 0; ai < 2; ++ai)
#pragma unroll
                for (int m = 0; m < 4; ++m) { bf16_t* rowp = P + (size_t)(row0 + ai * 128 + m * 16) * PW + col0;
                    float o[8];
#pragma unroll
                    for (int n = 0; n < 2; ++n) { const f32x4 a = acc[ai][0][m][n], g = acc[ai][1][m][n];
                        if (isrg) {
#pragma unroll
                            for (int j = 0; j < 4; ++j) o[n * 4 + j] = a[j] * sigmoidf_(a[j]) * sigmoidf_(g[j]);
                        } else { f32x2 x = gelu_pk((f32x2){a[0], a[1]}), y = gelu_pk((f32x2){a[2], a[3]});
                            o[n * 4 + 0] = x.x * sigmoidf_(g[0]); o[n * 4 + 1] = x.y * sigmoidf_(g[1]); o[n * 4 + 2] = y.x * sigmoidf_(g[2]); o[n * 4 + 3] = y.y * sigmoidf_(g[3]); } }
                    u32x4 w; w.x = cvt_pk_bf16_asm(o[0], o[1]); w.y = cvt_pk_bf16_asm(o[2], o[3]); w.z = cvt_pk_bf16_asm(o[4], o[5]); w.w = cvt_pk_bf16_asm(o[6], o[7]);
                    *(u32x4*)rowp = w; }
        }
    }
};
struct EpiX1 {
    static constexpr bool PERM = false;
    const float* x; float* x1; const float* mod; const float* b_ada;
    __device__ __forceinline__ void operator()(const f32x4 (&acc)[2][2][4][2], const Unit& u, int wr, int wc, int fr, int fq) const {
        const int row0 = u.pm * 256 + wr * 64 + fr, col0 = u.pn * 256 + wc * 32 + 4 * fq; const int b = u.pm >> 5;
        f32x4 gv[2][2];
#pragma unroll
        for (int bj = 0; bj < 2; ++bj)
#pragma unroll
            for (int n = 0; n < 2; ++n) gv[bj][n] = *(const f32x4*)(mod + b * 6144 + 2048 + col0 + bj * 128 + n * 16) + *(const f32x4*)(b_ada + 2048 + col0 + bj * 128 + n * 16);
#pragma unroll
        for (int ai = 0; ai < 2; ++ai)
#pragma unroll
            for (int m = 0; m < 4; ++m) { const size_t off = (size_t)(row0 + ai * 128 + m * 16) * DM + col0;
#pragma unroll
                for (int bj = 0; bj < 2; ++bj)
#pragma unroll
                    for (int n = 0; n < 2; ++n) { const f32x4 xv = *(const f32x4*)(x + off + bj * 128 + n * 16); *(f32x4*)(x1 + off + bj * 128 + n * 16) = xv + gv[bj][n] * acc[ai][bj][m][n]; } }
    }
};
struct EpiQ {
    static constexpr bool PERM = true;
    bf16_t* O;
    __device__ __forceinline__ void operator()(const f32x4 (&acc)[2][2][4][2], const Unit& u, int wr, int wc, int fr, int fq) const {
        const int row0 = u.pm * 256 + wr * 64 + fr, col0 = u.pn * 256 + wc * 32 + 8 * fq;
#pragma unroll
        for (int ai = 0; ai < 2; ++ai)
#pragma unroll
            for (int m = 0; m < 4; ++m) { bf16_t* rowp = O + (size_t)(row0 + ai * 128 + m * 16) * 2048 + col0;
#pragma unroll
                for (int bj = 0; bj < 2; ++bj) { const f32x4 v0 = acc[ai][bj][m][0], v1 = acc[ai][bj][m][1];
                    u32x4 w; w.x = cvt_pk_bf16_asm(v0[0], v0[1]); w.y = cvt_pk_bf16_asm(v0[2], v0[3]); w.z = cvt_pk_bf16_asm(v1[0], v1[1]); w.w = cvt_pk_bf16_asm(v1[2], v1[3]);
                    *(u32x4*)(rowp + bj * 128) = w; } }
    }
};

__device__ __forceinline__ int win_src_col(int n) {
    if (n < 2048) return n;
    if (n < 4096) { const int u = (n - 2048) >> 8, r = (n - 2048) & 255; return r < 128 ? 2048 + 128 * u + r : 5136 + 128 * u + (r - 128); }
    if (n < 6144) { const int u = (n - 4096) >> 8, r = (n - 4096) & 255; return r < 128 ? 3088 + 128 * u + r : 6160 + 128 * u + (r - 128); }
    return 4112 + (n - 6144);
}
__device__ void phase0(const Params& p, unsigned char* lds) {
    const int tid = threadIdx.x;
    float* mod = (float*)(p.ws + OFF_MOD);
    {
        float* ssc = (float*)lds;
        float* red = (float*)lds + 2048;
        for (int e = tid; e < 2048; e += 512) { const float cv = p.c[e]; ssc[e] = cv * sigmoidf_(cv); }
        __syncthreads();
        for (int cbk = blockIdx.x; cbk < 256; cbk += gridDim.x) {
            const int cc = tid % 24, rg = tid / 24;
            if (tid < 504) { float a0 = 0.f, a1 = 0.f;
                for (int k = rg; k < 1024; k += 21) { const float w = p.w_ada[(size_t)k * 6144 + cbk * 24 + cc]; a0 += ssc[k] * w; a1 += ssc[1024 + k] * w; }
                red[(rg * 24 + cc) * 2] = a0; red[(rg * 24 + cc) * 2 + 1] = a1; }
            __syncthreads();
            if (tid < 48) { const int c2 = tid % 24, bb = tid / 24; float s = 0.f;
                for (int g = 0; g < 21; ++g) s += red[(g * 24 + c2) * 2 + bb];
                mod[bb * 6144 + cbk * 24 + c2] = s; }
            __syncthreads();
        }
    }
    float* tile = (float*)lds;
    for (int tl = blockIdx.x; tl < 2560; tl += gridDim.x) {
        const float* W; bf16_t* Bt; int ldw, nt, kt, which;
        if (tl < 1792) { which = 0; W = p.w_in; ldw = INW; Bt = (bf16_t*)(p.ws + OFF_WINT); nt = tl >> 4; kt = tl & 15; }
        else if (tl < 2048) { which = 1; W = p.w_out; ldw = 1024; Bt = (bf16_t*)(p.ws + OFF_WOUTT); nt = (tl - 1792) >> 4; kt = tl & 15; }
        else { which = 2; W = p.w_q; ldw = 2048; Bt = (bf16_t*)(p.ws + OFF_WQT); nt = (tl - 2048) >> 4; kt = tl & 15; }
        { const int nn = tid & 63, kk0 = tid >> 6; const int n = nt * 64 + nn; const int sc = which == 0 ? win_src_col(n) : n;
#pragma unroll
            for (int i = 0; i < 8; ++i) { const int k = kk0 + 8 * i; tile[nn * 65 + k] = W[(size_t)(kt * 64 + k) * ldw + sc]; } }
        __syncthreads();
        { const int n = tid >> 3, kc = (tid & 7) * 8; const float* tp = tile + n * 65 + kc;
            u32x4 w; w.x = cvt_pk_bf16(tp[0], tp[1]); w.y = cvt_pk_bf16(tp[2], tp[3]); w.z = cvt_pk_bf16(tp[4], tp[5]); w.w = cvt_pk_bf16(tp[6], tp[7]);
            *(u32x4*)(Bt + (size_t)(nt * 64 + n) * 1024 + kt * 64 + kc) = w; }
        __syncthreads();
    }
    { bf16_t* kb = (bf16_t*)(p.ws + OFF_KEYS);
        for (int e = (blockIdx.x * 512 + tid) * 2; e < 32768; e += gridDim.x * 1024) {
            const float* src = e < 16384 ? p.keys1 + e : p.keys2 + (e - 16384);
            *(unsigned*)(kb + e) = cvt_pk_bf16(src[0], src[1]); } }
}

template <bool ALR>
__device__ void phase_norm(const Params& p, const float* xin, const float* nw, int shift_off, int scale_off, bf16_t* hout, unsigned char* lds) {
    const int tid = threadIdx.x, wid = tid >> 6, lane = tid & 63;
    const float* mod = (const float*)(p.ws + OFF_MOD);
    float* wat = (float*)lds;
    if (ALR) {
        for (int e = tid; e < 16384; e += 512) { const int d = e >> 4, r = e & 15; wat[r * 1024 + d] = p.w_in[(size_t)d * INW + 3072 + r]; }
        __syncthreads();
    }
    float* alr = (float*)(p.ws + OFF_ALR);
    for (int tg = blockIdx.x * 8 + wid; tg < 2048; tg += gridDim.x * 8) {
        const int b = tg >> 10;
        f32x4 w4[4], sc[4], sh[4];
#pragma unroll
        for (int i = 0; i < 4; ++i) { const int d = 256 * i + 4 * lane; w4[i] = *(const f32x4*)(nw + d);
            sc[i] = *(const f32x4*)(mod + b * 6144 + scale_off + d) + *(const f32x4*)(p.b_ada + scale_off + d) + 1.0f;
            sh[i] = *(const f32x4*)(mod + b * 6144 + shift_off + d) + *(const f32x4*)(p.b_ada + shift_off + d);
            w4[i] = w4[i] * sc[i]; }
        for (int tt = 0; tt < 8; ++tt) {
            const int t = tg * 8 + tt;
            f32x4 xv[4]; float ss = 0.f;
#pragma unroll
            for (int i = 0; i < 4; ++i) { xv[i] = *(const f32x4*)(xin + (size_t)t * DM + 256 * i + 4 * lane); ss += xv[i][0] * xv[i][0] + xv[i][1] * xv[i][1] + xv[i][2] * xv[i][2] + xv[i][3] * xv[i][3]; }
            ss = wave_sum(ss);
            const float rstd = rsqrtf(ss * (1.0f / 1024.0f) + EPS);
#pragma unroll
            for (int i = 0; i < 4; ++i) { xv[i] = xv[i] * rstd * w4[i] + sh[i];
                u32x2 w; w.x = cvt_pk_bf16(xv[i][0], xv[i][1]); w.y = cvt_pk_bf16(xv[i][2], xv[i][3]);
                *(u32x2*)(hout + (size_t)t * DM + 256 * i + 4 * lane) = w; }
            if (ALR) {
                float mine = 0.f;
#pragma unroll 2
                for (int r = 0; r < 16; ++r) { float s = 0.f;
#pragma unroll
                    for (int i = 0; i < 4; ++i) { const f32x4 wv = *(const f32x4*)(wat + r * 1024 + 256 * i + 4 * lane); s += xv[i][0] * wv[0] + xv[i][1] * wv[1] + xv[i][2] * wv[2] + xv[i][3] * wv[3]; }
                    s = wave_sum(s); mine = lane == r ? s : mine; }
                if (lane < 16) alr[(size_t)t * 16 + lane] = mine;
            }
        }
    }
}

__device__ __forceinline__ void gla_G(const Params& p, int t0, int h, float* sALR, float* sG) {
    const int tid = threadIdx.x;
    const float* alr = (const float*)(p.ws + OFF_ALR);
    if (tid < 256) *(f32x4*)(sALR + tid * 4) = *(const f32x4*)(alr + (size_t)t0 * 16 + tid * 4);
    __syncthreads();
    if (tid < 128) {
        float wup[16];
#pragma unroll
        for (int r = 0; r < 16; ++r) wup[r] = p.w_alpha_up[r * 512 + h * 128 + tid];
        const float bias = p.b_alpha[h * 128 + tid];
        float cum = 0.f;
        for (int pos = 0; pos < 64; ++pos) {
            float z = bias;
#pragma unroll
            for (int r4 = 0; r4 < 4; ++r4) { const f32x4 a = *(const f32x4*)(sALR + pos * 16 + r4 * 4); z += a[0] * wup[r4 * 4] + a[1] * wup[r4 * 4 + 1] + a[2] * wup[r4 * 4 + 2] + a[3] * wup[r4 * 4 + 3]; }
            const float ls = fminf(z, 0.f) - log1pf(__expf(-fabsf(z)));
            cum += ls * (1.0f / 16.0f);
            sG[pos * 128 + tid] = cum;
        }
    }
    __syncthreads();
}
__device__ __forceinline__ void gla_VT(const bf16_t* P, int t0, int h, bf16_t* sVT) {
    const int tid = threadIdx.x;
#pragma unroll
    for (int i = 0; i < 4; ++i) { const int task = tid + 512 * i, pos = task & 63, dg = task >> 6;
        const u32x4 w = *(const u32x4*)(P + (size_t)(t0 + pos) * PW + 1024 + h * 256 + dg * 8);
        bf16_t* d = sVT + (dg * 8) * 72 + pos;
        d[0] = (bf16_t)w.x; d[72] = (bf16_t)(w.x >> 16); d[144] = (bf16_t)w.y; d[216] = (bf16_t)(w.y >> 16);
        d[288] = (bf16_t)w.z; d[360] = (bf16_t)(w.z >> 16); d[432] = (bf16_t)w.w; d[504] = (bf16_t)(w.w >> 16); }
}

__device__ void phase_glaA(const Params& p, unsigned char* lds) {
    const int tid = threadIdx.x, wid = tid >> 6, lane = tid & 63, r = lane & 31, hh = lane >> 5;
    const bf16_t* P = (const bf16_t*)(p.ws + OFF_PROJ);
    { float* stats = (float*)(p.ws + OFF_STATS);
        for (int t = blockIdx.x * 8 + wid; t < NTOK; t += gridDim.x * 8) {
            const u32x4 a = *(const u32x4*)(P + (size_t)t * PW + 4096 + lane * 16), b = *(const u32x4*)(P + (size_t)t * PW + 4096 + lane * 16 + 8);
            float v[16] = {bflo(a.x), bfhi(a.x), bflo(a.y), bfhi(a.y), bflo(a.z), bfhi(a.z), bflo(a.w), bfhi(a.w), bflo(b.x), bfhi(b.x), bflo(b.y), bfhi(b.y), bflo(b.z), bfhi(b.z), bflo(b.w), bfhi(b.w)};
            float s = 0.f;
#pragma unroll
            for (int i = 0; i < 16; ++i) s += v[i];
            const float mean = wave_sum(s) * (1.0f / 1024.0f);
            float q = 0.f;
#pragma unroll
            for (int i = 0; i < 16; ++i) { const float d = v[i] - mean; q += d * d; }
            q = wave_sum(q);
            if (lane == 0) *(f32x2*)(stats + (size_t)t * 2) = (f32x2){mean, rsqrtf(q * (1.0f / 1024.0f) + EPS)};
        } }
    float* sALR = (float*)lds; float* sG = (float*)(lds + 4096);
    bf16_t* sKT = (bf16_t*)(lds + 36864); bf16_t* sVT = (bf16_t*)(lds + 55296);
    bf16_t* KV = (bf16_t*)p.out; float* decay = (float*)(p.ws + OFF_DECAY);
    for (int item = blockIdx.x; item < 1024; item += gridDim.x) {
        const int h = item & 3, n = (item >> 2) & 127, b = item >> 9, t0 = b * SEQ + n * 64;
        gla_G(p, t0, h, sALR, sG);
#pragma unroll
        for (int i = 0; i < 2; ++i) { const int task = tid + 512 * i, pos = task & 63, kg = task >> 6;
            const u32x4 w = *(const u32x4*)(P + (size_t)(t0 + pos) * PW + 512 + h * 128 + kg * 8);
            const unsigned ww[4] = {w.x, w.y, w.z, w.w};
            bf16_t* d = sKT + (kg * 8) * 72 + pos;
#pragma unroll
            for (int e = 0; e < 4; ++e) { const int kd = kg * 8 + 2 * e;
                const float f0 = __expf(sG[63 * 128 + kd] - sG[pos * 128 + kd]), f1 = __expf(sG[63 * 128 + kd + 1] - sG[pos * 128 + kd + 1]);
                const unsigned pk = cvt_pk_bf16(bflo(ww[e]) * f0, bfhi(ww[e]) * f1);
                d[(2 * e) * 72] = (bf16_t)pk; d[(2 * e + 1) * 72] = (bf16_t)(pk >> 16); } }
        gla_VT(P, t0, h, sVT);
        if (tid < 128) decay[item * 128 + tid] = __expf(sG[63 * 128 + tid]);
        __syncthreads();
        f32x16 acc[4];
#pragma unroll
        for (int mi = 0; mi < 4; ++mi) acc[mi] = zero16();
#pragma unroll
        for (int ks = 0; ks < 4; ++ks) {
            const bf16x8 bfr = *(const bf16x8*)(sVT + (wid * 32 + r) * 72 + ks * 16 + hh * 8);
#pragma unroll
            for (int mi = 0; mi < 4; ++mi) { const bf16x8 afr = *(const bf16x8*)(sKT + (mi * 32 + r) * 72 + ks * 16 + hh * 8); acc[mi] = MFMA32(afr, bfr, acc[mi]); }
        }
        bf16_t* dst = KV + (size_t)item * 32768 + (size_t)(wid * 32 + r) * 128;
#pragma unroll
        for (int mi = 0; mi < 4; ++mi)
#pragma unroll
            for (int g = 0; g < 4; ++g) { u32x2 w; w.x = cvt_pk_bf16(acc[mi][g * 4], acc[mi][g * 4 + 1]); w.y = cvt_pk_bf16(acc[mi][g * 4 + 2], acc[mi][g * 4 + 3]);
                *(u32x2*)(dst + mi * 32 + g * 8 + hh * 4) = w; }
        __syncthreads();
    }
}

__device__ void phase_scan_sgu(const Params& p, unsigned char* lds) {
    const int tid = threadIdx.x, wid = tid >> 6, lane = tid & 63, r = lane & 31, hh = lane >> 5;
    { unsigned* KV = (unsigned*)p.out; const float* decay = (const float*)(p.ws + OFF_DECAY);
        for (int gt = blockIdx.x * 512 + tid; gt < 131072; gt += gridDim.x * 512) {
            const int bh = gt >> 14, e = gt & 16383, kd = (e * 2) & 127, b = bh >> 2, h = bh & 3;
            float s0 = 0.f, s1 = 0.f;
            for (int n0 = 0; n0 < 128; n0 += 8) {
                unsigned w[8]; f32x2 d[8];
#pragma unroll
                for (int j = 0; j < 8; ++j) { const int item = ((b * 128 + n0 + j) << 2) + h; w[j] = KV[(size_t)item * 16384 + e]; d[j] = *(const f32x2*)(decay + item * 128 + kd); }
#pragma unroll
                for (int j = 0; j < 8; ++j) { const int item = ((b * 128 + n0 + j) << 2) + h; KV[(size_t)item * 16384 + e] = cvt_pk_bf16(s0, s1);
                    s0 = s0 * d[j].x + bflo(w[j]); s1 = s1 * d[j].y + bfhi(w[j]); }
            }
        } }
    const bf16_t* P = (const bf16_t*)(p.ws + OFF_PROJ);
    const float* stats = (const float*)(p.ws + OFF_STATS);
    bf16_t* merged = (bf16_t*)(p.ws + OFF_HB);
    bf16_t* sVT = (bf16_t*)lds;
    for (int item = blockIdx.x; item < 1024; item += gridDim.x) {
        const int g = item & 7, n = (item >> 3) & 63, b = item >> 9, t0 = b * SEQ + n * 128;
#pragma unroll
        for (int i = 0; i < 4; ++i) { const int task = tid + 512 * i, j = task & 127, cg8 = task >> 7;
            const u32x4 w = *(const u32x4*)(P + (size_t)(t0 + j) * PW + 4096 + g * 128 + cg8 * 8);
            const f32x2 st = *(const f32x2*)(stats + (size_t)(t0 + j) * 2);
            const f32x4 lw0 = *(const f32x4*)(p.sgu_ln_w + g * 128 + cg8 * 8), lw1 = *(const f32x4*)(p.sgu_ln_w + g * 128 + cg8 * 8 + 4);
            const f32x4 lb0 = *(const f32x4*)(p.sgu_ln_b + g * 128 + cg8 * 8), lb1 = *(const f32x4*)(p.sgu_ln_b + g * 128 + cg8 * 8 + 4);
            const float v[8] = {bflo(w.x), bfhi(w.x), bflo(w.y), bfhi(w.y), bflo(w.z), bfhi(w.z), bflo(w.w), bfhi(w.w)};
            bf16_t* d = sVT + (cg8 * 8) * 136 + j;
#pragma unroll
            for (int e = 0; e < 8; e += 2) { const float lw_a = e < 4 ? lw0[e] : lw1[e - 4], lw_b = e < 4 ? lw0[e + 1] : lw1[e - 3], lb_a = e < 4 ? lb0[e] : lb1[e - 4], lb_b = e < 4 ? lb0[e + 1] : lb1[e - 3];
                const unsigned pk = cvt_pk_bf16((v[e] - st.x) * st.y * lw_a + lb_a, (v[e + 1] - st.x) * st.y * lw_b + lb_b);
                d[e * 136] = (bf16_t)pk; d[(e + 1) * 136] = (bf16_t)(pk >> 16); } }
        __syncthreads();
        const int ni = wid & 3, mb = (wid >> 2) * 2, irow = ni * 32 + r;
        f32x16 acc[2] = {zero16(), zero16()};
        const float* wrow = p.sgu_w + (size_t)g * 16384 + (size_t)irow * 128;
        for (int ks = 0; ks < 2 * ni + 2; ++ks) {
            const int j0 = ks * 16 + hh * 8;
            const f32x4 wa = *(const f32x4*)(wrow + j0), wb = *(const f32x4*)(wrow + j0 + 4);
            float wv[8] = {wa[0], wa[1], wa[2], wa[3], wb[0], wb[1], wb[2], wb[3]};
#pragma unroll
            for (int e = 0; e < 8; ++e) wv[e] = (j0 + e <= irow) ? wv[e] : 0.f;
            u32x4 bw; bw.x = cvt_pk_bf16(wv[0], wv[1]); bw.y = cvt_pk_bf16(wv[2], wv[3]); bw.z = cvt_pk_bf16(wv[4], wv[5]); bw.w = cvt_pk_bf16(wv[6], wv[7]);
            const bf16x8 bfr = __builtin_bit_cast(bf16x8, bw);
#pragma unroll
            for (int mi = 0; mi < 2; ++mi) { const bf16x8 afr = *(const bf16x8*)(sVT + ((mb + mi) * 32 + r) * 136 + j0); acc[mi] = MFMA32(afr, bfr, acc[mi]); }
        }
        const float bs = p.sgu_b[g * 128 + irow];
        const size_t tok = (size_t)(t0 + irow);
#pragma unroll
        for (int mi = 0; mi < 2; ++mi)
#pragma unroll
            for (int g4 = 0; g4 < 4; ++g4) { const int c = (mb + mi) * 32 + g4 * 8 + hh * 4;
                const u32x2 ug = *(const u32x2*)(P + tok * PW + 3072 + g * 128 + c);
                u32x2 o; o.x = cvt_pk_bf16(bflo(ug.x) * (acc[mi][g4 * 4] + bs), bfhi(ug.x) * (acc[mi][g4 * 4 + 1] + bs));
                o.y = cvt_pk_bf16(bflo(ug.y) * (acc[mi][g4 * 4 + 2] + bs), bfhi(ug.y) * (acc[mi][g4 * 4 + 3] + bs));
                *(u32x2*)(merged + tok * DM + g * 128 + c) = o; }
        __syncthreads();
    }
}

__device__ void phase_glaC(const Params& p, unsigned char* lds) {
    const int tid = threadIdx.x, wid = tid >> 6, lane = tid & 63, r = lane & 31, hh = lane >> 5;
    const bf16_t* P = (const bf16_t*)(p.ws + OFF_PROJ);
    float* sALR = (float*)lds; float* sG = (float*)(lds + 4096);
    bf16_t* sQD = (bf16_t*)(lds + 36864); bf16_t* sKI = (bf16_t*)(lds + 54272); bf16_t* sVT = (bf16_t*)(lds + 71680); bf16_t* sAM = (bf16_t*)(lds + 108544); float* sSS = (float*)(lds + 117760);
    const bf16_t* ST = (const bf16_t*)p.out; bf16_t* merged = (bf16_t*)(p.ws + OFF_HB);
    for (int item = blockIdx.x; item < 1024; item += gridDim.x) {
        const int h = item & 3, n = (item >> 2) & 127, b = item >> 9, t0 = b * SEQ + n * 64;
        gla_G(p, t0, h, sALR, sG);
#pragma unroll
        for (int i = 0; i < 2; ++i) { const int task = tid + 512 * i, kg = task & 15, pos = task >> 4;
            const u32x4 qw = *(const u32x4*)(P + (size_t)(t0 + pos) * PW + h * 128 + kg * 8), kw = *(const u32x4*)(P + (size_t)(t0 + pos) * PW + 512 + h * 128 + kg * 8);
            const f32x4 g0 = *(const f32x4*)(sG + pos * 128 + kg * 8), g1 = *(const f32x4*)(sG + pos * 128 + kg * 8 + 4);
            const float gv[8] = {g0[0], g0[1], g0[2], g0[3], g1[0], g1[1], g1[2], g1[3]};
            const unsigned qq[4] = {qw.x, qw.y, qw.z, qw.w}, kk[4] = {kw.x, kw.y, kw.z, kw.w};
            unsigned qo[4], ko[4];
#pragma unroll
            for (int e = 0; e < 4; ++e) { const float e0 = __expf(gv[2 * e]), e1 = __expf(gv[2 * e + 1]);
                qo[e] = cvt_pk_bf16(bflo(qq[e]) * 0.08838834764831845f * e0, bfhi(qq[e]) * 0.08838834764831845f * e1);
                ko[e] = cvt_pk_bf16(bflo(kk[e]) * __builtin_amdgcn_rcpf(e0), bfhi(kk[e]) * __builtin_amdgcn_rcpf(e1)); }
            *(u32x4*)(sQD + pos * 136 + kg * 8) = (u32x4){qo[0], qo[1], qo[2], qo[3]};
            *(u32x4*)(sKI + pos * 136 + kg * 8) = (u32x4){ko[0], ko[1], ko[2], ko[3]}; }
        gla_VT(P, t0, h, sVT);
        __syncthreads();
        if (wid < 4) { const int mj = wid >> 1, nI = wid & 1;
            f32x16 a = zero16();
            if (mj <= nI) {
#pragma unroll
                for (int ks = 0; ks < 8; ++ks) { const bf16x8 afr = *(const bf16x8*)(sKI + (mj * 32 + r) * 136 + ks * 16 + hh * 8), bfr = *(const bf16x8*)(sQD + (nI * 32 + r) * 136 + ks * 16 + hh * 8); a = MFMA32(afr, bfr, a); } }
            const int i = nI * 32 + r;
#pragma unroll
            for (int g = 0; g < 4; ++g) { const int j = mj * 32 + g * 8 + hh * 4;
                u32x2 w; w.x = cvt_pk_bf16(j <= i ? a[g * 4] : 0.f, j + 1 <= i ? a[g * 4 + 1] : 0.f); w.y = cvt_pk_bf16(j + 2 <= i ? a[g * 4 + 2] : 0.f, j + 3 <= i ? a[g * 4 + 3] : 0.f);
                *(u32x2*)(sAM + i * 72 + j) = w; } }
        __syncthreads();
        const int nI = wid & 1, mb = (wid >> 1) * 2, i = nI * 32 + r;
        f32x16 acc[2] = {zero16(), zero16()};
        const bf16_t* Sg = ST + (size_t)item * 32768;
#pragma unroll
        for (int ks = 0; ks < 8; ++ks) { const bf16x8 bfr = *(const bf16x8*)(sQD + i * 136 + ks * 16 + hh * 8);
#pragma unroll
            for (int mi = 0; mi < 2; ++mi) { const bf16x8 afr = *(const bf16x8*)(Sg + (size_t)((mb + mi) * 32 + r) * 128 + ks * 16 + hh * 8); acc[mi] = MFMA32(afr, bfr, acc[mi]); } }
        for (int ks = 0; ks < 2 * nI + 2; ++ks) { const bf16x8 bfr = *(const bf16x8*)(sAM + i * 72 + ks * 16 + hh * 8);
#pragma unroll
            for (int mi = 0; mi < 2; ++mi) { const bf16x8 afr = *(const bf16x8*)(sVT + ((mb + mi) * 32 + r) * 72 + ks * 16 + hh * 8); acc[mi] = MFMA32(afr, bfr, acc[mi]); } }
        float ss = 0.f;
#pragma unroll
        for (int mi = 0; mi < 2; ++mi)
#pragma unroll
            for (int e = 0; e < 16; ++e) ss += acc[mi][e] * acc[mi][e];
        ss += __shfl_xor(ss, 32);
        if (hh == 0) sSS[(wid >> 1) * 64 + i] = ss;
        __syncthreads();
        const float tot = sSS[i] + sSS[64 + i] + sSS[128 + i] + sSS[192 + i];
        const float rstd = rsqrtf(tot * (1.0f / 256.0f) + EPS);
        const size_t tok = (size_t)(t0 + i);
#pragma unroll
        for (int mi = 0; mi < 2; ++mi)
#pragma unroll
            for (int g4 = 0; g4 < 4; ++g4) { const int ch = h * 256 + (mb + mi) * 32 + g4 * 8 + hh * 4;
                const f32x4 nwv = *(const f32x4*)(p.gla_norm_w + ch);
                const u32x2 rg = *(const u32x2*)(P + tok * PW + 2048 + ch), mg = *(const u32x2*)(merged + tok * DM + ch);
                u32x2 o; o.x = cvt_pk_bf16(acc[mi][g4 * 4] * rstd * nwv[0] * bflo(rg.x) + bflo(mg.x), acc[mi][g4 * 4 + 1] * rstd * nwv[1] * bfhi(rg.x) + bfhi(mg.x));
                o.y = cvt_pk_bf16(acc[mi][g4 * 4 + 2] * rstd * nwv[2] * bflo(rg.y) + bflo(mg.y), acc[mi][g4 * 4 + 3] * rstd * nwv[3] * bfhi(rg.y) + bfhi(mg.y));
                *(u32x2*)(merged + tok * DM + ch) = o; }
        __syncthreads();
    }
}

__device__ void phase_tables(const Params& p) {
    bf16_t* db = (bf16_t*)(p.ws + OFF_DOWN); bf16_t* ub = (bf16_t*)(p.ws + OFF_UP);
    for (size_t e = ((size_t)blockIdx.x * 512 + threadIdx.x) * 8; e < (size_t)16384 * 1024; e += (size_t)gridDim.x * 4096) {
        { const f32x4 a = __builtin_nontemporal_load((const f32x4*)(p.down + e)), b = __builtin_nontemporal_load((const f32x4*)(p.down + e + 4));
            u32x4 w; w.x = cvt_pk_bf16(a[0], a[1]); w.y = cvt_pk_bf16(a[2], a[3]); w.z = cvt_pk_bf16(b[0], b[1]); w.w = cvt_pk_bf16(b[2], b[3]); *(u32x4*)(db + e) = w; }
        { const f32x4 a = __builtin_nontemporal_load((const f32x4*)(p.up + e)), b = __builtin_nontemporal_load((const f32x4*)(p.up + e + 4));
            u32x4 w; w.x = cvt_pk_bf16(a[0], a[1]); w.y = cvt_pk_bf16(a[2], a[3]); w.z = cvt_pk_bf16(b[0], b[1]); w.w = cvt_pk_bf16(b[2], b[3]); *(u32x4*)(ub + e) = w; }
    }
}

#define INS16(L, xin) do { float _x = (xin); _Pragma("unroll") for (int _p = 0; _p < 16; ++_p) { const float _hi = fmaxf(L[_p], _x); _x = fminf(L[_p], _x); L[_p] = _hi; } } while (0)
__device__ void phase_topk(const Params& p, unsigned char* lds) {
    const int tid = threadIdx.x, wid = tid >> 6, lane = tid & 63, r = lane & 31, hh = lane >> 5;
    const bf16_t* qp = (const bf16_t*)(p.ws + OFF_QP); const bf16_t* keysb = (const bf16_t*)(p.ws + OFF_KEYS);
    int* idxo = (int*)(p.ws + OFF_IDX); float* go = (float*)(p.ws + OFF_G);
    float* myrows = (float*)lds + wid * 32 * 129;
    const float NEG = -__builtin_inff();
    for (int tile = blockIdx.x; tile < 256; tile += gridDim.x) {
        const int tokb = tile * 64 + (wid & 1) * 32;
        float v1[16], v2[16];
#pragma unroll
        for (int j = 0; j < 16; ++j) { v1[j] = NEG; v2[j] = NEG; }
#pragma unroll 1
        for (int pass = 0; pass < 4; ++pass) {
            const int half = pass >> 1, hg = pass & 1, head = hg * 4 + (wid >> 1);
            f32x16 acc[4] = {zero16(), zero16(), zero16(), zero16()};
            const bf16_t* arow = qp + (size_t)(tokb + r) * 2048 + head * 256 + half * 128 + 8 * hh;
            const bf16_t* kb = keysb + half * 16384 + r * 128 + 8 * hh;
#pragma unroll
            for (int ks = 0; ks < 8; ++ks) { const bf16x8 a = *(const bf16x8*)(arow + 16 * ks);
#pragma unroll
                for (int nt = 0; nt < 4; ++nt) { const bf16x8 bb = *(const bf16x8*)(kb + nt * 32 * 128 + 16 * ks); acc[nt] = MFMA32(a, bb, acc[nt]); } }
#pragma unroll
            for (int nt = 0; nt < 4; ++nt)
#pragma unroll
                for (int e = 0; e < 16; ++e) { const int m = (e & 3) + 8 * (e >> 2) + 4 * hh; myrows[m * 129 + nt * 32 + r] = acc[nt][e]; }
            asm volatile("s_waitcnt lgkmcnt(0)" ::: "memory"); __builtin_amdgcn_wave_barrier();
            float L[16];
#pragma unroll
            for (int j = 0; j < 16; ++j) L[j] = NEG;
            const float* rowp = myrows + r * 129 + hh * 64;
#pragma unroll 4
            for (int k = 0; k < 64; ++k) { const unsigned bits = (__float_as_uint(rowp[k]) & ~127u) | (unsigned)(127 - (hh * 64 + k)); INS16(L, __uint_as_float(bits)); }
            float O[16];
#pragma unroll
            for (int j = 0; j < 16; ++j) O[j] = __shfl_xor(L[j], 32);
#pragma unroll
            for (int j = 0; j < 16; ++j) INS16(L, O[j]);
            const bool mine = hh == hg;
            if (half == 0) {
#pragma unroll
                for (int j = 0; j < 16; ++j) v1[j] = mine ? L[j] : v1[j];
            } else {
#pragma unroll
                for (int j = 0; j < 16; ++j) v2[j] = mine ? L[j] : v2[j];
            }
            asm volatile("s_waitcnt lgkmcnt(0)" ::: "memory"); __builtin_amdgcn_wave_barrier();
        }
        float T[16]; int TI[16];
#pragma unroll
        for (int j = 0; j < 16; ++j) { T[j] = NEG; TI[j] = 0; }
#pragma unroll
        for (int a = 0; a < 16; ++a)
#pragma unroll
            for (int b = 0; b < 16; ++b)
                if ((a + 1) * (b + 1) <= 16) {
                    float s = v1[a] + v2[b]; int id = (127 - (int)(__float_as_uint(v1[a]) & 127u)) * 128 + (127 - (int)(__float_as_uint(v2[b]) & 127u));
#pragma unroll
                    for (int q = 0; q < 16; ++q) { const bool c = s > T[q]; const float ts = c ? T[q] : s; const int ti = c ? TI[q] : id; T[q] = c ? s : T[q]; TI[q] = c ? id : TI[q]; s = ts; id = ti; }
                }
        const int token = tokb + r, head = hh * 4 + (wid >> 1);
        const float t0v = T[0]; float tot = 0.f;
#pragma unroll
        for (int j = 0; j < 16; ++j) { T[j] = __expf(T[j] - t0v); tot += T[j]; }
        const float inv = 1.0f / tot;
#pragma unroll
        for (int j = 0; j < 16; j += 4) { *(f32x4*)(go + (size_t)token * 128 + head * 16 + j) = (f32x4){T[j] * inv, T[j + 1] * inv, T[j + 2] * inv, T[j + 3] * inv};
            *(int4*)(idxo + (size_t)token * 128 + head * 16 + j) = make_int4(TI[j], TI[j + 1], TI[j + 2], TI[j + 3]); }
    }
}

__device__ void phase_peer(const Params& p, unsigned char* lds) {
    const int tid = threadIdx.x, wid = tid >> 6, lane = tid & 63, l16 = lane & 15, q4 = lane >> 4;
    const bf16_t* h2 = (const bf16_t*)(p.ws + OFF_H2); const bf16_t* db = (const bf16_t*)(p.ws + OFF_DOWN); const bf16_t* ub = (const bf16_t*)(p.ws + OFF_UP);
    const int* idxo = (const int*)(p.ws + OFF_IDX); const float* go = (const float*)(p.ws + OFF_G);
    const float* mod = (const float*)(p.ws + OFF_MOD);
    float* sga = (float*)lds + wid * 128;
    for (int tg = blockIdx.x * 8 + wid; tg < 2048; tg += gridDim.x * 8) {
        const int b = tg >> 10;
        for (int tt = 0; tt < 8; ++tt) {
            const int t = tg * 8 + tt;
            const int idA = idxo[(size_t)t * 128 + lane], idB = idxo[(size_t)t * 128 + 64 + lane];
            const float gA = go[(size_t)t * 128 + lane], gB = go[(size_t)t * 128 + 64 + lane];
            u32x4 hq[8];
#pragma unroll
            for (int i = 0; i < 8; ++i) hq[i] = *(const u32x4*)(h2 + (size_t)t * DM + i * 128 + l16 * 8);
#pragma unroll 2
            for (int s = 0; s < 32; ++s) {
                const int slot = 4 * s + q4;
                const int e = __shfl(s < 16 ? idA : idB, slot & 63);
                const bf16_t* row = db + (size_t)e * DM + l16 * 8;
                u32x4 w[8];
#pragma unroll
                for (int i = 0; i < 8; ++i) w[i] = *(const u32x4*)(row + i * 128);
                float a = 0.f;
#pragma unroll
                for (int i = 0; i < 8; ++i) {
                    a = dot2bf(w[i].x, hq[i].x, a); a = dot2bf(w[i].y, hq[i].y, a); a = dot2bf(w[i].z, hq[i].z, a); a = dot2bf(w[i].w, hq[i].w, a); }
                a += __shfl_xor(a, 8); a += __shfl_xor(a, 4); a += __shfl_xor(a, 2); a += __shfl_xor(a, 1);
                const float gg = __shfl(s < 16 ? gA : gB, slot & 63);
                if (l16 == 0) sga[slot] = gelu1(a) * gg;
            }
            asm volatile("s_waitcnt lgkmcnt(0)" ::: "memory"); __builtin_amdgcn_wave_barrier();
            float acc[16];
#pragma unroll
            for (int j = 0; j < 16; ++j) acc[j] = 0.f;
#pragma unroll 4
            for (int slot = 0; slot < 128; ++slot) {
                const int e = __builtin_amdgcn_readlane(slot < 64 ? idA : idB, slot & 63);
                const float ga = sga[slot];
                const bf16_t* row = ub + (size_t)e * DM + lane * 8;
                const u32x4 w0 = *(const u32x4*)row, w1 = *(const u32x4*)(row + 512);
                acc[0] += ga * bflo(w0.x); acc[1] += ga * bfhi(w0.x); acc[2] += ga * bflo(w0.y); acc[3] += ga * bfhi(w0.y);
                acc[4] += ga * bflo(w0.z); acc[5] += ga * bfhi(w0.z); acc[6] += ga * bflo(w0.w); acc[7] += ga * bfhi(w0.w);
                acc[8] += ga * bflo(w1.x); acc[9] += ga * bfhi(w1.x); acc[10] += ga * bflo(w1.y); acc[11] += ga * bfhi(w1.y);
                acc[12] += ga * bflo(w1.z); acc[13] += ga * bfhi(w1.z); acc[14] += ga * bflo(w1.w); acc[15] += ga * bfhi(w1.w);
            }
            asm volatile("s_waitcnt lgkmcnt(0)" ::: "memory"); __builtin_amdgcn_wave_barrier();
            float xo[16]; float ss = 0.f;
#pragma unroll
            for (int i = 0; i < 2; ++i)
#pragma unroll
                for (int j4 = 0; j4 < 2; ++j4) { const int d = i * 512 + lane * 8 + j4 * 4;
                    const f32x4 xv = *(const f32x4*)(p.out + (size_t)t * DM + d);
                    const f32x4 g2 = *(const f32x4*)(mod + b * 6144 + 5120 + d) + *(const f32x4*)(p.b_ada + 5120 + d);
#pragma unroll
                    for (int j = 0; j < 4; ++j) { const float v = xv[j] + g2[j] * acc[i * 8 + j4 * 4 + j]; xo[i * 8 + j4 * 4 + j] = v; ss += v * v; } }
            ss = wave_sum(ss);
            const float rstd = rsqrtf(ss * (1.0f / 1024.0f) + EPS);
#pragma unroll
            for (int i = 0; i < 2; ++i)
#pragma unroll
                for (int j4 = 0; j4 < 2; ++j4) { const int d = i * 512 + lane * 8 + j4 * 4;
                    const f32x4 fw = *(const f32x4*)(p.final_w + d);
                    *(f32x4*)(p.out + (size_t)t * DM + d) = (f32x4){xo[i * 8 + j4 * 4] * rstd * fw[0], xo[i * 8 + j4 * 4 + 1] * rstd * fw[1], xo[i * 8 + j4 * 4 + 2] * rstd * fw[2], xo[i * 8 + j4 * 4 + 3] * rstd * fw[3]}; }
        }
    }
}

#ifndef DBG_STAGE
#define DBG_STAGE 0
#endif
__device__ void phase_final_only(const Params& p) {
    const int wid = threadIdx.x >> 6, lane = threadIdx.x & 63;
    for (int t = blockIdx.x * 8 + wid; t < NTOK; t += gridDim.x * 8) {
        f32x4 xv[4]; float ss = 0.f;
#pragma unroll
        for (int i = 0; i < 4; ++i) { xv[i] = *(const f32x4*)(p.out + (size_t)t * DM + 256 * i + 4 * lane); ss += xv[i][0] * xv[i][0] + xv[i][1] * xv[i][1] + xv[i][2] * xv[i][2] + xv[i][3] * xv[i][3]; }
        ss = wave_sum(ss);
        const float rstd = rsqrtf(ss * (1.0f / 1024.0f) + EPS);
#pragma unroll
        for (int i = 0; i < 4; ++i) { const f32x4 fw = *(const f32x4*)(p.final_w + 256 * i + 4 * lane); *(f32x4*)(p.out + (size_t)t * DM + 256 * i + 4 * lane) = xv[i] * rstd * fw; }
    }
}

__device__ void phase_dump_bf16(const Params& p, const bf16_t* src, int ld) {
    for (size_t e = (size_t)blockIdx.x * 512 + threadIdx.x; e < (size_t)NTOK * DM; e += (size_t)gridDim.x * 512) {
        const size_t t = e >> 10, d = e & 1023; float v = __uint_as_float((unsigned)src[t * ld + d] << 16); if (!(fabsf(v) < 1e30f)) v = 1000.f; p.out[e] = v; }
}
__device__ void dbg_check_bf16(const Params& p, const bf16_t* src, size_t n, unsigned bit) {
    unsigned* flags = (unsigned*)(p.ws + OFF_IDX);
    bool bad = false;
    for (size_t e = (size_t)blockIdx.x * 512 + threadIdx.x; e < n; e += (size_t)gridDim.x * 512) { const float v = __uint_as_float((unsigned)src[e] << 16); if (!(fabsf(v) < 1e30f)) bad = true; }
    if (bad) atomicOr(flags, bit);
}
__device__ void dbg_check_f32(const Params& p, const float* src, size_t n, unsigned bit, float lim) {
    unsigned* flags = (unsigned*)(p.ws + OFF_IDX);
    bool bad = false;
    for (size_t e = (size_t)blockIdx.x * 512 + threadIdx.x; e < n; e += (size_t)gridDim.x * 512) { const float v = src[e]; if (!(fabsf(v) < lim)) bad = true; }
    if (bad) atomicOr(flags, bit);
}
__device__ void dbg_final(const Params& p) {
    const unsigned f = *(const unsigned*)(p.ws + OFF_IDX);
    for (size_t e = (size_t)blockIdx.x * 512 + threadIdx.x; e < (size_t)NTOK * DM; e += (size_t)gridDim.x * 512) p.out[e] = p.x[e] * (1.0f + (float)f);
}
#define GSYNC() do { asm volatile("s_waitcnt vmcnt(0) lgkmcnt(0)" ::: "memory"); grid.sync(); __builtin_amdgcn_fence(__ATOMIC_ACQUIRE, "agent"); asm volatile("s_waitcnt vmcnt(0)" ::: "memory"); } while (0)
__global__ void __launch_bounds__(512, 2) fwd_megakernel(Params p) {
    extern __shared__ __attribute__((aligned(16))) unsigned char lds[];
    cg::grid_group grid = cg::this_grid();
    LAS unsigned char* lds3 = (LAS unsigned char*)lds;
    const float* mod = (const float*)(p.ws + OFF_MOD);
    phase0(p, lds);
#if DBG_STAGE == 6
    if (blockIdx.x == 0 && threadIdx.x == 0) *(unsigned*)(p.ws + OFF_IDX) = 0u;
#endif
    GSYNC();
    phase_norm<true>(p, p.x, p.norm1_w, 0, 1024, (bf16_t*)(p.ws + OFF_HB), lds);
    GSYNC();
#if DBG_STAGE == 3
    phase_dump_bf16(p, (const bf16_t*)(p.ws + OFF_HB), DM); return;
#endif
    { pg8::StaticOrder S; S.init(NTOK, 7168, gridDim.x, blockIdx.x); EpiProj E{(bf16_t*)(p.ws + OFF_PROJ)};
        pg8::gemm_phase(lds3, pg8::Gemm{(const bf16_t*)(p.ws + OFF_HB), (const bf16_t*)(p.ws + OFF_WINT), NTOK, 7168, 1024}, S, E); }
    GSYNC();
#if DBG_STAGE == 2
    phase_dump_bf16(p, (const bf16_t*)(p.ws + OFF_PROJ) + 1024, PW); return;
#endif
    phase_glaA(p, lds);
    GSYNC();
#if DBG_STAGE == 6
    dbg_check_bf16(p, (const bf16_t*)p.out, (size_t)NTOK * 2048, 1u);
    dbg_check_f32(p, (const float*)(p.ws + OFF_ALR), (size_t)NTOK * 16, 8u, 50.f);
    dbg_check_f32(p, (const float*)(p.ws + OFF_DECAY), (size_t)1024 * 128, 16u, 1.0001f);
#endif
    phase_scan_sgu(p, lds);
    GSYNC();
#if DBG_STAGE == 6
    dbg_check_bf16(p, (const bf16_t*)p.out, (size_t)NTOK * 2048, 2u);
#endif
#if DBG_STAGE == 4
    phase_dump_bf16(p, (const bf16_t*)(p.ws + OFF_HB), DM); return;
#endif
    phase_glaC(p, lds);
    GSYNC();
#if DBG_STAGE == 5
    phase_dump_bf16(p, (const bf16_t*)(p.ws + OFF_HB), DM); return;
#endif
#if DBG_STAGE == 6
    dbg_check_bf16(p, (const bf16_t*)(p.ws + OFF_HB), (size_t)NTOK * DM, 4u);
    GSYNC();
    dbg_final(p); return;
#endif
    { pg8::StaticOrder S; S.init(NTOK, 1024, gridDim.x, blockIdx.x); EpiX1 E{p.x, p.out, mod, p.b_ada};
        pg8::gemm_phase(lds3, pg8::Gemm{(const bf16_t*)(p.ws + OFF_HB), (const bf16_t*)(p.ws + OFF_WOUTT), NTOK, 1024, 1024}, S, E); }
    GSYNC();
#if DBG_STAGE == 1
    phase_final_only(p); return;
#endif
    phase_norm<false>(p, p.out, p.norm2_w, 3072, 4096, (bf16_t*)(p.ws + OFF_H2), lds);
    phase_tables(p);
    GSYNC();
    { pg8::StaticOrder S; S.init(NTOK, 2048, gridDim.x, blockIdx.x); EpiQ E{(bf16_t*)(p.ws + OFF_QP)};
        pg8::gemm_phase(lds3, pg8::Gemm{(const bf16_t*)(p.ws + OFF_H2), (const bf16_t*)(p.ws + OFF_WQT), NTOK, 2048, 1024}, S, E); }
    GSYNC();
    phase_topk(p, lds);
    GSYNC();
    phase_peer(p, lds);
}

extern "C" void kernel_launch(void* const* d_in, const int* in_sizes, int n_in, void* d_out, int out_size, void* d_ws, size_t ws_size, hipStream_t stream) {
    static int grid_blocks = 0;
    if (!grid_blocks) {
        int dev = 0, cus = 0, per_cu = 0;
        hipGetDevice(&dev);
        hipDeviceGetAttribute(&cus, hipDeviceAttributeMultiprocessorCount, dev);
        hipFuncSetAttribute((const void*)fwd_megakernel, hipFuncAttributeMaxDynamicSharedMemorySize, LDS_BYTES);
        hipOccupancyMaxActiveBlocksPerMultiprocessor(&per_cu, (const void*)fwd_megakernel, 512, LDS_BYTES);
        if (per_cu < 1) per_cu = 1;
        grid_blocks = cus * per_cu;
        if (ws_size < WS_END) fprintf(stderr, "kernel_launch: workspace too small (%zu < %zu)\n", ws_size, (size_t)WS_END);
    }
    Params p{};
    p.x = (const float*)d_in[0]; p.c = (const float*)d_in[1]; p.w_ada = (const float*)d_in[2]; p.b_ada = (const float*)d_in[3]; p.norm1_w = (const float*)d_in[4];
    p.w_in = (const float*)d_in[5]; p.w_alpha_up = (const float*)d_in[6]; p.b_alpha = (const float*)d_in[7]; p.gla_norm_w = (const float*)d_in[8];
    p.sgu_ln_w = (const float*)d_in[9]; p.sgu_ln_b = (const float*)d_in[10]; p.sgu_w = (const float*)d_in[11]; p.sgu_b = (const float*)d_in[12];
    p.w_out = (const float*)d_in[13]; p.norm2_w = (const float*)d_in[14]; p.w_q = (const float*)d_in[15]; p.keys1 = (const float*)d_in[16]; p.keys2 = (const float*)d_in[17];
    p.down = (const float*)d_in[18]; p.up = (const float*)d_in[19]; p.final_w = (const float*)d_in[20];
    p.out = (float*)d_out; p.ws = (unsigned char*)d_ws;
    void* args[] = {&p};
    hipError_t e = hipLaunchCooperativeKernel((const void*)fwd_megakernel, dim3(grid_blocks), dim3(512), args, LDS_BYTES, stream);
    if (e != hipSuccess) fprintf(stderr, "cooperative launch failed: %s (grid %d)\n", hipGetErrorString(e), grid_blocks);
}
```

```cpp
#include <hip/hip_runtime.h>
#include <hip/hip_cooperative_groups.h>
#include <cstdio>
namespace cg = cooperative_groups;

#define LAS __attribute__((address_space(3)))
typedef unsigned short bf16_t;
typedef short bf16x8 __attribute__((ext_vector_type(8)));
typedef float f32x2 __attribute__((ext_vector_type(2)));
typedef float f32x4 __attribute__((ext_vector_type(4)));
typedef float f32x16 __attribute__((ext_vector_type(16)));
typedef unsigned u32x2 __attribute__((ext_vector_type(2)));
typedef unsigned u32x4 __attribute__((ext_vector_type(4)));
typedef __bf16 bf16x2_t __attribute__((ext_vector_type(2)));

constexpr int NTOK = 16384, DM = 1024, SEQ = 8192, INW = 7184, PW = 5120;
constexpr float EPS = 1e-6f;
constexpr size_t MiB = 1024 * 1024;
constexpr size_t OFF_PROJ = 0;
constexpr size_t OFF_DOWN = 0;
constexpr size_t OFF_UP = 32 * MiB;
constexpr size_t OFF_DOWN8 = 0;
constexpr size_t OFF_UP8 = 16 * MiB;
constexpr size_t OFF_SCD = 32 * MiB;
constexpr size_t OFF_SCU = 32 * MiB + 65536;
constexpr size_t OFF_H2 = 64 * MiB;
constexpr size_t OFF_QP = 96 * MiB;
constexpr size_t OFF_HB = 160 * MiB;
constexpr size_t OFF_WINT = 192 * MiB;
constexpr size_t OFF_WOUTT = 206 * MiB;
constexpr size_t OFF_WQT = 208 * MiB;
constexpr size_t OFF_KEYS = 212 * MiB;
constexpr size_t OFF_MOD = OFF_KEYS + 65536;
constexpr size_t OFF_ALR = OFF_MOD + 65536;
constexpr size_t OFF_STATS = OFF_ALR + MiB;
constexpr size_t OFF_DECAY = OFF_STATS + 131072;
constexpr size_t OFF_BAR = OFF_DECAY + 524288;
constexpr size_t OFF_IDX = 214 * MiB;
constexpr size_t OFF_G = 222 * MiB;
constexpr size_t WS_END = 230 * MiB;
constexpr int LDS_BYTES = 135168;

struct Params {
    const float *x, *c, *w_ada, *b_ada, *norm1_w, *w_in, *w_alpha_up, *b_alpha, *gla_norm_w, *sgu_ln_w, *sgu_ln_b, *sgu_w, *sgu_b, *w_out, *norm2_w, *w_q, *keys1, *keys2, *down, *up, *final_w;
    float* out; unsigned char* ws;
};

__device__ __forceinline__ unsigned cvt_pk_bf16_asm(float lo, float hi) { unsigned r; asm volatile("v_cvt_pk_bf16_f32 %0, %1, %2" : "=v"(r) : "v"(lo), "v"(hi)); return r; }
__device__ __forceinline__ unsigned cvt_pk_bf16(float lo, float hi) { f32x2 v = {lo, hi}; bf16x2_t b = __builtin_convertvector(v, bf16x2_t); return __builtin_bit_cast(unsigned, b); }
__device__ __forceinline__ float bflo(unsigned w) { return __uint_as_float(w << 16); }
__device__ __forceinline__ float bfhi(unsigned w) { return __uint_as_float(w & 0xffff0000u); }
__device__ __forceinline__ float wave_sum(float v) {
#pragma unroll
    for (int o = 32; o; o >>= 1) v += __shfl_xor(v, o);
    return v;
}
__device__ __forceinline__ float sigmoidf_(float x) { return __builtin_amdgcn_rcpf(1.0f + __expf(-x)); }
__device__ __forceinline__ f32x2 gelu_pk(f32x2 v) {
    const f32x2 av = __builtin_elementwise_abs(v), d = av * 0.2316418882f + 1.0f;
    f32x2 t; t.x = __builtin_amdgcn_rcpf(d.x); t.y = __builtin_amdgcn_rcpf(d.y);
    f32x2 q = t * 0.5307027145f + (-0.7265760135f); q = q * t + 0.7107068705f; q = q * t + (-0.142248368f); q = q * t + 0.127414796f; q = q * t;
    const f32x2 s = (v * v) * (-0.72134752044f);
    f32x2 e; e.x = __builtin_amdgcn_exp2f(s.x); e.y = __builtin_amdgcn_exp2f(s.y);
    const f32x2 m = v * (q * e), r = v - m;
    f32x2 o; o.x = v.x < 0.f ? m.x : r.x; o.y = v.y < 0.f ? m.y : r.y; return o;
}
__device__ __forceinline__ float gelu1(float v) { f32x2 r = gelu_pk((f32x2){v, v}); return r.x; }
__device__ __forceinline__ f32x16 zero16() { f32x16 z;
#pragma unroll
    for (int i = 0; i < 16; ++i) z[i] = 0.f;
    return z; }
__device__ __forceinline__ float dot2bf(unsigned a, unsigned b, float c) { return __builtin_amdgcn_fdot2_f32_bf16(__builtin_bit_cast(bf16x2_t, a), __builtin_bit_cast(bf16x2_t, b), c, false); }
#define MFMA32(a, b, c) __builtin_amdgcn_mfma_f32_32x32x16_bf16((a), (b), (c), 0, 0, 0)


#define XB_TMO      128
#define XB_XCNT(j)  (256  + 64 * (j))
#define XB_XSUB(j)  (1280 + 64 * (j))
#define XB_XGEN(j)  (2304 + 64 * (j))
#define XB_TOP      3328
#define XB_TOPGEN   3392
#define XCD_BAR_WORDS 3456
#define XB_SPIN_CAP (1u << 18)
__device__ __forceinline__ unsigned xb_ld(unsigned* p)              { return __hip_atomic_load(p, __ATOMIC_RELAXED, __HIP_MEMORY_SCOPE_AGENT); }
__device__ __forceinline__ unsigned xb_add(unsigned* p, unsigned v) { return __hip_atomic_fetch_add(p, v, __ATOMIC_RELAXED, __HIP_MEMORY_SCOPE_AGENT); }
__device__ __forceinline__ unsigned xb_xcc_id() { return (unsigned)__builtin_amdgcn_s_getreg((3 << 11) | 20) & 0xFu; }
#define XB_SPIN(cond, bar) do { unsigned _sp = 0; while (cond) { __builtin_amdgcn_s_sleep(1); \
    if ((++_sp & 255u) == 0u) { if (xb_ld(&(bar)[XB_TMO])) break; if (_sp > XB_SPIN_CAP) { atomicAdd(&(bar)[XB_TMO], 1u); break; } } } } while (0)
struct XcdBarrier { unsigned* bar; unsigned x; volatile LAS unsigned* st; };
__device__ __forceinline__ XcdBarrier xcd_barrier_post(unsigned* bar, volatile LAS unsigned* st) {
    XcdBarrier b; b.bar = bar; b.x = xb_xcc_id(); b.st = st;
    if (threadIdx.x == 0) (void)xb_add(&bar[XB_XCNT(b.x)], 1u);
    return b;
}
__device__ __forceinline__ void xcd_barrier_complete(unsigned* bar, unsigned x, unsigned& nloc, unsigned& nx) {
    const unsigned G = gridDim.x * gridDim.y * gridDim.z;
    unsigned sum, cnt, mine, sp = 0u;
    for (;;) {
        sum = 0u; cnt = 0u; mine = 0u;
#pragma unroll
        for (unsigned j = 0; j < 16; ++j) { const unsigned c = xb_ld(&bar[XB_XCNT(j)]); sum += c; cnt += (c > 0u) ? 1u : 0u; mine = (j == x) ? c : mine; }
        if (sum == G) break;
        __builtin_amdgcn_s_sleep(1);
        if ((++sp & 255u) == 0u) { if (xb_ld(&bar[XB_TMO])) break; if (sp > XB_SPIN_CAP) { atomicAdd(&bar[XB_TMO], 1u); break; } }
    }
    nloc = mine > 0u ? mine : 1u; nx = cnt > 0u ? cnt : 1u;
}
__device__ __forceinline__ void xcd_barrier(const XcdBarrier& b) {
    asm volatile("s_waitcnt vmcnt(0)" ::: "memory");
    __syncthreads();
    if (threadIdx.x == 0) {
        unsigned* bar = b.bar;
        __builtin_amdgcn_s_waitcnt(0);
        unsigned nloc = b.st[0], nx = b.st[1];
        if (nloc == 0u) { xcd_barrier_complete(bar, b.x, nloc, nx); b.st[0] = nloc; b.st[1] = nx; }
        const unsigned old = xb_add(&bar[XB_XSUB(b.x)], 1u);
        const unsigned gen = old / nloc;
        if (old + 1u == (gen + 1u) * nloc) {
            __builtin_amdgcn_fence(__ATOMIC_RELEASE, "agent");
            asm volatile("s_waitcnt vmcnt(0)" ::: "memory");
            const unsigned og = xb_add(&bar[XB_TOP], 1u);
            const unsigned tg = og / nx;
            if (og + 1u == (tg + 1u) * nx) xb_add(&bar[XB_TOPGEN], 1u);
            else XB_SPIN(xb_ld(&bar[XB_TOPGEN]) == tg, bar);
            __builtin_amdgcn_fence(__ATOMIC_ACQUIRE, "agent");
            xb_add(&bar[XB_XGEN(b.x)], 1u);
            asm volatile("s_waitcnt vmcnt(0)" ::: "memory");
        } else {
            XB_SPIN(xb_ld(&bar[XB_XGEN(b.x)]) == gen, bar);
            __builtin_amdgcn_fence(__ATOMIC_ACQUIRE, "agent");
            asm volatile("s_waitcnt vmcnt(0)" ::: "memory");
        }
    }
    __syncthreads();
}

namespace pg8 {
constexpr int BM = 256, BK = 64, HALF = 128, HTB = HALF * BK * 2, STAGE_BYTES = 8 * HTB, NXCD = 8, WGM = 8;
__host__ __device__ __forceinline__ int lds_byte(int r, int c) { const int st = (r >> 4) * 2 + (c >> 5), rr = r & 15, cc = c & 31, ob = rr * 64 + cc * 2; return st * 1024 + (ob ^ (((ob >> 9) & 1) << 5)); }
__host__ __device__ __forceinline__ void stage_rc(int b, int& R, int& C) { const int st = b / 1024, sb = b % 1024, swz = sb ^ (((sb >> 9) & 1) << 5); R = (st >> 1) * 16 + swz / 64; C = (st & 1) * 32 + (swz % 64) / 2; }
__host__ __device__ __forceinline__ int perm32(int rho) { const int n = rho >> 4, i = rho & 15; return 8 * (i >> 2) + 4 * n + (i & 3); }
struct Unit { int pm, pn; };
struct Gemm { const bf16_t* A; const bf16_t* Bt; int M, N, K; };
struct StaticOrder {
    int nM, nN, nwg, G, c;
    __device__ void init(int M, int N, int G_, int c_) { nM = M / BM; nN = N / BM; nwg = nM * nN; G = G_; c = c_; }
    __device__ bool next(int i, Unit& u) const {
        const long L = (long)i * G + c; if (L >= nwg) return false;
        int wgid = (int)L; { const int q = nwg / NXCD, r = nwg % NXCD, xcd = wgid % NXCD, off = wgid / NXCD; wgid = (xcd < r ? xcd * (q + 1) : r * (q + 1) + (xcd - r) * q) + off; }
        const int nig = WGM * nN, gid = wgid / nig, fm = gid * WGM, gsz = (nM - fm) < WGM ? (nM - fm) : WGM;
        u.pm = fm + ((wgid % nig) % gsz); u.pn = (wgid % nig) / gsz; return true;
    }
    __device__ __forceinline__ void a_ready(const Unit&) const {}
    __device__ __forceinline__ void done(const Unit&) const {}
};

template <class Epi, class Sched>
__device__ __forceinline__ void gemm_phase(LAS unsigned char* lds, const Gemm g, const Sched& S, const Epi& E) {
    const int tid = threadIdx.x, wid = __builtin_amdgcn_readfirstlane(tid >> 6), lane = tid & 63, wr = wid >> 2, wc = wid & 3, fr = lane & 15, fq = lane >> 4;
    const int K = g.K, nt = K / BK;
    unsigned voffA[2], voffB[2];
#pragma unroll
    for (int i = 0; i < 2; ++i) { int R, C; stage_rc(tid * 16 + i * 8192, R, C); const int Rb = Epi::PERM ? ((R & ~31) + perm32(R & 31)) : R;
        voffA[i] = (unsigned)(R * K + C) * 2u; voffB[i] = (unsigned)(Rb * K + C) * 2u; }
    const size_t kstep = (size_t)(BK * 2);
    const size_t hstep = (size_t)HALF * K * 2;
    const size_t tstep = 2 * hstep;
    const unsigned ldsw = (unsigned)wid * 1024u;
    const int aoff = lds_byte(wr * 64 + fr, fq * 8), boff = lds_byte(wc * 32 + fr, fq * 8);
#define PG8_SA(b, h) (((b) * 2 + (h)) * HTB)
#define PG8_SB(b, h) ((4 + (b) * 2 + (h)) * HTB)
#define PG8_STAGE(bufoff, gbase, voff) do { _Pragma("unroll") for (int _i = 0; _i < 2; ++_i) \
        __builtin_amdgcn_global_load_lds((const unsigned*)((const char*)(gbase) + (voff)[_i]), (LAS unsigned*)(lds + (bufoff) + ldsw + _i * 8192), 16, 0, 0); } while (0)
#define PG8_LDA(dst, b, h) do { _Pragma("unroll") for (int m = 0; m < 4; ++m) _Pragma("unroll") for (int k = 0; k < 2; ++k) dst[m][k] = *(const LAS bf16x8*)(lds + PG8_SA(b, h) + aoff + m * 2048 + k * 1024); } while (0)
#define PG8_LDB(dst, b, h) do { _Pragma("unroll") for (int n = 0; n < 2; ++n) _Pragma("unroll") for (int k = 0; k < 2; ++k) dst[n][k] = *(const LAS bf16x8*)(lds + PG8_SB(b, h) + boff + n * 2048 + k * 1024); } while (0)
#define PG8_MMA(ai, bj, At, Bt) do { __builtin_amdgcn_s_setprio(1); _Pragma("unroll") for (int m = 0; m < 4; ++m) _Pragma("unroll") for (int n = 0; n < 2; ++n) _Pragma("unroll") for (int k = 0; k < 2; ++k) \
        acc[ai][bj][m][n] = __builtin_amdgcn_mfma_f32_16x16x32_bf16(Bt[n][k], At[m][k], acc[ai][bj][m][n], 0, 0, 0); __builtin_amdgcn_s_setprio(0); } while (0)
#define PG8_WAIT_V(n) asm volatile("s_waitcnt vmcnt(" #n ")" ::: "memory")
#define PG8_WAIT_L(n) asm volatile("s_waitcnt lgkmcnt(" #n ")" ::: "memory")
#define PG8_BAR __builtin_amdgcn_s_barrier()
#define PG8_SCHED __builtin_amdgcn_sched_barrier(0)
    Unit cur, nxt; int ui = 0;
    if (!S.next(0, cur)) return;
    f32x4 acc[2][2][4][2];
#pragma unroll
    for (int a = 0; a < 2; ++a)
#pragma unroll
        for (int b = 0; b < 2; ++b)
#pragma unroll
            for (int m = 0; m < 4; ++m)
#pragma unroll
                for (int n = 0; n < 2; ++n) acc[a][b][m][n] = (f32x4){0.f, 0.f, 0.f, 0.f};
    bf16x8 At[4][2], B0[2][2], B1[2][2];
    const char* cA = (const char*)g.A + (size_t)cur.pm * tstep; const char* cB = (const char*)g.Bt + (size_t)cur.pn * tstep;
    S.a_ready(cur);
    PG8_STAGE(PG8_SB(0, 0), cB, voffB); PG8_STAGE(PG8_SA(0, 0), cA, voffA); PG8_STAGE(PG8_SB(0, 1), cB + hstep, voffB); PG8_STAGE(PG8_SA(0, 1), cA + hstep, voffA);
    if (wr == 1) PG8_BAR;
    PG8_WAIT_V(4); PG8_BAR;
    PG8_STAGE(PG8_SB(1, 0), cB + kstep, voffB); PG8_STAGE(PG8_SA(1, 0), cA + kstep, voffA); PG8_STAGE(PG8_SB(1, 1), cB + hstep + kstep, voffB);
    PG8_WAIT_V(6); PG8_BAR;
    for (;;) {
        const bool has_next = S.next(ui + 1, nxt);
        const char* nA = has_next ? (const char*)g.A + (size_t)nxt.pm * tstep : cA; const char* nB = has_next ? (const char*)g.Bt + (size_t)nxt.pn * tstep : cB;
        for (int t = 0; t < nt; t += 2) {
            const bool last = (t == nt - 2);
            const char* a1 = cA + (size_t)(t + 1) * kstep;
            const char* a2 = last ? nA : cA + (size_t)(t + 2) * kstep; const char* b2 = last ? nB : cB + (size_t)(t + 2) * kstep;
            const char* a3 = a2 + kstep; const char* b3 = b2 + kstep;
            if (last && has_next) S.a_ready(nxt);
            PG8_LDB(B0, 0, 0); PG8_SCHED; PG8_LDA(At, 0, 0); PG8_STAGE(PG8_SA(1, 1), a1 + hstep, voffA);
            PG8_WAIT_L(8); PG8_BAR; PG8_WAIT_L(0); PG8_MMA(0, 0, At, B0); PG8_BAR; PG8_SCHED;
            PG8_LDB(B1, 0, 1); PG8_STAGE(PG8_SB(0, 0), b2, voffB);
            PG8_BAR; PG8_WAIT_L(0); PG8_MMA(0, 1, At, B1); PG8_BAR;
            PG8_LDA(At, 0, 1); PG8_STAGE(PG8_SA(0, 0), a2, voffA);
            PG8_BAR; PG8_WAIT_L(0); PG8_MMA(1, 0, At, B0); PG8_BAR; PG8_SCHED;
            PG8_STAGE(PG8_SB(0, 1), b2 + hstep, voffB);
            PG8_WAIT_V(6); PG8_BAR; PG8_MMA(1, 1, At, B1); PG8_BAR;
            PG8_LDB(B0, 1, 0); PG8_SCHED; PG8_LDA(At, 1, 0); PG8_STAGE(PG8_SA(0, 1), a2 + hstep, voffA);
            PG8_WAIT_L(8); PG8_BAR; PG8_WAIT_L(0); PG8_MMA(0, 0, At, B0); PG8_BAR; PG8_SCHED;
            PG8_LDB(B1, 1, 1); PG8_STAGE(PG8_SB(1, 0), b3, voffB);
            PG8_BAR; PG8_WAIT_L(0); PG8_MMA(0, 1, At, B1); PG8_BAR;
            PG8_LDA(At, 1, 1); PG8_STAGE(PG8_SA(1, 0), a3, voffA);
            PG8_BAR; PG8_WAIT_L(0); PG8_MMA(1, 0, At, B0); PG8_BAR; PG8_SCHED;
            PG8_STAGE(PG8_SB(1, 1), b3 + hstep, voffB);
            PG8_WAIT_V(6); PG8_BAR; PG8_MMA(1, 1, At, B1); PG8_BAR;
        }
        E(acc, cur, wr, wc, fr, fq); S.done(cur);
        if (!has_next) break;
#pragma unroll
        for (int a = 0; a < 2; ++a)
#pragma unroll
            for (int b = 0; b < 2; ++b)
#pragma unroll
                for (int m = 0; m < 4; ++m)
#pragma unroll
                    for (int n = 0; n < 2; ++n) acc[a][b][m][n] = (f32x4){0.f, 0.f, 0.f, 0.f};
        cur = nxt; cA = nA; cB = nB; ++ui;
    }
    PG8_WAIT_V(0);
    if (wr == 0) PG8_BAR;
    PG8_BAR;
#undef PG8_SA
#undef PG8_SB
#undef PG8_STAGE
#undef PG8_LDA
#undef PG8_LDB
#undef PG8_MMA
#undef PG8_WAIT_V
#undef PG8_WAIT_L
#undef PG8_BAR
#undef PG8_SCHED
}
}
using pg8::Unit;

struct EpiProj {
    static constexpr bool PERM = true;
    bf16_t* P;
    __device__ __forceinline__ void operator()(const f32x4 (&acc)[2][2][4][2], const Unit& u, int wr, int wc, int fr, int fq) const {
        const int row0 = u.pm * 256 + wr * 64 + fr; const int pn = u.pn;
        if (pn < 8 || pn >= 24) {
            const bool act = pn >= 24;
            const int col0 = (act ? 4096 + (pn - 24) * 256 : pn * 256) + wc * 32 + 8 * fq;
#pragma unroll
            for (int ai = 0; ai < 2; ++ai)
#pragma unroll
                for (int m = 0; m < 4; ++m) { bf16_t* rowp = P + (size_t)(row0 + ai * 128 + m * 16) * PW + col0;
#pragma unroll
                    for (int bj = 0; bj < 2; ++bj) { f32x4 v0 = acc[ai][bj][m][0], v1 = acc[ai][bj][m][1];
                        if (act) { f32x2 a = gelu_pk((f32x2){v0[0], v0[1]}), b = gelu_pk((f32x2){v0[2], v0[3]}), c = gelu_pk((f32x2){v1[0], v1[1]}), d = gelu_pk((f32x2){v1[2], v1[3]});
                            v0 = (f32x4){a.x, a.y, b.x, b.y}; v1 = (f32x4){c.x, c.y, d.x, d.y}; }
                        u32x4 w; w.x = cvt_pk_bf16_asm(v0[0], v0[1]); w.y = cvt_pk_bf16_asm(v0[2], v0[3]); w.z = cvt_pk_bf16_asm(v1[0], v1[1]); w.w = cvt_pk_bf16_asm(v1[2], v1[3]);
                        *(u32x4*)(rowp + bj * 128) = w; } }
        } else {
            const bool isrg = pn < 16;
            const int col0 = (isrg ? 2048 + (pn - 8) * 128 : 3072 + (pn - 16) * 128) + wc * 32 + 8 * fq;
#pragma unroll
            for (int ai = 0; ai < 2; ++ai)
#pragma unroll
                for (int m = 0; m < 4; ++m) { bf16_t* rowp = P + (size_t)(row0 + ai * 128 + m * 16) * PW + col0;
                    float o[8];
#pragma unroll
                    for (int n = 0; n < 2; ++n) { const f32x4 a = acc[ai][0][m][n], g = acc[ai][1][m][n];
                        if (isrg) {
#pragma unroll
                            for (int j = 0; j < 4; ++j) o[n * 4 + j] = a[j] * sigmoidf_(a[j]) * sigmoidf_(g[j]);
                        } else { f32x2 x = gelu_pk((f32x2){a[0], a[1]}), y = gelu_pk((f32x2){a[2], a[3]});
                            o[n * 4 + 0] = x.x * sigmoidf_(g[0]); o[n * 4 + 1] = x.y * sigmoidf_(g[1]); o[n * 4 + 2] = y.x * sigmoidf_(g[2]); o[n * 4 + 3] = y.y * sigmoidf_(g[3]); } }
                    u32x4 w; w.x = cvt_pk_bf16_asm(o[0], o[1]); w.y = cvt_pk_bf16_asm(o[2], o[3]); w.z = cvt_pk_bf16_asm(o[4], o[5]); w.w = cvt_pk_bf16_asm(o[6], o[7]);
                    *(u32x4*)rowp = w; }
        }
    }
};
struct EpiX1 {
    static constexpr bool PERM = false;
    const float* x; float* x1; const float* mod; const float* b_ada;
    __device__ __forceinline__ void operator()(const f32x4 (&acc)[2][2][4][2], const Unit& u, int wr, int wc, int fr, int fq) const {
        const int row0 = u.pm * 256 + wr * 64 + fr, col0 = u.pn * 256 + wc * 32 + 4 * fq; const int b = u.pm >> 5;
        f32x4 gv[2][2];
#pragma unroll
        for (int bj = 0; bj < 2; ++bj)
#pragma unroll
            for (int n = 0; n < 2; ++n) gv[bj][n] = *(const f32x4*)(mod + b * 6144 + 2048 + col0 + bj * 128 + n * 16) + *(const f32x4*)(b_ada + 2048 + col0 + bj * 128 + n * 16);
#pragma unroll
        for (int ai = 0; ai < 2; ++ai)
#pragma unroll
            for (int m = 0; m < 4; ++m) { const size_t off = (size_t)(row0 + ai * 128 + m * 16) * DM + col0;
#pragma unroll
                for (int bj = 0; bj < 2; ++bj)
#pragma unroll
                    for (int n = 0; n < 2; ++n) { const f32x4 xv = *(const f32x4*)(x + off + bj * 128 + n * 16); *(f32x4*)(x1 + off + bj * 128 + n * 16) = xv + gv[bj][n] * acc[ai][bj][m][n]; } }
    }
};
struct EpiQ {
    static constexpr bool PERM = true;
    bf16_t* O;
    __device__ __forceinline__ void operator()(const f32x4 (&acc)[2][2][4][2], const Unit& u, int wr, int wc, int fr, int fq) const {
        const int row0 = u.pm * 256 + wr * 64 + fr, col0 = u.pn * 256 + wc * 32 + 8 * fq;
#pragma unroll
        for (int ai = 0; ai < 2; ++ai)
#pragma unroll
            for (int m = 0; m < 4; ++m) { bf16_t* rowp = O + (size_t)(row0 + ai * 128 + m * 16) * 2048 + col0;
#pragma unroll
                for (int bj = 0; bj < 2; ++bj) { const f32x4 v0 = acc[ai][bj][m][0], v1 = acc[ai][bj][m][1];
                    u32x4 w; w.x = cvt_pk_bf16_asm(v0[0], v0[1]); w.y = cvt_pk_bf16_asm(v0[2], v0[3]); w.z = cvt_pk_bf16_asm(v1[0], v1[1]); w.w = cvt_pk_bf16_asm(v1[2], v1[3]);
                    *(u32x4*)(rowp + bj * 128) = w; } }
    }
};

__device__ __forceinline__ int win_src_col(int n) {
    if (n < 2048) return n;
    if (n < 4096) { const int u = (n - 2048) >> 8, r = (n - 2048) & 255; return r < 128 ? 2048 + 128 * u + r : 5136 + 128 * u + (r - 128); }
    if (n < 6144) { const int u = (n - 4096) >> 8, r = (n - 4096) & 255; return r < 128 ? 3088 + 128 * u + r : 6160 + 128 * u + (r - 128); }
    return 4112 + (n - 6144);
}
__device__ void phase0(const Params& p, unsigned char* lds) {
    const int tid = threadIdx.x;
    float* mod = (float*)(p.ws + OFF_MOD);
    {
        float* ssc = (float*)lds;
        float* red = (float*)lds + 2048;
        for (int e = tid; e < 2048; e += 512) { const float cv = p.c[e]; ssc[e] = cv * sigmoidf_(cv); }
        __syncthreads();
        for (int cbk = blockIdx.x; cbk < 256; cbk += gridDim.x) {
            const int cc = tid % 24, rg = tid / 24;
            if (tid < 504) { float a0 = 0.f, a1 = 0.f;
                for (int k = rg; k < 1024; k += 21) { const float w = p.w_ada[(size_t)k * 6144 + cbk * 24 + cc]; a0 += ssc[k] * w; a1 += ssc[1024 + k] * w; }
                red[(rg * 24 + cc) * 2] = a0; red[(rg * 24 + cc) * 2 + 1] = a1; }
            __syncthreads();
            if (tid < 48) { const int c2 = tid % 24, bb = tid / 24; float s = 0.f;
                for (int g = 0; g < 21; ++g) s += red[(g * 24 + c2) * 2 + bb];
                mod[bb * 6144 + cbk * 24 + c2] = s; }
            __syncthreads();
        }
    }
    float* tile = (float*)lds;
    for (int tl = blockIdx.x; tl < 2560; tl += gridDim.x) {
        const float* W; bf16_t* Bt; int ldw, nt, kt, which;
        if (tl < 1792) { which = 0; W = p.w_in; ldw = INW; Bt = (bf16_t*)(p.ws + OFF_WINT); nt = tl >> 4; kt = tl & 15; }
        else if (tl < 2048) { which = 1; W = p.w_out; ldw = 1024; Bt = (bf16_t*)(p.ws + OFF_WOUTT); nt = (tl - 1792) >> 4; kt = tl & 15; }
        else { which = 2; W = p.w_q; ldw = 2048; Bt = (bf16_t*)(p.ws + OFF_WQT); nt = (tl - 2048) >> 4; kt = tl & 15; }
        { const int nn = tid & 63, kk0 = tid >> 6; const int n = nt * 64 + nn; const int sc = which == 0 ? win_src_col(n) : n;
#pragma unroll
            for (int i = 0; i < 8; ++i) { const int k = kk0 + 8 * i; tile[nn * 65 + k] = W[(size_t)(kt * 64 + k) * ldw + sc]; } }
        __syncthreads();
        { const int n = tid >> 3, kc = (tid & 7) * 8; const float* tp = tile + n * 65 + kc;
            u32x4 w; w.x = cvt_pk_bf16(tp[0], tp[1]); w.y = cvt_pk_bf16(tp[2], tp[3]); w.z = cvt_pk_bf16(tp[4], tp[5]); w.w = cvt_pk_bf16(tp[6], tp[7]);
            *(u32x4*)(Bt + (size_t)(nt * 64 + n) * 1024 + kt * 64 + kc) = w; }
        __syncthreads();
    }
    { bf16_t* kb = (bf16_t*)(p.ws + OFF_KEYS);
        for (int e = (blockIdx.x * 512 + tid) * 2; e < 32768; e += gridDim.x * 1024) {
            const float* src = e < 16384 ? p.keys1 + e : p.keys2 + (e - 16384);
            *(unsigned*)(kb + e) = cvt_pk_bf16(src[0], src[1]); } }
}

template <bool ALR>
__device__ void phase_norm(const Params& p, const float* xin, const float* nw, int shift_off, int scale_off, bf16_t* hout, unsigned char* lds) {
    const int tid = threadIdx.x, wid = tid >> 6, lane = tid & 63;
    const float* mod = (const float*)(p.ws + OFF_MOD);
    float* wat = (float*)lds;
    if (ALR) {
        for (int e = tid; e < 16384; e += 512) { const int d = e >> 4, r = e & 15; wat[r * 1024 + d] = p.w_in[(size_t)d * INW + 3072 + r]; }
        __syncthreads();
    }
    float* alr = (float*)(p.ws + OFF_ALR);
    for (int tg = blockIdx.x * 8 + wid; tg < 2048; tg += gridDim.x * 8) {
        const int b = tg >> 10;
        f32x4 w4[4], sc[4], sh[4];
#pragma unroll
        for (int i = 0; i < 4; ++i) { const int d = 256 * i + 4 * lane; w4[i] = *(const f32x4*)(nw + d);
            sc[i] = *(const f32x4*)(mod + b * 6144 + scale_off + d) + *(const f32x4*)(p.b_ada + scale_off + d) + 1.0f;
            sh[i] = *(const f32x4*)(mod + b * 6144 + shift_off + d) + *(const f32x4*)(p.b_ada + shift_off + d);
            w4[i] = w4[i] * sc[i]; }
        for (int tt = 0; tt < 8; ++tt) {
            const int t = tg * 8 + tt;
            f32x4 xv[4]; float ss = 0.f;
#pragma unroll
            for (int i = 0; i < 4; ++i) { xv[i] = *(const f32x4*)(xin + (size_t)t * DM + 256 * i + 4 * lane); ss += xv[i][0] * xv[i][0] + xv[i][1] * xv[i][1] + xv[i][2] * xv[i][2] + xv[i][3] * xv[i][3]; }
            ss = wave_sum(ss);
            const float rstd = rsqrtf(ss * (1.0f / 1024.0f) + EPS);
#pragma unroll
            for (int i = 0; i < 4; ++i) { xv[i] = xv[i] * rstd * w4[i] + sh[i];
                u32x2 w; w.x = cvt_pk_bf16(xv[i][0], xv[i][1]); w.y = cvt_pk_bf16(xv[i][2], xv[i][3]);
                *(u32x2*)(hout + (size_t)t * DM + 256 * i + 4 * lane) = w; }
            if (ALR) {
                float mine = 0.f;
#pragma unroll 2
                for (int r = 0; r < 16; ++r) { float s = 0.f;
#pragma unroll
                    for (int i = 0; i < 4; ++i) { const f32x4 wv = *(const f32x4*)(wat + r * 1024 + 256 * i + 4 * lane); s += xv[i][0] * wv[0] + xv[i][1] * wv[1] + xv[i][2] * wv[2] + xv[i][3] * wv[3]; }
                    s = wave_sum(s); mine = lane == r ? s : mine; }
                if (lane < 16) alr[(size_t)t * 16 + lane] = mine;
            }
        }
    }
}

__device__ __forceinline__ void gla_G(const Params& p, int t0, int h, float* sALR, float* sG) {
    const int tid = threadIdx.x;
    const float* alr = (const float*)(p.ws + OFF_ALR);
    if (tid < 256) *(f32x4*)(sALR + tid * 4) = *(const f32x4*)(alr + (size_t)t0 * 16 + tid * 4);
    __syncthreads();
    if (tid < 128) {
        float wup[16];
#pragma unroll
        for (int r = 0; r < 16; ++r) wup[r] = p.w_alpha_up[r * 512 + h * 128 + tid];
        const float bias = p.b_alpha[h * 128 + tid];
        float cum = 0.f;
        for (int pos = 0; pos < 64; ++pos) {
            float z = bias;
#pragma unroll
            for (int r4 = 0; r4 < 4; ++r4) { const f32x4 a = *(const f32x4*)(sALR + pos * 16 + r4 * 4); z += a[0] * wup[r4 * 4] + a[1] * wup[r4 * 4 + 1] + a[2] * wup[r4 * 4 + 2] + a[3] * wup[r4 * 4 + 3]; }
            const float ls = fminf(z, 0.f) - log1pf(__expf(-fabsf(z)));
            cum += ls * (1.0f / 16.0f);
            sG[pos * 128 + tid] = cum;
        }
    }
    __syncthreads();
}
__device__ __forceinline__ void gla_VT(const bf16_t* P, int t0, int h, bf16_t* sVT) {
    const int tid = threadIdx.x;
#pragma unroll
    for (int i = 0; i < 4; ++i) { const int task = tid + 512 * i, pos = task & 63, dg = task >> 6;
        const u32x4 w = *(const u32x4*)(P + (size_t)(t0 + pos) * PW + 1024 + h * 256 + dg * 8);
        bf16_t* d = sVT + (dg * 8) * 72 + pos;
        d[0] = (bf16_t)w.x; d[72] = (bf16_t)(w.x >> 16); d[144] = (bf16_t)w.y; d[216] = (bf16_t)(w.y >> 16);
        d[288] = (bf16_t)w.z; d[360] = (bf16_t)(w.z >> 16); d[432] = (bf16_t)w.w; d[504] = (bf16_t)(w.w >> 16); }
}

__device__ void phase_glaA(const Params& p, unsigned char* lds) {
    const int tid = threadIdx.x, wid = tid >> 6, lane = tid & 63, r = lane & 31, hh = lane >> 5;
    const bf16_t* P = (const bf16_t*)(p.ws + OFF_PROJ);
    { float* stats = (float*)(p.ws + OFF_STATS);
        for (int t = blockIdx.x * 8 + wid; t < NTOK; t += gridDim.x * 8) {
            const u32x4 a = *(const u32x4*)(P + (size_t)t * PW + 4096 + lane * 16), b = *(const u32x4*)(P + (size_t)t * PW + 4096 + lane * 16 + 8);
            float v[16] = {bflo(a.x), bfhi(a.x), bflo(a.y), bfhi(a.y), bflo(a.z), bfhi(a.z), bflo(a.w), bfhi(a.w), bflo(b.x), bfhi(b.x), bflo(b.y), bfhi(b.y), bflo(b.z), bfhi(b.z), bflo(b.w), bfhi(b.w)};
            float s = 0.f;
#pragma unroll
            for (int i = 0; i < 16; ++i) s += v[i];
            const float mean = wave_sum(s) * (1.0f / 1024.0f);
            float q = 0.f;
#pragma unroll
            for (int i = 0; i < 16; ++i) { const float d = v[i] - mean; q += d * d; }
            q = wave_sum(q);
            if (lane == 0) *(f32x2*)(stats + (size_t)t * 2) = (f32x2){mean, rsqrtf(q * (1.0f / 1024.0f) + EPS)};
        } }
    float* sALR = (float*)lds; float* sG = (float*)(lds + 4096);
    bf16_t* sKT = (bf16_t*)(lds + 36864); bf16_t* sVT = (bf16_t*)(lds + 55296);
    bf16_t* KV = (bf16_t*)p.out; float* decay = (float*)(p.ws + OFF_DECAY);
    for (int item = blockIdx.x; item < 1024; item += gridDim.x) {
        const int h = item & 3, n = (item >> 2) & 127, b = item >> 9, t0 = b * SEQ + n * 64;
        gla_G(p, t0, h, sALR, sG);
#pragma unroll
        for (int i = 0; i < 2; ++i) { const int task = tid + 512 * i, pos = task & 63, kg = task >> 6;
            const u32x4 w = *(const u32x4*)(P + (size_t)(t0 + pos) * PW + 512 + h * 128 + kg * 8);
            const unsigned ww[4] = {w.x, w.y, w.z, w.w};
            bf16_t* d = sKT + (kg * 8) * 72 + pos;
#pragma unroll
            for (int e = 0; e < 4; ++e) { const int kd = kg * 8 + 2 * e;
                const float f0 = __expf(sG[63 * 128 + kd] - sG[pos * 128 + kd]), f1 = __expf(sG[63 * 128 + kd + 1] - sG[pos * 128 + kd + 1]);
                const unsigned pk = cvt_pk_bf16(bflo(ww[e]) * f0, bfhi(ww[e]) * f1);
                d[(2 * e) * 72] = (bf16_t)pk; d[(2 * e + 1) * 72] = (bf16_t)(pk >> 16); } }
        gla_VT(P, t0, h, sVT);
        if (tid < 128) decay[item * 128 + tid] = __expf(sG[63 * 128 + tid]);
        __syncthreads();
        f32x16 acc[4];
#pragma unroll
        for (int mi = 0; mi < 4; ++mi) acc[mi] = zero16();
#pragma unroll
        for (int ks = 0; ks < 4; ++ks) {
            const bf16x8 bfr = *(const bf16x8*)(sVT + (wid * 32 + r) * 72 + ks * 16 + hh * 8);
#pragma unroll
            for (int mi = 0; mi < 4; ++mi) { const bf16x8 afr = *(const bf16x8*)(sKT + (mi * 32 + r) * 72 + ks * 16 + hh * 8); acc[mi] = MFMA32(afr, bfr, acc[mi]); }
        }
        bf16_t* dst = KV + (size_t)item * 32768 + (size_t)(wid * 32 + r) * 128;
#pragma unroll
        for (int mi = 0; mi < 4; ++mi)
#pragma unroll
            for (int g = 0; g < 4; ++g) { u32x2 w; w.x = cvt_pk_bf16(acc[mi][g * 4], acc[mi][g * 4 + 1]); w.y = cvt_pk_bf16(acc[mi][g * 4 + 2], acc[mi][g * 4 + 3]);
                *(u32x2*)(dst + mi * 32 + g * 8 + hh * 4) = w; }
        __syncthreads();
    }
}

__device__ void phase_scan_sgu(const Params& p, unsigned char* lds) {
    const int tid = threadIdx.x, wid = tid >> 6, lane = tid & 63, r = lane & 31, hh = lane >> 5;
    { unsigned* KV = (unsigned*)p.out; const float* decay = (const float*)(p.ws + OFF_DECAY);
        for (int gt = blockIdx.x * 512 + tid; gt < 131072; gt += gridDim.x * 512) {
            const int bh = gt >> 14, e = gt & 16383, kd = (e * 2) & 127, b = bh >> 2, h = bh & 3;
            float s0 = 0.f, s1 = 0.f;
            for (int n0 = 0; n0 < 128; n0 += 8) {
                unsigned w[8]; f32x2 d[8];
#pragma unroll
                for (int j = 0; j < 8; ++j) { const int item = ((b * 128 + n0 + j) << 2) + h; w[j] = KV[(size_t)item * 16384 + e]; d[j] = *(const f32x2*)(decay + item * 128 + kd); }
#pragma unroll
                for (int j = 0; j < 8; ++j) { const int item = ((b * 128 + n0 + j) << 2) + h; KV[(size_t)item * 16384 + e] = cvt_pk_bf16(s0, s1);
                    s0 = s0 * d[j].x + bflo(w[j]); s1 = s1 * d[j].y + bfhi(w[j]); }
            }
        } }
    const bf16_t* P = (const bf16_t*)(p.ws + OFF_PROJ);
    const float* stats = (const float*)(p.ws + OFF_STATS);
    bf16_t* merged = (bf16_t*)(p.ws + OFF_HB);
    bf16_t* sVT = (bf16_t*)lds;
    for (int item = blockIdx.x; item < 1024; item += gridDim.x) {
        const int g = item & 7, n = (item >> 3) & 63, b = item >> 9, t0 = b * SEQ + n * 128;
#pragma unroll
        for (int i = 0; i < 4; ++i) { const int task = tid + 512 * i, j = task & 127, cg8 = task >> 7;
            const u32x4 w = *(const u32x4*)(P + (size_t)(t0 + j) * PW + 4096 + g * 128 + cg8 * 8);
            const f32x2 st = *(const f32x2*)(stats + (size_t)(t0 + j) * 2);
            const f32x4 lw0 = *(const f32x4*)(p.sgu_ln_w + g * 128 + cg8 * 8), lw1 = *(const f32x4*)(p.sgu_ln_w + g * 128 + cg8 * 8 + 4);
            const f32x4 lb0 = *(const f32x4*)(p.sgu_ln_b + g * 128 + cg8 * 8), lb1 = *(const f32x4*)(p.sgu_ln_b + g * 128 + cg8 * 8 + 4);
            const float v[8] = {bflo(w.x), bfhi(w.x), bflo(w.y), bfhi(w.y), bflo(w.z), bfhi(w.z), bflo(w.w), bfhi(w.w)};
            bf16_t* d = sVT + (cg8 * 8) * 136 + j;
#pragma unroll
            for (int e = 0; e < 8; e += 2) { const float lw_a = e < 4 ? lw0[e] : lw1[e - 4], lw_b = e < 4 ? lw0[e + 1] : lw1[e - 3], lb_a = e < 4 ? lb0[e] : lb1[e - 4], lb_b = e < 4 ? lb0[e + 1] : lb1[e - 3];
                const unsigned pk = cvt_pk_bf16((v[e] - st.x) * st.y * lw_a + lb_a, (v[e + 1] - st.x) * st.y * lw_b + lb_b);
                d[e * 136] = (bf16_t)pk; d[(e + 1) * 136] = (bf16_t)(pk >> 16); } }
        __syncthreads();
        const int ni = wid & 3, mb = (wid >> 2) * 2, irow = ni * 32 + r;
        f32x16 acc[2] = {zero16(), zero16()};
        const float* wrow = p.sgu_w + (size_t)g * 16384 + (size_t)irow * 128;
        for (int ks = 0; ks < 2 * ni + 2; ++ks) {
            const int j0 = ks * 16 + hh * 8;
            const f32x4 wa = *(const f32x4*)(wrow + j0), wb = *(const f32x4*)(wrow + j0 + 4);
            float wv[8] = {wa[0], wa[1], wa[2], wa[3], wb[0], wb[1], wb[2], wb[3]};
#pragma unroll
            for (int e = 0; e < 8; ++e) wv[e] = (j0 + e <= irow) ? wv[e] : 0.f;
            u32x4 bw; bw.x = cvt_pk_bf16(wv[0], wv[1]); bw.y = cvt_pk_bf16(wv[2], wv[3]); bw.z = cvt_pk_bf16(wv[4], wv[5]); bw.w = cvt_pk_bf16(wv[6], wv[7]);
            const bf16x8 bfr = __builtin_bit_cast(bf16x8, bw);
#pragma unroll
            for (int mi = 0; mi < 2; ++mi) { const bf16x8 afr = *(const bf16x8*)(sVT + ((mb + mi) * 32 + r) * 136 + j0); acc[mi] = MFMA32(afr, bfr, acc[mi]); }
        }
        const float bs = p.sgu_b[g * 128 + irow];
        const size_t tok = (size_t)(t0 + irow);
#pragma unroll
        for (int mi = 0; mi < 2; ++mi)
#pragma unroll
            for (int g4 = 0; g4 < 4; ++g4) { const int c = (mb + mi) * 32 + g4 * 8 + hh * 4;
                const u32x2 ug = *(const u32x2*)(P + tok * PW + 3072 + g * 128 + c);
                u32x2 o; o.x = cvt_pk_bf16(bflo(ug.x) * (acc[mi][g4 * 4] + bs), bfhi(ug.x) * (acc[mi][g4 * 4 + 1] + bs));
                o.y = cvt_pk_bf16(bflo(ug.y) * (acc[mi][g4 * 4 + 2] + bs), bfhi(ug.y) * (acc[mi][g4 * 4 + 3] + bs));
                *(u32x2*)(merged + tok * DM + g * 128 + c) = o; }
        __syncthreads();
    }
}

__device__ void phase_glaC(const Params& p, unsigned char* lds) {
    const int tid = threadIdx.x, wid = tid >> 6, lane = tid & 63, r = lane & 31, hh = lane >> 5;
    const bf16_t* P = (const bf16_t*)(p.ws + OFF_PROJ);
    float* sALR = (float*)lds; float* sG = (float*)(lds + 4096);
    bf16_t* sQD = (bf16_t*)(lds + 36864); bf16_t* sKI = (bf16_t*)(lds + 54272); bf16_t* sVT = (bf16_t*)(lds + 71680); bf16_t* sAM = (bf16_t*)(lds + 108544); float* sSS = (float*)(lds + 117760);
    const bf16_t* ST = (const bf16_t*)p.out; bf16_t* merged = (bf16_t*)(p.ws + OFF_HB);
    for (int item = blockIdx.x; item < 1024; item += gridDim.x) {
        const int h = item & 3, n = (item >> 2) & 127, b = item >> 9, t0 = b * SEQ + n * 64;
        gla_G(p, t0, h, sALR, sG);
#pragma unroll
        for (int i = 0; i < 2; ++i) { const int task = tid + 512 * i, kg = task & 15, pos = task >> 4;
            const u32x4 qw = *(const u32x4*)(P + (size_t)(t0 + pos) * PW + h * 128 + kg * 8), kw = *(const u32x4*)(P + (size_t)(t0 + pos) * PW + 512 + h * 128 + kg * 8);
            const f32x4 g0 = *(const f32x4*)(sG + pos * 128 + kg * 8), g1 = *(const f32x4*)(sG + pos * 128 + kg * 8 + 4);
            const float gv[8] = {g0[0], g0[1], g0[2], g0[3], g1[0], g1[1], g1[2], g1[3]};
            const unsigned qq[4] = {qw.x, qw.y, qw.z, qw.w}, kk[4] = {kw.x, kw.y, kw.z, kw.w};
            unsigned qo[4], ko[4];
#pragma unroll
            for (int e = 0; e < 4; ++e) { const float e0 = __expf(gv[2 * e]), e1 = __expf(gv[2 * e + 1]);
                qo[e] = cvt_pk_bf16(bflo(qq[e]) * 0.08838834764831845f * e0, bfhi(qq[e]) * 0.08838834764831845f * e1);
                ko[e] = cvt_pk_bf16(bflo(kk[e]) * __builtin_amdgcn_rcpf(e0), bfhi(kk[e]) * __builtin_amdgcn_rcpf(e1)); }
            *(u32x4*)(sQD + pos * 136 + kg * 8) = (u32x4){qo[0], qo[1], qo[2], qo[3]};
            *(u32x4*)(sKI + pos * 136 + kg * 8) = (u32x4){ko[0], ko[1], ko[2], ko[3]}; }
        gla_VT(P, t0, h, sVT);
        __syncthreads();
        if (wid < 4) { const int mj = wid >> 1, nI = wid & 1;
            f32x16 a = zero16();
            if (mj <= nI) {
#pragma unroll
                for (int ks = 0; ks < 8; ++ks) { const bf16x8 afr = *(const bf16x8*)(sKI + (mj * 32 + r) * 136 + ks * 16 + hh * 8), bfr = *(const bf16x8*)(sQD + (nI * 32 + r) * 136 + ks * 16 + hh * 8); a = MFMA32(afr, bfr, a); } }
            const int i = nI * 32 + r;
#pragma unroll
            for (int g = 0; g < 4; ++g) { const int j = mj * 32 + g * 8 + hh * 4;
                u32x2 w; w.x = cvt_pk_bf16(j <= i ? a[g * 4] : 0.f, j + 1 <= i ? a[g * 4 + 1] : 0.f); w.y = cvt_pk_bf16(j + 2 <= i ? a[g * 4 + 2] : 0.f, j + 3 <= i ? a[g * 4 + 3] : 0.f);
                *(u32x2*)(sAM + i * 72 + j) = w; } }
        __syncthreads();
        const int nI = wid & 1, mb = (wid >> 1) * 2, i = nI * 32 + r;
        f32x16 acc[2] = {zero16(), zero16()};
        const bf16_t* Sg = ST + (size_t)item * 32768;
#pragma unroll
        for (int ks = 0; ks < 8; ++ks) { const bf16x8 bfr = *(const bf16x8*)(sQD + i * 136 + ks * 16 + hh * 8);
#pragma unroll
            for (int mi = 0; mi < 2; ++mi) { const bf16x8 afr = *(const bf16x8*)(Sg + (size_t)((mb + mi) * 32 + r) * 128 + ks * 16 + hh * 8); acc[mi] = MFMA32(afr, bfr, acc[mi]); } }
        for (int ks = 0; ks < 2 * nI + 2; ++ks) { const bf16x8 bfr = *(const bf16x8*)(sAM + i * 72 + ks * 16 + hh * 8);
#pragma unroll
            for (int mi = 0; mi < 2; ++mi) { const bf16x8 afr = *(const bf16x8*)(sVT + ((mb + mi) * 32 + r) * 72 + ks * 16 + hh * 8); acc[mi] = MFMA32(afr, bfr, acc[mi]); } }
        float ss = 0.f;
#pragma unroll
        for (int mi = 0; mi < 2; ++mi)
#pragma unroll
            for (int e = 0; e < 16; ++e) ss += acc[mi][e] * acc[mi][e];
        ss += __shfl_xor(ss, 32);
        if (hh == 0) sSS[(wid >> 1) * 64 + i] = ss;
        __syncthreads();
        const float tot = sSS[i] + sSS[64 + i] + sSS[128 + i] + sSS[192 + i];
        const float rstd = rsqrtf(tot * (1.0f / 256.0f) + EPS);
        const size_t tok = (size_t)(t0 + i);
#pragma unroll
        for (int mi = 0; mi < 2; ++mi)
#pragma unroll
            for (int g4 = 0; g4 < 4; ++g4) { const int ch = h * 256 + (mb + mi) * 32 + g4 * 8 + hh * 4;
                const f32x4 nwv = *(const f32x4*)(p.gla_norm_w + ch);
                const u32x2 rg = *(const u32x2*)(P + tok * PW + 2048 + ch), mg = *(const u32x2*)(merged + tok * DM + ch);
                u32x2 o; o.x = cvt_pk_bf16(acc[mi][g4 * 4] * rstd * nwv[0] * bflo(rg.x) + bflo(mg.x), acc[mi][g4 * 4 + 1] * rstd * nwv[1] * bfhi(rg.x) + bfhi(mg.x));
                o.y = cvt_pk_bf16(acc[mi][g4 * 4 + 2] * rstd * nwv[2] * bflo(rg.y) + bflo(mg.y), acc[mi][g4 * 4 + 3] * rstd * nwv[3] * bfhi(rg.y) + bfhi(mg.y));
                *(u32x2*)(merged + tok * DM + ch) = o; }
        __syncthreads();
    }
}

__device__ void phase_tables(const Params& p) {
    bf16_t* db = (bf16_t*)(p.ws + OFF_DOWN); bf16_t* ub = (bf16_t*)(p.ws + OFF_UP);
    for (size_t e = ((size_t)blockIdx.x * 512 + threadIdx.x) * 8; e < (size_t)16384 * 1024; e += (size_t)gridDim.x * 4096) {
        { const f32x4 a = __builtin_nontemporal_load((const f32x4*)(p.down + e)), b = __builtin_nontemporal_load((const f32x4*)(p.down + e + 4));
            u32x4 w; w.x = cvt_pk_bf16(a[0], a[1]); w.y = cvt_pk_bf16(a[2], a[3]); w.z = cvt_pk_bf16(b[0], b[1]); w.w = cvt_pk_bf16(b[2], b[3]); *(u32x4*)(db + e) = w; }
        { const f32x4 a = __builtin_nontemporal_load((const f32x4*)(p.up + e)), b = __builtin_nontemporal_load((const f32x4*)(p.up + e + 4));
            u32x4 w; w.x = cvt_pk_bf16(a[0], a[1]); w.y = cvt_pk_bf16(a[2], a[3]); w.z = cvt_pk_bf16(b[0], b[1]); w.w = cvt_pk_bf16(b[2], b[3]); *(u32x4*)(ub + e) = w; }
    }
}

#define INS16(L, xin) do { float _x = (xin); _Pragma("unroll") for (int _p = 0; _p < 16; ++_p) { const float _hi = fmaxf(L[_p], _x); _x = fminf(L[_p], _x); L[_p] = _hi; } } while (0)
__device__ void phase_topk(const Params& p, unsigned char* lds) {
    const int tid = threadIdx.x, wid = tid >> 6, lane = tid & 63, r = lane & 31, hh = lane >> 5;
    const bf16_t* qp = (const bf16_t*)(p.ws + OFF_QP); const bf16_t* keysb = (const bf16_t*)(p.ws + OFF_KEYS);
    int* idxo = (int*)(p.ws + OFF_IDX); float* go = (float*)(p.ws + OFF_G);
    float* myrows = (float*)lds + wid * 32 * 129;
    const float NEG = -__builtin_inff();
    for (int tile = blockIdx.x; tile < 256; tile += gridDim.x) {
        const int tokb = tile * 64 + (wid & 1) * 32;
        float v1[16], v2[16];
#pragma unroll
        for (int j = 0; j < 16; ++j) { v1[j] = NEG; v2[j] = NEG; }
#pragma unroll 1
        for (int pass = 0; pass < 4; ++pass) {
            const int half = pass >> 1, hg = pass & 1, head = hg * 4 + (wid >> 1);
            f32x16 acc[4] = {zero16(), zero16(), zero16(), zero16()};
            const bf16_t* arow = qp + (size_t)(tokb + r) * 2048 + head * 256 + half * 128 + 8 * hh;
            const bf16_t* kb = keysb + half * 16384 + r * 128 + 8 * hh;
#pragma unroll
            for (int ks = 0; ks < 8; ++ks) { const bf16x8 a = *(const bf16x8*)(arow + 16 * ks);
#pragma unroll
                for (int nt = 0; nt < 4; ++nt) { const bf16x8 bb = *(const bf16x8*)(kb + nt * 32 * 128 + 16 * ks); acc[nt] = MFMA32(a, bb, acc[nt]); } }
#pragma unroll
            for (int nt = 0; nt < 4; ++nt)
#pragma unroll
                for (int e = 0; e < 16; ++e) { const int m = (e & 3) + 8 * (e >> 2) + 4 * hh; myrows[m * 129 + nt * 32 + r] = acc[nt][e]; }
            asm volatile("s_waitcnt lgkmcnt(0)" ::: "memory"); __builtin_amdgcn_wave_barrier();
            float L[16];
#pragma unroll
            for (int j = 0; j < 16; ++j) L[j] = NEG;
            const float* rowp = myrows + r * 129 + hh * 64;
#pragma unroll 4
            for (int k = 0; k < 64; ++k) { const unsigned bits = (__float_as_uint(rowp[k]) & ~127u) | (unsigned)(127 - (hh * 64 + k)); INS16(L, __uint_as_float(bits)); }
            float O[16];
#pragma unroll
            for (int j = 0; j < 16; ++j) O[j] = __shfl_xor(L[j], 32);
#pragma unroll
            for (int j = 0; j < 16; ++j) INS16(L, O[j]);
            const bool mine = hh == hg;
            if (half == 0) {
#pragma unroll
                for (int j = 0; j < 16; ++j) v1[j] = mine ? L[j] : v1[j];
            } else {
#pragma unroll
                for (int j = 0; j < 16; ++j) v2[j] = mine ? L[j] : v2[j];
            }
            asm volatile("s_waitcnt lgkmcnt(0)" ::: "memory"); __builtin_amdgcn_wave_barrier();
        }
        float T[16]; int TI[16];
#pragma unroll
        for (int j = 0; j < 16; ++j) { T[j] = NEG; TI[j] = 0; }
#pragma unroll
        for (int a = 0; a < 16; ++a)
#pragma unroll
            for (int b = 0; b < 16; ++b)
                if ((a + 1) * (b + 1) <= 16) {
                    float s = v1[a] + v2[b]; int id = (127 - (int)(__float_as_uint(v1[a]) & 127u)) * 128 + (127 - (int)(__float_as_uint(v2[b]) & 127u));
#pragma unroll
                    for (int q = 0; q < 16; ++q) { const bool c = s > T[q]; const float ts = c ? T[q] : s; const int ti = c ? TI[q] : id; T[q] = c ? s : T[q]; TI[q] = c ? id : TI[q]; s = ts; id = ti; }
                }
        const int token = tokb + r, head = hh * 4 + (wid >> 1);
        const float t0v = T[0]; float tot = 0.f;
#pragma unroll
        for (int j = 0; j < 16; ++j) { T[j] = __expf(T[j] - t0v); tot += T[j]; }
        const float inv = 1.0f / tot;
#pragma unroll
        for (int j = 0; j < 16; j += 4) { *(f32x4*)(go + (size_t)token * 128 + head * 16 + j) = (f32x4){T[j] * inv, T[j + 1] * inv, T[j + 2] * inv, T[j + 3] * inv};
            *(int4*)(idxo + (size_t)token * 128 + head * 16 + j) = make_int4(TI[j], TI[j + 1], TI[j + 2], TI[j + 3]); }
    }
}

__device__ void phase_peer(const Params& p, unsigned char* lds) {
    const int tid = threadIdx.x, wid = tid >> 6, lane = tid & 63, l16 = lane & 15, q4 = lane >> 4;
    const bf16_t* h2 = (const bf16_t*)(p.ws + OFF_H2); const bf16_t* db = (const bf16_t*)(p.ws + OFF_DOWN); const bf16_t* ub = (const bf16_t*)(p.ws + OFF_UP);
    const int* idxo = (const int*)(p.ws + OFF_IDX); const float* go = (const float*)(p.ws + OFF_G);
    const float* mod = (const float*)(p.ws + OFF_MOD);
    float* sga = (float*)lds + wid * 128;
    for (int tg = blockIdx.x * 8 + wid; tg < 2048; tg += gridDim.x * 8) {
        const int b = tg >> 10;
        for (int tt = 0; tt < 8; ++tt) {
            const int t = tg * 8 + tt;
            const int idA = idxo[(size_t)t * 128 + lane], idB = idxo[(size_t)t * 128 + 64 + lane];
            const float gA = go[(size_t)t * 128 + lane], gB = go[(size_t)t * 128 + 64 + lane];
            u32x4 hq[8];
#pragma unroll
            for (int i = 0; i < 8; ++i) hq[i] = *(const u32x4*)(h2 + (size_t)t * DM + i * 128 + l16 * 8);
#pragma unroll 2
            for (int s = 0; s < 32; ++s) {
                const int slot = 4 * s + q4;
                const int e = __shfl(s < 16 ? idA : idB, slot & 63);
                const bf16_t* row = db + (size_t)e * DM + l16 * 8;
                u32x4 w[8];
#pragma unroll
                for (int i = 0; i < 8; ++i) w[i] = *(const u32x4*)(row + i * 128);
                float a = 0.f;
#pragma unroll
                for (int i = 0; i < 8; ++i) {
                    a = dot2bf(w[i].x, hq[i].x, a); a = dot2bf(w[i].y, hq[i].y, a); a = dot2bf(w[i].z, hq[i].z, a); a = dot2bf(w[i].w, hq[i].w, a); }
                a += __shfl_xor(a, 8); a += __shfl_xor(a, 4); a += __shfl_xor(a, 2); a += __shfl_xor(a, 1);
                const float gg = __shfl(s < 16 ? gA : gB, slot & 63);
                if (l16 == 0) sga[slot] = gelu1(a) * gg;
            }
            asm volatile("s_waitcnt lgkmcnt(0)" ::: "memory"); __builtin_amdgcn_wave_barrier();
            float acc[16];
#pragma unroll
            for (int j = 0; j < 16; ++j) acc[j] = 0.f;
#pragma unroll 4
            for (int slot = 0; slot < 128; ++slot) {
                const int e = __builtin_amdgcn_readlane(slot < 64 ? idA : idB, slot & 63);
                const float ga = sga[slot];
                const bf16_t* row = ub + (size_t)e * DM + lane * 8;
                const u32x4 w0 = *(const u32x4*)row, w1 = *(const u32x4*)(row + 512);
                acc[0] += ga * bflo(w0.x); acc[1] += ga * bfhi(w0.x); acc[2] += ga * bflo(w0.y); acc[3] += ga * bfhi(w0.y);
                acc[4] += ga * bflo(w0.z); acc[5] += ga * bfhi(w0.z); acc[6] += ga * bflo(w0.w); acc[7] += ga * bfhi(w0.w);
                acc[8] += ga * bflo(w1.x); acc[9] += ga * bfhi(w1.x); acc[10] += ga * bflo(w1.y); acc[11] += ga * bfhi(w1.y);
                acc[12] += ga * bflo(w1.z); acc[13] += ga * bfhi(w1.z); acc[14] += ga * bflo(w1.w); acc[15] += ga * bfhi(w1.w);
            }
            asm volatile("s_waitcnt lgkmcnt(0)" ::: "memory"); __builtin_amdgcn_wave_barrier();
            float xo[16]; float ss = 0.f;
#pragma unroll
            for (int i = 0; i < 2; ++i)
#pragma unroll
                for (int j4 = 0; j4 < 2; ++j4) { const int d = i * 512 + lane * 8 + j4 * 4;
                    const f32x4 xv = *(const f32x4*)(p.out + (size_t)t * DM + d);
                    const f32x4 g2 = *(const f32x4*)(mod + b * 6144 + 5120 + d) + *(const f32x4*)(p.b_ada + 5120 + d);
#pragma unroll
                    for (int j = 0; j < 4; ++j) { const float v = xv[j] + g2[j] * acc[i * 8 + j4 * 4 + j]; xo[i * 8 + j4 * 4 + j] = v; ss += v * v; } }
            ss = wave_sum(ss);
            const float rstd = rsqrtf(ss * (1.0f / 1024.0f) + EPS);
#pragma unroll
            for (int i = 0; i < 2; ++i)
#pragma unroll
                for (int j4 = 0; j4 < 2; ++j4) { const int d = i * 512 + lane * 8 + j4 * 4;
                    const f32x4 fw = *(const f32x4*)(p.final_w + d);
                    *(f32x4*)(p.out + (size_t)t * DM + d) = (f32x4){xo[i * 8 + j4 * 4] * rstd * fw[0], xo[i * 8 + j4 * 4 + 1] * rstd * fw[1], xo[i * 8 + j4 * 4 + 2] * rstd * fw[2], xo[i * 8 + j4 * 4 + 3] * rstd * fw[3]}; }
        }
    }
}

__device__ void phase_tables8(const Params& p) {
    const int wid = threadIdx.x >> 6, lane = threadIdx.x & 63;
    for (int row = blockIdx.x * 8 + wid; row < 32768; row += gridDim.x * 8) {
        const bool isup = row >= 16384; const int e = row & 16383;
        const float* src = (isup ? p.up : p.down) + (size_t)e * DM + lane * 16;
        f32x4 v[4]; float m = 0.f;
#pragma unroll
        for (int i = 0; i < 4; ++i) { v[i] = __builtin_nontemporal_load((const f32x4*)(src + 4 * i)); m = fmaxf(m, fmaxf(fmaxf(fabsf(v[i][0]), fabsf(v[i][1])), fmaxf(fabsf(v[i][2]), fabsf(v[i][3])))); }
#pragma unroll
        for (int o = 32; o; o >>= 1) m = fmaxf(m, __shfl_xor(m, o));
        const float sc = m > 0.f ? m * (1.0f / 224.0f) : 1.0f, inv = m > 0.f ? 224.0f / m : 0.f;
        int w[4];
#pragma unroll
        for (int i = 0; i < 4; ++i) { w[i] = __builtin_amdgcn_cvt_pk_fp8_f32(v[i][0] * inv, v[i][1] * inv, 0, false); w[i] = __builtin_amdgcn_cvt_pk_fp8_f32(v[i][2] * inv, v[i][3] * inv, w[i], true); }
        unsigned char* dst = p.ws + (isup ? OFF_UP8 : OFF_DOWN8) + (size_t)e * 1024 + lane * 16;
        *(u32x4*)dst = (u32x4){(unsigned)w[0], (unsigned)w[1], (unsigned)w[2], (unsigned)w[3]};
        if (lane == 0) ((float*)(p.ws + (isup ? OFF_SCU : OFF_SCD)))[e] = sc;
    }
}

__device__ __forceinline__ float dot2bfv(bf16x2_t a, unsigned b, float c) { return __builtin_amdgcn_fdot2_f32_bf16(a, __builtin_bit_cast(bf16x2_t, b), c, false); }
#define PEER_FMA16(ACC, W, GA) do { \
    const f32x2 _a0 = __builtin_amdgcn_cvt_pk_f32_fp8((int)(W).x, false), _a1 = __builtin_amdgcn_cvt_pk_f32_fp8((int)(W).x, true); \
    const f32x2 _b0 = __builtin_amdgcn_cvt_pk_f32_fp8((int)(W).y, false), _b1 = __builtin_amdgcn_cvt_pk_f32_fp8((int)(W).y, true); \
    const f32x2 _c0 = __builtin_amdgcn_cvt_pk_f32_fp8((int)(W).z, false), _c1 = __builtin_amdgcn_cvt_pk_f32_fp8((int)(W).z, true); \
    const f32x2 _d0 = __builtin_amdgcn_cvt_pk_f32_fp8((int)(W).w, false), _d1 = __builtin_amdgcn_cvt_pk_f32_fp8((int)(W).w, true); \
    ACC[0] += (GA) * _a0.x; ACC[1] += (GA) * _a0.y; ACC[2] += (GA) * _a1.x; ACC[3] += (GA) * _a1.y; \
    ACC[4] += (GA) * _b0.x; ACC[5] += (GA) * _b0.y; ACC[6] += (GA) * _b1.x; ACC[7] += (GA) * _b1.y; \
    ACC[8] += (GA) * _c0.x; ACC[9] += (GA) * _c0.y; ACC[10] += (GA) * _c1.x; ACC[11] += (GA) * _c1.y; \
    ACC[12] += (GA) * _d0.x; ACC[13] += (GA) * _d0.y; ACC[14] += (GA) * _d1.x; ACC[15] += (GA) * _d1.y; } while (0)
__device__ void phase_peer2(const Params& p, unsigned char* lds) {
    const int tid = threadIdx.x, wid = tid >> 6, lane = tid & 63, l16 = lane & 15, q4 = lane >> 4;
    unsigned char* wl = lds + wid * 12288;
    int* se = (int*)wl;
    float* sg = (float*)(wl + 2048);
    unsigned char* hl = wl + 4096;
    const unsigned char* d8 = p.ws + OFF_DOWN8; const unsigned char* u8 = p.ws + OFF_UP8;
    const float* scd = (const float*)(p.ws + OFF_SCD); const float* scu = (const float*)(p.ws + OFF_SCU);
    const bf16_t* h2 = (const bf16_t*)(p.ws + OFF_H2);
    const int* idxo = (const int*)(p.ws + OFF_IDX); const float* go = (const float*)(p.ws + OFF_G);
    const float* mod = (const float*)(p.ws + OFF_MOD);
    const unsigned long long ltmask = (1ull << lane) - 1ull;
    for (int blk = blockIdx.x; blk < 512; blk += gridDim.x) {
        const int tok0 = blk * 32 + wid * 4; const int b = tok0 >> 13;
        {
            int ids[8]; float gs[8];
#pragma unroll
            for (int tk = 0; tk < 4; ++tk) { const size_t o = (size_t)(tok0 + tk) * 128 + lane; ids[2 * tk] = idxo[o]; ids[2 * tk + 1] = idxo[o + 64]; gs[2 * tk] = go[o]; gs[2 * tk + 1] = go[o + 64];
#pragma unroll
                for (int hb = 0; hb < 2; ++hb) { const int c = lane + 64 * hb, cp = (c >> 1) | ((c & 1) << 6);
                    *(u32x4*)(hl + tk * 2048 + cp * 16) = *(const u32x4*)(h2 + (size_t)(tok0 + tk) * DM + c * 8); } }
            int base = 0;
#pragma unroll
            for (int r = 0; r < 8; ++r)
#pragma unroll
                for (int k = 0; k < 8; ++k) { const bool m = (ids[k] >> 11) == r; const unsigned long long mk = __ballot(m);
                    if (m) { const int pos = base + __popcll(mk & ltmask); se[pos] = ids[k] | ((k >> 1) << 16); sg[pos] = gs[k]; }
                    base += __popcll(mk); }
        }
        asm volatile("s_waitcnt lgkmcnt(0)" ::: "memory"); __builtin_amdgcn_wave_barrier();
        {
            u32x4 bufA[8], bufB[8]; float sdA[2], suA[2], sdB[2], suB[2];
#define PEER_DLOAD(BUF, SD, SU, K) do { _Pragma("unroll") for (int _u = 0; _u < 2; ++_u) { const int _e = se[8 * (K) + 4 * _u + q4] & 0xffff; const unsigned char* _row = d8 + (size_t)_e * 1024 + l16 * 16; \
            _Pragma("unroll") for (int _i = 0; _i < 4; ++_i) BUF[_u * 4 + _i] = *(const u32x4*)(_row + _i * 256); SD[_u] = scd[_e]; SU[_u] = scu[_e]; } } while (0)
#define PEER_DCOMP(BUF, SD, SU, K) do { _Pragma("unroll") for (int _u = 0; _u < 2; ++_u) { const int _ix = 8 * (K) + 4 * _u + q4; const int _tk = se[_ix] >> 16; const unsigned char* _hb = hl + _tk * 2048 + l16 * 16; float _a = 0.f; \
            _Pragma("unroll") for (int _i = 0; _i < 4; ++_i) { const u32x4 _h0 = *(const u32x4*)(_hb + _i * 256), _h1 = *(const u32x4*)(_hb + 1024 + _i * 256); const u32x4 _w = BUF[_u * 4 + _i]; \
                _a = dot2bfv(__builtin_amdgcn_cvt_scalef32_pk_bf16_fp8((int)_w.x, 1.0f, false), _h0.x, _a); _a = dot2bfv(__builtin_amdgcn_cvt_scalef32_pk_bf16_fp8((int)_w.x, 1.0f, true), _h0.y, _a); \
                _a = dot2bfv(__builtin_amdgcn_cvt_scalef32_pk_bf16_fp8((int)_w.y, 1.0f, false), _h0.z, _a); _a = dot2bfv(__builtin_amdgcn_cvt_scalef32_pk_bf16_fp8((int)_w.y, 1.0f, true), _h0.w, _a); \
                _a = dot2bfv(__builtin_amdgcn_cvt_scalef32_pk_bf16_fp8((int)_w.z, 1.0f, false), _h1.x, _a); _a = dot2bfv(__builtin_amdgcn_cvt_scalef32_pk_bf16_fp8((int)_w.z, 1.0f, true), _h1.y, _a); \
                _a = dot2bfv(__builtin_amdgcn_cvt_scalef32_pk_bf16_fp8((int)_w.w, 1.0f, false), _h1.z, _a); _a = dot2bfv(__builtin_amdgcn_cvt_scalef32_pk_bf16_fp8((int)_w.w, 1.0f, true), _h1.w, _a); } \
            _a += __shfl_xor(_a, 8); _a += __shfl_xor(_a, 4); _a += __shfl_xor(_a, 2); _a += __shfl_xor(_a, 1); \
            const float _g = sg[_ix]; if (l16 == 0) sg[_ix] = gelu1(_a * SD[_u]) * _g * SU[_u]; } } while (0)
            PEER_DLOAD(bufA, sdA, suA, 0);
            for (int k = 0; k < 64; k += 2) {
                PEER_DLOAD(bufB, sdB, suB, k + 1);
                PEER_DCOMP(bufA, sdA, suA, k);
                if (k + 2 < 64) PEER_DLOAD(bufA, sdA, suA, k + 2);
                PEER_DCOMP(bufB, sdB, suB, k + 1);
            }
#undef PEER_DLOAD
#undef PEER_DCOMP
        }
        asm volatile("s_waitcnt lgkmcnt(0)" ::: "memory"); __builtin_amdgcn_wave_barrier();
        float acc0[16], acc1[16], acc2[16], acc3[16];
#pragma unroll
        for (int j = 0; j < 16; ++j) { acc0[j] = 0.f; acc1[j] = 0.f; acc2[j] = 0.f; acc3[j] = 0.f; }
        {
            u32x4 ring[8];
#pragma unroll
            for (int j = 0; j < 8; ++j) ring[j] = *(const u32x4*)(u8 + (size_t)(se[j] & 0xffff) * 1024 + lane * 16);
            for (int i = 0; i < 512; i += 8) {
#pragma unroll
                for (int j = 0; j < 8; ++j) {
                    const int tk = __builtin_amdgcn_readfirstlane(se[i + j]) >> 16; const float ga = sg[i + j];
                    const u32x4 w = ring[j];
                    if (i + 8 < 512) ring[j] = *(const u32x4*)(u8 + (size_t)(se[i + 8 + j] & 0xffff) * 1024 + lane * 16);
                    if (tk == 0) PEER_FMA16(acc0, w, ga); else if (tk == 1) PEER_FMA16(acc1, w, ga); else if (tk == 2) PEER_FMA16(acc2, w, ga); else PEER_FMA16(acc3, w, ga);
                }
            }
        }
        asm volatile("s_waitcnt lgkmcnt(0)" ::: "memory"); __builtin_amdgcn_wave_barrier();
#define PEER_FIN(ACC, TK) do { const size_t _o = (size_t)(tok0 + (TK)) * DM + lane * 16; f32x4 _x[4]; float _ss = 0.f; \
        _Pragma("unroll") for (int _j = 0; _j < 4; ++_j) { const f32x4 _xv = *(const f32x4*)(p.out + _o + 4 * _j); const f32x4 _g2 = *(const f32x4*)(mod + b * 6144 + 5120 + lane * 16 + 4 * _j) + *(const f32x4*)(p.b_ada + 5120 + lane * 16 + 4 * _j); \
            _x[_j] = _xv + _g2 * (f32x4){ACC[4 * _j], ACC[4 * _j + 1], ACC[4 * _j + 2], ACC[4 * _j + 3]}; _ss += _x[_j][0] * _x[_j][0] + _x[_j][1] * _x[_j][1] + _x[_j][2] * _x[_j][2] + _x[_j][3] * _x[_j][3]; } \
        _ss = wave_sum(_ss); const float _rs = rsqrtf(_ss * (1.0f / 1024.0f) + EPS); \
        _Pragma("unroll") for (int _j = 0; _j < 4; ++_j) { const f32x4 _fw = *(const f32x4*)(p.final_w + lane * 16 + 4 * _j); *(f32x4*)(p.out + _o + 4 * _j) = _x[_j] * _rs * _fw; } } while (0)
        PEER_FIN(acc0, 0); PEER_FIN(acc1, 1); PEER_FIN(acc2, 2); PEER_FIN(acc3, 3);
#undef PEER_FIN
    }
}

#ifndef DBG_STAGE
#define DBG_STAGE 0
#endif
__device__ void phase_final_only(const Params& p) {
    const int wid = threadIdx.x >> 6, lane = threadIdx.x & 63;
    for (int t = blockIdx.x * 8 + wid; t < NTOK; t += gridDim.x * 8) {
        f32x4 xv[4]; float ss = 0.f;
#pragma unroll
        for (int i = 0; i < 4; ++i) { xv[i] = *(const f32x4*)(p.out + (size_t)t * DM + 256 * i + 4 * lane); ss += xv[i][0] * xv[i][0] + xv[i][1] * xv[i][1] + xv[i][2] * xv[i][2] + xv[i][3] * xv[i][3]; }
        ss = wave_sum(ss);
        const float rstd = rsqrtf(ss * (1.0f / 1024.0f) + EPS);
#pragma unroll
        for (int i = 0; i < 4; ++i) { const f32x4 fw = *(const f32x4*)(p.final_w + 256 * i + 4 * lane); *(f32x4*)(p.out + (size_t)t * DM + 256 * i + 4 * lane) = xv[i] * rstd * fw; }
    }
}

__device__ void phase_dump_bf16(const Params& p, const bf16_t* src, int ld) {
    for (size_t e = (size_t)blockIdx.x * 512 + threadIdx.x; e < (size_t)NTOK * DM; e += (size_t)gridDim.x * 512) {
        const size_t t = e >> 10, d = e & 1023; float v = __uint_as_float((unsigned)src[t * ld + d] << 16); if (!(fabsf(v) < 1e30f)) v = 1000.f; p.out[e] = v; }
}
__device__ void dbg_check_bf16(const Params& p, const bf16_t* src, size_t n, unsigned bit) {
    unsigned* flags = (unsigned*)(p.ws + OFF_IDX);
    bool bad = false;
    for (size_t e = (size_t)blockIdx.x * 512 + threadIdx.x; e < n; e += (size_t)gridDim.x * 512) { const float v = __uint_as_float((unsigned)src[e] << 16); if (!(fabsf(v) < 1e30f)) bad = true; }
    if (bad) atomicOr(flags, bit);
}
__device__ void dbg_check_f32(const Params& p, const float* src, size_t n, unsigned bit, float lim) {
    unsigned* flags = (unsigned*)(p.ws + OFF_IDX);
    bool bad = false;
    for (size_t e = (size_t)blockIdx.x * 512 + threadIdx.x; e < n; e += (size_t)gridDim.x * 512) { const float v = src[e]; if (!(fabsf(v) < lim)) bad = true; }
    if (bad) atomicOr(flags, bit);
}
__device__ void dbg_final(const Params& p) {
    const unsigned f = *(const unsigned*)(p.ws + OFF_IDX);
    for (size_t e = (size_t)blockIdx.x * 512 + threadIdx.x; e < (size_t)NTOK * DM; e += (size_t)gridDim.x * 512) p.out[e] = p.x[e] * (1.0f + (float)f);
}
#define GSYNC() xcd_barrier(xb)
__global__ void __launch_bounds__(512, 2) fwd_megakernel(Params p) {
    extern __shared__ __attribute__((aligned(16))) unsigned char lds[];
    cg::grid_group grid = cg::this_grid();
    LAS unsigned char* lds3 = (LAS unsigned char*)lds;
    const float* mod = (const float*)(p.ws + OFF_MOD);
    volatile LAS unsigned* xst = (volatile LAS unsigned*)(lds3 + LDS_BYTES - 16);
    if (threadIdx.x == 0) { xst[0] = 0u; xst[1] = 0u; }
    __syncthreads();
    const XcdBarrier xb = xcd_barrier_post((unsigned*)(p.ws + OFF_BAR), xst);
    if (p.ws == nullptr) grid.sync();
    phase0(p, lds);
#if DBG_STAGE == 6
    if (blockIdx.x == 0 && threadIdx.x == 0) *(unsigned*)(p.ws + OFF_IDX) = 0u;
#endif
    GSYNC();
    phase_norm<true>(p, p.x, p.norm1_w, 0, 1024, (bf16_t*)(p.ws + OFF_HB), lds);
    GSYNC();
#if DBG_STAGE == 3
    phase_dump_bf16(p, (const bf16_t*)(p.ws + OFF_HB), DM); return;
#endif
    { pg8::StaticOrder S; S.init(NTOK, 7168, gridDim.x, blockIdx.x); EpiProj E{(bf16_t*)(p.ws + OFF_PROJ)};
        pg8::gemm_phase(lds3, pg8::Gemm{(const bf16_t*)(p.ws + OFF_HB), (const bf16_t*)(p.ws + OFF_WINT), NTOK, 7168, 1024}, S, E); }
    GSYNC();
#if DBG_STAGE == 2
    phase_dump_bf16(p, (const bf16_t*)(p.ws + OFF_PROJ) + 1024, PW); return;
#endif
    phase_glaA(p, lds);
    GSYNC();
#if DBG_STAGE == 6
    dbg_check_bf16(p, (const bf16_t*)p.out, (size_t)NTOK * 2048, 1u);
    dbg_check_f32(p, (const float*)(p.ws + OFF_ALR), (size_t)NTOK * 16, 8u, 50.f);
    dbg_check_f32(p, (const float*)(p.ws + OFF_DECAY), (size_t)1024 * 128, 16u, 1.0001f);
#endif
    phase_scan_sgu(p, lds);
    GSYNC();
#if DBG_STAGE == 6
    dbg_check_bf16(p, (const bf16_t*)p.out, (size_t)NTOK * 2048, 2u);
#endif
#if DBG_STAGE == 4
    phase_dump_bf16(p, (const bf16_t*)(p.ws + OFF_HB), DM); return;
#endif
    phase_glaC(p, lds);
    GSYNC();
#if DBG_STAGE == 5
    phase_dump_bf16(p, (const bf16_t*)(p.ws + OFF_HB), DM); return;
#endif
#if DBG_STAGE == 6
    dbg_check_bf16(p, (const bf16_t*)(p.ws + OFF_HB), (size_t)NTOK * DM, 4u);
    GSYNC();
    dbg_final(p); return;
#endif
    { pg8::StaticOrder S; S.init(NTOK, 1024, gridDim.x, blockIdx.x); EpiX1 E{p.x, p.out, mod, p.b_ada};
        pg8::gemm_phase(lds3, pg8::Gemm{(const bf16_t*)(p.ws + OFF_HB), (const bf16_t*)(p.ws + OFF_WOUTT), NTOK, 1024, 1024}, S, E); }
    GSYNC();
#if DBG_STAGE == 1
    phase_final_only(p); return;
#endif
    phase_norm<false>(p, p.out, p.norm2_w, 3072, 4096, (bf16_t*)(p.ws + OFF_H2), lds);
    phase_tables8(p);
    GSYNC();
    { pg8::StaticOrder S; S.init(NTOK, 2048, gridDim.x, blockIdx.x); EpiQ E{(bf16_t*)(p.ws + OFF_QP)};
        pg8::gemm_phase(lds3, pg8::Gemm{(const bf16_t*)(p.ws + OFF_H2), (const bf16_t*)(p.ws + OFF_WQT), NTOK, 2048, 1024}, S, E); }
    GSYNC();
    phase_topk(p, lds);
    GSYNC();
    phase_peer2(p, lds);
}

extern "C" void kernel_launch(void* const* d_in, const int* in_sizes, int n_in, void* d_out, int out_size, void* d_ws, size_t ws_size, hipStream_t stream) {
    static int grid_blocks = 0;
    if (!grid_blocks) {
        int dev = 0, cus = 0, per_cu = 0;
        hipGetDevice(&dev);
        hipDeviceGetAttribute(&cus, hipDeviceAttributeMultiprocessorCount, dev);
        hipFuncSetAttribute((const void*)fwd_megakernel, hipFuncAttributeMaxDynamicSharedMemorySize, LDS_BYTES);
        hipOccupancyMaxActiveBlocksPerMultiprocessor(&per_cu, (const void*)fwd_megakernel, 512, LDS_BYTES);
        if (per_cu < 1) per_cu = 1;
        grid_blocks = cus * per_cu;
        if (ws_size < WS_END) fprintf(stderr, "kernel_launch: workspace too small (%zu < %zu)\n", ws_size, (size_t)WS_END);
    }
    Params p{};
    p.x = (const float*)d_in[0]; p.c = (const float*)d_in[1]; p.w_ada = (const float*)d_in[2]; p.b_ada = (const float*)d_in[3]; p.norm1_w = (const float*)d_in[4];
    p.w_in = (const float*)d_in[5]; p.w_alpha_up = (const float*)d_in[6]; p.b_alpha = (const float*)d_in[7]; p.gla_norm_w = (const float*)d_in[8];
    p.sgu_ln_w = (const float*)d_in[9]; p.sgu_ln_b = (const float*)d_in[10]; p.sgu_w = (const float*)d_in[11]; p.sgu_b = (const float*)d_in[12];
    p.w_out = (const float*)d_in[13]; p.norm2_w = (const float*)d_in[14]; p.w_q = (const float*)d_in[15]; p.keys1 = (const float*)d_in[16]; p.keys2 = (const float*)d_in[17];
    p.down = (const float*)d_in[18]; p.up = (const float*)d_in[19]; p.final_w = (const float*)d_in[20];
    p.out = (float*)d_out; p.ws = (unsigned char*)d_ws;
    hipMemsetAsync((unsigned char*)d_ws + OFF_BAR, 0, XCD_BAR_WORDS * 4, stream);
    void* args[] = {&p};
    hipError_t e = hipLaunchCooperativeKernel((const void*)fwd_megakernel, dim3(grid_blocks), dim3(512), args, LDS_BYTES, stream);
    if (e != hipSuccess) fprintf(stderr, "cooperative launch failed: %s (grid %d)\n", hipGetErrorString(e), grid_blocks);
}
```

```cpp
#include <hip/hip_runtime.h>
#include <hip/hip_cooperative_groups.h>
#include <cstdio>
namespace cg = cooperative_groups;

#define LAS __attribute__((address_space(3)))
typedef unsigned short bf16_t;
typedef short bf16x8 __attribute__((ext_vector_type(8)));
typedef float f32x2 __attribute__((ext_vector_type(2)));
typedef float f32x4 __attribute__((ext_vector_type(4)));
typedef float f32x16 __attribute__((ext_vector_type(16)));
typedef unsigned u32x2 __attribute__((ext_vector_type(2)));
typedef unsigned u32x4 __attribute__((ext_vector_type(4)));
typedef __bf16 bf16x2_t __attribute__((ext_vector_type(2)));

constexpr int NTOK = 16384, DM = 1024, SEQ = 8192, INW = 7184, PW = 5120;
constexpr float EPS = 1e-6f;
constexpr size_t MiB = 1024 * 1024;
constexpr size_t OFF_PROJ = 0;
constexpr size_t OFF_DOWN = 0;
constexpr size_t OFF_UP = 32 * MiB;
constexpr size_t OFF_DOWN8 = 0;
constexpr size_t OFF_UP8 = 16 * MiB;
constexpr size_t OFF_SCD = 32 * MiB;
constexpr size_t OFF_SCU = 32 * MiB + 65536;
constexpr size_t OFF_H2 = 64 * MiB;
constexpr size_t OFF_QP = 96 * MiB;
constexpr size_t OFF_HB = 160 * MiB;
constexpr size_t OFF_WINT = 192 * MiB;
constexpr size_t OFF_WOUTT = 206 * MiB;
constexpr size_t OFF_WQT = 208 * MiB;
constexpr size_t OFF_KEYS = 212 * MiB;
constexpr size_t OFF_MOD = OFF_KEYS + 65536;
constexpr size_t OFF_ALR = OFF_MOD + 65536;
constexpr size_t OFF_STATS = OFF_ALR + MiB;
constexpr size_t OFF_DECAY = OFF_STATS + 131072;
constexpr size_t OFF_BAR = OFF_DECAY + 524288;
constexpr size_t OFF_IDX = 214 * MiB;
constexpr size_t OFF_G = 222 * MiB;
constexpr size_t WS_END = 230 * MiB;
constexpr int LDS_BYTES = 135168;

struct Params {
    const float *x, *c, *w_ada, *b_ada, *norm1_w, *w_in, *w_alpha_up, *b_alpha, *gla_norm_w, *sgu_ln_w, *sgu_ln_b, *sgu_w, *sgu_b, *w_out, *norm2_w, *w_q, *keys1, *keys2, *down, *up, *final_w;
    float* out; unsigned char* ws;
};

__device__ __forceinline__ unsigned cvt_pk_bf16_asm(float lo, float hi) { unsigned r; asm volatile("v_cvt_pk_bf16_f32 %0, %1, %2" : "=v"(r) : "v"(lo), "v"(hi)); return r; }
__device__ __forceinline__ unsigned cvt_pk_bf16(float lo, float hi) { f32x2 v = {lo, hi}; bf16x2_t b = __builtin_convertvector(v, bf16x2_t); return __builtin_bit_cast(unsigned, b); }
__device__ __forceinline__ float bflo(unsigned w) { return __uint_as_float(w << 16); }
__device__ __forceinline__ float bfhi(unsigned w) { return __uint_as_float(w & 0xffff0000u); }
__device__ __forceinline__ float wave_sum(float v) {
#pragma unroll
    for (int o = 32; o; o >>= 1) v += __shfl_xor(v, o);
    return v;
}
__device__ __forceinline__ float sigmoidf_(float x) { return __builtin_amdgcn_rcpf(1.0f + __expf(-x)); }
__device__ __forceinline__ f32x2 gelu_pk(f32x2 v) {
    const f32x2 av = __builtin_elementwise_abs(v), d = av * 0.2316418882f + 1.0f;
    f32x2 t; t.x = __builtin_amdgcn_rcpf(d.x); t.y = __builtin_amdgcn_rcpf(d.y);
    f32x2 q = t * 0.5307027145f + (-0.7265760135f); q = q * t + 0.7107068705f; q = q * t + (-0.142248368f); q = q * t + 0.127414796f; q = q * t;
    const f32x2 s = (v * v) * (-0.72134752044f);
    f32x2 e; e.x = __builtin_amdgcn_exp2f(s.x); e.y = __builtin_amdgcn_exp2f(s.y);
    const f32x2 m = v * (q * e), r = v - m;
    f32x2 o; o.x = v.x < 0.f ? m.x : r.x; o.y = v.y < 0.f ? m.y : r.y; return o;
}
__device__ __forceinline__ float gelu1(float v) { f32x2 r = gelu_pk((f32x2){v, v}); return r.x; }
__device__ __forceinline__ f32x16 zero16() { f32x16 z;
#pragma unroll
    for (int i = 0; i < 16; ++i) z[i] = 0.f;
    return z; }
__device__ __forceinline__ float dot2bf(unsigned a, unsigned b, float c) { return __builtin_amdgcn_fdot2_f32_bf16(__builtin_bit_cast(bf16x2_t, a), __builtin_bit_cast(bf16x2_t, b), c, false); }
#define MFMA32(a, b, c) __builtin_amdgcn_mfma_f32_32x32x16_bf16((a), (b), (c), 0, 0, 0)


#define XB_TMO      128
#define XB_XCNT(j)  (256  + 64 * (j))
#define XB_XSUB(j)  (1280 + 64 * (j))
#define XB_XGEN(j)  (2304 + 64 * (j))
#define XB_TOP      3328
#define XB_TOPGEN   3392
#define XCD_BAR_WORDS 3456
#define XB_SPIN_CAP (1u << 18)
__device__ __forceinline__ unsigned xb_ld(unsigned* p)              { return __hip_atomic_load(p, __ATOMIC_RELAXED, __HIP_MEMORY_SCOPE_AGENT); }
__device__ __forceinline__ unsigned xb_add(unsigned* p, unsigned v) { return __hip_atomic_fetch_add(p, v, __ATOMIC_RELAXED, __HIP_MEMORY_SCOPE_AGENT); }
__device__ __forceinline__ unsigned xb_xcc_id() { return (unsigned)__builtin_amdgcn_s_getreg((3 << 11) | 20) & 0xFu; }
#define XB_SPIN(cond, bar) do { unsigned _sp = 0; while (cond) { __builtin_amdgcn_s_sleep(1); \
    if ((++_sp & 255u) == 0u) { if (xb_ld(&(bar)[XB_TMO])) break; if (_sp > XB_SPIN_CAP) { atomicAdd(&(bar)[XB_TMO], 1u); break; } } } } while (0)
struct XcdBarrier { unsigned* bar; unsigned x; volatile LAS unsigned* st; };
__device__ __forceinline__ XcdBarrier xcd_barrier_post(unsigned* bar, volatile LAS unsigned* st) {
    XcdBarrier b; b.bar = bar; b.x = xb_xcc_id(); b.st = st;
    if (threadIdx.x == 0) (void)xb_add(&bar[XB_XCNT(b.x)], 1u);
    return b;
}
__device__ __forceinline__ void xcd_barrier_complete(unsigned* bar, unsigned x, unsigned& nloc, unsigned& nx) {
    const unsigned G = gridDim.x * gridDim.y * gridDim.z;
    unsigned sum, cnt, mine, sp = 0u;
    for (;;) {
        sum = 0u; cnt = 0u; mine = 0u;
#pragma unroll
        for (unsigned j = 0; j < 16; ++j) { const unsigned c = xb_ld(&bar[XB_XCNT(j)]); sum += c; cnt += (c > 0u) ? 1u : 0u; mine = (j == x) ? c : mine; }
        if (sum == G) break;
        __builtin_amdgcn_s_sleep(1);
        if ((++sp & 255u) == 0u) { if (xb_ld(&bar[XB_TMO])) break; if (sp > XB_SPIN_CAP) { atomicAdd(&bar[XB_TMO], 1u); break; } }
    }
    nloc = mine > 0u ? mine : 1u; nx = cnt > 0u ? cnt : 1u;
}
__device__ __forceinline__ void xcd_barrier(const XcdBarrier& b) {
    asm volatile("s_waitcnt vmcnt(0)" ::: "memory");
    __syncthreads();
    if (threadIdx.x == 0) {
        unsigned* bar = b.bar;
        __builtin_amdgcn_s_waitcnt(0);
        unsigned nloc = b.st[0], nx = b.st[1];
        if (nloc == 0u) { xcd_barrier_complete(bar, b.x, nloc, nx); b.st[0] = nloc; b.st[1] = nx; }
        const unsigned old = xb_add(&bar[XB_XSUB(b.x)], 1u);
        const unsigned gen = old / nloc;
        if (old + 1u == (gen + 1u) * nloc) {
            __builtin_amdgcn_fence(__ATOMIC_RELEASE, "agent");
            asm volatile("s_waitcnt vmcnt(0)" ::: "memory");
            const unsigned og = xb_add(&bar[XB_TOP], 1u);
            const unsigned tg = og / nx;
            if (og + 1u == (tg + 1u) * nx) xb_add(&bar[XB_TOPGEN], 1u);
            else XB_SPIN(xb_ld(&bar[XB_TOPGEN]) == tg, bar);
            __builtin_amdgcn_fence(__ATOMIC_ACQUIRE, "agent");
            xb_add(&bar[XB_XGEN(b.x)], 1u);
            asm volatile("s_waitcnt vmcnt(0)" ::: "memory");
        } else {
            XB_SPIN(xb_ld(&bar[XB_XGEN(b.x)]) == gen, bar);
            __builtin_amdgcn_fence(__ATOMIC_ACQUIRE, "agent");
            asm volatile("s_waitcnt vmcnt(0)" ::: "memory");
        }
    }
    __syncthreads();
}

namespace pg8 {
constexpr int BM = 256, BK = 64, HALF = 128, HTB = HALF * BK * 2, STAGE_BYTES = 8 * HTB, NXCD = 8, WGM = 8;
__host__ __device__ __forceinline__ int lds_byte(int r, int c) { const int st = (r >> 4) * 2 + (c >> 5), rr = r & 15, cc = c & 31, ob = rr * 64 + cc * 2; return st * 1024 + (ob ^ (((ob >> 9) & 1) << 5)); }
__host__ __device__ __forceinline__ void stage_rc(int b, int& R, int& C) { const int st = b / 1024, sb = b % 1024, swz = sb ^ (((sb >> 9) & 1) << 5); R = (st >> 1) * 16 + swz / 64; C = (st & 1) * 32 + (swz % 64) / 2; }
__host__ __device__ __forceinline__ int perm32(int rho) { const int n = rho >> 4, i = rho & 15; return 8 * (i >> 2) + 4 * n + (i & 3); }
struct Unit { int pm, pn; };
struct Gemm { const bf16_t* A; const bf16_t* Bt; int M, N, K; };
struct StaticOrder {
    int nM, nN, nwg, G, c;
    __device__ void init(int M, int N, int G_, int c_) { nM = M / BM; nN = N / BM; nwg = nM * nN; G = G_; c = c_; }
    __device__ bool next(int i, Unit& u) const {
        const long L = (long)i * G + c; if (L >= nwg) return false;
        int wgid = (int)L; { const int q = nwg / NXCD, r = nwg % NXCD, xcd = wgid % NXCD, off = wgid / NXCD; wgid = (xcd < r ? xcd * (q + 1) : r * (q + 1) + (xcd - r) * q) + off; }
        const int nig = WGM * nN, gid = wgid / nig, fm = gid * WGM, gsz = (nM - fm) < WGM ? (nM - fm) : WGM;
        u.pm = fm + ((wgid % nig) % gsz); u.pn = (wgid % nig) / gsz; return true;
    }
    __device__ __forceinline__ void a_ready(const Unit&) const {}
    __device__ __forceinline__ void done(const Unit&) const {}
};

template <class Epi, class Sched>
__device__ __forceinline__ void gemm_phase(LAS unsigned char* lds, const Gemm g, const Sched& S, const Epi& E) {
    const int tid = threadIdx.x, wid = __builtin_amdgcn_readfirstlane(tid >> 6), lane = tid & 63, wr = wid >> 2, wc = wid & 3, fr = lane & 15, fq = lane >> 4;
    const int K = g.K, nt = K / BK;
    unsigned voffA[2], voffB[2];
#pragma unroll
    for (int i = 0; i < 2; ++i) { int R, C; stage_rc(tid * 16 + i * 8192, R, C); const int Rb = Epi::PERM ? ((R & ~31) + perm32(R & 31)) : R;
        voffA[i] = (unsigned)(R * K + C) * 2u; voffB[i] = (unsigned)(Rb * K + C) * 2u; }
    const size_t kstep = (size_t)(BK * 2);
    const size_t hstep = (size_t)HALF * K * 2;
    const size_t tstep = 2 * hstep;
    const unsigned ldsw = (unsigned)wid * 1024u;
    const int aoff = lds_byte(wr * 64 + fr, fq * 8), boff = lds_byte(wc * 32 + fr, fq * 8);
#define PG8_SA(b, h) (((b) * 2 + (h)) * HTB)
#define PG8_SB(b, h) ((4 + (b) * 2 + (h)) * HTB)
#define PG8_STAGE(bufoff, gbase, voff) do { _Pragma("unroll") for (int _i = 0; _i < 2; ++_i) \
        __builtin_amdgcn_global_load_lds((const unsigned*)((const char*)(gbase) + (voff)[_i]), (LAS unsigned*)(lds + (bufoff) + ldsw + _i * 8192), 16, 0, 0); } while (0)
#define PG8_LDA(dst, b, h) do { _Pragma("unroll") for (int m = 0; m < 4; ++m) _Pragma("unroll") for (int k = 0; k < 2; ++k) dst[m][k] = *(const LAS bf16x8*)(lds + PG8_SA(b, h) + aoff + m * 2048 + k * 1024); } while (0)
#define PG8_LDB(dst, b, h) do { _Pragma("unroll") for (int n = 0; n < 2; ++n) _Pragma("unroll") for (int k = 0; k < 2; ++k) dst[n][k] = *(const LAS bf16x8*)(lds + PG8_SB(b, h) + boff + n * 2048 + k * 1024); } while (0)
#define PG8_MMA(ai, bj, At, Bt) do { __builtin_amdgcn_s_setprio(1); _Pragma("unroll") for (int m = 0; m < 4; ++m) _Pragma("unroll") for (int n = 0; n < 2; ++n) _Pragma("unroll") for (int k = 0; k < 2; ++k) \
        acc[ai][bj][m][n] = __builtin_amdgcn_mfma_f32_16x16x32_bf16(Bt[n][k], At[m][k], acc[ai][bj][m][n], 0, 0, 0); __builtin_amdgcn_s_setprio(0); } while (0)
#define PG8_WAIT_V(n) asm volatile("s_waitcnt vmcnt(" #n ")" ::: "memory")
#define PG8_WAIT_L(n) asm volatile("s_waitcnt lgkmcnt(" #n ")" ::: "memory")
#define PG8_BAR __builtin_amdgcn_s_barrier()
#define PG8_SCHED __builtin_amdgcn_sched_barrier(0)
    Unit cur, nxt; int ui = 0;
    if (!S.next(0, cur)) return;
    f32x4 acc[2][2][4][2];
#pragma unroll
    for (int a = 0; a < 2; ++a)
#pragma unroll
        for (int b = 0; b < 2; ++b)
#pragma unroll
            for (int m = 0; m < 4; ++m)
#pragma unroll
                for (int n = 0; n < 2; ++n) acc[a][b][m][n] = (f32x4){0.f, 0.f, 0.f, 0.f};
    bf16x8 At[4][2], B0[2][2], B1[2][2];
    const char* cA = (const char*)g.A + (size_t)cur.pm * tstep; const char* cB = (const char*)g.Bt + (size_t)cur.pn * tstep;
    S.a_ready(cur);
    PG8_STAGE(PG8_SB(0, 0), cB, voffB); PG8_STAGE(PG8_SA(0, 0), cA, voffA); PG8_STAGE(PG8_SB(0, 1), cB + hstep, voffB); PG8_STAGE(PG8_SA(0, 1), cA + hstep, voffA);
    if (wr == 1) PG8_BAR;
    PG8_WAIT_V(4); PG8_BAR;
    PG8_STAGE(PG8_SB(1, 0), cB + kstep, voffB); PG8_STAGE(PG8_SA(1, 0), cA + kstep, voffA); PG8_STAGE(PG8_SB(1, 1), cB + hstep + kstep, voffB);
    PG8_WAIT_V(6); PG8_BAR;
    for (;;) {
        const bool has_next = S.next(ui + 1, nxt);
        const char* nA = has_next ? (const char*)g.A + (size_t)nxt.pm * tstep : cA; const char* nB = has_next ? (const char*)g.Bt + (size_t)nxt.pn * tstep : cB;
        for (int t = 0; t < nt; t += 2) {
            const bool last = (t == nt - 2);
            const char* a1 = cA + (size_t)(t + 1) * kstep;
            const char* a2 = last ? nA : cA + (size_t)(t + 2) * kstep; const char* b2 = last ? nB : cB + (size_t)(t + 2) * kstep;
            const char* a3 = a2 + kstep; const char* b3 = b2 + kstep;
            if (last && has_next) S.a_ready(nxt);
            PG8_LDB(B0, 0, 0); PG8_SCHED; PG8_LDA(At, 0, 0); PG8_STAGE(PG8_SA(1, 1), a1 + hstep, voffA);
            PG8_WAIT_L(8); PG8_BAR; PG8_WAIT_L(0); PG8_MMA(0, 0, At, B0); PG8_BAR; PG8_SCHED;
            PG8_LDB(B1, 0, 1); PG8_STAGE(PG8_SB(0, 0), b2, voffB);
            PG8_BAR; PG8_WAIT_L(0); PG8_MMA(0, 1, At, B1); PG8_BAR;
            PG8_LDA(At, 0, 1); PG8_STAGE(PG8_SA(0, 0), a2, voffA);
            PG8_BAR; PG8_WAIT_L(0); PG8_MMA(1, 0, At, B0); PG8_BAR; PG8_SCHED;
            PG8_STAGE(PG8_SB(0, 1), b2 + hstep, voffB);
            PG8_WAIT_V(6); PG8_BAR; PG8_MMA(1, 1, At, B1); PG8_BAR;
            PG8_LDB(B0, 1, 0); PG8_SCHED; PG8_LDA(At, 1, 0); PG8_STAGE(PG8_SA(0, 1), a2 + hstep, voffA);
            PG8_WAIT_L(8); PG8_BAR; PG8_WAIT_L(0); PG8_MMA(0, 0, At, B0); PG8_BAR; PG8_SCHED;
            PG8_LDB(B1, 1, 1); PG8_STAGE(PG8_SB(1, 0), b3, voffB);
            PG8_BAR; PG8_WAIT_L(0); PG8_MMA(0, 1, At, B1); PG8_BAR;
            PG8_LDA(At, 1, 1); PG8_STAGE(PG8_SA(1, 0), a3, voffA);
            PG8_BAR; PG8_WAIT_L(0); PG8_MMA(1, 0, At, B0); PG8_BAR; PG8_SCHED;
            PG8_STAGE(PG8_SB(1, 1), b3 + hstep, voffB);
            PG8_WAIT_V(6); PG8_BAR; PG8_MMA(1, 1, At, B1); PG8_BAR;
        }
        E(acc, cur, wr, wc, fr, fq); S.done(cur);
        if (!has_next) break;
#pragma unroll
        for (int a = 0; a < 2; ++a)
#pragma unroll
            for (int b = 0; b < 2; ++b)
#pragma unroll
                for (int m = 0; m < 4; ++m)
#pragma unroll
                    for (int n = 0; n < 2; ++n) acc[a][b][m][n] = (f32x4){0.f, 0.f, 0.f, 0.f};
        cur = nxt; cA = nA; cB = nB; ++ui;
    }
    PG8_WAIT_V(0);
    if (wr == 0) PG8_BAR;
    PG8_BAR;
#undef PG8_SA
#undef PG8_SB
#undef PG8_STAGE
#undef PG8_LDA
#undef PG8_LDB
#undef PG8_MMA
#undef PG8_WAIT_V
#undef PG8_WAIT_L
#undef PG8_BAR
#undef PG8_SCHED
}
}
using pg8::Unit;

struct EpiProj {
    static constexpr bool PERM = true;
    bf16_t* P;
    __device__ __forceinline__ void operator()(const f32x4 (&acc)[2][2][4][2], const Unit& u, int wr, int wc, int fr, int fq) const {
        const int row0 = u.pm * 256 + wr * 64 + fr; const int pn = u.pn;
        if (pn < 8 || pn >= 24) {
            const bool act = pn >= 24;
            const int col0 = (act ? 4096 + (pn - 24) * 256 : pn * 256) + wc * 32 + 8 * fq;
#pragma unroll
            for (int ai = 0; ai < 2; ++ai)
#pragma unroll
                for (int m = 0; m < 4; ++m) { bf16_t* rowp = P + (size_t)(row0 + ai * 128 + m * 16) * PW + col0;
#pragma unroll
                    for (int bj = 0; bj < 2; ++bj) { f32x4 v0 = acc[ai][bj][m][0], v1 = acc[ai][bj][m][1];
                        if (act) { f32x2 a = gelu_pk((f32x2){v0[0], v0[1]}), b = gelu_pk((f32x2){v0[2], v0[3]}), c = gelu_pk((f32x2){v1[0], v1[1]}), d = gelu_pk((f32x2){v1[2], v1[3]});
                            v0 = (f32x4){a.x, a.y, b.x, b.y}; v1 = (f32x4){c.x, c.y, d.x, d.y}; }
                        u32x4 w; w.x = cvt_pk_bf16_asm(v0[0], v0[1]); w.y = cvt_pk_bf16_asm(v0[2], v0[3]); w.z = cvt_pk_bf16_asm(v1[0], v1[1]); w.w = cvt_pk_bf16_asm(v1[2], v1[3]);
                        *(u32x4*)(rowp + bj * 128) = w; } }
        } else {
            const bool isrg = pn < 16;
            const int col0 = (isrg ? 2048 + (pn - 8) * 128 : 3072 + (pn - 16) * 128) + wc * 32 + 8 * fq;
#pragma unroll
            for (int ai = 0; ai < 2; ++ai)
#pragma unroll
                for (int m = 0; m < 4; ++m) { bf16_t* rowp = P + (size_t)(row0 + ai * 128 + m * 16) * PW + col0;
                    float o[8];
#pragma unroll
                    for (int n = 0; n < 2; ++n) { const f32x4 a = acc[ai][0][m][n], g = acc[ai][1][m][n];
                        if (isrg) {
#pragma unroll
                            for (int j = 0; j < 4; ++j) o[n * 4 + j] = a[j] * sigmoidf_(a[j]) * sigmoidf_(g[j]);
                        } else { f32x2 x = gelu_pk((f32x2){a[0], a[1]}), y = gelu_pk((f32x2){a[2], a[3]});
                            o[n * 4 + 0] = x.x * sigmoidf_(g[0]); o[n * 4 + 1] = x.y * sigmoidf_(g[1]); o[n * 4 + 2] = y.x * sigmoidf_(g[2]); o[n * 4 + 3] = y.y * sigmoidf_(g[3]); } }
                    u32x4 w; w.x = cvt_pk_bf16_asm(o[0], o[1]); w.y = cvt_pk_bf16_asm(o[2], o[3]); w.z = cvt_pk_bf16_asm(o[4], o[5]); w.w = cvt_pk_bf16_asm(o[6], o[7]);
                    *(u32x4*)rowp = w; }
        }
    }
};
struct EpiX1 {
    static constexpr bool PERM = false;
    const float* x; float* x1; const float* mod; const float* b_ada;
    __device__ __forceinline__ void operator()(const f32x4 (&acc)[2][2][4][2], const Unit& u, int wr, int wc, int fr, int fq) const {
        const int row0 = u.pm * 256 + wr * 64 + fr, col0 = u.pn * 256 + wc * 32 + 4 * fq; const int b = u.pm >> 5;
        f32x4 gv[2][2];
#pragma unroll
        for (int bj = 0; bj < 2; ++bj)
#pragma unroll
            for (int n = 0; n < 2; ++n) gv[bj][n] = *(const f32x4*)(mod + b * 6144 + 2048 + col0 + bj * 128 + n * 16) + *(const f32x4*)(b_ada + 2048 + col0 + bj * 128 + n * 16);
#pragma unroll
        for (int ai = 0; ai < 2; ++ai)
#pragma unroll
            for (int m = 0; m < 4; ++m) { const size_t off = (size_t)(row0 + ai * 128 + m * 16) * DM + col0;
#pragma unroll
                for (int bj = 0; bj < 2; ++bj)
#pragma unroll
                    for (int n = 0; n < 2; ++n) { const f32x4 xv = *(const f32x4*)(x + off + bj * 128 + n * 16); *(f32x4*)(x1 + off + bj * 128 + n * 16) = xv + gv[bj][n] * acc[ai][bj][m][n]; } }
    }
};
struct EpiQ {
    static constexpr bool PERM = true;
    bf16_t* O;
    __device__ __forceinline__ void operator()(const f32x4 (&acc)[2][2][4][2], const Unit& u, int wr, int wc, int fr, int fq) const {
        const int row0 = u.pm * 256 + wr * 64 + fr, col0 = u.pn * 256 + wc * 32 + 8 * fq;
#pragma unroll
        for (int ai = 0; ai < 2; ++ai)
#pragma unroll
            for (int m = 0; m < 4; ++m) { bf16_t* rowp = O + (size_t)(row0 + ai * 128 + m * 16) * 2048 + col0;
#pragma unroll
                for (int bj = 0; bj < 2; ++bj) { const f32x4 v0 = acc[ai][bj][m][0], v1 = acc[ai][bj][m][1];
                    u32x4 w; w.x = cvt_pk_bf16_asm(v0[0], v0[1]); w.y = cvt_pk_bf16_asm(v0[2], v0[3]); w.z = cvt_pk_bf16_asm(v1[0], v1[1]); w.w = cvt_pk_bf16_asm(v1[2], v1[3]);
                    *(u32x4*)(rowp + bj * 128) = w; } }
    }
};

__device__ __forceinline__ int win_src_col(int n) {
    if (n < 2048) return n;
    if (n < 4096) { const int u = (n - 2048) >> 8, r = (n - 2048) & 255; return r < 128 ? 2048 + 128 * u + r : 5136 + 128 * u + (r - 128); }
    if (n < 6144) { const int u = (n - 4096) >> 8, r = (n - 4096) & 255; return r < 128 ? 3088 + 128 * u + r : 6160 + 128 * u + (r - 128); }
    return 4112 + (n - 6144);
}
__device__ void phase0(const Params& p, unsigned char* lds) {
    const int tid = threadIdx.x;
    float* mod = (float*)(p.ws + OFF_MOD);
    {
        float* ssc = (float*)lds;
        float* red = (float*)lds + 2048;
        for (int e = tid; e < 2048; e += 512) { const float cv = p.c[e]; ssc[e] = cv * sigmoidf_(cv); }
        __syncthreads();
        for (int cbk = blockIdx.x; cbk < 256; cbk += gridDim.x) {
            const int cc = tid % 24, rg = tid / 24;
            if (tid < 504) { float a0 = 0.f, a1 = 0.f;
                for (int k = rg; k < 1024; k += 21) { const float w = p.w_ada[(size_t)k * 6144 + cbk * 24 + cc]; a0 += ssc[k] * w; a1 += ssc[1024 + k] * w; }
                red[(rg * 24 + cc) * 2] = a0; red[(rg * 24 + cc) * 2 + 1] = a1; }
            __syncthreads();
            if (tid < 48) { const int c2 = tid % 24, bb = tid / 24; float s = 0.f;
                for (int g = 0; g < 21; ++g) s += red[(g * 24 + c2) * 2 + bb];
                mod[bb * 6144 + cbk * 24 + c2] = s; }
            __syncthreads();
        }
    }
    float* tile = (float*)lds;
    for (int tl = blockIdx.x; tl < 2560; tl += gridDim.x) {
        const float* W; bf16_t* Bt; int ldw, nt, kt, which;
        if (tl < 1792) { which = 0; W = p.w_in; ldw = INW; Bt = (bf16_t*)(p.ws + OFF_WINT); nt = tl >> 4; kt = tl & 15; }
        else if (tl < 2048) { which = 1; W = p.w_out; ldw = 1024; Bt = (bf16_t*)(p.ws + OFF_WOUTT); nt = (tl - 1792) >> 4; kt = tl & 15; }
        else { which = 2; W = p.w_q; ldw = 2048; Bt = (bf16_t*)(p.ws + OFF_WQT); nt = (tl - 2048) >> 4; kt = tl & 15; }
        { const int nn = tid & 63, kk0 = tid >> 6; const int n = nt * 64 + nn; const int sc = which == 0 ? win_src_col(n) : n;
#pragma unroll
            for (int i = 0; i < 8; ++i) { const int k = kk0 + 8 * i; tile[nn * 65 + k] = W[(size_t)(kt * 64 + k) * ldw + sc]; } }
        __syncthreads();
        { const int n = tid >> 3, kc = (tid & 7) * 8; const float* tp = tile + n * 65 + kc;
            u32x4 w; w.x = cvt_pk_bf16(tp[0], tp[1]); w.y = cvt_pk_bf16(tp[2], tp[3]); w.z = cvt_pk_bf16(tp[4], tp[5]); w.w = cvt_pk_bf16(tp[6], tp[7]);
            *(u32x4*)(Bt + (size_t)(nt * 64 + n) * 1024 + kt * 64 + kc) = w; }
        __syncthreads();
    }
    { bf16_t* kb = (bf16_t*)(p.ws + OFF_KEYS);
        for (int e = (blockIdx.x * 512 + tid) * 2; e < 32768; e += gridDim.x * 1024) {
            const float* src = e < 16384 ? p.keys1 + e : p.keys2 + (e - 16384);
            *(unsigned*)(kb + e) = cvt_pk_bf16(src[0], src[1]); } }
}

template <bool ALR>
__device__ void phase_norm(const Params& p, const float* xin, const float* nw, int shift_off, int scale_off, bf16_t* hout, unsigned char* lds) {
    const int tid = threadIdx.x, wid = tid >> 6, lane = tid & 63;
    const float* mod = (const float*)(p.ws + OFF_MOD);
    float* wat = (float*)lds;
    if (ALR) {
        for (int e = tid; e < 16384; e += 512) { const int d = e >> 4, r = e & 15; wat[r * 1024 + d] = p.w_in[(size_t)d * INW + 3072 + r]; }
        __syncthreads();
    }
    float* alr = (float*)(p.ws + OFF_ALR);
    for (int tg = blockIdx.x * 8 + wid; tg < 2048; tg += gridDim.x * 8) {
        const int b = tg >> 10;
        f32x4 w4[4], sc[4], sh[4];
#pragma unroll
        for (int i = 0; i < 4; ++i) { const int d = 256 * i + 4 * lane; w4[i] = *(const f32x4*)(nw + d);
            sc[i] = *(const f32x4*)(mod + b * 6144 + scale_off + d) + *(const f32x4*)(p.b_ada + scale_off + d) + 1.0f;
            sh[i] = *(const f32x4*)(mod + b * 6144 + shift_off + d) + *(const f32x4*)(p.b_ada + shift_off + d);
            w4[i] = w4[i] * sc[i]; }
        f32x4 xn[4];
#pragma unroll
        for (int i = 0; i < 4; ++i) xn[i] = *(const f32x4*)(xin + (size_t)(tg * 8) * DM + 256 * i + 4 * lane);
        for (int tt = 0; tt < 8; ++tt) {
            const int t = tg * 8 + tt;
            f32x4 xv[4]; float ss = 0.f;
#pragma unroll
            for (int i = 0; i < 4; ++i) { xv[i] = xn[i]; ss += xv[i][0] * xv[i][0] + xv[i][1] * xv[i][1] + xv[i][2] * xv[i][2] + xv[i][3] * xv[i][3]; }
            if (tt < 7) {
#pragma unroll
                for (int i = 0; i < 4; ++i) xn[i] = *(const f32x4*)(xin + (size_t)(t + 1) * DM + 256 * i + 4 * lane); }
            ss = wave_sum(ss);
            const float rstd = rsqrtf(ss * (1.0f / 1024.0f) + EPS);
#pragma unroll
            for (int i = 0; i < 4; ++i) { xv[i] = xv[i] * rstd * w4[i] + sh[i];
                u32x2 w; w.x = cvt_pk_bf16(xv[i][0], xv[i][1]); w.y = cvt_pk_bf16(xv[i][2], xv[i][3]);
                *(u32x2*)(hout + (size_t)t * DM + 256 * i + 4 * lane) = w; }
            if (ALR) {
                float ps[16];
#pragma unroll
                for (int r = 0; r < 16; ++r) { float s = 0.f;
#pragma unroll
                    for (int i = 0; i < 4; ++i) { const f32x4 wv = *(const f32x4*)(wat + r * 1024 + 256 * i + 4 * lane); s += xv[i][0] * wv[0] + xv[i][1] * wv[1] + xv[i][2] * wv[2] + xv[i][3] * wv[3]; }
                    ps[r] = s; if (r & 1) asm volatile("" ::: "memory"); }
                float t8[8], t4[4], t2[2];
                { const bool up = (lane & 32) != 0;
#pragma unroll
                  for (int j = 0; j < 8; ++j) { const float snd = up ? ps[j] : ps[j + 8], keep = up ? ps[j + 8] : ps[j]; t8[j] = keep + __shfl_xor(snd, 32); } }
                { const bool up = (lane & 16) != 0;
#pragma unroll
                  for (int j = 0; j < 4; ++j) { const float snd = up ? t8[j] : t8[j + 4], keep = up ? t8[j + 4] : t8[j]; t4[j] = keep + __shfl_xor(snd, 16); } }
                { const bool up = (lane & 8) != 0;
#pragma unroll
                  for (int j = 0; j < 2; ++j) { const float snd = up ? t4[j] : t4[j + 2], keep = up ? t4[j + 2] : t4[j]; t2[j] = keep + __shfl_xor(snd, 8); } }
                float t1;
                { const bool up = (lane & 4) != 0; const float snd = up ? t2[0] : t2[1], keep = up ? t2[1] : t2[0]; t1 = keep + __shfl_xor(snd, 4); }
                t1 += __shfl_xor(t1, 2); t1 += __shfl_xor(t1, 1);
                if ((lane & 3) == 0) alr[(size_t)t * 16 + ((lane >> 5) & 1) * 8 + ((lane >> 4) & 1) * 4 + ((lane >> 3) & 1) * 2 + ((lane >> 2) & 1)] = t1;
            }
        }
    }
}

template <bool TR>
__device__ __forceinline__ void gla_G(const Params& p, int t0, int h, float* sALR, float* sG, float* sGT) {
    const int tid = threadIdx.x;
    const float* alr = (const float*)(p.ws + OFF_ALR);
    if (tid < 256) *(f32x4*)(sALR + tid * 4) = *(const f32x4*)(alr + (size_t)t0 * 16 + tid * 4);
    const int col = tid & 127, pg = tid >> 7;
    float wup[16];
#pragma unroll
    for (int r = 0; r < 16; ++r) wup[r] = p.w_alpha_up[r * 512 + h * 128 + col];
    const float bias = p.b_alpha[h * 128 + col];
    __syncthreads();
#pragma unroll 4
    for (int pp = 0; pp < 16; ++pp) { const int pos = pg * 16 + pp;
        float z0 = bias, z1 = 0.f, z2 = 0.f, z3 = 0.f;
#pragma unroll
        for (int r4 = 0; r4 < 4; ++r4) { const f32x4 a = *(const f32x4*)(sALR + pos * 16 + r4 * 4); z0 += a[0] * wup[r4 * 4]; z1 += a[1] * wup[r4 * 4 + 1]; z2 += a[2] * wup[r4 * 4 + 2]; z3 += a[3] * wup[r4 * 4 + 3]; }
        const float z = (z0 + z1) + (z2 + z3);
        sG[pos * 128 + col] = (fminf(z, 0.f) - __logf(1.0f + __expf(-fabsf(z)))) * (1.0f / 16.0f); }
    __syncthreads();
    if (tid < 128) { float cum = 0.f;
#pragma unroll 16
        for (int pos = 0; pos < 64; ++pos) { cum += sG[pos * 128 + tid]; if (TR) sGT[tid * 65 + pos] = cum; else sG[pos * 128 + tid] = cum; } }
    __syncthreads();
}
__device__ __forceinline__ void gla_VT(const bf16_t* P, int t0, int h, bf16_t* sVT) {
    const int tid = threadIdx.x;
#pragma unroll
    for (int i = 0; i < 4; ++i) { const int task = tid + 512 * i, pos = task & 63, dg = task >> 6;
        const u32x4 w = *(const u32x4*)(P + (size_t)(t0 + pos) * PW + 1024 + h * 256 + dg * 8);
        bf16_t* d = sVT + (dg * 8) * 72 + pos;
        d[0] = (bf16_t)w.x; d[72] = (bf16_t)(w.x >> 16); d[144] = (bf16_t)w.y; d[216] = (bf16_t)(w.y >> 16);
        d[288] = (bf16_t)w.z; d[360] = (bf16_t)(w.z >> 16); d[432] = (bf16_t)w.w; d[504] = (bf16_t)(w.w >> 16); }
}

__device__ void phase_glaA(const Params& p, unsigned char* lds) {
    const int tid = threadIdx.x, wid = tid >> 6, lane = tid & 63, r = lane & 31, hh = lane >> 5;
    const bf16_t* P = (const bf16_t*)(p.ws + OFF_PROJ);
    { float* stats = (float*)(p.ws + OFF_STATS);
        for (int t = blockIdx.x * 8 + wid; t < NTOK; t += gridDim.x * 8) {
            const u32x4 a = *(const u32x4*)(P + (size_t)t * PW + 4096 + lane * 16), b = *(const u32x4*)(P + (size_t)t * PW + 4096 + lane * 16 + 8);
            float v[16] = {bflo(a.x), bfhi(a.x), bflo(a.y), bfhi(a.y), bflo(a.z), bfhi(a.z), bflo(a.w), bfhi(a.w), bflo(b.x), bfhi(b.x), bflo(b.y), bfhi(b.y), bflo(b.z), bfhi(b.z), bflo(b.w), bfhi(b.w)};
            float s = 0.f;
#pragma unroll
            for (int i = 0; i < 16; ++i) s += v[i];
            const float mean = wave_sum(s) * (1.0f / 1024.0f);
            float q = 0.f;
#pragma unroll
            for (int i = 0; i < 16; ++i) { const float d = v[i] - mean; q += d * d; }
            q = wave_sum(q);
            if (lane == 0) *(f32x2*)(stats + (size_t)t * 2) = (f32x2){mean, rsqrtf(q * (1.0f / 1024.0f) + EPS)};
        } }
    float* sALR = (float*)lds; float* sG = (float*)(lds + 4096);
    bf16_t* sKT = (bf16_t*)(lds + 36864); bf16_t* sVT = (bf16_t*)(lds + 55296); float* sGT = (float*)(lds + 92160);
    bf16_t* KV = (bf16_t*)p.out; float* decay = (float*)(p.ws + OFF_DECAY);
    for (int item = blockIdx.x; item < 1024; item += gridDim.x) {
        const int h = item & 3, n = (item >> 2) & 127, b = item >> 9, t0 = b * SEQ + n * 64;
        gla_G<true>(p, t0, h, sALR, sG, sGT);
#pragma unroll
        for (int i = 0; i < 2; ++i) { const int task = tid + 512 * i, pos = task & 63, kg = task >> 6;
            const u32x4 w = *(const u32x4*)(P + (size_t)(t0 + pos) * PW + 512 + h * 128 + kg * 8);
            const unsigned ww[4] = {w.x, w.y, w.z, w.w};
            bf16_t* d = sKT + (kg * 8) * 72 + pos;
#pragma unroll
            for (int e = 0; e < 4; ++e) { const int kd = kg * 8 + 2 * e;
                const float f0 = __expf(sGT[kd * 65 + 63] - sGT[kd * 65 + pos]), f1 = __expf(sGT[(kd + 1) * 65 + 63] - sGT[(kd + 1) * 65 + pos]);
                const unsigned pk = cvt_pk_bf16(bflo(ww[e]) * f0, bfhi(ww[e]) * f1);
                d[(2 * e) * 72] = (bf16_t)pk; d[(2 * e + 1) * 72] = (bf16_t)(pk >> 16); } }
        gla_VT(P, t0, h, sVT);
        if (tid < 128) decay[item * 128 + tid] = __expf(sGT[tid * 65 + 63]);
        __syncthreads();
        f32x16 acc[4];
#pragma unroll
        for (int mi = 0; mi < 4; ++mi) acc[mi] = zero16();
#pragma unroll
        for (int ks = 0; ks < 4; ++ks) {
            const bf16x8 bfr = *(const bf16x8*)(sVT + (wid * 32 + r) * 72 + ks * 16 + hh * 8);
#pragma unroll
            for (int mi = 0; mi < 4; ++mi) { const bf16x8 afr = *(const bf16x8*)(sKT + (mi * 32 + r) * 72 + ks * 16 + hh * 8); acc[mi] = MFMA32(afr, bfr, acc[mi]); }
        }
        bf16_t* dst = KV + (size_t)item * 32768 + (size_t)(wid * 32 + r) * 128;
#pragma unroll
        for (int mi = 0; mi < 4; ++mi)
#pragma unroll
            for (int g = 0; g < 4; ++g) { u32x2 w; w.x = cvt_pk_bf16(acc[mi][g * 4], acc[mi][g * 4 + 1]); w.y = cvt_pk_bf16(acc[mi][g * 4 + 2], acc[mi][g * 4 + 3]);
                *(u32x2*)(dst + mi * 32 + g * 8 + hh * 4) = w; }
        __syncthreads();
    }
}

__device__ void phase_scan_sgu(const Params& p, unsigned char* lds) {
    const int tid = threadIdx.x, wid = tid >> 6, lane = tid & 63, r = lane & 31, hh = lane >> 5;
    { unsigned* KV = (unsigned*)p.out; const float* decay = (const float*)(p.ws + OFF_DECAY);
        for (int gt = blockIdx.x * 512 + tid; gt < 131072; gt += gridDim.x * 512) {
            const int bh = gt >> 14, e = gt & 16383, kd = (e * 2) & 127, b = bh >> 2, h = bh & 3;
            float s0 = 0.f, s1 = 0.f;
            for (int n0 = 0; n0 < 128; n0 += 8) {
                unsigned w[8]; f32x2 d[8];
#pragma unroll
                for (int j = 0; j < 8; ++j) { const int item = ((b * 128 + n0 + j) << 2) + h; w[j] = KV[(size_t)item * 16384 + e]; d[j] = *(const f32x2*)(decay + item * 128 + kd); }
#pragma unroll
                for (int j = 0; j < 8; ++j) { const int item = ((b * 128 + n0 + j) << 2) + h; KV[(size_t)item * 16384 + e] = cvt_pk_bf16(s0, s1);
                    s0 = s0 * d[j].x + bflo(w[j]); s1 = s1 * d[j].y + bfhi(w[j]); }
            }
        } }
    const bf16_t* P = (const bf16_t*)(p.ws + OFF_PROJ);
    const float* stats = (const float*)(p.ws + OFF_STATS);
    bf16_t* merged = (bf16_t*)(p.ws + OFF_HB);
    bf16_t* sVT = (bf16_t*)lds;
    for (int item = blockIdx.x; item < 1024; item += gridDim.x) {
        const int g = item & 7, n = (item >> 3) & 63, b = item >> 9, t0 = b * SEQ + n * 128;
#pragma unroll
        for (int i = 0; i < 4; ++i) { const int task = tid + 512 * i, j = task & 127, cg8 = task >> 7;
            const u32x4 w = *(const u32x4*)(P + (size_t)(t0 + j) * PW + 4096 + g * 128 + cg8 * 8);
            const f32x2 st = *(const f32x2*)(stats + (size_t)(t0 + j) * 2);
            const f32x4 lw0 = *(const f32x4*)(p.sgu_ln_w + g * 128 + cg8 * 8), lw1 = *(const f32x4*)(p.sgu_ln_w + g * 128 + cg8 * 8 + 4);
            const f32x4 lb0 = *(const f32x4*)(p.sgu_ln_b + g * 128 + cg8 * 8), lb1 = *(const f32x4*)(p.sgu_ln_b + g * 128 + cg8 * 8 + 4);
            const float v[8] = {bflo(w.x), bfhi(w.x), bflo(w.y), bfhi(w.y), bflo(w.z), bfhi(w.z), bflo(w.w), bfhi(w.w)};
            bf16_t* d = sVT + (cg8 * 8) * 136 + j;
#pragma unroll
            for (int e = 0; e < 8; e += 2) { const float lw_a = e < 4 ? lw0[e] : lw1[e - 4], lw_b = e < 4 ? lw0[e + 1] : lw1[e - 3], lb_a = e < 4 ? lb0[e] : lb1[e - 4], lb_b = e < 4 ? lb0[e + 1] : lb1[e - 3];
                const unsigned pk = cvt_pk_bf16((v[e] - st.x) * st.y * lw_a + lb_a, (v[e + 1] - st.x) * st.y * lw_b + lb_b);
                d[e * 136] = (bf16_t)pk; d[(e + 1) * 136] = (bf16_t)(pk >> 16); } }
        __syncthreads();
        const int ni = wid & 3, mb = (wid >> 2) * 2, irow = ni * 32 + r;
        f32x16 acc[2] = {zero16(), zero16()};
        const float* wrow = p.sgu_w + (size_t)g * 16384 + (size_t)irow * 128;
        for (int ks = 0; ks < 2 * ni + 2; ++ks) {
            const int j0 = ks * 16 + hh * 8;
            const f32x4 wa = *(const f32x4*)(wrow + j0), wb = *(const f32x4*)(wrow + j0 + 4);
            float wv[8] = {wa[0], wa[1], wa[2], wa[3], wb[0], wb[1], wb[2], wb[3]};
#pragma unroll
            for (int e = 0; e < 8; ++e) wv[e] = (j0 + e <= irow) ? wv[e] : 0.f;
            u32x4 bw; bw.x = cvt_pk_bf16(wv[0], wv[1]); bw.y = cvt_pk_bf16(wv[2], wv[3]); bw.z = cvt_pk_bf16(wv[4], wv[5]); bw.w = cvt_pk_bf16(wv[6], wv[7]);
            const bf16x8 bfr = __builtin_bit_cast(bf16x8, bw);
#pragma unroll
            for (int mi = 0; mi < 2; ++mi) { const bf16x8 afr = *(const bf16x8*)(sVT + ((mb + mi) * 32 + r) * 136 + j0); acc[mi] = MFMA32(afr, bfr, acc[mi]); }
        }
        const float bs = p.sgu_b[g * 128 + irow];
        const size_t tok = (size_t)(t0 + irow);
#pragma unroll
        for (int mi = 0; mi < 2; ++mi)
#pragma unroll
            for (int g4 = 0; g4 < 4; ++g4) { const int c = (mb + mi) * 32 + g4 * 8 + hh * 4;
                const u32x2 ug = *(const u32x2*)(P + tok * PW + 3072 + g * 128 + c);
                u32x2 o; o.x = cvt_pk_bf16(bflo(ug.x) * (acc[mi][g4 * 4] + bs), bfhi(ug.x) * (acc[mi][g4 * 4 + 1] + bs));
                o.y = cvt_pk_bf16(bflo(ug.y) * (acc[mi][g4 * 4 + 2] + bs), bfhi(ug.y) * (acc[mi][g4 * 4 + 3] + bs));
                *(u32x2*)(merged + tok * DM + g * 128 + c) = o; }
        __syncthreads();
    }
}

__device__ void phase_glaC(const Params& p, unsigned char* lds) {
    const int tid = threadIdx.x, wid = tid >> 6, lane = tid & 63, r = lane & 31, hh = lane >> 5;
    const bf16_t* P = (const bf16_t*)(p.ws + OFF_PROJ);
    float* sALR = (float*)lds; float* sG = (float*)(lds + 4096);
    bf16_t* sQD = (bf16_t*)(lds + 36864); bf16_t* sKI = (bf16_t*)(lds + 54272); bf16_t* sVT = (bf16_t*)(lds + 71680); bf16_t* sAM = (bf16_t*)(lds + 108544); float* sSS = (float*)(lds + 117760);
    const bf16_t* ST = (const bf16_t*)p.out; bf16_t* merged = (bf16_t*)(p.ws + OFF_HB);
    for (int item = blockIdx.x; item < 1024; item += gridDim.x) {
        const int h = item & 3, n = (item >> 2) & 127, b = item >> 9, t0 = b * SEQ + n * 64;
        gla_G<false>(p, t0, h, sALR, sG, nullptr);
#pragma unroll
        for (int i = 0; i < 2; ++i) { const int task = tid + 512 * i, kg = task & 15, pos = task >> 4;
            const u32x4 qw = *(const u32x4*)(P + (size_t)(t0 + pos) * PW + h * 128 + kg * 8), kw = *(const u32x4*)(P + (size_t)(t0 + pos) * PW + 512 + h * 128 + kg * 8);
            const f32x4 g0 = *(const f32x4*)(sG + pos * 128 + kg * 8), g1 = *(const f32x4*)(sG + pos * 128 + kg * 8 + 4);
            const float gv[8] = {g0[0], g0[1], g0[2], g0[3], g1[0], g1[1], g1[2], g1[3]};
            const unsigned qq[4] = {qw.x, qw.y, qw.z, qw.w}, kk[4] = {kw.x, kw.y, kw.z, kw.w};
            unsigned qo[4], ko[4];
#pragma unroll
            for (int e = 0; e < 4; ++e) { const float e0 = __expf(gv[2 * e]), e1 = __expf(gv[2 * e + 1]);
                qo[e] = cvt_pk_bf16(bflo(qq[e]) * 0.08838834764831845f * e0, bfhi(qq[e]) * 0.08838834764831845f * e1);
                ko[e] = cvt_pk_bf16(bflo(kk[e]) * __builtin_amdgcn_rcpf(e0), bfhi(kk[e]) * __builtin_amdgcn_rcpf(e1)); }
            *(u32x4*)(sQD + pos * 136 + kg * 8) = (u32x4){qo[0], qo[1], qo[2], qo[3]};
            *(u32x4*)(sKI + pos * 136 + kg * 8) = (u32x4){ko[0], ko[1], ko[2], ko[3]}; }
        gla_VT(P, t0, h, sVT);
        __syncthreads();
        if (wid < 4) { const int mj = wid >> 1, nI = wid & 1;
            f32x16 a = zero16();
            if (mj <= nI) {
#pragma unroll
                for (int ks = 0; ks < 8; ++ks) { const bf16x8 afr = *(const bf16x8*)(sKI + (mj * 32 + r) * 136 + ks * 16 + hh * 8), bfr = *(const bf16x8*)(sQD + (nI * 32 + r) * 136 + ks * 16 + hh * 8); a = MFMA32(afr, bfr, a); } }
            const int i = nI * 32 + r;
#pragma unroll
            for (int g = 0; g < 4; ++g) { const int j = mj * 32 + g * 8 + hh * 4;
                u32x2 w; w.x = cvt_pk_bf16(j <= i ? a[g * 4] : 0.f, j + 1 <= i ? a[g * 4 + 1] : 0.f); w.y = cvt_pk_bf16(j + 2 <= i ? a[g * 4 + 2] : 0.f, j + 3 <= i ? a[g * 4 + 3] : 0.f);
                *(u32x2*)(sAM + i * 72 + j) = w; } }
        __syncthreads();
        const int nI = wid & 1, mb = (wid >> 1) * 2, i = nI * 32 + r;
        f32x16 acc[2] = {zero16(), zero16()};
        const bf16_t* Sg = ST + (size_t)item * 32768;
#pragma unroll
        for (int ks = 0; ks < 8; ++ks) { const bf16x8 bfr = *(const bf16x8*)(sQD + i * 136 + ks * 16 + hh * 8);
#pragma unroll
            for (int mi = 0; mi < 2; ++mi) { const bf16x8 afr = *(const bf16x8*)(Sg + (size_t)((mb + mi) * 32 + r) * 128 + ks * 16 + hh * 8); acc[mi] = MFMA32(afr, bfr, acc[mi]); } }
        for (int ks = 0; ks < 2 * nI + 2; ++ks) { const bf16x8 bfr = *(const bf16x8*)(sAM + i * 72 + ks * 16 + hh * 8);
#pragma unroll
            for (int mi = 0; mi < 2; ++mi) { const bf16x8 afr = *(const bf16x8*)(sVT + ((mb + mi) * 32 + r) * 72 + ks * 16 + hh * 8); acc[mi] = MFMA32(afr, bfr, acc[mi]); } }
        float ss = 0.f;
#pragma unroll
        for (int mi = 0; mi < 2; ++mi)
#pragma unroll
            for (int e = 0; e < 16; ++e) ss += acc[mi][e] * acc[mi][e];
        ss += __shfl_xor(ss, 32);
        if (hh == 0) sSS[(wid >> 1) * 64 + i] = ss;
        __syncthreads();
        const float tot = sSS[i] + sSS[64 + i] + sSS[128 + i] + sSS[192 + i];
        const float rstd = rsqrtf(tot * (1.0f / 256.0f) + EPS);
        const size_t tok = (size_t)(t0 + i);
#pragma unroll
        for (int mi = 0; mi < 2; ++mi)
#pragma unroll
            for (int g4 = 0; g4 < 4; ++g4) { const int ch = h * 256 + (mb + mi) * 32 + g4 * 8 + hh * 4;
                const f32x4 nwv = *(const f32x4*)(p.gla_norm_w + ch);
                const u32x2 rg = *(const u32x2*)(P + tok * PW + 2048 + ch), mg = *(const u32x2*)(merged + tok * DM + ch);
                u32x2 o; o.x = cvt_pk_bf16(acc[mi][g4 * 4] * rstd * nwv[0] * bflo(rg.x) + bflo(mg.x), acc[mi][g4 * 4 + 1] * rstd * nwv[1] * bfhi(rg.x) + bfhi(mg.x));
                o.y = cvt_pk_bf16(acc[mi][g4 * 4 + 2] * rstd * nwv[2] * bflo(rg.y) + bflo(mg.y), acc[mi][g4 * 4 + 3] * rstd * nwv[3] * bfhi(rg.y) + bfhi(mg.y));
                *(u32x2*)(merged + tok * DM + ch) = o; }
        __syncthreads();
    }
}

__device__ void phase_tables(const Params& p) {
    bf16_t* db = (bf16_t*)(p.ws + OFF_DOWN); bf16_t* ub = (bf16_t*)(p.ws + OFF_UP);
    for (size_t e = ((size_t)blockIdx.x * 512 + threadIdx.x) * 8; e < (size_t)16384 * 1024; e += (size_t)gridDim.x * 4096) {
        { const f32x4 a = __builtin_nontemporal_load((const f32x4*)(p.down + e)), b = __builtin_nontemporal_load((const f32x4*)(p.down + e + 4));
            u32x4 w; w.x = cvt_pk_bf16(a[0], a[1]); w.y = cvt_pk_bf16(a[2], a[3]); w.z = cvt_pk_bf16(b[0], b[1]); w.w = cvt_pk_bf16(b[2], b[3]); *(u32x4*)(db + e) = w; }
        { const f32x4 a = __builtin_nontemporal_load((const f32x4*)(p.up + e)), b = __builtin_nontemporal_load((const f32x4*)(p.up + e + 4));
            u32x4 w; w.x = cvt_pk_bf16(a[0], a[1]); w.y = cvt_pk_bf16(a[2], a[3]); w.z = cvt_pk_bf16(b[0], b[1]); w.w = cvt_pk_bf16(b[2], b[3]); *(u32x4*)(ub + e) = w; }
    }
}

#define SORT16(L) do { float _h; _h = fmaxf(L[0], L[1]); L[1] = fminf(L[0], L[1]); L[0] = _h; _h = fmaxf(L[2], L[3]); L[3] = fminf(L[2], L[3]); L[2] = _h; _h = fmaxf(L[0], L[2]); L[2] = fminf(L[0], L[2]); L[0] = _h; _h = fmaxf(L[1], L[3]); L[3] = fminf(L[1], L[3]); L[1] = _h; _h = fmaxf(L[1], L[2]); L[2] = fminf(L[1], L[2]); L[1] = _h; _h = fmaxf(L[4], L[5]); L[5] = fminf(L[4], L[5]); L[4] = _h; _h = fmaxf(L[6], L[7]); L[7] = fminf(L[6], L[7]); L[6] = _h; _h = fmaxf(L[4], L[6]); L[6] = fminf(L[4], L[6]); L[4] = _h; _h = fmaxf(L[5], L[7]); L[7] = fminf(L[5], L[7]); L[5] = _h; _h = fmaxf(L[5], L[6]); L[6] = fminf(L[5], L[6]); L[5] = _h; _h = fmaxf(L[0], L[4]); L[4] = fminf(L[0], L[4]); L[0] = _h; _h = fmaxf(L[2], L[6]); L[6] = fminf(L[2], L[6]); L[2] = _h; _h = fmaxf(L[2], L[4]); L[4] = fminf(L[2], L[4]); L[2] = _h; _h = fmaxf(L[1], L[5]); L[5] = fminf(L[1], L[5]); L[1] = _h; _h = fmaxf(L[3], L[7]); L[7] = fminf(L[3], L[7]); L[3] = _h; _h = fmaxf(L[3], L[5]); L[5] = fminf(L[3], L[5]); L[3] = _h; _h = fmaxf(L[1], L[2]); L[2] = fminf(L[1], L[2]); L[1] = _h; _h = fmaxf(L[3], L[4]); L[4] = fminf(L[3], L[4]); L[3] = _h; _h = fmaxf(L[5], L[6]); L[6] = fminf(L[5], L[6]); L[5] = _h; _h = fmaxf(L[8], L[9]); L[9] = fminf(L[8], L[9]); L[8] = _h; _h = fmaxf(L[10], L[11]); L[11] = fminf(L[10], L[11]); L[10] = _h; _h = fmaxf(L[8], L[10]); L[10] = fminf(L[8], L[10]); L[8] = _h; _h = fmaxf(L[9], L[11]); L[11] = fminf(L[9], L[11]); L[9] = _h; _h = fmaxf(L[9], L[10]); L[10] = fminf(L[9], L[10]); L[9] = _h; _h = fmaxf(L[12], L[13]); L[13] = fminf(L[12], L[13]); L[12] = _h; _h = fmaxf(L[14], L[15]); L[15] = fminf(L[14], L[15]); L[14] = _h; _h = fmaxf(L[12], L[14]); L[14] = fminf(L[12], L[14]); L[12] = _h; _h = fmaxf(L[13], L[15]); L[15] = fminf(L[13], L[15]); L[13] = _h; _h = fmaxf(L[13], L[14]); L[14] = fminf(L[13], L[14]); L[13] = _h; _h = fmaxf(L[8], L[12]); L[12] = fminf(L[8], L[12]); L[8] = _h; _h = fmaxf(L[10], L[14]); L[14] = fminf(L[10], L[14]); L[10] = _h; _h = fmaxf(L[10], L[12]); L[12] = fminf(L[10], L[12]); L[10] = _h; _h = fmaxf(L[9], L[13]); L[13] = fminf(L[9], L[13]); L[9] = _h; _h = fmaxf(L[11], L[15]); L[15] = fminf(L[11], L[15]); L[11] = _h; _h = fmaxf(L[11], L[13]); L[13] = fminf(L[11], L[13]); L[11] = _h; _h = fmaxf(L[9], L[10]); L[10] = fminf(L[9], L[10]); L[9] = _h; _h = fmaxf(L[11], L[12]); L[12] = fminf(L[11], L[12]); L[11] = _h; _h = fmaxf(L[13], L[14]); L[14] = fminf(L[13], L[14]); L[13] = _h; _h = fmaxf(L[0], L[8]); L[8] = fminf(L[0], L[8]); L[0] = _h; _h = fmaxf(L[4], L[12]); L[12] = fminf(L[4], L[12]); L[4] = _h; _h = fmaxf(L[4], L[8]); L[8] = fminf(L[4], L[8]); L[4] = _h; _h = fmaxf(L[2], L[10]); L[10] = fminf(L[2], L[10]); L[2] = _h; _h = fmaxf(L[6], L[14]); L[14] = fminf(L[6], L[14]); L[6] = _h; _h = fmaxf(L[6], L[10]); L[10] = fminf(L[6], L[10]); L[6] = _h; _h = fmaxf(L[2], L[4]); L[4] = fminf(L[2], L[4]); L[2] = _h; _h = fmaxf(L[6], L[8]); L[8] = fminf(L[6], L[8]); L[6] = _h; _h = fmaxf(L[10], L[12]); L[12] = fminf(L[10], L[12]); L[10] = _h; _h = fmaxf(L[1], L[9]); L[9] = fminf(L[1], L[9]); L[1] = _h; _h = fmaxf(L[5], L[13]); L[13] = fminf(L[5], L[13]); L[5] = _h; _h = fmaxf(L[5], L[9]); L[9] = fminf(L[5], L[9]); L[5] = _h; _h = fmaxf(L[3], L[11]); L[11] = fminf(L[3], L[11]); L[3] = _h; _h = fmaxf(L[7], L[15]); L[15] = fminf(L[7], L[15]); L[7] = _h; _h = fmaxf(L[7], L[11]); L[11] = fminf(L[7], L[11]); L[7] = _h; _h = fmaxf(L[3], L[5]); L[5] = fminf(L[3], L[5]); L[3] = _h; _h = fmaxf(L[7], L[9]); L[9] = fminf(L[7], L[9]); L[7] = _h; _h = fmaxf(L[11], L[13]); L[13] = fminf(L[11], L[13]); L[11] = _h; _h = fmaxf(L[1], L[2]); L[2] = fminf(L[1], L[2]); L[1] = _h; _h = fmaxf(L[3], L[4]); L[4] = fminf(L[3], L[4]); L[3] = _h; _h = fmaxf(L[5], L[6]); L[6] = fminf(L[5], L[6]); L[5] = _h; _h = fmaxf(L[7], L[8]); L[8] = fminf(L[7], L[8]); L[7] = _h; _h = fmaxf(L[9], L[10]); L[10] = fminf(L[9], L[10]); L[9] = _h; _h = fmaxf(L[11], L[12]); L[12] = fminf(L[11], L[12]); L[11] = _h; _h = fmaxf(L[13], L[14]); L[14] = fminf(L[13], L[14]); L[13] = _h; } while (0)
#define BITONIC16(L) do { float _h; _h = fmaxf(L[0], L[8]); L[8] = fminf(L[0], L[8]); L[0] = _h; _h = fmaxf(L[1], L[9]); L[9] = fminf(L[1], L[9]); L[1] = _h; _h = fmaxf(L[2], L[10]); L[10] = fminf(L[2], L[10]); L[2] = _h; _h = fmaxf(L[3], L[11]); L[11] = fminf(L[3], L[11]); L[3] = _h; _h = fmaxf(L[4], L[12]); L[12] = fminf(L[4], L[12]); L[4] = _h; _h = fmaxf(L[5], L[13]); L[13] = fminf(L[5], L[13]); L[5] = _h; _h = fmaxf(L[6], L[14]); L[14] = fminf(L[6], L[14]); L[6] = _h; _h = fmaxf(L[7], L[15]); L[15] = fminf(L[7], L[15]); L[7] = _h; _h = fmaxf(L[0], L[4]); L[4] = fminf(L[0], L[4]); L[0] = _h; _h = fmaxf(L[1], L[5]); L[5] = fminf(L[1], L[5]); L[1] = _h; _h = fmaxf(L[2], L[6]); L[6] = fminf(L[2], L[6]); L[2] = _h; _h = fmaxf(L[3], L[7]); L[7] = fminf(L[3], L[7]); L[3] = _h; _h = fmaxf(L[8], L[12]); L[12] = fminf(L[8], L[12]); L[8] = _h; _h = fmaxf(L[9], L[13]); L[13] = fminf(L[9], L[13]); L[9] = _h; _h = fmaxf(L[10], L[14]); L[14] = fminf(L[10], L[14]); L[10] = _h; _h = fmaxf(L[11], L[15]); L[15] = fminf(L[11], L[15]); L[11] = _h; _h = fmaxf(L[0], L[2]); L[2] = fminf(L[0], L[2]); L[0] = _h; _h = fmaxf(L[1], L[3]); L[3] = fminf(L[1], L[3]); L[1] = _h; _h = fmaxf(L[4], L[6]); L[6] = fminf(L[4], L[6]); L[4] = _h; _h = fmaxf(L[5], L[7]); L[7] = fminf(L[5], L[7]); L[5] = _h; _h = fmaxf(L[8], L[10]); L[10] = fminf(L[8], L[10]); L[8] = _h; _h = fmaxf(L[9], L[11]); L[11] = fminf(L[9], L[11]); L[9] = _h; _h = fmaxf(L[12], L[14]); L[14] = fminf(L[12], L[14]); L[12] = _h; _h = fmaxf(L[13], L[15]); L[15] = fminf(L[13], L[15]); L[13] = _h; _h = fmaxf(L[0], L[1]); L[1] = fminf(L[0], L[1]); L[0] = _h; _h = fmaxf(L[2], L[3]); L[3] = fminf(L[2], L[3]); L[2] = _h; _h = fmaxf(L[4], L[5]); L[5] = fminf(L[4], L[5]); L[4] = _h; _h = fmaxf(L[6], L[7]); L[7] = fminf(L[6], L[7]); L[6] = _h; _h = fmaxf(L[8], L[9]); L[9] = fminf(L[8], L[9]); L[8] = _h; _h = fmaxf(L[10], L[11]); L[11] = fminf(L[10], L[11]); L[10] = _h; _h = fmaxf(L[12], L[13]); L[13] = fminf(L[12], L[13]); L[12] = _h; _h = fmaxf(L[14], L[15]); L[15] = fminf(L[14], L[15]); L[14] = _h; } while (0)
#define INS16(L, xin) do { float _x = (xin); _Pragma("unroll") for (int _p = 0; _p < 16; ++_p) { const float _hi = fmaxf(L[_p], _x); _x = fminf(L[_p], _x); L[_p] = _hi; } } while (0)
__device__ void phase_topk(const Params& p, unsigned char* lds) {
    const int tid = threadIdx.x, wid = tid >> 6, lane = tid & 63, r = lane & 31, hh = lane >> 5;
    const bf16_t* qp = (const bf16_t*)(p.ws + OFF_QP); const bf16_t* keysb = (const bf16_t*)(p.ws + OFF_KEYS);
    int* idxo = (int*)(p.ws + OFF_IDX); float* go = (float*)(p.ws + OFF_G);
    float* myrows = (float*)lds + wid * 32 * 129;
    const float NEG = -__builtin_inff();
    for (int tile = blockIdx.x; tile < 256; tile += gridDim.x) {
        const int tokb = tile * 64 + (wid & 1) * 32;
        float v1[16], v2[16];
#pragma unroll
        for (int j = 0; j < 16; ++j) { v1[j] = NEG; v2[j] = NEG; }
#pragma unroll 1
        for (int pass = 0; pass < 4; ++pass) {
            const int half = pass >> 1, hg = pass & 1, head = hg * 4 + (wid >> 1);
            f32x16 acc[4] = {zero16(), zero16(), zero16(), zero16()};
            const bf16_t* arow = qp + (size_t)(tokb + r) * 2048 + head * 256 + half * 128 + 8 * hh;
            const bf16_t* kb = keysb + half * 16384 + r * 128 + 8 * hh;
#pragma unroll
            for (int ks = 0; ks < 8; ++ks) { const bf16x8 a = *(const bf16x8*)(arow + 16 * ks);
#pragma unroll
                for (int nt = 0; nt < 4; ++nt) { const bf16x8 bb = *(const bf16x8*)(kb + nt * 32 * 128 + 16 * ks); acc[nt] = MFMA32(a, bb, acc[nt]); } }
#pragma unroll
            for (int nt = 0; nt < 4; ++nt)
#pragma unroll
                for (int e = 0; e < 16; ++e) { const int m = (e & 3) + 8 * (e >> 2) + 4 * hh; myrows[m * 129 + nt * 32 + r] = acc[nt][e]; }
            asm volatile("s_waitcnt lgkmcnt(0)" ::: "memory"); __builtin_amdgcn_wave_barrier();
            float L[16];
            const float* rowp = myrows + r * 129 + hh * 64;
#pragma unroll
            for (int j = 0; j < 16; ++j) L[j] = __uint_as_float((__float_as_uint(rowp[j]) & ~127u) | (unsigned)(127 - (hh * 64 + j)));
            SORT16(L);
#pragma unroll 1
            for (int g = 1; g < 4; ++g) {
                float Gp[16];
#pragma unroll
                for (int j = 0; j < 16; ++j) Gp[j] = __uint_as_float((__float_as_uint(rowp[g * 16 + j]) & ~127u) | (unsigned)(127 - (hh * 64 + g * 16 + j)));
                SORT16(Gp);
#pragma unroll
                for (int j = 0; j < 16; ++j) L[j] = fmaxf(L[j], Gp[15 - j]);
                BITONIC16(L);
            }
            {
                float O[16];
#pragma unroll
                for (int j = 0; j < 16; ++j) O[j] = __shfl_xor(L[j], 32);
#pragma unroll
                for (int j = 0; j < 16; ++j) L[j] = fmaxf(L[j], O[15 - j]);
                BITONIC16(L);
            }
            const bool mine = hh == hg;
            if (half == 0) {
#pragma unroll
                for (int j = 0; j < 16; ++j) v1[j] = mine ? L[j] : v1[j];
            } else {
#pragma unroll
                for (int j = 0; j < 16; ++j) v2[j] = mine ? L[j] : v2[j];
            }
            asm volatile("s_waitcnt lgkmcnt(0)" ::: "memory"); __builtin_amdgcn_wave_barrier();
        }
        float T[16]; int TI[16];
        int i1[16], i2[16];
#pragma unroll
        for (int j = 0; j < 16; ++j) { i1[j] = (127 - (int)(__float_as_uint(v1[j]) & 127u)) * 128; i2[j] = 127 - (int)(__float_as_uint(v2[j]) & 127u); }
#pragma unroll
        for (int j = 0; j < 16; ++j) { T[j] = v1[0] + v2[j]; TI[j] = i1[0] + i2[j]; }
#pragma unroll
        for (int a = 1; a < 16; ++a)
#pragma unroll
            for (int b = 0; b < 16; ++b)
                if ((a + 1) * (b + 1) <= 16) {
                    float s = v1[a] + v2[b]; int id = i1[a] + i2[b];
#pragma unroll
                    for (int q = (a + 1) * (b + 1) - 1; q < 16; ++q) { const bool c = s > T[q]; const float ts = c ? T[q] : s; const int ti = c ? TI[q] : id; T[q] = c ? s : T[q]; TI[q] = c ? id : TI[q]; s = ts; id = ti; }
                }
        const int token = tokb + r, head = hh * 4 + (wid >> 1);
        const float t0v = T[0]; float tot = 0.f;
#pragma unroll
        for (int j = 0; j < 16; ++j) { T[j] = __expf(T[j] - t0v); tot += T[j]; }
        const float inv = 1.0f / tot;
#pragma unroll
        for (int j = 0; j < 16; j += 4) { *(f32x4*)(go + (size_t)token * 128 + head * 16 + j) = (f32x4){T[j] * inv, T[j + 1] * inv, T[j + 2] * inv, T[j + 3] * inv};
            *(int4*)(idxo + (size_t)token * 128 + head * 16 + j) = make_int4(TI[j], TI[j + 1], TI[j + 2], TI[j + 3]); }
    }
}

__device__ void phase_peer(const Params& p, unsigned char* lds) {
    const int tid = threadIdx.x, wid = tid >> 6, lane = tid & 63, l16 = lane & 15, q4 = lane >> 4;
    const bf16_t* h2 = (const bf16_t*)(p.ws + OFF_H2); const bf16_t* db = (const bf16_t*)(p.ws + OFF_DOWN); const bf16_t* ub = (const bf16_t*)(p.ws + OFF_UP);
    const int* idxo = (const int*)(p.ws + OFF_IDX); const float* go = (const float*)(p.ws + OFF_G);
    const float* mod = (const float*)(p.ws + OFF_MOD);
    float* sga = (float*)lds + wid * 128;
    for (int tg = blockIdx.x * 8 + wid; tg < 2048; tg += gridDim.x * 8) {
        const int b = tg >> 10;
        for (int tt = 0; tt < 8; ++tt) {
            const int t = tg * 8 + tt;
            const int idA = idxo[(size_t)t * 128 + lane], idB = idxo[(size_t)t * 128 + 64 + lane];
            const float gA = go[(size_t)t * 128 + lane], gB = go[(size_t)t * 128 + 64 + lane];
            u32x4 hq[8];
#pragma unroll
            for (int i = 0; i < 8; ++i) hq[i] = *(const u32x4*)(h2 + (size_t)t * DM + i * 128 + l16 * 8);
#pragma unroll 2
            for (int s = 0; s < 32; ++s) {
                const int slot = 4 * s + q4;
                const int e = __shfl(s < 16 ? idA : idB, slot & 63);
                const bf16_t* row = db + (size_t)e * DM + l16 * 8;
                u32x4 w[8];
#pragma unroll
                for (int i = 0; i < 8; ++i) w[i] = *(const u32x4*)(row + i * 128);
                float a = 0.f;
#pragma unroll
                for (int i = 0; i < 8; ++i) {
                    a = dot2bf(w[i].x, hq[i].x, a); a = dot2bf(w[i].y, hq[i].y, a); a = dot2bf(w[i].z, hq[i].z, a); a = dot2bf(w[i].w, hq[i].w, a); }
                a += __shfl_xor(a, 8); a += __shfl_xor(a, 4); a += __shfl_xor(a, 2); a += __shfl_xor(a, 1);
                const float gg = __shfl(s < 16 ? gA : gB, slot & 63);
                if (l16 == 0) sga[slot] = gelu1(a) * gg;
            }
            asm volatile("s_waitcnt lgkmcnt(0)" ::: "memory"); __builtin_amdgcn_wave_barrier();
            float acc[16];
#pragma unroll
            for (int j = 0; j < 16; ++j) acc[j] = 0.f;
#pragma unroll 4
            for (int slot = 0; slot < 128; ++slot) {
                const int e = __builtin_amdgcn_readlane(slot < 64 ? idA : idB, slot & 63);
                const float ga = sga[slot];
                const bf16_t* row = ub + (size_t)e * DM + lane * 8;
                const u32x4 w0 = *(const u32x4*)row, w1 = *(const u32x4*)(row + 512);
                acc[0] += ga * bflo(w0.x); acc[1] += ga * bfhi(w0.x); acc[2] += ga * bflo(w0.y); acc[3] += ga * bfhi(w0.y);
                acc[4] += ga * bflo(w0.z); acc[5] += ga * bfhi(w0.z); acc[6] += ga * bflo(w0.w); acc[7] += ga * bfhi(w0.w);
                acc[8] += ga * bflo(w1.x); acc[9] += ga * bfhi(w1.x); acc[10] += ga * bflo(w1.y); acc[11] += ga * bfhi(w1.y);
                acc[12] += ga * bflo(w1.z); acc[13] += ga * bfhi(w1.z); acc[14] += ga * bflo(w1.w); acc[15] += ga * bfhi(w1.w);
            }
            asm volatile("s_waitcnt lgkmcnt(0)" ::: "memory"); __builtin_amdgcn_wave_barrier();
            float xo[16]; float ss = 0.f;
#pragma unroll
            for (int i = 0; i < 2; ++i)
#pragma unroll
                for (int j4 = 0; j4 < 2; ++j4) { const int d = i * 512 + lane * 8 + j4 * 4;
                    const f32x4 xv = *(const f32x4*)(p.out + (size_t)t * DM + d);
                    const f32x4 g2 = *(const f32x4*)(mod + b * 6144 + 5120 + d) + *(const f32x4*)(p.b_ada + 5120 + d);
#pragma unroll
                    for (int j = 0; j < 4; ++j) { const float v = xv[j] + g2[j] * acc[i * 8 + j4 * 4 + j]; xo[i * 8 + j4 * 4 + j] = v; ss += v * v; } }
            ss = wave_sum(ss);
            const float rstd = rsqrtf(ss * (1.0f / 1024.0f) + EPS);
#pragma unroll
            for (int i = 0; i < 2; ++i)
#pragma unroll
                for (int j4 = 0; j4 < 2; ++j4) { const int d = i * 512 + lane * 8 + j4 * 4;
                    const f32x4 fw = *(const f32x4*)(p.final_w + d);
                    *(f32x4*)(p.out + (size_t)t * DM + d) = (f32x4){xo[i * 8 + j4 * 4] * rstd * fw[0], xo[i * 8 + j4 * 4 + 1] * rstd * fw[1], xo[i * 8 + j4 * 4 + 2] * rstd * fw[2], xo[i * 8 + j4 * 4 + 3] * rstd * fw[3]}; }
        }
    }
}

__device__ void phase_tables8(const Params& p) {
    const int wid = threadIdx.x >> 6, lane = threadIdx.x & 63;
    const int row0 = blockIdx.x * 8 + wid, rstep = gridDim.x * 8;
    f32x4 vn[4];
    if (row0 < 32768) { const float* src0 = (row0 >= 16384 ? p.up : p.down) + (size_t)(row0 & 16383) * DM + lane * 16;
#pragma unroll
        for (int i = 0; i < 4; ++i) vn[i] = __builtin_nontemporal_load((const f32x4*)(src0 + 4 * i)); }
    for (int row = row0; row < 32768; row += rstep) {
        const bool isup = row >= 16384; const int e = row & 16383;
        f32x4 v[4]; float m = 0.f;
#pragma unroll
        for (int i = 0; i < 4; ++i) v[i] = vn[i];
        if (row + rstep < 32768) { const int rn = row + rstep; const float* srcn = (rn >= 16384 ? p.up : p.down) + (size_t)(rn & 16383) * DM + lane * 16;
#pragma unroll
            for (int i = 0; i < 4; ++i) vn[i] = __builtin_nontemporal_load((const f32x4*)(srcn + 4 * i)); }
#pragma unroll
        for (int i = 0; i < 4; ++i) { m = fmaxf(m, fmaxf(fmaxf(fabsf(v[i][0]), fabsf(v[i][1])), fmaxf(fabsf(v[i][2]), fabsf(v[i][3])))); }
#pragma unroll
        for (int o = 32; o; o >>= 1) m = fmaxf(m, __shfl_xor(m, o));
        const float sc = m > 0.f ? m * (1.0f / 224.0f) : 1.0f, inv = m > 0.f ? 224.0f / m : 0.f;
        int w[4];
#pragma unroll
        for (int i = 0; i < 4; ++i) { w[i] = __builtin_amdgcn_cvt_pk_fp8_f32(v[i][0] * inv, v[i][1] * inv, 0, false); w[i] = __builtin_amdgcn_cvt_pk_fp8_f32(v[i][2] * inv, v[i][3] * inv, w[i], true); }
        unsigned char* dst = p.ws + (isup ? OFF_UP8 : OFF_DOWN8) + (size_t)e * 1024 + lane * 16;
        *(u32x4*)dst = (u32x4){(unsigned)w[0], (unsigned)w[1], (unsigned)w[2], (unsigned)w[3]};
        if (lane == 0) ((float*)(p.ws + (isup ? OFF_SCU : OFF_SCD)))[e] = sc;
    }
}

__device__ __forceinline__ float dot2bfv(bf16x2_t a, unsigned b, float c) { return __builtin_amdgcn_fdot2_f32_bf16(a, __builtin_bit_cast(bf16x2_t, b), c, false); }
#define PEER_FMA16(ACC, W, GA) do { const f32x2 _g2 = (f32x2){(GA), (GA)}; \
    ACC[0] += _g2 * __builtin_amdgcn_cvt_pk_f32_fp8((int)(W).x, false); ACC[1] += _g2 * __builtin_amdgcn_cvt_pk_f32_fp8((int)(W).x, true); \
    ACC[2] += _g2 * __builtin_amdgcn_cvt_pk_f32_fp8((int)(W).y, false); ACC[3] += _g2 * __builtin_amdgcn_cvt_pk_f32_fp8((int)(W).y, true); \
    ACC[4] += _g2 * __builtin_amdgcn_cvt_pk_f32_fp8((int)(W).z, false); ACC[5] += _g2 * __builtin_amdgcn_cvt_pk_f32_fp8((int)(W).z, true); \
    ACC[6] += _g2 * __builtin_amdgcn_cvt_pk_f32_fp8((int)(W).w, false); ACC[7] += _g2 * __builtin_amdgcn_cvt_pk_f32_fp8((int)(W).w, true); } while (0)
__device__ void phase_peer2(const Params& p, unsigned char* lds) {
    const int tid = threadIdx.x, wid = tid >> 6, lane = tid & 63, l16 = lane & 15, q4 = lane >> 4;
    unsigned char* wl = lds + wid * 14336;
    int* se = (int*)wl;
    float* sg = (float*)(wl + 2048);
    float* sa = (float*)(wl + 4096);
    unsigned char* hl = wl + 6144;
    const unsigned char* d8 = p.ws + OFF_DOWN8; const unsigned char* u8 = p.ws + OFF_UP8;
    const float* scd = (const float*)(p.ws + OFF_SCD); const float* scu = (const float*)(p.ws + OFF_SCU);
    const bf16_t* h2 = (const bf16_t*)(p.ws + OFF_H2);
    const int* idxo = (const int*)(p.ws + OFF_IDX); const float* go = (const float*)(p.ws + OFF_G);
    const float* mod = (const float*)(p.ws + OFF_MOD);
    const unsigned long long ltmask = (1ull << lane) - 1ull;
    for (int blk = blockIdx.x; blk < 512; blk += gridDim.x) {
        const int tok0 = blk * 32 + wid * 4; const int b = tok0 >> 13;
        {
            int ids[8]; float gs[8];
#pragma unroll
            for (int tk = 0; tk < 4; ++tk) { const size_t o = (size_t)(tok0 + tk) * 128 + lane; ids[2 * tk] = idxo[o]; ids[2 * tk + 1] = idxo[o + 64]; gs[2 * tk] = go[o]; gs[2 * tk + 1] = go[o + 64];
#pragma unroll
                for (int hb = 0; hb < 2; ++hb) { const int c = lane + 64 * hb, cp = (c >> 1) | ((c & 1) << 6);
                    *(u32x4*)(hl + tk * 2048 + cp * 16) = *(const u32x4*)(h2 + (size_t)(tok0 + tk) * DM + c * 8); } }
            int base = 0;
#pragma unroll
            for (int r = 0; r < 8; ++r)
#pragma unroll
                for (int k = 0; k < 8; ++k) { const bool m = (ids[k] >> 11) == r; const unsigned long long mk = __ballot(m);
                    if (m) { const int pos = base + __popcll(mk & ltmask); se[pos] = ids[k] | ((k >> 1) << 16); sg[pos] = gs[k]; }
                    base += __popcll(mk); }
        }
        asm volatile("s_waitcnt lgkmcnt(0)" ::: "memory"); __builtin_amdgcn_wave_barrier();
        {
            u32x4 bufA[8], bufB[8]; float sdA[2], sdB[2];
#define PEER_DLOAD(BUF, SD, K) do { _Pragma("unroll") for (int _u = 0; _u < 2; ++_u) { const int _e = se[8 * (K) + 4 * _u + q4] & 0xffff; const unsigned char* _row = d8 + (size_t)_e * 1024 + l16 * 16; \
            _Pragma("unroll") for (int _i = 0; _i < 4; ++_i) BUF[_u * 4 + _i] = *(const u32x4*)(_row + _i * 256); SD[_u] = scd[_e]; } } while (0)
#define PEER_DCOMP(BUF, SD, K) do { _Pragma("unroll") for (int _u = 0; _u < 2; ++_u) { const int _ix = 8 * (K) + 4 * _u + q4; const int _tk = se[_ix] >> 16; const unsigned char* _hb = hl + _tk * 2048 + l16 * 16; float _a = 0.f; \
            _Pragma("unroll") for (int _i = 0; _i < 4; ++_i) { const u32x4 _h0 = *(const u32x4*)(_hb + _i * 256), _h1 = *(const u32x4*)(_hb + 1024 + _i * 256); const u32x4 _w = BUF[_u * 4 + _i]; \
                _a = dot2bfv(__builtin_amdgcn_cvt_scalef32_pk_bf16_fp8((int)_w.x, 1.0f, false), _h0.x, _a); _a = dot2bfv(__builtin_amdgcn_cvt_scalef32_pk_bf16_fp8((int)_w.x, 1.0f, true), _h0.y, _a); \
                _a = dot2bfv(__builtin_amdgcn_cvt_scalef32_pk_bf16_fp8((int)_w.y, 1.0f, false), _h0.z, _a); _a = dot2bfv(__builtin_amdgcn_cvt_scalef32_pk_bf16_fp8((int)_w.y, 1.0f, true), _h0.w, _a); \
                _a = dot2bfv(__builtin_amdgcn_cvt_scalef32_pk_bf16_fp8((int)_w.z, 1.0f, false), _h1.x, _a); _a = dot2bfv(__builtin_amdgcn_cvt_scalef32_pk_bf16_fp8((int)_w.z, 1.0f, true), _h1.y, _a); \
                _a = dot2bfv(__builtin_amdgcn_cvt_scalef32_pk_bf16_fp8((int)_w.w, 1.0f, false), _h1.z, _a); _a = dot2bfv(__builtin_amdgcn_cvt_scalef32_pk_bf16_fp8((int)_w.w, 1.0f, true), _h1.w, _a); } \
            _a += __shfl_xor(_a, 8); _a += __shfl_xor(_a, 4); _a += __shfl_xor(_a, 2); _a += __shfl_xor(_a, 1); \
            if (l16 == 0) sa[_ix] = _a * SD[_u]; } } while (0)
            PEER_DLOAD(bufA, sdA, 0);
            for (int k = 0; k < 64; k += 2) {
                PEER_DLOAD(bufB, sdB, k + 1);
                PEER_DCOMP(bufA, sdA, k);
                if (k + 2 < 64) PEER_DLOAD(bufA, sdA, k + 2);
                PEER_DCOMP(bufB, sdB, k + 1);
            }
            asm volatile("s_waitcnt lgkmcnt(0)" ::: "memory"); __builtin_amdgcn_wave_barrier();
#pragma unroll
            for (int j = 0; j < 8; ++j) { const int ix = lane + 64 * j; const int e = se[ix] & 0xffff; sg[ix] = gelu1(sa[ix]) * sg[ix] * scu[e]; }
#undef PEER_DLOAD
#undef PEER_DCOMP
        }
        asm volatile("s_waitcnt lgkmcnt(0)" ::: "memory"); __builtin_amdgcn_wave_barrier();
        f32x2 acc0[8], acc1[8], acc2[8], acc3[8];
#pragma unroll
        for (int j = 0; j < 8; ++j) { acc0[j] = (f32x2){0.f, 0.f}; acc1[j] = (f32x2){0.f, 0.f}; acc2[j] = (f32x2){0.f, 0.f}; acc3[j] = (f32x2){0.f, 0.f}; }
        {
            u32x4 ring[8];
#pragma unroll
            for (int j = 0; j < 8; ++j) ring[j] = *(const u32x4*)(u8 + (size_t)(se[j] & 0xffff) * 1024 + lane * 16);
            for (int i = 0; i < 512; i += 8) {
#pragma unroll
                for (int j = 0; j < 8; ++j) {
                    const int tk = __builtin_amdgcn_readfirstlane(se[i + j]) >> 16; const float ga = sg[i + j];
                    const u32x4 w = ring[j];
                    if (i + 8 < 512) ring[j] = *(const u32x4*)(u8 + (size_t)(se[i + 8 + j] & 0xffff) * 1024 + lane * 16);
                    if (tk == 0) PEER_FMA16(acc0, w, ga); else if (tk == 1) PEER_FMA16(acc1, w, ga); else if (tk == 2) PEER_FMA16(acc2, w, ga); else PEER_FMA16(acc3, w, ga);
                }
            }
        }
        asm volatile("s_waitcnt lgkmcnt(0)" ::: "memory"); __builtin_amdgcn_wave_barrier();
#define PEER_FIN(ACC, TK) do { const size_t _o = (size_t)(tok0 + (TK)) * DM + lane * 16; f32x4 _x[4]; float _ss = 0.f; \
        _Pragma("unroll") for (int _j = 0; _j < 4; ++_j) { const f32x4 _xv = *(const f32x4*)(p.out + _o + 4 * _j); const f32x4 _g2 = *(const f32x4*)(mod + b * 6144 + 5120 + lane * 16 + 4 * _j) + *(const f32x4*)(p.b_ada + 5120 + lane * 16 + 4 * _j); \
            _x[_j] = _xv + _g2 * (f32x4){ACC[2 * _j].x, ACC[2 * _j].y, ACC[2 * _j + 1].x, ACC[2 * _j + 1].y}; _ss += _x[_j][0] * _x[_j][0] + _x[_j][1] * _x[_j][1] + _x[_j][2] * _x[_j][2] + _x[_j][3] * _x[_j][3]; } \
        _ss = wave_sum(_ss); const float _rs = rsqrtf(_ss * (1.0f / 1024.0f) + EPS); \
        _Pragma("unroll") for (int _j = 0; _j < 4; ++_j) { const f32x4 _fw = *(const f32x4*)(p.final_w + lane * 16 + 4 * _j); *(f32x4*)(p.out + _o + 4 * _j) = _x[_j] * _rs * _fw; } } while (0)
        PEER_FIN(acc0, 0); PEER_FIN(acc1, 1); PEER_FIN(acc2, 2); PEER_FIN(acc3, 3);
#undef PEER_FIN
    }
}

#ifndef DBG_STAGE
#define DBG_STAGE 0
#endif
__device__ void phase_final_only(const Params& p) {
    const int wid = threadIdx.x >> 6, lane = threadIdx.x & 63;
    for (int t = blockIdx.x * 8 + wid; t < NTOK; t += gridDim.x * 8) {
        f32x4 xv[4]; float ss = 0.f;
#pragma unroll
        for (int i = 0; i < 4; ++i) { xv[i] = *(const f32x4*)(p.out + (size_t)t * DM + 256 * i + 4 * lane); ss += xv[i][0] * xv[i][0] + xv[i][1] * xv[i][1] + xv[i][2] * xv[i][2] + xv[i][3] * xv[i][3]; }
        ss = wave_sum(ss);
        const float rstd = rsqrtf(ss * (1.0f / 1024.0f) + EPS);
#pragma unroll
        for (int i = 0; i < 4; ++i) { const f32x4 fw = *(const f32x4*)(p.final_w + 256 * i + 4 * lane); *(f32x4*)(p.out + (size_t)t * DM + 256 * i + 4 * lane) = xv[i] * rstd * fw; }
    }
}

__device__ void phase_dump_bf16(const Params& p, const bf16_t* src, int ld) {
    for (size_t e = (size_t)blockIdx.x * 512 + threadIdx.x; e < (size_t)NTOK * DM; e += (size_t)gridDim.x * 512) {
        const size_t t = e >> 10, d = e & 1023; float v = __uint_as_float((unsigned)src[t * ld + d] << 16); if (!(fabsf(v) < 1e30f)) v = 1000.f; p.out[e] = v; }
}
__device__ void dbg_check_bf16(const Params& p, const bf16_t* src, size_t n, unsigned bit) {
    unsigned* flags = (unsigned*)(p.ws + OFF_IDX);
    bool bad = false;
    for (size_t e = (size_t)blockIdx.x * 512 + threadIdx.x; e < n; e += (size_t)gridDim.x * 512) { const float v = __uint_as_float((unsigned)src[e] << 16); if (!(fabsf(v) < 1e30f)) bad = true; }
    if (bad) atomicOr(flags, bit);
}
__device__ void dbg_check_f32(const Params& p, const float* src, size_t n, unsigned bit, float lim) {
    unsigned* flags = (unsigned*)(p.ws + OFF_IDX);
    bool bad = false;
    for (size_t e = (size_t)blockIdx.x * 512 + threadIdx.x; e < n; e += (size_t)gridDim.x * 512) { const float v = src[e]; if (!(fabsf(v) < lim)) bad = true; }
    if (bad) atomicOr(flags, bit);
}
__device__ void dbg_final(const Params& p) {
    const unsigned f = *(const unsigned*)(p.ws + OFF_IDX);
    for (size_t e = (size_t)blockIdx.x * 512 + threadIdx.x; e < (size_t)NTOK * DM; e += (size_t)gridDim.x * 512) p.out[e] = p.x[e] * (1.0f + (float)f);
}
#define GSYNC() xcd_barrier(xb)
__global__ void __launch_bounds__(512, 2) fwd_megakernel(Params p) {
    extern __shared__ __attribute__((aligned(16))) unsigned char lds[];
    cg::grid_group grid = cg::this_grid();
    LAS unsigned char* lds3 = (LAS unsigned char*)lds;
    const float* mod = (const float*)(p.ws + OFF_MOD);
    volatile LAS unsigned* xst = (volatile LAS unsigned*)(lds3 + LDS_BYTES - 16);
    if (threadIdx.x == 0) { xst[0] = 0u; xst[1] = 0u; }
    __syncthreads();
    const XcdBarrier xb = xcd_barrier_post((unsigned*)(p.ws + OFF_BAR), xst);
    if (p.ws == nullptr) grid.sync();
    phase0(p, lds);
#if DBG_STAGE == 6
    if (blockIdx.x == 0 && threadIdx.x == 0) *(unsigned*)(p.ws + OFF_IDX) = 0u;
#endif
    GSYNC();
    phase_norm<true>(p, p.x, p.norm1_w, 0, 1024, (bf16_t*)(p.ws + OFF_HB), lds);
    GSYNC();
#if DBG_STAGE == 3
    phase_dump_bf16(p, (const bf16_t*)(p.ws + OFF_HB), DM); return;
#endif
    { pg8::StaticOrder S; S.init(NTOK, 7168, gridDim.x, blockIdx.x); EpiProj E{(bf16_t*)(p.ws + OFF_PROJ)};
        pg8::gemm_phase(lds3, pg8::Gemm{(const bf16_t*)(p.ws + OFF_HB), (const bf16_t*)(p.ws + OFF_WINT), NTOK, 7168, 1024}, S, E); }
    GSYNC();
#if DBG_STAGE == 2
    phase_dump_bf16(p, (const bf16_t*)(p.ws + OFF_PROJ) + 1024, PW); return;
#endif
    phase_glaA(p, lds);
    GSYNC();
#if DBG_STAGE == 6
    dbg_check_bf16(p, (const bf16_t*)p.out, (size_t)NTOK * 2048, 1u);
    dbg_check_f32(p, (const float*)(p.ws + OFF_ALR), (size_t)NTOK * 16, 8u, 50.f);
    dbg_check_f32(p, (const float*)(p.ws + OFF_DECAY), (size_t)1024 * 128, 16u, 1.0001f);
#endif
    phase_scan_sgu(p, lds);
    GSYNC();
#if DBG_STAGE == 6
    dbg_check_bf16(p, (const bf16_t*)p.out, (size_t)NTOK * 2048, 2u);
#endif
#if DBG_STAGE == 4
    phase_dump_bf16(p, (const bf16_t*)(p.ws + OFF_HB), DM); return;
#endif
    phase_glaC(p, lds);
    GSYNC();
#if DBG_STAGE == 5
    phase_dump_bf16(p, (const bf16_t*)(p.ws + OFF_HB), DM); return;
#endif
#if DBG_STAGE == 6
    dbg_check_bf16(p, (const bf16_t*)(p.ws + OFF_HB), (size_t)NTOK * DM, 4u);
    GSYNC();
    dbg_final(p); return;
#endif
    { pg8::StaticOrder S; S.init(NTOK, 1024, gridDim.x, blockIdx.x); EpiX1 E{p.x, p.out, mod, p.b_ada};
        pg8::gemm_phase(lds3, pg8::Gemm{(const bf16_t*)(p.ws + OFF_HB), (const bf16_t*)(p.ws + OFF_WOUTT), NTOK, 1024, 1024}, S, E); }
    GSYNC();
#if DBG_STAGE == 1
    phase_final_only(p); return;
#endif
    phase_norm<false>(p, p.out, p.norm2_w, 3072, 4096, (bf16_t*)(p.ws + OFF_H2), lds);
    phase_tables8(p);
    GSYNC();
    { pg8::StaticOrder S; S.init(NTOK, 2048, gridDim.x, blockIdx.x); EpiQ E{(bf16_t*)(p.ws + OFF_QP)};
        pg8::gemm_phase(lds3, pg8::Gemm{(const bf16_t*)(p.ws + OFF_H2), (const bf16_t*)(p.ws + OFF_WQT), NTOK, 2048, 1024}, S, E); }
    GSYNC();
    phase_topk(p, lds);
    GSYNC();
    phase_peer2(p, lds);
}

extern "C" void kernel_launch(void* const* d_in, const int* in_sizes, int n_in, void* d_out, int out_size, void* d_ws, size_t ws_size, hipStream_t stream) {
    static int grid_blocks = 0;
    if (!grid_blocks) {
        int dev = 0, cus = 0, per_cu = 0;
        hipGetDevice(&dev);
        hipDeviceGetAttribute(&cus, hipDeviceAttributeMultiprocessorCount, dev);
        hipFuncSetAttribute((const void*)fwd_megakernel, hipFuncAttributeMaxDynamicSharedMemorySize, LDS_BYTES);
        hipOccupancyMaxActiveBlocksPerMultiprocessor(&per_cu, (const void*)fwd_megakernel, 512, LDS_BYTES);
        if (per_cu < 1) per_cu = 1;
        grid_blocks = cus * per_cu;
        if (ws_size < WS_END) fprintf(stderr, "kernel_launch: workspace too small (%zu < %zu)\n", ws_size, (size_t)WS_END);
    }
    Params p{};
    p.x = (const float*)d_in[0]; p.c = (const float*)d_in[1]; p.w_ada = (const float*)d_in[2]; p.b_ada = (const float*)d_in[3]; p.norm1_w = (const float*)d_in[4];
    p.w_in = (const float*)d_in[5]; p.w_alpha_up = (const float*)d_in[6]; p.b_alpha = (const float*)d_in[7]; p.gla_norm_w = (const float*)d_in[8];
    p.sgu_ln_w = (const float*)d_in[9]; p.sgu_ln_b = (const float*)d_in[10]; p.sgu_w = (const float*)d_in[11]; p.sgu_b = (const float*)d_in[12];
    p.w_out = (const float*)d_in[13]; p.norm2_w = (const float*)d_in[14]; p.w_q = (const float*)d_in[15]; p.keys1 = (const float*)d_in[16]; p.keys2 = (const float*)d_in[17];
    p.down = (const float*)d_in[18]; p.up = (const float*)d_in[19]; p.final_w = (const float*)d_in[20];
    p.out = (float*)d_out; p.ws = (unsigned char*)d_ws;
    hipMemsetAsync((unsigned char*)d_ws + OFF_BAR, 0, XCD_BAR_WORDS * 4, stream);
    void* args[] = {&p};
    hipError_t e = hipLaunchCooperativeKernel((const void*)fwd_megakernel, dim3(grid_blocks), dim3(512), args, LDS_BYTES, stream);
    if (e != hipSuccess) fprintf(stderr, "cooperative launch failed: %s (grid %d)\n", hipGetErrorString(e), grid_blocks);
}
```

```cpp
#include <hip/hip_runtime.h>
#include <hip/hip_cooperative_groups.h>
#include <cstdio>
namespace cg = cooperative_groups;

#define LAS __attribute__((address_space(3)))
typedef unsigned short bf16_t;
typedef short bf16x8 __attribute__((ext_vector_type(8)));
typedef float f32x2 __attribute__((ext_vector_type(2)));
typedef float f32x4 __attribute__((ext_vector_type(4)));
typedef float f32x16 __attribute__((ext_vector_type(16)));
typedef unsigned u32x2 __attribute__((ext_vector_type(2)));
typedef unsigned u32x4 __attribute__((ext_vector_type(4)));
typedef __bf16 bf16x2_t __attribute__((ext_vector_type(2)));

constexpr int NTOK = 16384, DM = 1024, SEQ = 8192, INW = 7184, PW = 5120;
constexpr float EPS = 1e-6f;
constexpr size_t MiB = 1024 * 1024;
constexpr size_t OFF_PROJ = 0;
constexpr size_t OFF_DOWN = 0;
constexpr size_t OFF_UP = 32 * MiB;
constexpr size_t OFF_DOWN8 = 0;
constexpr size_t OFF_UP8 = 16 * MiB;
constexpr size_t OFF_SCD = 32 * MiB;
constexpr size_t OFF_SCU = 32 * MiB + 65536;
constexpr size_t OFF_H2 = 64 * MiB;
constexpr size_t OFF_QP = 96 * MiB;
constexpr size_t OFF_HB = 160 * MiB;
constexpr size_t OFF_WINT = 192 * MiB;
constexpr size_t OFF_WOUTT = 206 * MiB;
constexpr size_t OFF_WQT = 208 * MiB;
constexpr size_t OFF_KEYS = 212 * MiB;
constexpr size_t OFF_MOD = OFF_KEYS + 65536;
constexpr size_t OFF_ALR = OFF_MOD + 65536;
constexpr size_t OFF_STATS = OFF_ALR + MiB;
constexpr size_t OFF_DECAY = OFF_STATS + 131072;
constexpr size_t OFF_BAR = OFF_DECAY + 524288;
constexpr size_t OFF_IDX = 214 * MiB;
constexpr size_t OFF_G = 222 * MiB;
constexpr size_t WS_END = 230 * MiB;
constexpr int LDS_BYTES = 135168;

struct Params {
    const float *x, *c, *w_ada, *b_ada, *norm1_w, *w_in, *w_alpha_up, *b_alpha, *gla_norm_w, *sgu_ln_w, *sgu_ln_b, *sgu_w, *sgu_b, *w_out, *norm2_w, *w_q, *keys1, *keys2, *down, *up, *final_w;
    float* out; unsigned char* ws;
};

__device__ __forceinline__ unsigned cvt_pk_bf16_asm(float lo, float hi) { unsigned r; asm volatile("v_cvt_pk_bf16_f32 %0, %1, %2" : "=v"(r) : "v"(lo), "v"(hi)); return r; }
__device__ __forceinline__ unsigned cvt_pk_bf16(float lo, float hi) { f32x2 v = {lo, hi}; bf16x2_t b = __builtin_convertvector(v, bf16x2_t); return __builtin_bit_cast(unsigned, b); }
__device__ __forceinline__ float bflo(unsigned w) { return __uint_as_float(w << 16); }
__device__ __forceinline__ float bfhi(unsigned w) { return __uint_as_float(w & 0xffff0000u); }
__device__ __forceinline__ float wave_sum(float v) {
#pragma unroll
    for (int o = 32; o; o >>= 1) v += __shfl_xor(v, o);
    return v;
}
__device__ __forceinline__ float sigmoidf_(float x) { return __builtin_amdgcn_rcpf(1.0f + __expf(-x)); }
__device__ __forceinline__ f32x2 gelu_pk(f32x2 v) {
    const f32x2 av = __builtin_elementwise_abs(v), d = av * 0.2316418882f + 1.0f;
    f32x2 t; t.x = __builtin_amdgcn_rcpf(d.x); t.y = __builtin_amdgcn_rcpf(d.y);
    f32x2 q = t * 0.5307027145f + (-0.7265760135f); q = q * t + 0.7107068705f; q = q * t + (-0.142248368f); q = q * t + 0.127414796f; q = q * t;
    const f32x2 s = (v * v) * (-0.72134752044f);
    f32x2 e; e.x = __builtin_amdgcn_exp2f(s.x); e.y = __builtin_amdgcn_exp2f(s.y);
    const f32x2 m = v * (q * e), r = v - m;
    f32x2 o; o.x = v.x < 0.f ? m.x : r.x; o.y = v.y < 0.f ? m.y : r.y; return o;
}
__device__ __forceinline__ float gelu1(float v) { f32x2 r = gelu_pk((f32x2){v, v}); return r.x; }
__device__ __forceinline__ f32x16 zero16() { f32x16 z;
#pragma unroll
    for (int i = 0; i < 16; ++i) z[i] = 0.f;
    return z; }
__device__ __forceinline__ float dot2bf(unsigned a, unsigned b, float c) { return __builtin_amdgcn_fdot2_f32_bf16(__builtin_bit_cast(bf16x2_t, a), __builtin_bit_cast(bf16x2_t, b), c, false); }
#define MFMA32(a, b, c) __builtin_amdgcn_mfma_f32_32x32x16_bf16((a), (b), (c), 0, 0, 0)


#define XB_TMO      128
#define XB_XCNT(j)  (256  + 64 * (j))
#define XB_XSUB(j)  (1280 + 64 * (j))
#define XB_XGEN(j)  (2304 + 64 * (j))
#define XB_TOP      3328
#define XB_TOPGEN   3392
#define XCD_BAR_WORDS 3456
#define XB_SPIN_CAP (1u << 18)
__device__ __forceinline__ unsigned xb_ld(unsigned* p)              { return __hip_atomic_load(p, __ATOMIC_RELAXED, __HIP_MEMORY_SCOPE_AGENT); }
__device__ __forceinline__ unsigned xb_add(unsigned* p, unsigned v) { return __hip_atomic_fetch_add(p, v, __ATOMIC_RELAXED, __HIP_MEMORY_SCOPE_AGENT); }
__device__ __forceinline__ unsigned xb_xcc_id() { return (unsigned)__builtin_amdgcn_s_getreg((3 << 11) | 20) & 0xFu; }
#define XB_SPIN(cond, bar) do { unsigned _sp = 0; while (cond) { __builtin_amdgcn_s_sleep(1); \
    if ((++_sp & 255u) == 0u) { if (xb_ld(&(bar)[XB_TMO])) break; if (_sp > XB_SPIN_CAP) { atomicAdd(&(bar)[XB_TMO], 1u); break; } } } } while (0)
struct XcdBarrier { unsigned* bar; unsigned x; volatile LAS unsigned* st; };
__device__ __forceinline__ XcdBarrier xcd_barrier_post(unsigned* bar, volatile LAS unsigned* st) {
    XcdBarrier b; b.bar = bar; b.x = xb_xcc_id(); b.st = st;
    if (threadIdx.x == 0) (void)xb_add(&bar[XB_XCNT(b.x)], 1u);
    return b;
}
__device__ __forceinline__ void xcd_barrier_complete(unsigned* bar, unsigned x, unsigned& nloc, unsigned& nx) {
    const unsigned G = gridDim.x * gridDim.y * gridDim.z;
    unsigned sum, cnt, mine, sp = 0u;
    for (;;) {
        sum = 0u; cnt = 0u; mine = 0u;
#pragma unroll
        for (unsigned j = 0; j < 16; ++j) { const unsigned c = xb_ld(&bar[XB_XCNT(j)]); sum += c; cnt += (c > 0u) ? 1u : 0u; mine = (j == x) ? c : mine; }
        if (sum == G) break;
        __builtin_amdgcn_s_sleep(1);
        if ((++sp & 255u) == 0u) { if (xb_ld(&bar[XB_TMO])) break; if (sp > XB_SPIN_CAP) { atomicAdd(&bar[XB_TMO], 1u); break; } }
    }
    nloc = mine > 0u ? mine : 1u; nx = cnt > 0u ? cnt : 1u;
}
__device__ __forceinline__ void xcd_barrier(const XcdBarrier& b) {
    asm volatile("s_waitcnt vmcnt(0)" ::: "memory");
    __syncthreads();
    if (threadIdx.x == 0) {
        unsigned* bar = b.bar;
        __builtin_amdgcn_s_waitcnt(0);
        unsigned nloc = b.st[0], nx = b.st[1];
        if (nloc == 0u) { xcd_barrier_complete(bar, b.x, nloc, nx); b.st[0] = nloc; b.st[1] = nx; }
        const unsigned old = xb_add(&bar[XB_XSUB(b.x)], 1u);
        const unsigned gen = old / nloc;
        if (old + 1u == (gen + 1u) * nloc) {
            __builtin_amdgcn_fence(__ATOMIC_RELEASE, "agent");
            asm volatile("s_waitcnt vmcnt(0)" ::: "memory");
            const unsigned og = xb_add(&bar[XB_TOP], 1u);
            const unsigned tg = og / nx;
            if (og + 1u == (tg + 1u) * nx) xb_add(&bar[XB_TOPGEN], 1u);
            else XB_SPIN(xb_ld(&bar[XB_TOPGEN]) == tg, bar);
            __builtin_amdgcn_fence(__ATOMIC_ACQUIRE, "agent");
            xb_add(&bar[XB_XGEN(b.x)], 1u);
            asm volatile("s_waitcnt vmcnt(0)" ::: "memory");
        } else {
            XB_SPIN(xb_ld(&bar[XB_XGEN(b.x)]) == gen, bar);
            __builtin_amdgcn_fence(__ATOMIC_ACQUIRE, "agent");
            asm volatile("s_waitcnt vmcnt(0)" ::: "memory");
        }
    }
    __syncthreads();
}

namespace pg8 {
constexpr int BM = 256, BK = 64, HALF = 128, HTB = HALF * BK * 2, STAGE_BYTES = 8 * HTB, NXCD = 8, WGM = 8;
__host__ __device__ __forceinline__ int lds_byte(int r, int c) { const int st = (r >> 4) * 2 + (c >> 5), rr = r & 15, cc = c & 31, ob = rr * 64 + cc * 2; return st * 1024 + (ob ^ (((ob >> 9) & 1) << 5)); }
__host__ __device__ __forceinline__ void stage_rc(int b, int& R, int& C) { const int st = b / 1024, sb = b % 1024, swz = sb ^ (((sb >> 9) & 1) << 5); R = (st >> 1) * 16 + swz / 64; C = (st & 1) * 32 + (swz % 64) / 2; }
__host__ __device__ __forceinline__ int perm32(int rho) { const int n = rho >> 4, i = rho & 15; return 8 * (i >> 2) + 4 * n + (i & 3); }
struct Unit { int pm, pn; };
struct Gemm { const bf16_t* A; const bf16_t* Bt; int M, N, K; };
struct StaticOrder {
    int nM, nN, nwg, G, c;
    __device__ void init(int M, int N, int G_, int c_) { nM = M / BM; nN = N / BM; nwg = nM * nN; G = G_; c = c_; }
    __device__ bool next(int i, Unit& u) const {
        const long L = (long)i * G + c; if (L >= nwg) return false;
        int wgid = (int)L; { const int q = nwg / NXCD, r = nwg % NXCD, xcd = wgid % NXCD, off = wgid / NXCD; wgid = (xcd < r ? xcd * (q + 1) : r * (q + 1) + (xcd - r) * q) + off; }
        const int nig = WGM * nN, gid = wgid / nig, fm = gid * WGM, gsz = (nM - fm) < WGM ? (nM - fm) : WGM;
        u.pm = fm + ((wgid % nig) % gsz); u.pn = (wgid % nig) / gsz; return true;
    }
    __device__ __forceinline__ void a_ready(const Unit&) const {}
    __device__ __forceinline__ void done(const Unit&) const {}
};

template <class Epi, class Sched>
__device__ __forceinline__ void gemm_phase(LAS unsigned char* lds, const Gemm g, const Sched& S, const Epi& E) {
    const int tid = threadIdx.x, wid = __builtin_amdgcn_readfirstlane(tid >> 6), lane = tid & 63, wr = wid >> 2, wc = wid & 3, fr = lane & 15, fq = lane >> 4;
    const int K = g.K, nt = K / BK;
    unsigned voffA[2], voffB[2];
#pragma unroll
    for (int i = 0; i < 2; ++i) { int R, C; stage_rc(tid * 16 + i * 8192, R, C); const int Rb = Epi::PERM ? ((R & ~31) + perm32(R & 31)) : R;
        voffA[i] = (unsigned)(R * K + C) * 2u; voffB[i] = (unsigned)(Rb * K + C) * 2u; }
    const size_t kstep = (size_t)(BK * 2);
    const size_t hstep = (size_t)HALF * K * 2;
    const size_t tstep = 2 * hstep;
    const unsigned ldsw = (unsigned)wid * 1024u;
    const int aoff = lds_byte(wr * 64 + fr, fq * 8), boff = lds_byte(wc * 32 + fr, fq * 8);
#define PG8_SA(b, h) (((b) * 2 + (h)) * HTB)
#define PG8_SB(b, h) ((4 + (b) * 2 + (h)) * HTB)
#define PG8_STAGE(bufoff, gbase, voff) do { _Pragma("unroll") for (int _i = 0; _i < 2; ++_i) \
        __builtin_amdgcn_global_load_lds((const unsigned*)((const char*)(gbase) + (voff)[_i]), (LAS unsigned*)(lds + (bufoff) + ldsw + _i * 8192), 16, 0, 0); } while (0)
#define PG8_LDA(dst, b, h) do { _Pragma("unroll") for (int m = 0; m < 4; ++m) _Pragma("unroll") for (int k = 0; k < 2; ++k) dst[m][k] = *(const LAS bf16x8*)(lds + PG8_SA(b, h) + aoff + m * 2048 + k * 1024); } while (0)
#define PG8_LDB(dst, b, h) do { _Pragma("unroll") for (int n = 0; n < 2; ++n) _Pragma("unroll") for (int k = 0; k < 2; ++k) dst[n][k] = *(const LAS bf16x8*)(lds + PG8_SB(b, h) + boff + n * 2048 + k * 1024); } while (0)
#define PG8_MMA(ai, bj, At, Bt) do { __builtin_amdgcn_s_setprio(1); _Pragma("unroll") for (int m = 0; m < 4; ++m) _Pragma("unroll") for (int n = 0; n < 2; ++n) _Pragma("unroll") for (int k = 0; k < 2; ++k) \
        acc[ai][bj][m][n] = __builtin_amdgcn_mfma_f32_16x16x32_bf16(Bt[n][k], At[m][k], acc[ai][bj][m][n], 0, 0, 0); __builtin_amdgcn_s_setprio(0); } while (0)
#define PG8_WAIT_V(n) asm volatile("s_waitcnt vmcnt(" #n ")" ::: "memory")
#define PG8_WAIT_L(n) asm volatile("s_waitcnt lgkmcnt(" #n ")" ::: "memory")
#define PG8_BAR __builtin_amdgcn_s_barrier()
#define PG8_SCHED __builtin_amdgcn_sched_barrier(0)
    Unit cur, nxt; int ui = 0;
    if (!S.next(0, cur)) return;
    f32x4 acc[2][2][4][2];
#pragma unroll
    for (int a = 0; a < 2; ++a)
#pragma unroll
        for (int b = 0; b < 2; ++b)
#pragma unroll
            for (int m = 0; m < 4; ++m)
#pragma unroll
                for (int n = 0; n < 2; ++n) acc[a][b][m][n] = (f32x4){0.f, 0.f, 0.f, 0.f};
    bf16x8 At[4][2], B0[2][2], B1[2][2];
    const char* cA = (const char*)g.A + (size_t)cur.pm * tstep; const char* cB = (const char*)g.Bt + (size_t)cur.pn * tstep;
    S.a_ready(cur);
    PG8_STAGE(PG8_SB(0, 0), cB, voffB); PG8_STAGE(PG8_SA(0, 0), cA, voffA); PG8_STAGE(PG8_SB(0, 1), cB + hstep, voffB); PG8_STAGE(PG8_SA(0, 1), cA + hstep, voffA);
    if (wr == 1) PG8_BAR;
    PG8_WAIT_V(4); PG8_BAR;
    PG8_STAGE(PG8_SB(1, 0), cB + kstep, voffB); PG8_STAGE(PG8_SA(1, 0), cA + kstep, voffA); PG8_STAGE(PG8_SB(1, 1), cB + hstep + kstep, voffB);
    PG8_WAIT_V(6); PG8_BAR;
    for (;;) {
        const bool has_next = S.next(ui + 1, nxt);
        const char* nA = has_next ? (const char*)g.A + (size_t)nxt.pm * tstep : cA; const char* nB = has_next ? (const char*)g.Bt + (size_t)nxt.pn * tstep : cB;
        for (int t = 0; t < nt; t += 2) {
            const bool last = (t == nt - 2);
            const char* a1 = cA + (size_t)(t + 1) * kstep;
            const char* a2 = last ? nA : cA + (size_t)(t + 2) * kstep; const char* b2 = last ? nB : cB + (size_t)(t + 2) * kstep;
            const char* a3 = a2 + kstep; const char* b3 = b2 + kstep;
            if (last && has_next) S.a_ready(nxt);
            PG8_LDB(B0, 0, 0); PG8_SCHED; PG8_LDA(At, 0, 0); PG8_STAGE(PG8_SA(1, 1), a1 + hstep, voffA);
            PG8_WAIT_L(8); PG8_BAR; PG8_WAIT_L(0); PG8_MMA(0, 0, At, B0); PG8_BAR; PG8_SCHED;
            PG8_LDB(B1, 0, 1); PG8_STAGE(PG8_SB(0, 0), b2, voffB);
            PG8_BAR; PG8_WAIT_L(0); PG8_MMA(0, 1, At, B1); PG8_BAR;
            PG8_LDA(At, 0, 1); PG8_STAGE(PG8_SA(0, 0), a2, voffA);
            PG8_BAR; PG8_WAIT_L(0); PG8_MMA(1, 0, At, B0); PG8_BAR; PG8_SCHED;
            PG8_STAGE(PG8_SB(0, 1), b2 + hstep, voffB);
            PG8_WAIT_V(6); PG8_BAR; PG8_MMA(1, 1, At, B1); PG8_BAR;
            PG8_LDB(B0, 1, 0); PG8_SCHED; PG8_LDA(At, 1, 0); PG8_STAGE(PG8_SA(0, 1), a2 + hstep, voffA);
            PG8_WAIT_L(8); PG8_BAR; PG8_WAIT_L(0); PG8_MMA(0, 0, At, B0); PG8_BAR; PG8_SCHED;
            PG8_LDB(B1, 1, 1); PG8_STAGE(PG8_SB(1, 0), b3, voffB);
            PG8_BAR; PG8_WAIT_L(0); PG8_MMA(0, 1, At, B1); PG8_BAR;
            PG8_LDA(At, 1, 1); PG8_STAGE(PG8_SA(1, 0), a3, voffA);
            PG8_BAR; PG8_WAIT_L(0); PG8_MMA(1, 0, At, B0); PG8_BAR; PG8_SCHED;
            PG8_STAGE(PG8_SB(1, 1), b3 + hstep, voffB);
            PG8_WAIT_V(6); PG8_BAR; PG8_MMA(1, 1, At, B1); PG8_BAR;
        }
        E(acc, cur, wr, wc, fr, fq); S.done(cur);
        if (!has_next) break;
#pragma unroll
        for (int a = 0; a < 2; ++a)
#pragma unroll
            for (int b = 0; b < 2; ++b)
#pragma unroll
                for (int m = 0; m < 4; ++m)
#pragma unroll
                    for (int n = 0; n < 2; ++n) acc[a][b][m][n] = (f32x4){0.f, 0.f, 0.f, 0.f};
        cur = nxt; cA = nA; cB = nB; ++ui;
    }
    PG8_WAIT_V(0);
    if (wr == 0) PG8_BAR;
    PG8_BAR;
#undef PG8_SA
#undef PG8_SB
#undef PG8_STAGE
#undef PG8_LDA
#undef PG8_LDB
#undef PG8_MMA
#undef PG8_WAIT_V
#undef PG8_WAIT_L
#undef PG8_BAR
#undef PG8_SCHED
}
}
using pg8::Unit;

struct EpiProj {
    static constexpr bool PERM = true;
    bf16_t* P;
    __device__ __forceinline__ void operator()(const f32x4 (&acc)[2][2][4][2], const Unit& u, int wr, int wc, int fr, int fq) const {
        const int row0 = u.pm * 256 + wr * 64 + fr; const int pn = u.pn;
        if (pn < 8 || pn >= 24) {
            const bool act = pn >= 24;
            const int col0 = (act ? 4096 + (pn - 24) * 256 : pn * 256) + wc * 32 + 8 * fq;
#pragma unroll
            for (int ai = 0; ai < 2; ++ai)
#pragma unroll
                for (int m = 0; m < 4; ++m) { bf16_t* rowp = P + (size_t)(row0 + ai * 128 + m * 16) * PW + col0;
#pragma unroll
                    for (int bj = 0; bj < 2; ++bj) { f32x4 v0 = acc[ai][bj][m][0], v1 = acc[ai][bj][m][1];
                        if (act) { f32x2 a = gelu_pk((f32x2){v0[0], v0[1]}), b = gelu_pk((f32x2){v0[2], v0[3]}), c = gelu_pk((f32x2){v1[0], v1[1]}), d = gelu_pk((f32x2){v1[2], v1[3]});
                            v0 = (f32x4){a.x, a.y, b.x, b.y}; v1 = (f32x4){c.x, c.y, d.x, d.y}; }
                        u32x4 w; w.x = cvt_pk_bf16_asm(v0[0], v0[1]); w.y = cvt_pk_bf16_asm(v0[2], v0[3]); w.z = cvt_pk_bf16_asm(v1[0], v1[1]); w.w = cvt_pk_bf16_asm(v1[2], v1[3]);
                        *(u32x4*)(rowp + bj * 128) = w; } }
        } else {
            const bool isrg = pn < 16;
            const int col0 = (isrg ? 2048 + (pn - 8) * 128 : 3072 + (pn - 16) * 128) + wc * 32 + 8 * fq;
#pragma unroll
            for (int ai = 0; ai < 2; ++ai)
#pragma unroll
                for (int m = 0; m < 4; ++m) { bf16_t* rowp = P + (size_t)(row0 + ai * 128 + m * 16) * PW + col0;
                    float o[8];
#pragma unroll
                    for (int n = 0; n < 2; ++n) { const f32x4 a = acc[ai][0][m][n], g = acc[ai][1][m][n];
                        if (isrg) {
#pragma unroll
                            for (int j = 0; j < 4; ++j) o[n * 4 + j] = a[j] * sigmoidf_(a[j]) * sigmoidf_(g[j]);
                        } else { f32x2 x = gelu_pk((f32x2){a[0], a[1]}), y = gelu_pk((f32x2){a[2], a[3]});
                            o[n * 4 + 0] = x.x * sigmoidf_(g[0]); o[n * 4 + 1] = x.y * sigmoidf_(g[1]); o[n * 4 + 2] = y.x * sigmoidf_(g[2]); o[n * 4 + 3] = y.y * sigmoidf_(g[3]); } }
                    u32x4 w; w.x = cvt_pk_bf16_asm(o[0], o[1]); w.y = cvt_pk_bf16_asm(o[2], o[3]); w.z = cvt_pk_bf16_asm(o[4], o[5]); w.w = cvt_pk_bf16_asm(o[6], o[7]);
                    *(u32x4*)rowp = w; }
        }
    }
};
struct EpiX1 {
    static constexpr bool PERM = false;
    const float* x; float* x1; const float* mod; const float* b_ada;
    __device__ __forceinline__ void operator()(const f32x4 (&acc)[2][2][4][2], const Unit& u, int wr, int wc, int fr, int fq) const {
        const int row0 = u.pm * 256 + wr * 64 + fr, col0 = u.pn * 256 + wc * 32 + 4 * fq; const int b = u.pm >> 5;
        f32x4 gv[2][2];
#pragma unroll
        for (int bj = 0; bj < 2; ++bj)
#pragma unroll
            for (int n = 0; n < 2; ++n) gv[bj][n] = *(const f32x4*)(mod + b * 6144 + 2048 + col0 + bj * 128 + n * 16) + *(const f32x4*)(b_ada + 2048 + col0 + bj * 128 + n * 16);
#pragma unroll
        for (int ai = 0; ai < 2; ++ai)
#pragma unroll
            for (int m = 0; m < 4; ++m) { const size_t off = (size_t)(row0 + ai * 128 + m * 16) * DM + col0;
#pragma unroll
                for (int bj = 0; bj < 2; ++bj)
#pragma unroll
                    for (int n = 0; n < 2; ++n) { const f32x4 xv = *(const f32x4*)(x + off + bj * 128 + n * 16); *(f32x4*)(x1 + off + bj * 128 + n * 16) = xv + gv[bj][n] * acc[ai][bj][m][n]; } }
    }
};
struct EpiQ {
    static constexpr bool PERM = true;
    bf16_t* O;
    __device__ __forceinline__ void operator()(const f32x4 (&acc)[2][2][4][2], const Unit& u, int wr, int wc, int fr, int fq) const {
        const int row0 = u.pm * 256 + wr * 64 + fr, col0 = u.pn * 256 + wc * 32 + 8 * fq;
#pragma unroll
        for (int ai = 0; ai < 2; ++ai)
#pragma unroll
            for (int m = 0; m < 4; ++m) { bf16_t* rowp = O + (size_t)(row0 + ai * 128 + m * 16) * 2048 + col0;
#pragma unroll
                for (int bj = 0; bj < 2; ++bj) { const f32x4 v0 = acc[ai][bj][m][0], v1 = acc[ai][bj][m][1];
                    u32x4 w; w.x = cvt_pk_bf16_asm(v0[0], v0[1]); w.y = cvt_pk_bf16_asm(v0[2], v0[3]); w.z = cvt_pk_bf16_asm(v1[0], v1[1]); w.w = cvt_pk_bf16_asm(v1[2], v1[3]);
                    *(u32x4*)(rowp + bj * 128) = w; } }
    }
};

__device__ __forceinline__ int win_src_col(int n) {
    if (n < 2048) return n;
    if (n < 4096) { const int u = (n - 2048) >> 8, r = (n - 2048) & 255; return r < 128 ? 2048 + 128 * u + r : 5136 + 128 * u + (r - 128); }
    if (n < 6144) { const int u = (n - 4096) >> 8, r = (n - 4096) & 255; return r < 128 ? 3088 + 128 * u + r : 6160 + 128 * u + (r - 128); }
    return 4112 + (n - 6144);
}
__device__ void phase0(const Params& p, unsigned char* lds) {
    const int tid = threadIdx.x;
    float* mod = (float*)(p.ws + OFF_MOD);
    {
        float* ssc = (float*)lds;
        float* red = (float*)lds + 2048;
        for (int e = tid; e < 2048; e += 512) { const float cv = p.c[e]; ssc[e] = cv * sigmoidf_(cv); }
        __syncthreads();
        for (int cbk = blockIdx.x; cbk < 256; cbk += gridDim.x) {
            const int cc = tid % 24, rg = tid / 24;
            if (tid < 504) { float a0 = 0.f, a1 = 0.f;
                const float* wp = p.w_ada + cbk * 24 + cc;
#pragma unroll 1
                for (int j0 = 0; j0 < 49; j0 += 7) { float w[7];
#pragma unroll
                    for (int u = 0; u < 7; ++u) { const int k = rg + 21 * (j0 + u); w[u] = k < 1024 ? wp[(size_t)k * 6144] : 0.f; }
#pragma unroll
                    for (int u = 0; u < 7; ++u) { const int k = rg + 21 * (j0 + u); if (k < 1024) { a0 += ssc[k] * w[u]; a1 += ssc[1024 + k] * w[u]; } } }
                red[(rg * 24 + cc) * 2] = a0; red[(rg * 24 + cc) * 2 + 1] = a1; }
            __syncthreads();
            if (tid < 48) { const int c2 = tid % 24, bb = tid / 24; float s = 0.f;
                for (int g = 0; g < 21; ++g) s += red[(g * 24 + c2) * 2 + bb];
                mod[bb * 6144 + cbk * 24 + c2] = s; }
            __syncthreads();
        }
    }
    float* tile = (float*)lds;
    for (int tl = blockIdx.x; tl < 2560; tl += gridDim.x) {
        const float* W; bf16_t* Bt; int ldw, nt, kt, which;
        if (tl < 1792) { which = 0; W = p.w_in; ldw = INW; Bt = (bf16_t*)(p.ws + OFF_WINT); nt = tl >> 4; kt = tl & 15; }
        else if (tl < 2048) { which = 1; W = p.w_out; ldw = 1024; Bt = (bf16_t*)(p.ws + OFF_WOUTT); nt = (tl - 1792) >> 4; kt = tl & 15; }
        else { which = 2; W = p.w_q; ldw = 2048; Bt = (bf16_t*)(p.ws + OFF_WQT); nt = (tl - 2048) >> 4; kt = tl & 15; }
        { const int nn = tid & 63, kk0 = tid >> 6; const int n = nt * 64 + nn; const int sc = which == 0 ? win_src_col(n) : n;
#pragma unroll
            for (int i = 0; i < 8; ++i) { const int k = kk0 + 8 * i; tile[nn * 65 + k] = W[(size_t)(kt * 64 + k) * ldw + sc]; } }
        __syncthreads();
        { const int n = tid >> 3, kc = (tid & 7) * 8; const float* tp = tile + n * 65 + kc;
            u32x4 w; w.x = cvt_pk_bf16(tp[0], tp[1]); w.y = cvt_pk_bf16(tp[2], tp[3]); w.z = cvt_pk_bf16(tp[4], tp[5]); w.w = cvt_pk_bf16(tp[6], tp[7]);
            *(u32x4*)(Bt + (size_t)(nt * 64 + n) * 1024 + kt * 64 + kc) = w; }
        __syncthreads();
    }
    { bf16_t* kb = (bf16_t*)(p.ws + OFF_KEYS);
        for (int e = (blockIdx.x * 512 + tid) * 2; e < 32768; e += gridDim.x * 1024) {
            const float* src = e < 16384 ? p.keys1 + e : p.keys2 + (e - 16384);
            *(unsigned*)(kb + e) = cvt_pk_bf16(src[0], src[1]); } }
}

template <bool ALR>
__device__ void phase_norm(const Params& p, const float* xin, const float* nw, int shift_off, int scale_off, bf16_t* hout, unsigned char* lds) {
    const int tid = threadIdx.x, wid = tid >> 6, lane = tid & 63;
    const float* mod = (const float*)(p.ws + OFF_MOD);
    float* wat = (float*)lds;
    if (ALR) {
        for (int e = tid; e < 16384; e += 512) { const int d = e >> 4, r = e & 15; wat[r * 1024 + d] = p.w_in[(size_t)d * INW + 3072 + r]; }
        __syncthreads();
    }
    float* alr = (float*)(p.ws + OFF_ALR);
    for (int tg = blockIdx.x * 8 + wid; tg < 2048; tg += gridDim.x * 8) {
        const int b = tg >> 10;
        f32x4 w4[4], sc[4], sh[4];
#pragma unroll
        for (int i = 0; i < 4; ++i) { const int d = 256 * i + 4 * lane; w4[i] = *(const f32x4*)(nw + d);
            sc[i] = *(const f32x4*)(mod + b * 6144 + scale_off + d) + *(const f32x4*)(p.b_ada + scale_off + d) + 1.0f;
            sh[i] = *(const f32x4*)(mod + b * 6144 + shift_off + d) + *(const f32x4*)(p.b_ada + shift_off + d);
            w4[i] = w4[i] * sc[i]; }
        f32x4 xn[4];
#pragma unroll
        for (int i = 0; i < 4; ++i) xn[i] = *(const f32x4*)(xin + (size_t)(tg * 8) * DM + 256 * i + 4 * lane);
        for (int tt = 0; tt < 8; ++tt) {
            const int t = tg * 8 + tt;
            f32x4 xv[4]; float ss = 0.f;
#pragma unroll
            for (int i = 0; i < 4; ++i) { xv[i] = xn[i]; ss += xv[i][0] * xv[i][0] + xv[i][1] * xv[i][1] + xv[i][2] * xv[i][2] + xv[i][3] * xv[i][3]; }
            if (tt < 7) {
#pragma unroll
                for (int i = 0; i < 4; ++i) xn[i] = *(const f32x4*)(xin + (size_t)(t + 1) * DM + 256 * i + 4 * lane); }
            ss = wave_sum(ss);
            const float rstd = rsqrtf(ss * (1.0f / 1024.0f) + EPS);
#pragma unroll
            for (int i = 0; i < 4; ++i) { xv[i] = xv[i] * rstd * w4[i] + sh[i];
                u32x2 w; w.x = cvt_pk_bf16(xv[i][0], xv[i][1]); w.y = cvt_pk_bf16(xv[i][2], xv[i][3]);
                *(u32x2*)(hout + (size_t)t * DM + 256 * i + 4 * lane) = w; }
            if (ALR) {
                float ps[16];
#pragma unroll
                for (int r = 0; r < 16; ++r) { float s = 0.f;
#pragma unroll
                    for (int i = 0; i < 4; ++i) { const f32x4 wv = *(const f32x4*)(wat + r * 1024 + 256 * i + 4 * lane); s += xv[i][0] * wv[0] + xv[i][1] * wv[1] + xv[i][2] * wv[2] + xv[i][3] * wv[3]; }
                    ps[r] = s; if (r & 1) asm volatile("" ::: "memory"); }
                float t8[8], t4[4], t2[2];
                { const bool up = (lane & 32) != 0;
#pragma unroll
                  for (int j = 0; j < 8; ++j) { const float snd = up ? ps[j] : ps[j + 8], keep = up ? ps[j + 8] : ps[j]; t8[j] = keep + __shfl_xor(snd, 32); } }
                { const bool up = (lane & 16) != 0;
#pragma unroll
                  for (int j = 0; j < 4; ++j) { const float snd = up ? t8[j] : t8[j + 4], keep = up ? t8[j + 4] : t8[j]; t4[j] = keep + __shfl_xor(snd, 16); } }
                { const bool up = (lane & 8) != 0;
#pragma unroll
                  for (int j = 0; j < 2; ++j) { const float snd = up ? t4[j] : t4[j + 2], keep = up ? t4[j + 2] : t4[j]; t2[j] = keep + __shfl_xor(snd, 8); } }
                float t1;
                { const bool up = (lane & 4) != 0; const float snd = up ? t2[0] : t2[1], keep = up ? t2[1] : t2[0]; t1 = keep + __shfl_xor(snd, 4); }
                t1 += __shfl_xor(t1, 2); t1 += __shfl_xor(t1, 1);
                if ((lane & 3) == 0) alr[(size_t)t * 16 + ((lane >> 5) & 1) * 8 + ((lane >> 4) & 1) * 4 + ((lane >> 3) & 1) * 2 + ((lane >> 2) & 1)] = t1;
            }
        }
    }
}

template <bool TR>
__device__ __forceinline__ void gla_G(const Params& p, int t0, int h, float* sALR, float* sG, float* sGT) {
    const int tid = threadIdx.x;
    const float* alr = (const float*)(p.ws + OFF_ALR);
    if (tid < 256) *(f32x4*)(sALR + tid * 4) = *(const f32x4*)(alr + (size_t)t0 * 16 + tid * 4);
    const int col = tid & 127, pg = tid >> 7;
    float wup[16];
#pragma unroll
    for (int r = 0; r < 16; ++r) wup[r] = p.w_alpha_up[r * 512 + h * 128 + col];
    const float bias = p.b_alpha[h * 128 + col];
    __syncthreads();
#pragma unroll 4
    for (int pp = 0; pp < 16; ++pp) { const int pos = pg * 16 + pp;
        float z0 = bias, z1 = 0.f, z2 = 0.f, z3 = 0.f;
#pragma unroll
        for (int r4 = 0; r4 < 4; ++r4) { const f32x4 a = *(const f32x4*)(sALR + pos * 16 + r4 * 4); z0 += a[0] * wup[r4 * 4]; z1 += a[1] * wup[r4 * 4 + 1]; z2 += a[2] * wup[r4 * 4 + 2]; z3 += a[3] * wup[r4 * 4 + 3]; }
        const float z = (z0 + z1) + (z2 + z3);
        sG[pos * 128 + col] = (fminf(z, 0.f) - __logf(1.0f + __expf(-fabsf(z)))) * (1.0f / 16.0f); }
    __syncthreads();
    if (tid < 128) { float cum = 0.f;
#pragma unroll 16
        for (int pos = 0; pos < 64; ++pos) { cum += sG[pos * 128 + tid]; if (TR) sGT[tid * 65 + pos] = cum; else sG[pos * 128 + tid] = cum; } }
    __syncthreads();
}
__device__ __forceinline__ void gla_VT(const bf16_t* P, int t0, int h, bf16_t* sVT) {
    const int tid = threadIdx.x;
#pragma unroll
    for (int i = 0; i < 4; ++i) { const int task = tid + 512 * i, pos = task & 63, dg = task >> 6;
        const u32x4 w = *(const u32x4*)(P + (size_t)(t0 + pos) * PW + 1024 + h * 256 + dg * 8);
        bf16_t* d = sVT + (dg * 8) * 72 + pos;
        d[0] = (bf16_t)w.x; d[72] = (bf16_t)(w.x >> 16); d[144] = (bf16_t)w.y; d[216] = (bf16_t)(w.y >> 16);
        d[288] = (bf16_t)w.z; d[360] = (bf16_t)(w.z >> 16); d[432] = (bf16_t)w.w; d[504] = (bf16_t)(w.w >> 16); }
}

__device__ void phase_glaA(const Params& p, unsigned char* lds) {
    const int tid = threadIdx.x, wid = tid >> 6, lane = tid & 63, r = lane & 31, hh = lane >> 5;
    const bf16_t* P = (const bf16_t*)(p.ws + OFF_PROJ);
    { float* stats = (float*)(p.ws + OFF_STATS);
        const int tst0 = blockIdx.x * 8 + wid, tstep = gridDim.x * 8;
        u32x4 an = (u32x4){0u, 0u, 0u, 0u}, bn = an;
        if (tst0 < NTOK) { an = *(const u32x4*)(P + (size_t)tst0 * PW + 4096 + lane * 16); bn = *(const u32x4*)(P + (size_t)tst0 * PW + 4096 + lane * 16 + 8); }
        for (int t = tst0; t < NTOK; t += tstep) {
            const u32x4 a = an, b = bn;
            if (t + tstep < NTOK) { an = *(const u32x4*)(P + (size_t)(t + tstep) * PW + 4096 + lane * 16); bn = *(const u32x4*)(P + (size_t)(t + tstep) * PW + 4096 + lane * 16 + 8); }
            float v[16] = {bflo(a.x), bfhi(a.x), bflo(a.y), bfhi(a.y), bflo(a.z), bfhi(a.z), bflo(a.w), bfhi(a.w), bflo(b.x), bfhi(b.x), bflo(b.y), bfhi(b.y), bflo(b.z), bfhi(b.z), bflo(b.w), bfhi(b.w)};
            float s = 0.f;
#pragma unroll
            for (int i = 0; i < 16; ++i) s += v[i];
            const float mean = wave_sum(s) * (1.0f / 1024.0f);
            float q = 0.f;
#pragma unroll
            for (int i = 0; i < 16; ++i) { const float d = v[i] - mean; q += d * d; }
            q = wave_sum(q);
            if (lane == 0) *(f32x2*)(stats + (size_t)t * 2) = (f32x2){mean, rsqrtf(q * (1.0f / 1024.0f) + EPS)};
        } }
    float* sALR = (float*)lds; float* sG = (float*)(lds + 4096);
    bf16_t* sKT = (bf16_t*)(lds + 36864); bf16_t* sVT = (bf16_t*)(lds + 55296); float* sGT = (float*)(lds + 92160);
    bf16_t* KV = (bf16_t*)p.out; float* decay = (float*)(p.ws + OFF_DECAY);
    for (int item = blockIdx.x; item < 1024; item += gridDim.x) {
        const int h = item & 3, n = (item >> 2) & 127, b = item >> 9, t0 = b * SEQ + n * 64;
        gla_G<true>(p, t0, h, sALR, sG, sGT);
#pragma unroll
        for (int i = 0; i < 2; ++i) { const int task = tid + 512 * i, pos = task & 63, kg = task >> 6;
            const u32x4 w = *(const u32x4*)(P + (size_t)(t0 + pos) * PW + 512 + h * 128 + kg * 8);
            const unsigned ww[4] = {w.x, w.y, w.z, w.w};
            bf16_t* d = sKT + (kg * 8) * 72 + pos;
#pragma unroll
            for (int e = 0; e < 4; ++e) { const int kd = kg * 8 + 2 * e;
                const float f0 = __expf(sGT[kd * 65 + 63] - sGT[kd * 65 + pos]), f1 = __expf(sGT[(kd + 1) * 65 + 63] - sGT[(kd + 1) * 65 + pos]);
                const unsigned pk = cvt_pk_bf16(bflo(ww[e]) * f0, bfhi(ww[e]) * f1);
                d[(2 * e) * 72] = (bf16_t)pk; d[(2 * e + 1) * 72] = (bf16_t)(pk >> 16); } }
        gla_VT(P, t0, h, sVT);
        if (tid < 128) decay[item * 128 + tid] = __expf(sGT[tid * 65 + 63]);
        __syncthreads();
        f32x16 acc[4];
#pragma unroll
        for (int mi = 0; mi < 4; ++mi) acc[mi] = zero16();
#pragma unroll
        for (int ks = 0; ks < 4; ++ks) {
            const bf16x8 bfr = *(const bf16x8*)(sVT + (wid * 32 + r) * 72 + ks * 16 + hh * 8);
#pragma unroll
            for (int mi = 0; mi < 4; ++mi) { const bf16x8 afr = *(const bf16x8*)(sKT + (mi * 32 + r) * 72 + ks * 16 + hh * 8); acc[mi] = MFMA32(afr, bfr, acc[mi]); }
        }
        bf16_t* dst = KV + (size_t)item * 32768 + (size_t)(wid * 32 + r) * 128;
#pragma unroll
        for (int mi = 0; mi < 4; ++mi)
#pragma unroll
            for (int g = 0; g < 4; ++g) { u32x2 w; w.x = cvt_pk_bf16(acc[mi][g * 4], acc[mi][g * 4 + 1]); w.y = cvt_pk_bf16(acc[mi][g * 4 + 2], acc[mi][g * 4 + 3]);
                *(u32x2*)(dst + mi * 32 + g * 8 + hh * 4) = w; }
        __syncthreads();
    }
}

__device__ void phase_scan_sgu(const Params& p, unsigned char* lds) {
    const int tid = threadIdx.x, wid = tid >> 6, lane = tid & 63, r = lane & 31, hh = lane >> 5;
    { unsigned* KV = (unsigned*)p.out; const float* decay = (const float*)(p.ws + OFF_DECAY);
        for (int gt = blockIdx.x * 512 + tid; gt < 131072; gt += gridDim.x * 512) {
            const int bh = gt >> 14, e = gt & 16383, kd = (e * 2) & 127, b = bh >> 2, h = bh & 3;
            float s0 = 0.f, s1 = 0.f;
            for (int n0 = 0; n0 < 128; n0 += 16) {
                unsigned w[16]; f32x2 d[16];
#pragma unroll
                for (int j = 0; j < 16; ++j) { const int item = ((b * 128 + n0 + j) << 2) + h; w[j] = KV[(size_t)item * 16384 + e]; d[j] = *(const f32x2*)(decay + item * 128 + kd); }
#pragma unroll
                for (int j = 0; j < 16; ++j) { const int item = ((b * 128 + n0 + j) << 2) + h; KV[(size_t)item * 16384 + e] = cvt_pk_bf16(s0, s1);
                    s0 = s0 * d[j].x + bflo(w[j]); s1 = s1 * d[j].y + bfhi(w[j]); }
            }
        } }
    const bf16_t* P = (const bf16_t*)(p.ws + OFF_PROJ);
    const float* stats = (const float*)(p.ws + OFF_STATS);
    bf16_t* merged = (bf16_t*)(p.ws + OFF_HB);
    bf16_t* sVT = (bf16_t*)lds;
    for (int item = blockIdx.x; item < 1024; item += gridDim.x) {
        const int g = item & 7, n = (item >> 3) & 63, b = item >> 9, t0 = b * SEQ + n * 128;
#pragma unroll
        for (int i = 0; i < 4; ++i) { const int task = tid + 512 * i, j = task & 127, cg8 = task >> 7;
            const u32x4 w = *(const u32x4*)(P + (size_t)(t0 + j) * PW + 4096 + g * 128 + cg8 * 8);
            const f32x2 st = *(const f32x2*)(stats + (size_t)(t0 + j) * 2);
            const f32x4 lw0 = *(const f32x4*)(p.sgu_ln_w + g * 128 + cg8 * 8), lw1 = *(const f32x4*)(p.sgu_ln_w + g * 128 + cg8 * 8 + 4);
            const f32x4 lb0 = *(const f32x4*)(p.sgu_ln_b + g * 128 + cg8 * 8), lb1 = *(const f32x4*)(p.sgu_ln_b + g * 128 + cg8 * 8 + 4);
            const float v[8] = {bflo(w.x), bfhi(w.x), bflo(w.y), bfhi(w.y), bflo(w.z), bfhi(w.z), bflo(w.w), bfhi(w.w)};
            bf16_t* d = sVT + (cg8 * 8) * 136 + j;
#pragma unroll
            for (int e = 0; e < 8; e += 2) { const float lw_a = e < 4 ? lw0[e] : lw1[e - 4], lw_b = e < 4 ? lw0[e + 1] : lw1[e - 3], lb_a = e < 4 ? lb0[e] : lb1[e - 4], lb_b = e < 4 ? lb0[e + 1] : lb1[e - 3];
                const unsigned pk = cvt_pk_bf16((v[e] - st.x) * st.y * lw_a + lb_a, (v[e + 1] - st.x) * st.y * lw_b + lb_b);
                d[e * 136] = (bf16_t)pk; d[(e + 1) * 136] = (bf16_t)(pk >> 16); } }
        __syncthreads();
        const int ni = wid & 3, mb = (wid >> 2) * 2, irow = ni * 32 + r;
        f32x16 acc[2] = {zero16(), zero16()};
        const float* wrow = p.sgu_w + (size_t)g * 16384 + (size_t)irow * 128;
        for (int ks = 0; ks < 2 * ni + 2; ++ks) {
            const int j0 = ks * 16 + hh * 8;
            const f32x4 wa = *(const f32x4*)(wrow + j0), wb = *(const f32x4*)(wrow + j0 + 4);
            float wv[8] = {wa[0], wa[1], wa[2], wa[3], wb[0], wb[1], wb[2], wb[3]};
#pragma unroll
            for (int e = 0; e < 8; ++e) wv[e] = (j0 + e <= irow) ? wv[e] : 0.f;
            u32x4 bw; bw.x = cvt_pk_bf16(wv[0], wv[1]); bw.y = cvt_pk_bf16(wv[2], wv[3]); bw.z = cvt_pk_bf16(wv[4], wv[5]); bw.w = cvt_pk_bf16(wv[6], wv[7]);
            const bf16x8 bfr = __builtin_bit_cast(bf16x8, bw);
#pragma unroll
            for (int mi = 0; mi < 2; ++mi) { const bf16x8 afr = *(const bf16x8*)(sVT + ((mb + mi) * 32 + r) * 136 + j0); acc[mi] = MFMA32(afr, bfr, acc[mi]); }
        }
        const float bs = p.sgu_b[g * 128 + irow];
        const size_t tok = (size_t)(t0 + irow);
#pragma unroll
        for (int mi = 0; mi < 2; ++mi)
#pragma unroll
            for (int g4 = 0; g4 < 4; ++g4) { const int c = (mb + mi) * 32 + g4 * 8 + hh * 4;
                const u32x2 ug = *(const u32x2*)(P + tok * PW + 3072 + g * 128 + c);
                u32x2 o; o.x = cvt_pk_bf16(bflo(ug.x) * (acc[mi][g4 * 4] + bs), bfhi(ug.x) * (acc[mi][g4 * 4 + 1] + bs));
                o.y = cvt_pk_bf16(bflo(ug.y) * (acc[mi][g4 * 4 + 2] + bs), bfhi(ug.y) * (acc[mi][g4 * 4 + 3] + bs));
                *(u32x2*)(merged + tok * DM + g * 128 + c) = o; }
        __syncthreads();
    }
}

__device__ void phase_glaC(const Params& p, unsigned char* lds) {
    const int tid = threadIdx.x, wid = tid >> 6, lane = tid & 63, r = lane & 31, hh = lane >> 5;
    const bf16_t* P = (const bf16_t*)(p.ws + OFF_PROJ);
    float* sALR = (float*)lds; float* sG = (float*)(lds + 4096);
    bf16_t* sQD = (bf16_t*)(lds + 36864); bf16_t* sKI = (bf16_t*)(lds + 54272); bf16_t* sVT = (bf16_t*)(lds + 71680); bf16_t* sAM = (bf16_t*)(lds + 108544); float* sSS = (float*)(lds + 117760);
    const bf16_t* ST = (const bf16_t*)p.out; bf16_t* merged = (bf16_t*)(p.ws + OFF_HB);
    for (int item = blockIdx.x; item < 1024; item += gridDim.x) {
        const int h = item & 3, n = (item >> 2) & 127, b = item >> 9, t0 = b * SEQ + n * 64;
        gla_G<false>(p, t0, h, sALR, sG, nullptr);
#pragma unroll
        for (int i = 0; i < 2; ++i) { const int task = tid + 512 * i, kg = task & 15, pos = task >> 4;
            const u32x4 qw = *(const u32x4*)(P + (size_t)(t0 + pos) * PW + h * 128 + kg * 8), kw = *(const u32x4*)(P + (size_t)(t0 + pos) * PW + 512 + h * 128 + kg * 8);
            const f32x4 g0 = *(const f32x4*)(sG + pos * 128 + kg * 8), g1 = *(const f32x4*)(sG + pos * 128 + kg * 8 + 4);
            const float gv[8] = {g0[0], g0[1], g0[2], g0[3], g1[0], g1[1], g1[2], g1[3]};
            const unsigned qq[4] = {qw.x, qw.y, qw.z, qw.w}, kk[4] = {kw.x, kw.y, kw.z, kw.w};
            unsigned qo[4], ko[4];
#pragma unroll
            for (int e = 0; e < 4; ++e) { const float e0 = __expf(gv[2 * e]), e1 = __expf(gv[2 * e + 1]);
                qo[e] = cvt_pk_bf16(bflo(qq[e]) * 0.08838834764831845f * e0, bfhi(qq[e]) * 0.08838834764831845f * e1);
                ko[e] = cvt_pk_bf16(bflo(kk[e]) * __builtin_amdgcn_rcpf(e0), bfhi(kk[e]) * __builtin_amdgcn_rcpf(e1)); }
            *(u32x4*)(sQD + pos * 136 + kg * 8) = (u32x4){qo[0], qo[1], qo[2], qo[3]};
            *(u32x4*)(sKI + pos * 136 + kg * 8) = (u32x4){ko[0], ko[1], ko[2], ko[3]}; }
        gla_VT(P, t0, h, sVT);
        __syncthreads();
        if (wid < 4) { const int mj = wid >> 1, nI = wid & 1;
            f32x16 a = zero16();
            if (mj <= nI) {
#pragma unroll
                for (int ks = 0; ks < 8; ++ks) { const bf16x8 afr = *(const bf16x8*)(sKI + (mj * 32 + r) * 136 + ks * 16 + hh * 8), bfr = *(const bf16x8*)(sQD + (nI * 32 + r) * 136 + ks * 16 + hh * 8); a = MFMA32(afr, bfr, a); } }
            const int i = nI * 32 + r;
#pragma unroll
            for (int g = 0; g < 4; ++g) { const int j = mj * 32 + g * 8 + hh * 4;
                u32x2 w; w.x = cvt_pk_bf16(j <= i ? a[g * 4] : 0.f, j + 1 <= i ? a[g * 4 + 1] : 0.f); w.y = cvt_pk_bf16(j + 2 <= i ? a[g * 4 + 2] : 0.f, j + 3 <= i ? a[g * 4 + 3] : 0.f);
                *(u32x2*)(sAM + i * 72 + j) = w; } }
        __syncthreads();
        const int nI = wid & 1, mb = (wid >> 1) * 2, i = nI * 32 + r;
        f32x16 acc[2] = {zero16(), zero16()};
        const bf16_t* Sg = ST + (size_t)item * 32768;
#pragma unroll
        for (int ks = 0; ks < 8; ++ks) { const bf16x8 bfr = *(const bf16x8*)(sQD + i * 136 + ks * 16 + hh * 8);
#pragma unroll
            for (int mi = 0; mi < 2; ++mi) { const bf16x8 afr = *(const bf16x8*)(Sg + (size_t)((mb + mi) * 32 + r) * 128 + ks * 16 + hh * 8); acc[mi] = MFMA32(afr, bfr, acc[mi]); } }
        for (int ks = 0; ks < 2 * nI + 2; ++ks) { const bf16x8 bfr = *(const bf16x8*)(sAM + i * 72 + ks * 16 + hh * 8);
#pragma unroll
            for (int mi = 0; mi < 2; ++mi) { const bf16x8 afr = *(const bf16x8*)(sVT + ((mb + mi) * 32 + r) * 72 + ks * 16 + hh * 8); acc[mi] = MFMA32(afr, bfr, acc[mi]); } }
        float ss = 0.f;
#pragma unroll
        for (int mi = 0; mi < 2; ++mi)
#pragma unroll
            for (int e = 0; e < 16; ++e) ss += acc[mi][e] * acc[mi][e];
        ss += __shfl_xor(ss, 32);
        if (hh == 0) sSS[(wid >> 1) * 64 + i] = ss;
        __syncthreads();
        const float tot = sSS[i] + sSS[64 + i] + sSS[128 + i] + sSS[192 + i];
        const float rstd = rsqrtf(tot * (1.0f / 256.0f) + EPS);
        const size_t tok = (size_t)(t0 + i);
#pragma unroll
        for (int mi = 0; mi < 2; ++mi)
#pragma unroll
            for (int g4 = 0; g4 < 4; ++g4) { const int ch = h * 256 + (mb + mi) * 32 + g4 * 8 + hh * 4;
                const f32x4 nwv = *(const f32x4*)(p.gla_norm_w + ch);
                const u32x2 rg = *(const u32x2*)(P + tok * PW + 2048 + ch), mg = *(const u32x2*)(merged + tok * DM + ch);
                u32x2 o; o.x = cvt_pk_bf16(acc[mi][g4 * 4] * rstd * nwv[0] * bflo(rg.x) + bflo(mg.x), acc[mi][g4 * 4 + 1] * rstd * nwv[1] * bfhi(rg.x) + bfhi(mg.x));
                o.y = cvt_pk_bf16(acc[mi][g4 * 4 + 2] * rstd * nwv[2] * bflo(rg.y) + bflo(mg.y), acc[mi][g4 * 4 + 3] * rstd * nwv[3] * bfhi(rg.y) + bfhi(mg.y));
                *(u32x2*)(merged + tok * DM + ch) = o; }
        __syncthreads();
    }
}

__device__ void phase_tables(const Params& p) {
    bf16_t* db = (bf16_t*)(p.ws + OFF_DOWN); bf16_t* ub = (bf16_t*)(p.ws + OFF_UP);
    for (size_t e = ((size_t)blockIdx.x * 512 + threadIdx.x) * 8; e < (size_t)16384 * 1024; e += (size_t)gridDim.x * 4096) {
        { const f32x4 a = __builtin_nontemporal_load((const f32x4*)(p.down + e)), b = __builtin_nontemporal_load((const f32x4*)(p.down + e + 4));
            u32x4 w; w.x = cvt_pk_bf16(a[0], a[1]); w.y = cvt_pk_bf16(a[2], a[3]); w.z = cvt_pk_bf16(b[0], b[1]); w.w = cvt_pk_bf16(b[2], b[3]); *(u32x4*)(db + e) = w; }
        { const f32x4 a = __builtin_nontemporal_load((const f32x4*)(p.up + e)), b = __builtin_nontemporal_load((const f32x4*)(p.up + e + 4));
            u32x4 w; w.x = cvt_pk_bf16(a[0], a[1]); w.y = cvt_pk_bf16(a[2], a[3]); w.z = cvt_pk_bf16(b[0], b[1]); w.w = cvt_pk_bf16(b[2], b[3]); *(u32x4*)(ub + e) = w; }
    }
}

#define SORT16(L) do { float _h; _h = fmaxf(L[0], L[1]); L[1] = fminf(L[0], L[1]); L[0] = _h; _h = fmaxf(L[2], L[3]); L[3] = fminf(L[2], L[3]); L[2] = _h; _h = fmaxf(L[0], L[2]); L[2] = fminf(L[0], L[2]); L[0] = _h; _h = fmaxf(L[1], L[3]); L[3] = fminf(L[1], L[3]); L[1] = _h; _h = fmaxf(L[1], L[2]); L[2] = fminf(L[1], L[2]); L[1] = _h; _h = fmaxf(L[4], L[5]); L[5] = fminf(L[4], L[5]); L[4] = _h; _h = fmaxf(L[6], L[7]); L[7] = fminf(L[6], L[7]); L[6] = _h; _h = fmaxf(L[4], L[6]); L[6] = fminf(L[4], L[6]); L[4] = _h; _h = fmaxf(L[5], L[7]); L[7] = fminf(L[5], L[7]); L[5] = _h; _h = fmaxf(L[5], L[6]); L[6] = fminf(L[5], L[6]); L[5] = _h; _h = fmaxf(L[0], L[4]); L[4] = fminf(L[0], L[4]); L[0] = _h; _h = fmaxf(L[2], L[6]); L[6] = fminf(L[2], L[6]); L[2] = _h; _h = fmaxf(L[2], L[4]); L[4] = fminf(L[2], L[4]); L[2] = _h; _h = fmaxf(L[1], L[5]); L[5] = fminf(L[1], L[5]); L[1] = _h; _h = fmaxf(L[3], L[7]); L[7] = fminf(L[3], L[7]); L[3] = _h; _h = fmaxf(L[3], L[5]); L[5] = fminf(L[3], L[5]); L[3] = _h; _h = fmaxf(L[1], L[2]); L[2] = fminf(L[1], L[2]); L[1] = _h; _h = fmaxf(L[3], L[4]); L[4] = fminf(L[3], L[4]); L[3] = _h; _h = fmaxf(L[5], L[6]); L[6] = fminf(L[5], L[6]); L[5] = _h; _h = fmaxf(L[8], L[9]); L[9] = fminf(L[8], L[9]); L[8] = _h; _h = fmaxf(L[10], L[11]); L[11] = fminf(L[10], L[11]); L[10] = _h; _h = fmaxf(L[8], L[10]); L[10] = fminf(L[8], L[10]); L[8] = _h; _h = fmaxf(L[9], L[11]); L[11] = fminf(L[9], L[11]); L[9] = _h; _h = fmaxf(L[9], L[10]); L[10] = fminf(L[9], L[10]); L[9] = _h; _h = fmaxf(L[12], L[13]); L[13] = fminf(L[12], L[13]); L[12] = _h; _h = fmaxf(L[14], L[15]); L[15] = fminf(L[14], L[15]); L[14] = _h; _h = fmaxf(L[12], L[14]); L[14] = fminf(L[12], L[14]); L[12] = _h; _h = fmaxf(L[13], L[15]); L[15] = fminf(L[13], L[15]); L[13] = _h; _h = fmaxf(L[13], L[14]); L[14] = fminf(L[13], L[14]); L[13] = _h; _h = fmaxf(L[8], L[12]); L[12] = fminf(L[8], L[12]); L[8] = _h; _h = fmaxf(L[10], L[14]); L[14] = fminf(L[10], L[14]); L[10] = _h; _h = fmaxf(L[10], L[12]); L[12] = fminf(L[10], L[12]); L[10] = _h; _h = fmaxf(L[9], L[13]); L[13] = fminf(L[9], L[13]); L[9] = _h; _h = fmaxf(L[11], L[15]); L[15] = fminf(L[11], L[15]); L[11] = _h; _h = fmaxf(L[11], L[13]); L[13] = fminf(L[11], L[13]); L[11] = _h; _h = fmaxf(L[9], L[10]); L[10] = fminf(L[9], L[10]); L[9] = _h; _h = fmaxf(L[11], L[12]); L[12] = fminf(L[11], L[12]); L[11] = _h; _h = fmaxf(L[13], L[14]); L[14] = fminf(L[13], L[14]); L[13] = _h; _h = fmaxf(L[0], L[8]); L[8] = fminf(L[0], L[8]); L[0] = _h; _h = fmaxf(L[4], L[12]); L[12] = fminf(L[4], L[12]); L[4] = _h; _h = fmaxf(L[4], L[8]); L[8] = fminf(L[4], L[8]); L[4] = _h; _h = fmaxf(L[2], L[10]); L[10] = fminf(L[2], L[10]); L[2] = _h; _h = fmaxf(L[6], L[14]); L[14] = fminf(L[6], L[14]); L[6] = _h; _h = fmaxf(L[6], L[10]); L[10] = fminf(L[6], L[10]); L[6] = _h; _h = fmaxf(L[2], L[4]); L[4] = fminf(L[2], L[4]); L[2] = _h; _h = fmaxf(L[6], L[8]); L[8] = fminf(L[6], L[8]); L[6] = _h; _h = fmaxf(L[10], L[12]); L[12] = fminf(L[10], L[12]); L[10] = _h; _h = fmaxf(L[1], L[9]); L[9] = fminf(L[1], L[9]); L[1] = _h; _h = fmaxf(L[5], L[13]); L[13] = fminf(L[5], L[13]); L[5] = _h; _h = fmaxf(L[5], L[9]); L[9] = fminf(L[5], L[9]); L[5] = _h; _h = fmaxf(L[3], L[11]); L[11] = fminf(L[3], L[11]); L[3] = _h; _h = fmaxf(L[7], L[15]); L[15] = fminf(L[7], L[15]); L[7] = _h; _h = fmaxf(L[7], L[11]); L[11] = fminf(L[7], L[11]); L[7] = _h; _h = fmaxf(L[3], L[5]); L[5] = fminf(L[3], L[5]); L[3] = _h; _h = fmaxf(L[7], L[9]); L[9] = fminf(L[7], L[9]); L[7] = _h; _h = fmaxf(L[11], L[13]); L[13] = fminf(L[11], L[13]); L[11] = _h; _h = fmaxf(L[1], L[2]); L[2] = fminf(L[1], L[2]); L[1] = _h; _h = fmaxf(L[3], L[4]); L[4] = fminf(L[3], L[4]); L[3] = _h; _h = fmaxf(L[5], L[6]); L[6] = fminf(L[5], L[6]); L[5] = _h; _h = fmaxf(L[7], L[8]); L[8] = fminf(L[7], L[8]); L[7] = _h; _h = fmaxf(L[9], L[10]); L[10] = fminf(L[9], L[10]); L[9] = _h; _h = fmaxf(L[11], L[12]); L[12] = fminf(L[11], L[12]); L[11] = _h; _h = fmaxf(L[13], L[14]); L[14] = fminf(L[13], L[14]); L[13] = _h; } while (0)
#define BITONIC16(L) do { float _h; _h = fmaxf(L[0], L[8]); L[8] = fminf(L[0], L[8]); L[0] = _h; _h = fmaxf(L[1], L[9]); L[9] = fminf(L[1], L[9]); L[1] = _h; _h = fmaxf(L[2], L[10]); L[10] = fminf(L[2], L[10]); L[2] = _h; _h = fmaxf(L[3], L[11]); L[11] = fminf(L[3], L[11]); L[3] = _h; _h = fmaxf(L[4], L[12]); L[12] = fminf(L[4], L[12]); L[4] = _h; _h = fmaxf(L[5], L[13]); L[13] = fminf(L[5], L[13]); L[5] = _h; _h = fmaxf(L[6], L[14]); L[14] = fminf(L[6], L[14]); L[6] = _h; _h = fmaxf(L[7], L[15]); L[15] = fminf(L[7], L[15]); L[7] = _h; _h = fmaxf(L[0], L[4]); L[4] = fminf(L[0], L[4]); L[0] = _h; _h = fmaxf(L[1], L[5]); L[5] = fminf(L[1], L[5]); L[1] = _h; _h = fmaxf(L[2], L[6]); L[6] = fminf(L[2], L[6]); L[2] = _h; _h = fmaxf(L[3], L[7]); L[7] = fminf(L[3], L[7]); L[3] = _h; _h = fmaxf(L[8], L[12]); L[12] = fminf(L[8], L[12]); L[8] = _h; _h = fmaxf(L[9], L[13]); L[13] = fminf(L[9], L[13]); L[9] = _h; _h = fmaxf(L[10], L[14]); L[14] = fminf(L[10], L[14]); L[10] = _h; _h = fmaxf(L[11], L[15]); L[15] = fminf(L[11], L[15]); L[11] = _h; _h = fmaxf(L[0], L[2]); L[2] = fminf(L[0], L[2]); L[0] = _h; _h = fmaxf(L[1], L[3]); L[3] = fminf(L[1], L[3]); L[1] = _h; _h = fmaxf(L[4], L[6]); L[6] = fminf(L[4], L[6]); L[4] = _h; _h = fmaxf(L[5], L[7]); L[7] = fminf(L[5], L[7]); L[5] = _h; _h = fmaxf(L[8], L[10]); L[10] = fminf(L[8], L[10]); L[8] = _h; _h = fmaxf(L[9], L[11]); L[11] = fminf(L[9], L[11]); L[9] = _h; _h = fmaxf(L[12], L[14]); L[14] = fminf(L[12], L[14]); L[12] = _h; _h = fmaxf(L[13], L[15]); L[15] = fminf(L[13], L[15]); L[13] = _h; _h = fmaxf(L[0], L[1]); L[1] = fminf(L[0], L[1]); L[0] = _h; _h = fmaxf(L[2], L[3]); L[3] = fminf(L[2], L[3]); L[2] = _h; _h = fmaxf(L[4], L[5]); L[5] = fminf(L[4], L[5]); L[4] = _h; _h = fmaxf(L[6], L[7]); L[7] = fminf(L[6], L[7]); L[6] = _h; _h = fmaxf(L[8], L[9]); L[9] = fminf(L[8], L[9]); L[8] = _h; _h = fmaxf(L[10], L[11]); L[11] = fminf(L[10], L[11]); L[10] = _h; _h = fmaxf(L[12], L[13]); L[13] = fminf(L[12], L[13]); L[12] = _h; _h = fmaxf(L[14], L[15]); L[15] = fminf(L[14], L[15]); L[14] = _h; } while (0)
#define INS16(L, xin) do { float _x = (xin); _Pragma("unroll") for (int _p = 0; _p < 16; ++_p) { const float _hi = fmaxf(L[_p], _x); _x = fminf(L[_p], _x); L[_p] = _hi; } } while (0)
__device__ void phase_topk(const Params& p, unsigned char* lds) {
    const int tid = threadIdx.x, wid = tid >> 6, lane = tid & 63, r = lane & 31, hh = lane >> 5;
    const bf16_t* qp = (const bf16_t*)(p.ws + OFF_QP); const bf16_t* keysb = (const bf16_t*)(p.ws + OFF_KEYS);
    int* idxo = (int*)(p.ws + OFF_IDX); float* go = (float*)(p.ws + OFF_G);
    float* myrows = (float*)lds + wid * 32 * 129;
    const float NEG = -__builtin_inff();
    for (int tile = blockIdx.x; tile < 256; tile += gridDim.x) {
        const int tokb = tile * 64 + (wid & 1) * 32;
        float v1[16], v2[16];
#pragma unroll
        for (int j = 0; j < 16; ++j) { v1[j] = NEG; v2[j] = NEG; }
#pragma unroll 1
        for (int pass = 0; pass < 4; ++pass) {
            const int half = pass >> 1, hg = pass & 1, head = hg * 4 + (wid >> 1);
            f32x16 acc[4] = {zero16(), zero16(), zero16(), zero16()};
            const bf16_t* arow = qp + (size_t)(tokb + r) * 2048 + head * 256 + half * 128 + 8 * hh;
            const bf16_t* kb = keysb + half * 16384 + r * 128 + 8 * hh;
#pragma unroll
            for (int ks = 0; ks < 8; ++ks) { const bf16x8 a = *(const bf16x8*)(arow + 16 * ks);
#pragma unroll
                for (int nt = 0; nt < 4; ++nt) { const bf16x8 bb = *(const bf16x8*)(kb + nt * 32 * 128 + 16 * ks); acc[nt] = MFMA32(a, bb, acc[nt]); } }
#pragma unroll
            for (int nt = 0; nt < 4; ++nt)
#pragma unroll
                for (int e = 0; e < 16; ++e) { const int m = (e & 3) + 8 * (e >> 2) + 4 * hh; myrows[m * 129 + nt * 32 + r] = acc[nt][e]; }
            asm volatile("s_waitcnt lgkmcnt(0)" ::: "memory"); __builtin_amdgcn_wave_barrier();
            float L[16];
            const float* rowp = myrows + r * 129 + hh * 64;
#pragma unroll
            for (int j = 0; j < 16; ++j) L[j] = __uint_as_float((__float_as_uint(rowp[j]) & ~127u) | (unsigned)(127 - (hh * 64 + j)));
            SORT16(L);
#pragma unroll 1
            for (int g = 1; g < 4; ++g) {
                float Gp[16];
#pragma unroll
                for (int j = 0; j < 16; ++j) Gp[j] = __uint_as_float((__float_as_uint(rowp[g * 16 + j]) & ~127u) | (unsigned)(127 - (hh * 64 + g * 16 + j)));
                SORT16(Gp);
#pragma unroll
                for (int j = 0; j < 16; ++j) L[j] = fmaxf(L[j], Gp[15 - j]);
                BITONIC16(L);
            }
            {
                float O[16];
#pragma unroll
                for (int j = 0; j < 16; ++j) O[j] = __shfl_xor(L[j], 32);
#pragma unroll
                for (int j = 0; j < 16; ++j) L[j] = fmaxf(L[j], O[15 - j]);
                BITONIC16(L);
            }
            const bool mine = hh == hg;
            if (half == 0) {
#pragma unroll
                for (int j = 0; j < 16; ++j) v1[j] = mine ? L[j] : v1[j];
            } else {
#pragma unroll
                for (int j = 0; j < 16; ++j) v2[j] = mine ? L[j] : v2[j];
            }
            asm volatile("s_waitcnt lgkmcnt(0)" ::: "memory"); __builtin_amdgcn_wave_barrier();
        }
        float T[16]; int TI[16];
        int i1[16], i2[16];
#pragma unroll
        for (int j = 0; j < 16; ++j) { i1[j] = (127 - (int)(__float_as_uint(v1[j]) & 127u)) * 128; i2[j] = 127 - (int)(__float_as_uint(v2[j]) & 127u); }
#pragma unroll
        for (int j = 0; j < 16; ++j) { T[j] = v1[0] + v2[j]; TI[j] = i1[0] + i2[j]; }
#pragma unroll
        for (int a = 1; a < 16; ++a)
#pragma unroll
            for (int b = 0; b < 16; ++b)
                if ((a + 1) * (b + 1) <= 16) {
                    float s = v1[a] + v2[b]; int id = i1[a] + i2[b];
#pragma unroll
                    for (int q = (a + 1) * (b + 1) - 1; q < 16; ++q) { const bool c = s > T[q]; const float ts = c ? T[q] : s; const int ti = c ? TI[q] : id; T[q] = c ? s : T[q]; TI[q] = c ? id : TI[q]; s = ts; id = ti; }
                }
        const int token = tokb + r, head = hh * 4 + (wid >> 1);
        const float t0v = T[0]; float tot = 0.f;
#pragma unroll
        for (int j = 0; j < 16; ++j) { T[j] = __expf(T[j] - t0v); tot += T[j]; }
        const float inv = 1.0f / tot;
#pragma unroll
        for (int j = 0; j < 16; j += 4) { *(f32x4*)(go + (size_t)token * 128 + head * 16 + j) = (f32x4){T[j] * inv, T[j + 1] * inv, T[j + 2] * inv, T[j + 3] * inv};
            *(int4*)(idxo + (size_t)token * 128 + head * 16 + j) = make_int4(TI[j], TI[j + 1], TI[j + 2], TI[j + 3]); }
    }
}

__device__ void phase_peer(const Params& p, unsigned char* lds) {
    const int tid = threadIdx.x, wid = tid >> 6, lane = tid & 63, l16 = lane & 15, q4 = lane >> 4;
    const bf16_t* h2 = (const bf16_t*)(p.ws + OFF_H2); const bf16_t* db = (const bf16_t*)(p.ws + OFF_DOWN); const bf16_t* ub = (const bf16_t*)(p.ws + OFF_UP);
    const int* idxo = (const int*)(p.ws + OFF_IDX); const float* go = (const float*)(p.ws + OFF_G);
    const float* mod = (const float*)(p.ws + OFF_MOD);
    float* sga = (float*)lds + wid * 128;
    for (int tg = blockIdx.x * 8 + wid; tg < 2048; tg += gridDim.x * 8) {
        const int b = tg >> 10;
        for (int tt = 0; tt < 8; ++tt) {
            const int t = tg * 8 + tt;
            const int idA = idxo[(size_t)t * 128 + lane], idB = idxo[(size_t)t * 128 + 64 + lane];
            const float gA = go[(size_t)t * 128 + lane], gB = go[(size_t)t * 128 + 64 + lane];
            u32x4 hq[8];
#pragma unroll
            for (int i = 0; i < 8; ++i) hq[i] = *(const u32x4*)(h2 + (size_t)t * DM + i * 128 + l16 * 8);
#pragma unroll 2
            for (int s = 0; s < 32; ++s) {
                const int slot = 4 * s + q4;
                const int e = __shfl(s < 16 ? idA : idB, slot & 63);
                const bf16_t* row = db + (size_t)e * DM + l16 * 8;
                u32x4 w[8];
#pragma unroll
                for (int i = 0; i < 8; ++i) w[i] = *(const u32x4*)(row + i * 128);
                float a = 0.f;
#pragma unroll
                for (int i = 0; i < 8; ++i) {
                    a = dot2bf(w[i].x, hq[i].x, a); a = dot2bf(w[i].y, hq[i].y, a); a = dot2bf(w[i].z, hq[i].z, a); a = dot2bf(w[i].w, hq[i].w, a); }
                a += __shfl_xor(a, 8); a += __shfl_xor(a, 4); a += __shfl_xor(a, 2); a += __shfl_xor(a, 1);
                const float gg = __shfl(s < 16 ? gA : gB, slot & 63);
                if (l16 == 0) sga[slot] = gelu1(a) * gg;
            }
            asm volatile("s_waitcnt lgkmcnt(0)" ::: "memory"); __builtin_amdgcn_wave_barrier();
            float acc[16];
#pragma unroll
            for (int j = 0; j < 16; ++j) acc[j] = 0.f;
#pragma unroll 4
            for (int slot = 0; slot < 128; ++slot) {
                const int e = __builtin_amdgcn_readlane(slot < 64 ? idA : idB, slot & 63);
                const float ga = sga[slot];
                const bf16_t* row = ub + (size_t)e * DM + lane * 8;
                const u32x4 w0 = *(const u32x4*)row, w1 = *(const u32x4*)(row + 512);
                acc[0] += ga * bflo(w0.x); acc[1] += ga * bfhi(w0.x); acc[2] += ga * bflo(w0.y); acc[3] += ga * bfhi(w0.y);
                acc[4] += ga * bflo(w0.z); acc[5] += ga * bfhi(w0.z); acc[6] += ga * bflo(w0.w); acc[7] += ga * bfhi(w0.w);
                acc[8] += ga * bflo(w1.x); acc[9] += ga * bfhi(w1.x); acc[10] += ga * bflo(w1.y); acc[11] += ga * bfhi(w1.y);
                acc[12] += ga * bflo(w1.z); acc[13] += ga * bfhi(w1.z); acc[14] += ga * bflo(w1.w); acc[15] += ga * bfhi(w1.w);
            }
            asm volatile("s_waitcnt lgkmcnt(0)" ::: "memory"); __builtin_amdgcn_wave_barrier();
            float xo[16]; float ss = 0.f;
#pragma unroll
            for (int i = 0; i < 2; ++i)
#pragma unroll
                for (int j4 = 0; j4 < 2; ++j4) { const int d = i * 512 + lane * 8 + j4 * 4;
                    const f32x4 xv = *(const f32x4*)(p.out + (size_t)t * DM + d);
                    const f32x4 g2 = *(const f32x4*)(mod + b * 6144 + 5120 + d) + *(const f32x4*)(p.b_ada + 5120 + d);
#pragma unroll
                    for (int j = 0; j < 4; ++j) { const float v = xv[j] + g2[j] * acc[i * 8 + j4 * 4 + j]; xo[i * 8 + j4 * 4 + j] = v; ss += v * v; } }
            ss = wave_sum(ss);
            const float rstd = rsqrtf(ss * (1.0f / 1024.0f) + EPS);
#pragma unroll
            for (int i = 0; i < 2; ++i)
#pragma unroll
                for (int j4 = 0; j4 < 2; ++j4) { const int d = i * 512 + lane * 8 + j4 * 4;
                    const f32x4 fw = *(const f32x4*)(p.final_w + d);
                    *(f32x4*)(p.out + (size_t)t * DM + d) = (f32x4){xo[i * 8 + j4 * 4] * rstd * fw[0], xo[i * 8 + j4 * 4 + 1] * rstd * fw[1], xo[i * 8 + j4 * 4 + 2] * rstd * fw[2], xo[i * 8 + j4 * 4 + 3] * rstd * fw[3]}; }
        }
    }
}

__device__ void phase_tables8(const Params& p) {
    const int wid = threadIdx.x >> 6, lane = threadIdx.x & 63;
    const int row0 = blockIdx.x * 8 + wid, rstep = gridDim.x * 8;
    f32x4 vn[4];
    if (row0 < 32768) { const float* src0 = (row0 >= 16384 ? p.up : p.down) + (size_t)(row0 & 16383) * DM + lane * 16;
#pragma unroll
        for (int i = 0; i < 4; ++i) vn[i] = __builtin_nontemporal_load((const f32x4*)(src0 + 4 * i)); }
    for (int row = row0; row < 32768; row += rstep) {
        const bool isup = row >= 16384; const int e = row & 16383;
        f32x4 v[4]; float m = 0.f;
#pragma unroll
        for (int i = 0; i < 4; ++i) v[i] = vn[i];
        if (row + rstep < 32768) { const int rn = row + rstep; const float* srcn = (rn >= 16384 ? p.up : p.down) + (size_t)(rn & 16383) * DM + lane * 16;
#pragma unroll
            for (int i = 0; i < 4; ++i) vn[i] = __builtin_nontemporal_load((const f32x4*)(srcn + 4 * i)); }
#pragma unroll
        for (int i = 0; i < 4; ++i) { m = fmaxf(m, fmaxf(fmaxf(fabsf(v[i][0]), fabsf(v[i][1])), fmaxf(fabsf(v[i][2]), fabsf(v[i][3])))); }
#pragma unroll
        for (int o = 32; o; o >>= 1) m = fmaxf(m, __shfl_xor(m, o));
        const float sc = m > 0.f ? m * (1.0f / 224.0f) : 1.0f, inv = m > 0.f ? 224.0f / m : 0.f;
        int w[4];
#pragma unroll
        for (int i = 0; i < 4; ++i) { w[i] = __builtin_amdgcn_cvt_pk_fp8_f32(v[i][0] * inv, v[i][1] * inv, 0, false); w[i] = __builtin_amdgcn_cvt_pk_fp8_f32(v[i][2] * inv, v[i][3] * inv, w[i], true); }
        unsigned char* dst = p.ws + (isup ? OFF_UP8 : OFF_DOWN8) + (size_t)e * 1024 + lane * 16;
        *(u32x4*)dst = (u32x4){(unsigned)w[0], (unsigned)w[1], (unsigned)w[2], (unsigned)w[3]};
        if (lane == 0) ((float*)(p.ws + (isup ? OFF_SCU : OFF_SCD)))[e] = sc;
    }
}

__device__ __forceinline__ float dot2bfv(bf16x2_t a, unsigned b, float c) { return __builtin_amdgcn_fdot2_f32_bf16(a, __builtin_bit_cast(bf16x2_t, b), c, false); }
#define PEER_FMA16(ACC, W, GA) do { const f32x2 _g2 = (f32x2){(GA), (GA)}; \
    ACC[0] += _g2 * __builtin_amdgcn_cvt_pk_f32_fp8((int)(W).x, false); ACC[1] += _g2 * __builtin_amdgcn_cvt_pk_f32_fp8((int)(W).x, true); \
    ACC[2] += _g2 * __builtin_amdgcn_cvt_pk_f32_fp8((int)(W).y, false); ACC[3] += _g2 * __builtin_amdgcn_cvt_pk_f32_fp8((int)(W).y, true); \
    ACC[4] += _g2 * __builtin_amdgcn_cvt_pk_f32_fp8((int)(W).z, false); ACC[5] += _g2 * __builtin_amdgcn_cvt_pk_f32_fp8((int)(W).z, true); \
    ACC[6] += _g2 * __builtin_amdgcn_cvt_pk_f32_fp8((int)(W).w, false); ACC[7] += _g2 * __builtin_amdgcn_cvt_pk_f32_fp8((int)(W).w, true); } while (0)
__device__ void phase_peer2(const Params& p, unsigned char* lds) {
    const int tid = threadIdx.x, wid = tid >> 6, lane = tid & 63, l16 = lane & 15, q4 = lane >> 4;
    unsigned char* wl = lds + wid * 14336;
    int* se = (int*)wl;
    float* sg = (float*)(wl + 2048);
    float* sa = (float*)(wl + 4096);
    unsigned char* hl = wl + 6144;
    const unsigned char* d8 = p.ws + OFF_DOWN8; const unsigned char* u8 = p.ws + OFF_UP8;
    const float* scd = (const float*)(p.ws + OFF_SCD); const float* scu = (const float*)(p.ws + OFF_SCU);
    const bf16_t* h2 = (const bf16_t*)(p.ws + OFF_H2);
    const int* idxo = (const int*)(p.ws + OFF_IDX); const float* go = (const float*)(p.ws + OFF_G);
    const float* mod = (const float*)(p.ws + OFF_MOD);
    const unsigned long long ltmask = (1ull << lane) - 1ull;
    for (int blk2 = blockIdx.x * 2; blk2 < 512; blk2 += (blk2 & 1) ? 2 * gridDim.x - 1 : 1) {
        const int blk = blk2; const int tok0 = blk * 32 + wid * 4; const int b = tok0 >> 13;
        {
            int ids[8]; float gs[8];
#pragma unroll
            for (int tk = 0; tk < 4; ++tk) { const size_t o = (size_t)(tok0 + tk) * 128 + lane; ids[2 * tk] = idxo[o]; ids[2 * tk + 1] = idxo[o + 64]; gs[2 * tk] = go[o]; gs[2 * tk + 1] = go[o + 64];
#pragma unroll
                for (int hb = 0; hb < 2; ++hb) { const int c = lane + 64 * hb, cp = (c >> 1) | ((c & 1) << 6);
                    *(u32x4*)(hl + tk * 2048 + cp * 16) = *(const u32x4*)(h2 + (size_t)(tok0 + tk) * DM + c * 8); } }
            int base = 0;
#pragma unroll
            for (int r = 0; r < 8; ++r)
#pragma unroll
                for (int k = 0; k < 8; ++k) { const bool m = (ids[k] >> 11) == r; const unsigned long long mk = __ballot(m);
                    if (m) { const int pos = base + __popcll(mk & ltmask); se[pos] = ids[k] | ((k >> 1) << 16); sg[pos] = gs[k]; }
                    base += __popcll(mk); }
        }
        asm volatile("s_waitcnt lgkmcnt(0)" ::: "memory"); __builtin_amdgcn_wave_barrier();
        {
            u32x4 bufA[8], bufB[8], bufC[8]; float sdA[2], sdB[2], sdC[2];
#define PEER_DLOAD(BUF, SD, K) do { _Pragma("unroll") for (int _u = 0; _u < 2; ++_u) { const int _e = se[8 * (K) + 4 * _u + q4] & 0xffff; const unsigned char* _row = d8 + (size_t)_e * 1024 + l16 * 16; \
            _Pragma("unroll") for (int _i = 0; _i < 4; ++_i) BUF[_u * 4 + _i] = *(const u32x4*)(_row + _i * 256); SD[_u] = scd[_e]; } } while (0)
#define PEER_DCOMP(BUF, SD, K) do { _Pragma("unroll") for (int _u = 0; _u < 2; ++_u) { const int _ix = 8 * (K) + 4 * _u + q4; const int _tk = se[_ix] >> 16; const unsigned char* _hb = hl + _tk * 2048 + l16 * 16; float _a = 0.f; \
            _Pragma("unroll") for (int _i = 0; _i < 4; ++_i) { const u32x4 _h0 = *(const u32x4*)(_hb + _i * 256), _h1 = *(const u32x4*)(_hb + 1024 + _i * 256); const u32x4 _w = BUF[_u * 4 + _i]; \
                _a = dot2bfv(__builtin_amdgcn_cvt_scalef32_pk_bf16_fp8((int)_w.x, 1.0f, false), _h0.x, _a); _a = dot2bfv(__builtin_amdgcn_cvt_scalef32_pk_bf16_fp8((int)_w.x, 1.0f, true), _h0.y, _a); \
                _a = dot2bfv(__builtin_amdgcn_cvt_scalef32_pk_bf16_fp8((int)_w.y, 1.0f, false), _h0.z, _a); _a = dot2bfv(__builtin_amdgcn_cvt_scalef32_pk_bf16_fp8((int)_w.y, 1.0f, true), _h0.w, _a); \
                _a = dot2bfv(__builtin_amdgcn_cvt_scalef32_pk_bf16_fp8((int)_w.z, 1.0f, false), _h1.x, _a); _a = dot2bfv(__builtin_amdgcn_cvt_scalef32_pk_bf16_fp8((int)_w.z, 1.0f, true), _h1.y, _a); \
                _a = dot2bfv(__builtin_amdgcn_cvt_scalef32_pk_bf16_fp8((int)_w.w, 1.0f, false), _h1.z, _a); _a = dot2bfv(__builtin_amdgcn_cvt_scalef32_pk_bf16_fp8((int)_w.w, 1.0f, true), _h1.w, _a); } \
            _a += __shfl_xor(_a, 8); _a += __shfl_xor(_a, 4); _a += __shfl_xor(_a, 2); _a += __shfl_xor(_a, 1); \
            if (l16 == 0) sa[_ix] = _a * SD[_u]; } } while (0)
            PEER_DLOAD(bufA, sdA, 0); PEER_DLOAD(bufB, sdB, 1);
            for (int k = 0; k < 63; k += 3) {
                PEER_DLOAD(bufC, sdC, k + 2);
                PEER_DCOMP(bufA, sdA, k);
                PEER_DLOAD(bufA, sdA, k + 3);
                PEER_DCOMP(bufB, sdB, k + 1);
                if (k + 4 < 64) PEER_DLOAD(bufB, sdB, k + 4);
                PEER_DCOMP(bufC, sdC, k + 2);
            }
            PEER_DCOMP(bufA, sdA, 63);
            asm volatile("s_waitcnt lgkmcnt(0)" ::: "memory"); __builtin_amdgcn_wave_barrier();
#pragma unroll
            for (int j = 0; j < 8; ++j) { const int ix = lane + 64 * j; const int e = se[ix] & 0xffff; sg[ix] = gelu1(sa[ix]) * sg[ix] * scu[e]; }
#undef PEER_DLOAD
#undef PEER_DCOMP
        }
        asm volatile("s_waitcnt lgkmcnt(0)" ::: "memory"); __builtin_amdgcn_wave_barrier();
        f32x2 acc0[8], acc1[8], acc2[8], acc3[8];
#pragma unroll
        for (int j = 0; j < 8; ++j) { acc0[j] = (f32x2){0.f, 0.f}; acc1[j] = (f32x2){0.f, 0.f}; acc2[j] = (f32x2){0.f, 0.f}; acc3[j] = (f32x2){0.f, 0.f}; }
        {
            u32x4 ring[16];
#pragma unroll
            for (int j = 0; j < 16; ++j) ring[j] = *(const u32x4*)(u8 + (size_t)(se[j] & 0xffff) * 1024 + lane * 16);
            for (int i = 0; i < 512; i += 16) {
#pragma unroll
                for (int j = 0; j < 16; ++j) {
                    const int tk = __builtin_amdgcn_readfirstlane(se[i + j]) >> 16; const float ga = sg[i + j];
                    const u32x4 w = ring[j];
                    if (i + 16 < 512) ring[j] = *(const u32x4*)(u8 + (size_t)(se[i + 16 + j] & 0xffff) * 1024 + lane * 16);
                    if (tk == 0) PEER_FMA16(acc0, w, ga); else if (tk == 1) PEER_FMA16(acc1, w, ga); else if (tk == 2) PEER_FMA16(acc2, w, ga); else PEER_FMA16(acc3, w, ga);
                }
            }
        }
        asm volatile("s_waitcnt lgkmcnt(0)" ::: "memory"); __builtin_amdgcn_wave_barrier();
#define PEER_FIN(ACC, TK) do { const size_t _o = (size_t)(tok0 + (TK)) * DM + lane * 16; f32x4 _x[4]; float _ss = 0.f; \
        _Pragma("unroll") for (int _j = 0; _j < 4; ++_j) { const f32x4 _xv = *(const f32x4*)(p.out + _o + 4 * _j); const f32x4 _g2 = *(const f32x4*)(mod + b * 6144 + 5120 + lane * 16 + 4 * _j) + *(const f32x4*)(p.b_ada + 5120 + lane * 16 + 4 * _j); \
            _x[_j] = _xv + _g2 * (f32x4){ACC[2 * _j].x, ACC[2 * _j].y, ACC[2 * _j + 1].x, ACC[2 * _j + 1].y}; _ss += _x[_j][0] * _x[_j][0] + _x[_j][1] * _x[_j][1] + _x[_j][2] * _x[_j][2] + _x[_j][3] * _x[_j][3]; } \
        _ss = wave_sum(_ss); const float _rs = rsqrtf(_ss * (1.0f / 1024.0f) + EPS); \
        _Pragma("unroll") for (int _j = 0; _j < 4; ++_j) { const f32x4 _fw = *(const f32x4*)(p.final_w + lane * 16 + 4 * _j); *(f32x4*)(p.out + _o + 4 * _j) = _x[_j] * _rs * _fw; } } while (0)
        PEER_FIN(acc0, 0); PEER_FIN(acc1, 1); PEER_FIN(acc2, 2); PEER_FIN(acc3, 3);
#undef PEER_FIN
    }
}

#ifndef DBG_STAGE
#define DBG_STAGE 0
#endif
__device__ void phase_final_only(const Params& p) {
    const int wid = threadIdx.x >> 6, lane = threadIdx.x & 63;
    for (int t = blockIdx.x * 8 + wid; t < NTOK; t += gridDim.x * 8) {
        f32x4 xv[4]; float ss = 0.f;
#pragma unroll
        for (int i = 0; i < 4; ++i) { xv[i] = *(const f32x4*)(p.out + (size_t)t * DM + 256 * i + 4 * lane); ss += xv[i][0] * xv[i][0] + xv[i][1] * xv[i][1] + xv[i][2] * xv[i][2] + xv[i][3] * xv[i][3]; }
        ss = wave_sum(ss);
        const float rstd = rsqrtf(ss * (1.0f / 1024.0f) + EPS);
#pragma unroll
        for (int i = 0; i < 4; ++i) { const f32x4 fw = *(const f32x4*)(p.final_w + 256 * i + 4 * lane); *(f32x4*)(p.out + (size_t)t * DM + 256 * i + 4 * lane) = xv[i] * rstd * fw; }
    }
}

__device__ void phase_dump_bf16(const Params& p, const bf16_t* src, int ld) {
    for (size_t e = (size_t)blockIdx.x * 512 + threadIdx.x; e < (size_t)NTOK * DM; e += (size_t)gridDim.x * 512) {
        const size_t t = e >> 10, d = e & 1023; float v = __uint_as_float((unsigned)src[t * ld + d] << 16); if (!(fabsf(v) < 1e30f)) v = 1000.f; p.out[e] = v; }
}
__device__ void dbg_check_bf16(const Params& p, const bf16_t* src, size_t n, unsigned bit) {
    unsigned* flags = (unsigned*)(p.ws + OFF_IDX);
    bool bad = false;
    for (size_t e = (size_t)blockIdx.x * 512 + threadIdx.x; e < n; e += (size_t)gridDim.x * 512) { const float v = __uint_as_float((unsigned)src[e] << 16); if (!(fabsf(v) < 1e30f)) bad = true; }
    if (bad) atomicOr(flags, bit);
}
__device__ void dbg_check_f32(const Params& p, const float* src, size_t n, unsigned bit, float lim) {
    unsigned* flags = (unsigned*)(p.ws + OFF_IDX);
    bool bad = false;
    for (size_t e = (size_t)blockIdx.x * 512 + threadIdx.x; e < n; e += (size_t)gridDim.x * 512) { const float v = src[e]; if (!(fabsf(v) < lim)) bad = true; }
    if (bad) atomicOr(flags, bit);
}
__device__ void dbg_final(const Params& p) {
    const unsigned f = *(const unsigned*)(p.ws + OFF_IDX);
    for (size_t e = (size_t)blockIdx.x * 512 + threadIdx.x; e < (size_t)NTOK * DM; e += (size_t)gridDim.x * 512) p.out[e] = p.x[e] * (1.0f + (float)f);
}
#define GSYNC() xcd_barrier(xb)
__global__ void __launch_bounds__(512, 2) fwd_megakernel(Params p) {
    extern __shared__ __attribute__((aligned(16))) unsigned char lds[];
    cg::grid_group grid = cg::this_grid();
    LAS unsigned char* lds3 = (LAS unsigned char*)lds;
    const float* mod = (const float*)(p.ws + OFF_MOD);
    volatile LAS unsigned* xst = (volatile LAS unsigned*)(lds3 + LDS_BYTES - 16);
    if (threadIdx.x == 0) { xst[0] = 0u; xst[1] = 0u; }
    __syncthreads();
    const XcdBarrier xb = xcd_barrier_post((unsigned*)(p.ws + OFF_BAR), xst);
    if (p.ws == nullptr) grid.sync();
    phase0(p, lds);
#if DBG_STAGE == 6
    if (blockIdx.x == 0 && threadIdx.x == 0) *(unsigned*)(p.ws + OFF_IDX) = 0u;
#endif
    GSYNC();
    phase_norm<true>(p, p.x, p.norm1_w, 0, 1024, (bf16_t*)(p.ws + OFF_HB), lds);
    GSYNC();
#if DBG_STAGE == 3
    phase_dump_bf16(p, (const bf16_t*)(p.ws + OFF_HB), DM); return;
#endif
    { pg8::StaticOrder S; S.init(NTOK, 7168, gridDim.x, blockIdx.x); EpiProj E{(bf16_t*)(p.ws + OFF_PROJ)};
        pg8::gemm_phase(lds3, pg8::Gemm{(const bf16_t*)(p.ws + OFF_HB), (const bf16_t*)(p.ws + OFF_WINT), NTOK, 7168, 1024}, S, E); }
    GSYNC();
#if DBG_STAGE == 2
    phase_dump_bf16(p, (const bf16_t*)(p.ws + OFF_PROJ) + 1024, PW); return;
#endif
    phase_glaA(p, lds);
    GSYNC();
#if DBG_STAGE == 6
    dbg_check_bf16(p, (const bf16_t*)p.out, (size_t)NTOK * 2048, 1u);
    dbg_check_f32(p, (const float*)(p.ws + OFF_ALR), (size_t)NTOK * 16, 8u, 50.f);
    dbg_check_f32(p, (const float*)(p.ws + OFF_DECAY), (size_t)1024 * 128, 16u, 1.0001f);
#endif
    phase_scan_sgu(p, lds);
    GSYNC();
#if DBG_STAGE == 6
    dbg_check_bf16(p, (const bf16_t*)p.out, (size_t)NTOK * 2048, 2u);
#endif
#if DBG_STAGE == 4
    phase_dump_bf16(p, (const bf16_t*)(p.ws + OFF_HB), DM); return;
#endif
    phase_glaC(p, lds);
    GSYNC();
#if DBG_STAGE == 5
    phase_dump_bf16(p, (const bf16_t*)(p.ws + OFF_HB), DM); return;
#endif
#if DBG_STAGE == 6
    dbg_check_bf16(p, (const bf16_t*)(p.ws + OFF_HB), (size_t)NTOK * DM, 4u);
    GSYNC();
    dbg_final(p); return;
#endif
    { pg8::StaticOrder S; S.init(NTOK, 1024, gridDim.x, blockIdx.x); EpiX1 E{p.x, p.out, mod, p.b_ada};
        pg8::gemm_phase(lds3, pg8::Gemm{(const bf16_t*)(p.ws + OFF_HB), (const bf16_t*)(p.ws + OFF_WOUTT), NTOK, 1024, 1024}, S, E); }
    GSYNC();
#if DBG_STAGE == 1
    phase_final_only(p); return;
#endif
    phase_norm<false>(p, p.out, p.norm2_w, 3072, 4096, (bf16_t*)(p.ws + OFF_H2), lds);
    phase_tables8(p);
    GSYNC();
    { pg8::StaticOrder S; S.init(NTOK, 2048, gridDim.x, blockIdx.x); EpiQ E{(bf16_t*)(p.ws + OFF_QP)};
        pg8::gemm_phase(lds3, pg8::Gemm{(const bf16_t*)(p.ws + OFF_H2), (const bf16_t*)(p.ws + OFF_WQT), NTOK, 2048, 1024}, S, E); }
    GSYNC();
    phase_topk(p, lds);
    asm volatile("s_waitcnt vmcnt(0) lgkmcnt(0)" ::: "memory"); __syncthreads();
    phase_peer2(p, lds);
}

extern "C" void kernel_launch(void* const* d_in, const int* in_sizes, int n_in, void* d_out, int out_size, void* d_ws, size_t ws_size, hipStream_t stream) {
    static int grid_blocks = 0;
    if (!grid_blocks) {
        int dev = 0, cus = 0, per_cu = 0;
        hipGetDevice(&dev);
        hipDeviceGetAttribute(&cus, hipDeviceAttributeMultiprocessorCount, dev);
        hipFuncSetAttribute((const void*)fwd_megakernel, hipFuncAttributeMaxDynamicSharedMemorySize, LDS_BYTES);
        hipOccupancyMaxActiveBlocksPerMultiprocessor(&per_cu, (const void*)fwd_megakernel, 512, LDS_BYTES);
        if (per_cu < 1) per_cu = 1;
        grid_blocks = cus * per_cu;
        if (ws_size < WS_END) fprintf(stderr, "kernel_launch: workspace too small (%zu < %zu)\n", ws_size, (size_t)WS_END);
    }
    Params p{};
    p.x = (const float*)d_in[0]; p.c = (const float*)d_in[1]; p.w_ada = (const float*)d_in[2]; p.b_ada = (const float*)d_in[3]; p.norm1_w = (const float*)d_in[4];
    p.w_in = (const float*)d_in[5]; p.w_alpha_up = (const float*)d_in[6]; p.b_alpha = (const float*)d_in[7]; p.gla_norm_w = (const float*)d_in[8];
    p.sgu_ln_w = (const float*)d_in[9]; p.sgu_ln_b = (const float*)d_in[10]; p.sgu_w = (const float*)d_in[11]; p.sgu_b = (const float*)d_in[12];
    p.w_out = (const float*)d_in[13]; p.norm2_w = (const float*)d_in[14]; p.w_q = (const float*)d_in[15]; p.keys1 = (const float*)d_in[16]; p.keys2 = (const float*)d_in[17];
    p.down = (const float*)d_in[18]; p.up = (const float*)d_in[19]; p.final_w = (const float*)d_in[20];
    p.out = (float*)d_out; p.ws = (unsigned char*)d_ws;
    hipMemsetAsync((unsigned char*)d_ws + OFF_BAR, 0, XCD_BAR_WORDS * 4, stream);
    void* args[] = {&p};
    hipError_t e = hipLaunchCooperativeKernel((const void*)fwd_megakernel, dim3(grid_blocks), dim3(512), args, LDS_BYTES, stream);
    if (e != hipSuccess) fprintf(stderr, "cooperative launch failed: %s (grid %d)\n", hipGetErrorString(e), grid_blocks);
}
```

```cpp
#include <hip/hip_runtime.h>
#include <hip/hip_cooperative_groups.h>
#include <cstdio>
namespace cg = cooperative_groups;

#define LAS __attribute__((address_space(3)))
typedef unsigned short bf16_t;
typedef short bf16x8 __attribute__((ext_vector_type(8)));
typedef float f32x2 __attribute__((ext_vector_type(2)));
typedef float f32x4 __attribute__((ext_vector_type(4)));
typedef float f32x16 __attribute__((ext_vector_type(16)));
typedef unsigned u32x2 __attribute__((ext_vector_type(2)));
typedef unsigned u32x4 __attribute__((ext_vector_type(4)));
typedef __bf16 bf16x2_t __attribute__((ext_vector_type(2)));

constexpr int NTOK = 16384, DM = 1024, SEQ = 8192, INW = 7184, PW = 5120;
constexpr float EPS = 1e-6f;
constexpr size_t MiB = 1024 * 1024;
constexpr size_t OFF_PROJ = 0;
constexpr size_t OFF_DOWN = 0;
constexpr size_t OFF_UP = 32 * MiB;
constexpr size_t OFF_DOWN8 = 0;
constexpr size_t OFF_UP8 = 16 * MiB;
constexpr size_t OFF_SCD = 32 * MiB;
constexpr size_t OFF_SCU = 32 * MiB + 65536;
constexpr size_t OFF_H2 = 64 * MiB;
constexpr size_t OFF_QP = 96 * MiB;
constexpr size_t OFF_HB = 160 * MiB;
constexpr size_t OFF_WINT = 192 * MiB;
constexpr size_t OFF_WOUTT = 206 * MiB;
constexpr size_t OFF_WQT = 208 * MiB;
constexpr size_t OFF_KEYS = 212 * MiB;
constexpr size_t OFF_MOD = OFF_KEYS + 65536;
constexpr size_t OFF_ALR = OFF_MOD + 65536;
constexpr size_t OFF_STATS = OFF_ALR + MiB;
constexpr size_t OFF_DECAY = OFF_STATS + 131072;
constexpr size_t OFF_BAR = OFF_DECAY + 524288;
constexpr size_t OFF_IDX = 214 * MiB;
constexpr size_t OFF_G = 222 * MiB;
constexpr size_t WS_END = 230 * MiB;
constexpr int LDS_BYTES = 135168;

struct Params {
    const float *x, *c, *w_ada, *b_ada, *norm1_w, *w_in, *w_alpha_up, *b_alpha, *gla_norm_w, *sgu_ln_w, *sgu_ln_b, *sgu_w, *sgu_b, *w_out, *norm2_w, *w_q, *keys1, *keys2, *down, *up, *final_w;
    float* out; unsigned char* ws;
};

__device__ __forceinline__ unsigned cvt_pk_bf16_asm(float lo, float hi) { unsigned r; asm volatile("v_cvt_pk_bf16_f32 %0, %1, %2" : "=v"(r) : "v"(lo), "v"(hi)); return r; }
__device__ __forceinline__ unsigned cvt_pk_bf16(float lo, float hi) { f32x2 v = {lo, hi}; bf16x2_t b = __builtin_convertvector(v, bf16x2_t); return __builtin_bit_cast(unsigned, b); }
__device__ __forceinline__ float bflo(unsigned w) { return __uint_as_float(w << 16); }
__device__ __forceinline__ float bfhi(unsigned w) { return __uint_as_float(w & 0xffff0000u); }
__device__ __forceinline__ float wave_sum(float v) {
#pragma unroll
    for (int o = 32; o; o >>= 1) v += __shfl_xor(v, o);
    return v;
}
__device__ __forceinline__ float sigmoidf_(float x) { return __builtin_amdgcn_rcpf(1.0f + __expf(-x)); }
__device__ __forceinline__ f32x2 gelu_pk(f32x2 v) {
    const f32x2 av = __builtin_elementwise_abs(v), d = av * 0.2316418882f + 1.0f;
    f32x2 t; t.x = __builtin_amdgcn_rcpf(d.x); t.y = __builtin_amdgcn_rcpf(d.y);
    f32x2 q = t * 0.5307027145f + (-0.7265760135f); q = q * t + 0.7107068705f; q = q * t + (-0.142248368f); q = q * t + 0.127414796f; q = q * t;
    const f32x2 s = (v * v) * (-0.72134752044f);
    f32x2 e; e.x = __builtin_amdgcn_exp2f(s.x); e.y = __builtin_amdgcn_exp2f(s.y);
    const f32x2 m = v * (q * e), r = v - m;
    f32x2 o; o.x = v.x < 0.f ? m.x : r.x; o.y = v.y < 0.f ? m.y : r.y; return o;
}
__device__ __forceinline__ float gelu1(float v) { f32x2 r = gelu_pk((f32x2){v, v}); return r.x; }
__device__ __forceinline__ f32x16 zero16() { f32x16 z;
#pragma unroll
    for (int i = 0; i < 16; ++i) z[i] = 0.f;
    return z; }
__device__ __forceinline__ float dot2bf(unsigned a, unsigned b, float c) { return __builtin_amdgcn_fdot2_f32_bf16(__builtin_bit_cast(bf16x2_t, a), __builtin_bit_cast(bf16x2_t, b), c, false); }
#define MFMA32(a, b, c) __builtin_amdgcn_mfma_f32_32x32x16_bf16((a), (b), (c), 0, 0, 0)


#define XB_TMO      128
#define XB_XCNT(j)  (256  + 64 * (j))
#define XB_XSUB(j)  (1280 + 64 * (j))
#define XB_XGEN(j)  (2304 + 64 * (j))
#define XB_TOP      3328
#define XB_TOPGEN   3392
#define XCD_BAR_WORDS 3456
#define XB_SPIN_CAP (1u << 18)
__device__ __forceinline__ unsigned xb_ld(unsigned* p)              { return __hip_atomic_load(p, __ATOMIC_RELAXED, __HIP_MEMORY_SCOPE_AGENT); }
__device__ __forceinline__ unsigned xb_add(unsigned* p, unsigned v) { return __hip_atomic_fetch_add(p, v, __ATOMIC_RELAXED, __HIP_MEMORY_SCOPE_AGENT); }
__device__ __forceinline__ unsigned xb_xcc_id() { return (unsigned)__builtin_amdgcn_s_getreg((3 << 11) | 20) & 0xFu; }
#define XB_SPIN(cond, bar) do { unsigned _sp = 0; while (cond) { __builtin_amdgcn_s_sleep(1); \
    if ((++_sp & 255u) == 0u) { if (xb_ld(&(bar)[XB_TMO])) break; if (_sp > XB_SPIN_CAP) { atomicAdd(&(bar)[XB_TMO], 1u); break; } } } } while (0)
struct XcdBarrier { unsigned* bar; unsigned x; volatile LAS unsigned* st; };
__device__ __forceinline__ XcdBarrier xcd_barrier_post(unsigned* bar, volatile LAS unsigned* st) {
    XcdBarrier b; b.bar = bar; b.x = xb_xcc_id(); b.st = st;
    if (threadIdx.x == 0) (void)xb_add(&bar[XB_XCNT(b.x)], 1u);
    return b;
}
__device__ __forceinline__ void xcd_barrier_complete(unsigned* bar, unsigned x, unsigned& nloc, unsigned& nx) {
    const unsigned G = gridDim.x * gridDim.y * gridDim.z;
    unsigned sum, cnt, mine, sp = 0u;
    for (;;) {
        sum = 0u; cnt = 0u; mine = 0u;
#pragma unroll
        for (unsigned j = 0; j < 16; ++j) { const unsigned c = xb_ld(&bar[XB_XCNT(j)]); sum += c; cnt += (c > 0u) ? 1u : 0u; mine = (j == x) ? c : mine; }
        if (sum == G) break;
        __builtin_amdgcn_s_sleep(1);
        if ((++sp & 255u) == 0u) { if (xb_ld(&bar[XB_TMO])) break; if (sp > XB_SPIN_CAP) { atomicAdd(&bar[XB_TMO], 1u); break; } }
    }
    nloc = mine > 0u ? mine : 1u; nx = cnt > 0u ? cnt : 1u;
}
__device__ __forceinline__ void xcd_barrier(const XcdBarrier& b) {
    asm volatile("s_waitcnt vmcnt(0)" ::: "memory");
    __syncthreads();
    if (threadIdx.x == 0) {
        unsigned* bar = b.bar;
        __builtin_amdgcn_s_waitcnt(0);
        unsigned nloc = b.st[0], nx = b.st[1];
        if (nloc == 0u) { xcd_barrier_complete(bar, b.x, nloc, nx); b.st[0] = nloc; b.st[1] = nx; }
        const unsigned old = xb_add(&bar[XB_XSUB(b.x)], 1u);
        const unsigned gen = old / nloc;
        if (old + 1u == (gen + 1u) * nloc) {
            __builtin_amdgcn_fence(__ATOMIC_RELEASE, "agent");
            asm volatile("s_waitcnt vmcnt(0)" ::: "memory");
            const unsigned og = xb_add(&bar[XB_TOP], 1u);
            const unsigned tg = og / nx;
            if (og + 1u == (tg + 1u) * nx) xb_add(&bar[XB_TOPGEN], 1u);
            else XB_SPIN(xb_ld(&bar[XB_TOPGEN]) == tg, bar);
            __builtin_amdgcn_fence(__ATOMIC_ACQUIRE, "agent");
            xb_add(&bar[XB_XGEN(b.x)], 1u);
            asm volatile("s_waitcnt vmcnt(0)" ::: "memory");
        } else {
            XB_SPIN(xb_ld(&bar[XB_XGEN(b.x)]) == gen, bar);
            __builtin_amdgcn_fence(__ATOMIC_ACQUIRE, "agent");
            asm volatile("s_waitcnt vmcnt(0)" ::: "memory");
        }
    }
    __syncthreads();
}

namespace pg8 {
constexpr int BM = 256, BK = 64, HALF = 128, HTB = HALF * BK * 2, STAGE_BYTES = 8 * HTB, NXCD = 8, WGM = 8;
__host__ __device__ __forceinline__ int lds_byte(int r, int c) { const int st = (r >> 4) * 2 + (c >> 5), rr = r & 15, cc = c & 31, ob = rr * 64 + cc * 2; return st * 1024 + (ob ^ (((ob >> 9) & 1) << 5)); }
__host__ __device__ __forceinline__ void stage_rc(int b, int& R, int& C) { const int st = b / 1024, sb = b % 1024, swz = sb ^ (((sb >> 9) & 1) << 5); R = (st >> 1) * 16 + swz / 64; C = (st & 1) * 32 + (swz % 64) / 2; }
__host__ __device__ __forceinline__ int perm32(int rho) { const int n = rho >> 4, i = rho & 15; return 8 * (i >> 2) + 4 * n + (i & 3); }
struct Unit { int pm, pn; };
struct Gemm { const bf16_t* A; const bf16_t* Bt; int M, N, K; };
struct StaticOrder {
    int nM, nN, nwg, G, c;
    __device__ void init(int M, int N, int G_, int c_) { nM = M / BM; nN = N / BM; nwg = nM * nN; G = G_; c = c_; }
    __device__ bool next(int i, Unit& u) const {
        const long L = (long)i * G + c; if (L >= nwg) return false;
        int wgid = (int)L; { const int q = nwg / NXCD, r = nwg % NXCD, xcd = wgid % NXCD, off = wgid / NXCD; wgid = (xcd < r ? xcd * (q + 1) : r * (q + 1) + (xcd - r) * q) + off; }
        const int nig = WGM * nN, gid = wgid / nig, fm = gid * WGM, gsz = (nM - fm) < WGM ? (nM - fm) : WGM;
        u.pm = fm + ((wgid % nig) % gsz); u.pn = (wgid % nig) / gsz; return true;
    }
    __device__ __forceinline__ void a_ready(const Unit&) const {}
    __device__ __forceinline__ void done(const Unit&) const {}
};

template <class Epi, class Sched>
__device__ __forceinline__ void gemm_phase(LAS unsigned char* lds, const Gemm g, const Sched& S, const Epi& E) {
    const int tid = threadIdx.x, wid = __builtin_amdgcn_readfirstlane(tid >> 6), lane = tid & 63, wr = wid >> 2, wc = wid & 3, fr = lane & 15, fq = lane >> 4;
    const int K = g.K, nt = K / BK;
    unsigned voffA[2], voffB[2];
#pragma unroll
    for (int i = 0; i < 2; ++i) { int R, C; stage_rc(tid * 16 + i * 8192, R, C); const int Rb = Epi::PERM ? ((R & ~31) + perm32(R & 31)) : R;
        voffA[i] = (unsigned)(R * K + C) * 2u; voffB[i] = (unsigned)(Rb * K + C) * 2u; }
    const size_t kstep = (size_t)(BK * 2);
    const size_t hstep = (size_t)HALF * K * 2;
    const size_t tstep = 2 * hstep;
    const unsigned ldsw = (unsigned)wid * 1024u;
    const int aoff = lds_byte(wr * 64 + fr, fq * 8), boff = lds_byte(wc * 32 + fr, fq * 8);
#define PG8_SA(b, h) (((b) * 2 + (h)) * HTB)
#define PG8_SB(b, h) ((4 + (b) * 2 + (h)) * HTB)
#define PG8_STAGE(bufoff, gbase, voff) do { _Pragma("unroll") for (int _i = 0; _i < 2; ++_i) \
        __builtin_amdgcn_global_load_lds((const unsigned*)((const char*)(gbase) + (voff)[_i]), (LAS unsigned*)(lds + (bufoff) + ldsw + _i * 8192), 16, 0, 0); } while (0)
#define PG8_LDA(dst, b, h) do { _Pragma("unroll") for (int m = 0; m < 4; ++m) _Pragma("unroll") for (int k = 0; k < 2; ++k) dst[m][k] = *(const LAS bf16x8*)(lds + PG8_SA(b, h) + aoff + m * 2048 + k * 1024); } while (0)
#define PG8_LDB(dst, b, h) do { _Pragma("unroll") for (int n = 0; n < 2; ++n) _Pragma("unroll") for (int k = 0; k < 2; ++k) dst[n][k] = *(const LAS bf16x8*)(lds + PG8_SB(b, h) + boff + n * 2048 + k * 1024); } while (0)
#define PG8_MMA(ai, bj, At, Bt) do { __builtin_amdgcn_s_setprio(1); _Pragma("unroll") for (int m = 0; m < 4; ++m) _Pragma("unroll") for (int n = 0; n < 2; ++n) _Pragma("unroll") for (int k = 0; k < 2; ++k) \
        acc[ai][bj][m][n] = __builtin_amdgcn_mfma_f32_16x16x32_bf16(Bt[n][k], At[m][k], acc[ai][bj][m][n], 0, 0, 0); __builtin_amdgcn_s_setprio(0); } while (0)
#define PG8_WAIT_V(n) asm volatile("s_waitcnt vmcnt(" #n ")" ::: "memory")
#define PG8_WAIT_L(n) asm volatile("s_waitcnt lgkmcnt(" #n ")" ::: "memory")
#define PG8_BAR __builtin_amdgcn_s_barrier()
#define PG8_SCHED __builtin_amdgcn_sched_barrier(0)
    Unit cur, nxt; int ui = 0;
    if (!S.next(0, cur)) return;
    f32x4 acc[2][2][4][2];
#pragma unroll
    for (int a = 0; a < 2; ++a)
#pragma unroll
        for (int b = 0; b < 2; ++b)
#pragma unroll
            for (int m = 0; m < 4; ++m)
#pragma unroll
                for (int n = 0; n < 2; ++n) acc[a][b][m][n] = (f32x4){0.f, 0.f, 0.f, 0.f};
    bf16x8 At[4][2], B0[2][2], B1[2][2];
    const char* cA = (const char*)g.A + (size_t)cur.pm * tstep; const char* cB = (const char*)g.Bt + (size_t)cur.pn * tstep;
    S.a_ready(cur);
    PG8_STAGE(PG8_SB(0, 0), cB, voffB); PG8_STAGE(PG8_SA(0, 0), cA, voffA); PG8_STAGE(PG8_SB(0, 1), cB + hstep, voffB); PG8_STAGE(PG8_SA(0, 1), cA + hstep, voffA);
    if (wr == 1) PG8_BAR;
    PG8_WAIT_V(4); PG8_BAR;
    PG8_STAGE(PG8_SB(1, 0), cB + kstep, voffB); PG8_STAGE(PG8_SA(1, 0), cA + kstep, voffA); PG8_STAGE(PG8_SB(1, 1), cB + hstep + kstep, voffB);
    PG8_WAIT_V(6); PG8_BAR;
    for (;;) {
        const bool has_next = S.next(ui + 1, nxt);
        const char* nA = has_next ? (const char*)g.A + (size_t)nxt.pm * tstep : cA; const char* nB = has_next ? (const char*)g.Bt + (size_t)nxt.pn * tstep : cB;
        for (int t = 0; t < nt; t += 2) {
            const bool last = (t == nt - 2);
            const char* a1 = cA + (size_t)(t + 1) * kstep;
            const char* a2 = last ? nA : cA + (size_t)(t + 2) * kstep; const char* b2 = last ? nB : cB + (size_t)(t + 2) * kstep;
            const char* a3 = a2 + kstep; const char* b3 = b2 + kstep;
            if (last && has_next) S.a_ready(nxt);
            PG8_LDB(B0, 0, 0); PG8_SCHED; PG8_LDA(At, 0, 0); PG8_STAGE(PG8_SA(1, 1), a1 + hstep, voffA);
            PG8_WAIT_L(8); PG8_BAR; PG8_WAIT_L(0); PG8_MMA(0, 0, At, B0); PG8_BAR; PG8_SCHED;
            PG8_LDB(B1, 0, 1); PG8_STAGE(PG8_SB(0, 0), b2, voffB);
            PG8_BAR; PG8_WAIT_L(0); PG8_MMA(0, 1, At, B1); PG8_BAR;
            PG8_LDA(At, 0, 1); PG8_STAGE(PG8_SA(0, 0), a2, voffA);
            PG8_BAR; PG8_WAIT_L(0); PG8_MMA(1, 0, At, B0); PG8_BAR; PG8_SCHED;
            PG8_STAGE(PG8_SB(0, 1), b2 + hstep, voffB);
            PG8_WAIT_V(6); PG8_BAR; PG8_MMA(1, 1, At, B1); PG8_BAR;
            PG8_LDB(B0, 1, 0); PG8_SCHED; PG8_LDA(At, 1, 0); PG8_STAGE(PG8_SA(0, 1), a2 + hstep, voffA);
            PG8_WAIT_L(8); PG8_BAR; PG8_WAIT_L(0); PG8_MMA(0, 0, At, B0); PG8_BAR; PG8_SCHED;
            PG8_LDB(B1, 1, 1); PG8_STAGE(PG8_SB(1, 0), b3, voffB);
            PG8_BAR; PG8_WAIT_L(0); PG8_MMA(0, 1, At, B1); PG8_BAR;
            PG8_LDA(At, 1, 1); PG8_STAGE(PG8_SA(1, 0), a3, voffA);
            PG8_BAR; PG8_WAIT_L(0); PG8_MMA(1, 0, At, B0); PG8_BAR; PG8_SCHED;
            PG8_STAGE(PG8_SB(1, 1), b3 + hstep, voffB);
            PG8_WAIT_V(6); PG8_BAR; PG8_MMA(1, 1, At, B1); PG8_BAR;
        }
        E(acc, cur, wr, wc, fr, fq); S.done(cur);
        if (!has_next) break;
#pragma unroll
        for (int a = 0; a < 2; ++a)
#pragma unroll
            for (int b = 0; b < 2; ++b)
#pragma unroll
                for (int m = 0; m < 4; ++m)
#pragma unroll
                    for (int n = 0; n < 2; ++n) acc[a][b][m][n] = (f32x4){0.f, 0.f, 0.f, 0.f};
        cur = nxt; cA = nA; cB = nB; ++ui;
    }
    PG8_WAIT_V(0);
    if (wr == 0) PG8_BAR;
    PG8_BAR;
#undef PG8_SA
#undef PG8_SB
#undef PG8_STAGE
#undef PG8_LDA
#undef PG8_LDB
#undef PG8_MMA
#undef PG8_WAIT_V
#undef PG8_WAIT_L
#undef PG8_BAR
#undef PG8_SCHED
}
}
using pg8::Unit;

struct EpiProj {
    static constexpr bool PERM = true;
    bf16_t* P;
    __device__ __forceinline__ void operator()(const f32x4 (&acc)[2][2][4][2], const Unit& u, int wr, int wc, int fr, int fq) const {
        const int row0 = u.pm * 256 + wr * 64 + fr; const int pn = u.pn;
        if (pn < 8 || pn >= 24) {
            const bool act = pn >= 24;
            const int col0 = (act ? 4096 + (pn - 24) * 256 : pn * 256) + wc * 32 + 8 * fq;
#pragma unroll
            for (int ai = 0; ai < 2; ++ai)
#pragma unroll
                for (int m = 0; m < 4; ++m) { bf16_t* rowp = P + (size_t)(row0 + ai * 128 + m * 16) * PW + col0;
#pragma unroll
                    for (int bj = 0; bj < 2; ++bj) { f32x4 v0 = acc[ai][bj][m][0], v1 = acc[ai][bj][m][1];
                        if (act) { f32x2 a = gelu_pk((f32x2){v0[0], v0[1]}), b = gelu_pk((f32x2){v0[2], v0[3]}), c = gelu_pk((f32x2){v1[0], v1[1]}), d = gelu_pk((f32x2){v1[2], v1[3]});
                            v0 = (f32x4){a.x, a.y, b.x, b.y}; v1 = (f32x4){c.x, c.y, d.x, d.y}; }
                        u32x4 w; w.x = cvt_pk_bf16_asm(v0[0], v0[1]); w.y = cvt_pk_bf16_asm(v0[2], v0[3]); w.z = cvt_pk_bf16_asm(v1[0], v1[1]); w.w = cvt_pk_bf16_asm(v1[2], v1[3]);
                        *(u32x4*)(rowp + bj * 128) = w; } }
        } else {
            const bool isrg = pn < 16;
            const int col0 = (isrg ? 2048 + (pn - 8) * 128 : 3072 + (pn - 16) * 128) + wc * 32 + 8 * fq;
#pragma unroll
            for (int ai = 0; ai < 2; ++ai)
#pragma unroll
                for (int m = 0; m < 4; ++m) { bf16_t* rowp = P + (size_t)(row0 + ai * 128 + m * 16) * PW + col0;
                    float o[8];
#pragma unroll
                    for (int n = 0; n < 2; ++n) { const f32x4 a = acc[ai][0][m][n], g = acc[ai][1][m][n];
                        if (isrg) {
#pragma unroll
                            for (int j = 0; j < 4; ++j) o[n * 4 + j] = a[j] * sigmoidf_(a[j]) * sigmoidf_(g[j]);
                        } else { f32x2 x = gelu_pk((f32x2){a[0], a[1]}), y = gelu_pk((f32x2){a[2], a[3]});
                            o[n * 4 + 0] = x.x * sigmoidf_(g[0]); o[n * 4 + 1] = x.y * sigmoidf_(g[1]); o[n * 4 + 2] = y.x * sigmoidf_(g[2]); o[n * 4 + 3] = y.y * sigmoidf_(g[3]); } }
                    u32x4 w; w.x = cvt_pk_bf16_asm(o[0], o[1]); w.y = cvt_pk_bf16_asm(o[2], o[3]); w.z = cvt_pk_bf16_asm(o[4], o[5]); w.w = cvt_pk_bf16_asm(o[6], o[7]);
                    *(u32x4*)rowp = w; }
        }
    }
};
struct EpiX1 {
    static constexpr bool PERM = false;
    const float* x; float* x1; const float* mod; const float* b_ada;
    __device__ __forceinline__ void operator()(const f32x4 (&acc)[2][2][4][2], const Unit& u, int wr, int wc, int fr, int fq) const {
        const int row0 = u.pm * 256 + wr * 64 + fr, col0 = u.pn * 256 + wc * 32 + 4 * fq; const int b = u.pm >> 5;
        f32x4 gv[2][2];
#pragma unroll
        for (int bj = 0; bj < 2; ++bj)
#pragma unroll
            for (int n = 0; n < 2; ++n) gv[bj][n] = *(const f32x4*)(mod + b * 6144 + 2048 + col0 + bj * 128 + n * 16) + *(const f32x4*)(b_ada + 2048 + col0 + bj * 128 + n * 16);
#pragma unroll
        for (int ai = 0; ai < 2; ++ai)
#pragma unroll
            for (int m = 0; m < 4; ++m) { const size_t off = (size_t)(row0 + ai * 128 + m * 16) * DM + col0;
#pragma unroll
                for (int bj = 0; bj < 2; ++bj)
#pragma unroll
                    for (int n = 0; n < 2; ++n) { const f32x4 xv = *(const f32x4*)(x + off + bj * 128 + n * 16); *(f32x4*)(x1 + off + bj * 128 + n * 16) = xv + gv[bj][n] * acc[ai][bj][m][n]; } }
    }
};
struct EpiQ {
    static constexpr bool PERM = true;
    bf16_t* O;
    __device__ __forceinline__ void operator()(const f32x4 (&acc)[2][2][4][2], const Unit& u, int wr, int wc, int fr, int fq) const {
        const int row0 = u.pm * 256 + wr * 64 + fr, col0 = u.pn * 256 + wc * 32 + 8 * fq;
#pragma unroll
        for (int ai = 0; ai < 2; ++ai)
#pragma unroll
            for (int m = 0; m < 4; ++m) { bf16_t* rowp = O + (size_t)(row0 + ai * 128 + m * 16) * 2048 + col0;
#pragma unroll
                for (int bj = 0; bj < 2; ++bj) { const f32x4 v0 = acc[ai][bj][m][0], v1 = acc[ai][bj][m][1];
                    u32x4 w; w.x = cvt_pk_bf16_asm(v0[0], v0[1]); w.y = cvt_pk_bf16_asm(v0[2], v0[3]); w.z = cvt_pk_bf16_asm(v1[0], v1[1]); w.w = cvt_pk_bf16_asm(v1[2], v1[3]);
                    *(u32x4*)(rowp + bj * 128) = w; } }
    }
};

__device__ __forceinline__ int win_src_col(int n) {
    if (n < 2048) return n;
    if (n < 4096) { const int u = (n - 2048) >> 8, r = (n - 2048) & 255; return r < 128 ? 2048 + 128 * u + r : 5136 + 128 * u + (r - 128); }
    if (n < 6144) { const int u = (n - 4096) >> 8, r = (n - 4096) & 255; return r < 128 ? 3088 + 128 * u + r : 6160 + 128 * u + (r - 128); }
    return 4112 + (n - 6144);
}
__device__ void phase0(const Params& p, unsigned char* lds) {
    const int tid = threadIdx.x;
    float* mod = (float*)(p.ws + OFF_MOD);
    {
        float* ssc = (float*)lds;
        float* red = (float*)lds + 2048;
        for (int e = tid; e < 2048; e += 512) { const float cv = p.c[e]; ssc[e] = cv * sigmoidf_(cv); }
        __syncthreads();
        for (int cbk = blockIdx.x; cbk < 256; cbk += gridDim.x) {
            const int cc = tid % 24, rg = tid / 24;
            if (tid < 504) { float a0 = 0.f, a1 = 0.f;
                const float* wp = p.w_ada + cbk * 24 + cc;
#pragma unroll 1
                for (int j0 = 0; j0 < 49; j0 += 7) { float w[7];
#pragma unroll
                    for (int u = 0; u < 7; ++u) { const int k = rg + 21 * (j0 + u); w[u] = k < 1024 ? wp[(size_t)k * 6144] : 0.f; }
#pragma unroll
                    for (int u = 0; u < 7; ++u) { const int k = rg + 21 * (j0 + u); if (k < 1024) { a0 += ssc[k] * w[u]; a1 += ssc[1024 + k] * w[u]; } } }
                red[(rg * 24 + cc) * 2] = a0; red[(rg * 24 + cc) * 2 + 1] = a1; }
            __syncthreads();
            if (tid < 48) { const int c2 = tid % 24, bb = tid / 24; float s = 0.f;
                for (int g = 0; g < 21; ++g) s += red[(g * 24 + c2) * 2 + bb];
                mod[bb * 6144 + cbk * 24 + c2] = s; }
            __syncthreads();
        }
    }
    float* tile = (float*)lds;
    for (int tl = blockIdx.x; tl < 2560; tl += gridDim.x) {
        const float* W; bf16_t* Bt; int ldw, nt, kt, which;
        if (tl < 1792) { which = 0; W = p.w_in; ldw = INW; Bt = (bf16_t*)(p.ws + OFF_WINT); nt = tl >> 4; kt = tl & 15; }
        else if (tl < 2048) { which = 1; W = p.w_out; ldw = 1024; Bt = (bf16_t*)(p.ws + OFF_WOUTT); nt = (tl - 1792) >> 4; kt = tl & 15; }
        else { which = 2; W = p.w_q; ldw = 2048; Bt = (bf16_t*)(p.ws + OFF_WQT); nt = (tl - 2048) >> 4; kt = tl & 15; }
        { const int nn = tid & 63, kk0 = tid >> 6; const int n = nt * 64 + nn; const int sc = which == 0 ? win_src_col(n) : n;
#pragma unroll
            for (int i = 0; i < 8; ++i) { const int k = kk0 + 8 * i; tile[nn * 65 + k] = W[(size_t)(kt * 64 + k) * ldw + sc]; } }
        __syncthreads();
        { const int n = tid >> 3, kc = (tid & 7) * 8; const float* tp = tile + n * 65 + kc;
            u32x4 w; w.x = cvt_pk_bf16(tp[0], tp[1]); w.y = cvt_pk_bf16(tp[2], tp[3]); w.z = cvt_pk_bf16(tp[4], tp[5]); w.w = cvt_pk_bf16(tp[6], tp[7]);
            *(u32x4*)(Bt + (size_t)(nt * 64 + n) * 1024 + kt * 64 + kc) = w; }
        __syncthreads();
    }
    { bf16_t* kb = (bf16_t*)(p.ws + OFF_KEYS);
        for (int e = (blockIdx.x * 512 + tid) * 2; e < 32768; e += gridDim.x * 1024) {
            const float* src = e < 16384 ? p.keys1 + e : p.keys2 + (e - 16384);
            *(unsigned*)(kb + e) = cvt_pk_bf16(src[0], src[1]); } }
}

template <bool ALR>
__device__ void phase_norm(const Params& p, const float* xin, const float* nw, int shift_off, int scale_off, bf16_t* hout, unsigned char* lds) {
    const int tid = threadIdx.x, wid = tid >> 6, lane = tid & 63;
    const float* mod = (const float*)(p.ws + OFF_MOD);
    float* wat = (float*)lds;
    if (ALR) {
        for (int e = tid; e < 16384; e += 512) { const int d = e >> 4, r = e & 15; wat[r * 1024 + d] = p.w_in[(size_t)d * INW + 3072 + r]; }
        __syncthreads();
    }
    float* alr = (float*)(p.ws + OFF_ALR);
    for (int tg = blockIdx.x * 8 + wid; tg < 2048; tg += gridDim.x * 8) {
        const int b = tg >> 10;
        f32x4 w4[4], sc[4], sh[4];
#pragma unroll
        for (int i = 0; i < 4; ++i) { const int d = 256 * i + 4 * lane; w4[i] = *(const f32x4*)(nw + d);
            sc[i] = *(const f32x4*)(mod + b * 6144 + scale_off + d) + *(const f32x4*)(p.b_ada + scale_off + d) + 1.0f;
            sh[i] = *(const f32x4*)(mod + b * 6144 + shift_off + d) + *(const f32x4*)(p.b_ada + shift_off + d);
            w4[i] = w4[i] * sc[i]; }
        f32x4 xn[4];
#pragma unroll
        for (int i = 0; i < 4; ++i) xn[i] = *(const f32x4*)(xin + (size_t)(tg * 8) * DM + 256 * i + 4 * lane);
        for (int tt = 0; tt < 8; ++tt) {
            const int t = tg * 8 + tt;
            f32x4 xv[4]; float ss = 0.f;
#pragma unroll
            for (int i = 0; i < 4; ++i) { xv[i] = xn[i]; ss += xv[i][0] * xv[i][0] + xv[i][1] * xv[i][1] + xv[i][2] * xv[i][2] + xv[i][3] * xv[i][3]; }
            if (tt < 7) {
#pragma unroll
                for (int i = 0; i < 4; ++i) xn[i] = *(const f32x4*)(xin + (size_t)(t + 1) * DM + 256 * i + 4 * lane); }
            ss = wave_sum(ss);
            const float rstd = rsqrtf(ss * (1.0f / 1024.0f) + EPS);
#pragma unroll
            for (int i = 0; i < 4; ++i) { xv[i] = xv[i] * rstd * w4[i] + sh[i];
                u32x2 w; w.x = cvt_pk_bf16(xv[i][0], xv[i][1]); w.y = cvt_pk_bf16(xv[i][2], xv[i][3]);
                *(u32x2*)(hout + (size_t)t * DM + 256 * i + 4 * lane) = w; }
            if (ALR) {
                float ps[16];
#pragma unroll
                for (int r = 0; r < 16; ++r) { float s = 0.f;
#pragma unroll
                    for (int i = 0; i < 4; ++i) { const f32x4 wv = *(const f32x4*)(wat + r * 1024 + 256 * i + 4 * lane); s += xv[i][0] * wv[0] + xv[i][1] * wv[1] + xv[i][2] * wv[2] + xv[i][3] * wv[3]; }
                    ps[r] = s; if (r & 1) asm volatile("" ::: "memory"); }
                float t8[8], t4[4], t2[2];
                { const bool up = (lane & 32) != 0;
#pragma unroll
                  for (int j = 0; j < 8; ++j) { const float snd = up ? ps[j] : ps[j + 8], keep = up ? ps[j + 8] : ps[j]; t8[j] = keep + __shfl_xor(snd, 32); } }
                { const bool up = (lane & 16) != 0;
#pragma unroll
                  for (int j = 0; j < 4; ++j) { const float snd = up ? t8[j] : t8[j + 4], keep = up ? t8[j + 4] : t8[j]; t4[j] = keep + __shfl_xor(snd, 16); } }
                { const bool up = (lane & 8) != 0;
#pragma unroll
                  for (int j = 0; j < 2; ++j) { const float snd = up ? t4[j] : t4[j + 2], keep = up ? t4[j + 2] : t4[j]; t2[j] = keep + __shfl_xor(snd, 8); } }
                float t1;
                { const bool up = (lane & 4) != 0; const float snd = up ? t2[0] : t2[1], keep = up ? t2[1] : t2[0]; t1 = keep + __shfl_xor(snd, 4); }
                t1 += __shfl_xor(t1, 2); t1 += __shfl_xor(t1, 1);
                if ((lane & 3) == 0) alr[(size_t)t * 16 + ((lane >> 5) & 1) * 8 + ((lane >> 4) & 1) * 4 + ((lane >> 3) & 1) * 2 + ((lane >> 2) & 1)] = t1;
            }
        }
    }
}

template <bool TR>
__device__ __forceinline__ void gla_G(const Params& p, int t0, int h, float* sALR, float* sG, float* sGT) {
    const int tid = threadIdx.x;
    const float* alr = (const float*)(p.ws + OFF_ALR);
    if (tid < 256) *(f32x4*)(sALR + tid * 4) = *(const f32x4*)(alr + (size_t)t0 * 16 + tid * 4);
    const int col = tid & 127, pg = tid >> 7;
    float wup[16];
#pragma unroll
    for (int r = 0; r < 16; ++r) wup[r] = p.w_alpha_up[r * 512 + h * 128 + col];
    const float bias = p.b_alpha[h * 128 + col];
    __syncthreads();
#pragma unroll 4
    for (int pp = 0; pp < 16; ++pp) { const int pos = pg * 16 + pp;
        float z0 = bias, z1 = 0.f, z2 = 0.f, z3 = 0.f;
#pragma unroll
        for (int r4 = 0; r4 < 4; ++r4) { const f32x4 a = *(const f32x4*)(sALR + pos * 16 + r4 * 4); z0 += a[0] * wup[r4 * 4]; z1 += a[1] * wup[r4 * 4 + 1]; z2 += a[2] * wup[r4 * 4 + 2]; z3 += a[3] * wup[r4 * 4 + 3]; }
        const float z = (z0 + z1) + (z2 + z3);
        sG[pos * 128 + col] = (fminf(z, 0.f) - __logf(1.0f + __expf(-fabsf(z)))) * (1.0f / 16.0f); }
    __syncthreads();
    if (tid < 128) { float cum = 0.f;
#pragma unroll 16
        for (int pos = 0; pos < 64; ++pos) { cum += sG[pos * 128 + tid]; if (TR) sGT[tid * 65 + pos] = cum; else sG[pos * 128 + tid] = cum; } }
    __syncthreads();
}
__device__ __forceinline__ void gla_VT(const bf16_t* P, int t0, int h, bf16_t* sVT) {
    const int tid = threadIdx.x;
#pragma unroll
    for (int i = 0; i < 4; ++i) { const int task = tid + 512 * i, pos = task & 63, dg = task >> 6;
        const u32x4 w = *(const u32x4*)(P + (size_t)(t0 + pos) * PW + 1024 + h * 256 + dg * 8);
        bf16_t* d = sVT + (dg * 8) * 72 + pos;
        d[0] = (bf16_t)w.x; d[72] = (bf16_t)(w.x >> 16); d[144] = (bf16_t)w.y; d[216] = (bf16_t)(w.y >> 16);
        d[288] = (bf16_t)w.z; d[360] = (bf16_t)(w.z >> 16); d[432] = (bf16_t)w.w; d[504] = (bf16_t)(w.w >> 16); }
}

__device__ void phase_glaA(const Params& p, unsigned char* lds) {
    const int tid = threadIdx.x, wid = tid >> 6, lane = tid & 63, r = lane & 31, hh = lane >> 5;
    const bf16_t* P = (const bf16_t*)(p.ws + OFF_PROJ);
    { float* stats = (float*)(p.ws + OFF_STATS);
        const int tst0 = blockIdx.x * 8 + wid, tstep = gridDim.x * 8;
        u32x4 an = (u32x4){0u, 0u, 0u, 0u}, bn = an;
        if (tst0 < NTOK) { an = *(const u32x4*)(P + (size_t)tst0 * PW + 4096 + lane * 16); bn = *(const u32x4*)(P + (size_t)tst0 * PW + 4096 + lane * 16 + 8); }
        for (int t = tst0; t < NTOK; t += tstep) {
            const u32x4 a = an, b = bn;
            if (t + tstep < NTOK) { an = *(const u32x4*)(P + (size_t)(t + tstep) * PW + 4096 + lane * 16); bn = *(const u32x4*)(P + (size_t)(t + tstep) * PW + 4096 + lane * 16 + 8); }
            float v[16] = {bflo(a.x), bfhi(a.x), bflo(a.y), bfhi(a.y), bflo(a.z), bfhi(a.z), bflo(a.w), bfhi(a.w), bflo(b.x), bfhi(b.x), bflo(b.y), bfhi(b.y), bflo(b.z), bfhi(b.z), bflo(b.w), bfhi(b.w)};
            float s = 0.f;
#pragma unroll
            for (int i = 0; i < 16; ++i) s += v[i];
            const float mean = wave_sum(s) * (1.0f / 1024.0f);
            float q = 0.f;
#pragma unroll
            for (int i = 0; i < 16; ++i) { const float d = v[i] - mean; q += d * d; }
            q = wave_sum(q);
            if (lane == 0) *(f32x2*)(stats + (size_t)t * 2) = (f32x2){mean, rsqrtf(q * (1.0f / 1024.0f) + EPS)};
        } }
    float* sALR = (float*)lds; float* sG = (float*)(lds + 4096);
    bf16_t* sKT = (bf16_t*)(lds + 36864); bf16_t* sVT = (bf16_t*)(lds + 55296); float* sGT = (float*)(lds + 92160);
    bf16_t* KV = (bf16_t*)p.out; float* decay = (float*)(p.ws + OFF_DECAY);
    for (int item = blockIdx.x; item < 1024; item += gridDim.x) {
        const int h = item & 3, n = (item >> 2) & 127, b = item >> 9, t0 = b * SEQ + n * 64;
        gla_G<true>(p, t0, h, sALR, sG, sGT);
#pragma unroll
        for (int i = 0; i < 2; ++i) { const int task = tid + 512 * i, pos = task & 63, kg = task >> 6;
            const u32x4 w = *(const u32x4*)(P + (size_t)(t0 + pos) * PW + 512 + h * 128 + kg * 8);
            const unsigned ww[4] = {w.x, w.y, w.z, w.w};
            bf16_t* d = sKT + (kg * 8) * 72 + pos;
#pragma unroll
            for (int e = 0; e < 4; ++e) { const int kd = kg * 8 + 2 * e;
                const float f0 = __expf(sGT[kd * 65 + 63] - sGT[kd * 65 + pos]), f1 = __expf(sGT[(kd + 1) * 65 + 63] - sGT[(kd + 1) * 65 + pos]);
                const unsigned pk = cvt_pk_bf16(bflo(ww[e]) * f0, bfhi(ww[e]) * f1);
                d[(2 * e) * 72] = (bf16_t)pk; d[(2 * e + 1) * 72] = (bf16_t)(pk >> 16); } }
        gla_VT(P, t0, h, sVT);
        if (tid < 128) decay[item * 128 + tid] = __expf(sGT[tid * 65 + 63]);
        __syncthreads();
        f32x16 acc[4];
#pragma unroll
        for (int mi = 0; mi < 4; ++mi) acc[mi] = zero16();
#pragma unroll
        for (int ks = 0; ks < 4; ++ks) {
            const bf16x8 bfr = *(const bf16x8*)(sVT + (wid * 32 + r) * 72 + ks * 16 + hh * 8);
#pragma unroll
            for (int mi = 0; mi < 4; ++mi) { const bf16x8 afr = *(const bf16x8*)(sKT + (mi * 32 + r) * 72 + ks * 16 + hh * 8); acc[mi] = MFMA32(afr, bfr, acc[mi]); }
        }
        bf16_t* dst = KV + (size_t)item * 32768 + (size_t)(wid * 32 + r) * 128;
#pragma unroll
        for (int mi = 0; mi < 4; ++mi)
#pragma unroll
            for (int g = 0; g < 4; ++g) { u32x2 w; w.x = cvt_pk_bf16(acc[mi][g * 4], acc[mi][g * 4 + 1]); w.y = cvt_pk_bf16(acc[mi][g * 4 + 2], acc[mi][g * 4 + 3]);
                *(u32x2*)(dst + mi * 32 + g * 8 + hh * 4) = w; }
        __syncthreads();
    }
}

__device__ void phase_scan_sgu(const Params& p, unsigned char* lds) {
    const int tid = threadIdx.x, wid = tid >> 6, lane = tid & 63, r = lane & 31, hh = lane >> 5;
    { unsigned* KV = (unsigned*)p.out; const float* decay = (const float*)(p.ws + OFF_DECAY);
        for (int gt = blockIdx.x * 512 + tid; gt < 131072; gt += gridDim.x * 512) {
            const int bh = gt >> 14, e = gt & 16383, kd = (e * 2) & 127, b = bh >> 2, h = bh & 3;
            float s0 = 0.f, s1 = 0.f;
            for (int n0 = 0; n0 < 128; n0 += 16) {
                unsigned w[16]; f32x2 d[16];
#pragma unroll
                for (int j = 0; j < 16; ++j) { const int item = ((b * 128 + n0 + j) << 2) + h; w[j] = KV[(size_t)item * 16384 + e]; d[j] = *(const f32x2*)(decay + item * 128 + kd); }
#pragma unroll
                for (int j = 0; j < 16; ++j) { const int item = ((b * 128 + n0 + j) << 2) + h; KV[(size_t)item * 16384 + e] = cvt_pk_bf16(s0, s1);
                    s0 = s0 * d[j].x + bflo(w[j]); s1 = s1 * d[j].y + bfhi(w[j]); }
            }
        } }
    const bf16_t* P = (const bf16_t*)(p.ws + OFF_PROJ);
    const float* stats = (const float*)(p.ws + OFF_STATS);
    bf16_t* merged = (bf16_t*)(p.ws + OFF_HB);
    bf16_t* sVT = (bf16_t*)lds;
    for (int item = blockIdx.x; item < 1024; item += gridDim.x) {
        const int g = item & 7, n = (item >> 3) & 63, b = item >> 9, t0 = b * SEQ + n * 128;
#pragma unroll
        for (int i = 0; i < 4; ++i) { const int task = tid + 512 * i, j = task & 127, cg8 = task >> 7;
            const u32x4 w = *(const u32x4*)(P + (size_t)(t0 + j) * PW + 4096 + g * 128 + cg8 * 8);
            const f32x2 st = *(const f32x2*)(stats + (size_t)(t0 + j) * 2);
            const f32x4 lw0 = *(const f32x4*)(p.sgu_ln_w + g * 128 + cg8 * 8), lw1 = *(const f32x4*)(p.sgu_ln_w + g * 128 + cg8 * 8 + 4);
            const f32x4 lb0 = *(const f32x4*)(p.sgu_ln_b + g * 128 + cg8 * 8), lb1 = *(const f32x4*)(p.sgu_ln_b + g * 128 + cg8 * 8 + 4);
            const float v[8] = {bflo(w.x), bfhi(w.x), bflo(w.y), bfhi(w.y), bflo(w.z), bfhi(w.z), bflo(w.w), bfhi(w.w)};
            bf16_t* d = sVT + (cg8 * 8) * 136 + j;
#pragma unroll
            for (int e = 0; e < 8; e += 2) { const float lw_a = e < 4 ? lw0[e] : lw1[e - 4], lw_b = e < 4 ? lw0[e + 1] : lw1[e - 3], lb_a = e < 4 ? lb0[e] : lb1[e - 4], lb_b = e < 4 ? lb0[e + 1] : lb1[e - 3];
                const unsigned pk = cvt_pk_bf16((v[e] - st.x) * st.y * lw_a + lb_a, (v[e + 1] - st.x) * st.y * lw_b + lb_b);
                d[e * 136] = (bf16_t)pk; d[(e + 1) * 136] = (bf16_t)(pk >> 16); } }
        __syncthreads();
        const int ni = wid & 3, mb = (wid >> 2) * 2, irow = ni * 32 + r;
        f32x16 acc[2] = {zero16(), zero16()};
        const float* wrow = p.sgu_w + (size_t)g * 16384 + (size_t)irow * 128;
        for (int ks = 0; ks < 2 * ni + 2; ++ks) {
            const int j0 = ks * 16 + hh * 8;
            const f32x4 wa = *(const f32x4*)(wrow + j0), wb = *(const f32x4*)(wrow + j0 + 4);
            float wv[8] = {wa[0], wa[1], wa[2], wa[3], wb[0], wb[1], wb[2], wb[3]};
#pragma unroll
            for (int e = 0; e < 8; ++e) wv[e] = (j0 + e <= irow) ? wv[e] : 0.f;
            u32x4 bw; bw.x = cvt_pk_bf16(wv[0], wv[1]); bw.y = cvt_pk_bf16(wv[2], wv[3]); bw.z = cvt_pk_bf16(wv[4], wv[5]); bw.w = cvt_pk_bf16(wv[6], wv[7]);
            const bf16x8 bfr = __builtin_bit_cast(bf16x8, bw);
#pragma unroll
            for (int mi = 0; mi < 2; ++mi) { const bf16x8 afr = *(const bf16x8*)(sVT + ((mb + mi) * 32 + r) * 136 + j0); acc[mi] = MFMA32(afr, bfr, acc[mi]); }
        }
        const float bs = p.sgu_b[g * 128 + irow];
        const size_t tok = (size_t)(t0 + irow);
#pragma unroll
        for (int mi = 0; mi < 2; ++mi)
#pragma unroll
            for (int g4 = 0; g4 < 4; ++g4) { const int c = (mb + mi) * 32 + g4 * 8 + hh * 4;
                const u32x2 ug = *(const u32x2*)(P + tok * PW + 3072 + g * 128 + c);
                u32x2 o; o.x = cvt_pk_bf16(bflo(ug.x) * (acc[mi][g4 * 4] + bs), bfhi(ug.x) * (acc[mi][g4 * 4 + 1] + bs));
                o.y = cvt_pk_bf16(bflo(ug.y) * (acc[mi][g4 * 4 + 2] + bs), bfhi(ug.y) * (acc[mi][g4 * 4 + 3] + bs));
                *(u32x2*)(merged + tok * DM + g * 128 + c) = o; }
        __syncthreads();
    }
}

__device__ void phase_glaC(const Params& p, unsigned char* lds) {
    const int tid = threadIdx.x, wid = tid >> 6, lane = tid & 63, r = lane & 31, hh = lane >> 5;
    const bf16_t* P = (const bf16_t*)(p.ws + OFF_PROJ);
    float* sALR = (float*)lds; float* sG = (float*)(lds + 4096);
    bf16_t* sQD = (bf16_t*)(lds + 36864); bf16_t* sKI = (bf16_t*)(lds + 54272); bf16_t* sVT = (bf16_t*)(lds + 71680); bf16_t* sAM = (bf16_t*)(lds + 108544); float* sSS = (float*)(lds + 117760);
    const bf16_t* ST = (const bf16_t*)p.out; bf16_t* merged = (bf16_t*)(p.ws + OFF_HB);
    for (int item = blockIdx.x; item < 1024; item += gridDim.x) {
        const int h = item & 3, n = (item >> 2) & 127, b = item >> 9, t0 = b * SEQ + n * 64;
        gla_G<false>(p, t0, h, sALR, sG, nullptr);
#pragma unroll
        for (int i = 0; i < 2; ++i) { const int task = tid + 512 * i, kg = task & 15, pos = task >> 4;
            const u32x4 qw = *(const u32x4*)(P + (size_t)(t0 + pos) * PW + h * 128 + kg * 8), kw = *(const u32x4*)(P + (size_t)(t0 + pos) * PW + 512 + h * 128 + kg * 8);
            const f32x4 g0 = *(const f32x4*)(sG + pos * 128 + kg * 8), g1 = *(const f32x4*)(sG + pos * 128 + kg * 8 + 4);
            const float gv[8] = {g0[0], g0[1], g0[2], g0[3], g1[0], g1[1], g1[2], g1[3]};
            const unsigned qq[4] = {qw.x, qw.y, qw.z, qw.w}, kk[4] = {kw.x, kw.y, kw.z, kw.w};
            unsigned qo[4], ko[4];
#pragma unroll
            for (int e = 0; e < 4; ++e) { const float e0 = __expf(gv[2 * e]), e1 = __expf(gv[2 * e + 1]);
                qo[e] = cvt_pk_bf16(bflo(qq[e]) * 0.08838834764831845f * e0, bfhi(qq[e]) * 0.08838834764831845f * e1);
                ko[e] = cvt_pk_bf16(bflo(kk[e]) * __builtin_amdgcn_rcpf(e0), bfhi(kk[e]) * __builtin_amdgcn_rcpf(e1)); }
            *(u32x4*)(sQD + pos * 136 + kg * 8) = (u32x4){qo[0], qo[1], qo[2], qo[3]};
            *(u32x4*)(sKI + pos * 136 + kg * 8) = (u32x4){ko[0], ko[1], ko[2], ko[3]}; }
        gla_VT(P, t0, h, sVT);
        __syncthreads();
        if (wid < 4) { const int mj = wid >> 1, nI = wid & 1;
            f32x16 a = zero16();
            if (mj <= nI) {
#pragma unroll
                for (int ks = 0; ks < 8; ++ks) { const bf16x8 afr = *(const bf16x8*)(sKI + (mj * 32 + r) * 136 + ks * 16 + hh * 8), bfr = *(const bf16x8*)(sQD + (nI * 32 + r) * 136 + ks * 16 + hh * 8); a = MFMA32(afr, bfr, a); } }
            const int i = nI * 32 + r;
#pragma unroll
            for (int g = 0; g < 4; ++g) { const int j = mj * 32 + g * 8 + hh * 4;
                u32x2 w; w.x = cvt_pk_bf16(j <= i ? a[g * 4] : 0.f, j + 1 <= i ? a[g * 4 + 1] : 0.f); w.y = cvt_pk_bf16(j + 2 <= i ? a[g * 4 + 2] : 0.f, j + 3 <= i ? a[g * 4 + 3] : 0.f);
                *(u32x2*)(sAM + i * 72 + j) = w; } }
        __syncthreads();
        const int nI = wid & 1, mb = (wid >> 1) * 2, i = nI * 32 + r;
        f32x16 acc[2] = {zero16(), zero16()};
        const bf16_t* Sg = ST + (size_t)item * 32768;
#pragma unroll
        for (int ks = 0; ks < 8; ++ks) { const bf16x8 bfr = *(const bf16x8*)(sQD + i * 136 + ks * 16 + hh * 8);
#pragma unroll
            for (int mi = 0; mi < 2; ++mi) { const bf16x8 afr = *(const bf16x8*)(Sg + (size_t)((mb + mi) * 32 + r) * 128 + ks * 16 + hh * 8); acc[mi] = MFMA32(afr, bfr, acc[mi]); } }
        for (int ks = 0; ks < 2 * nI + 2; ++ks) { const bf16x8 bfr = *(const bf16x8*)(sAM + i * 72 + ks * 16 + hh * 8);
#pragma unroll
            for (int mi = 0; mi < 2; ++mi) { const bf16x8 afr = *(const bf16x8*)(sVT + ((mb + mi) * 32 + r) * 72 + ks * 16 + hh * 8); acc[mi] = MFMA32(afr, bfr, acc[mi]); } }
        float ss = 0.f;
#pragma unroll
        for (int mi = 0; mi < 2; ++mi)
#pragma unroll
            for (int e = 0; e < 16; ++e) ss += acc[mi][e] * acc[mi][e];
        ss += __shfl_xor(ss, 32);
        if (hh == 0) sSS[(wid >> 1) * 64 + i] = ss;
        __syncthreads();
        const float tot = sSS[i] + sSS[64 + i] + sSS[128 + i] + sSS[192 + i];
        const float rstd = rsqrtf(tot * (1.0f / 256.0f) + EPS);
        const size_t tok = (size_t)(t0 + i);
#pragma unroll
        for (int mi = 0; mi < 2; ++mi)
#pragma unroll
            for (int g4 = 0; g4 < 4; ++g4) { const int ch = h * 256 + (mb + mi) * 32 + g4 * 8 + hh * 4;
                const f32x4 nwv = *(const f32x4*)(p.gla_norm_w + ch);
                const u32x2 rg = *(const u32x2*)(P + tok * PW + 2048 + ch), mg = *(const u32x2*)(merged + tok * DM + ch);
                u32x2 o; o.x = cvt_pk_bf16(acc[mi][g4 * 4] * rstd * nwv[0] * bflo(rg.x) + bflo(mg.x), acc[mi][g4 * 4 + 1] * rstd * nwv[1] * bfhi(rg.x) + bfhi(mg.x));
                o.y = cvt_pk_bf16(acc[mi][g4 * 4 + 2] * rstd * nwv[2] * bflo(rg.y) + bflo(mg.y), acc[mi][g4 * 4 + 3] * rstd * nwv[3] * bfhi(rg.y) + bfhi(mg.y));
                *(u32x2*)(merged + tok * DM + ch) = o; }
        __syncthreads();
    }
}

__device__ void phase_tables(const Params& p) {
    bf16_t* db = (bf16_t*)(p.ws + OFF_DOWN); bf16_t* ub = (bf16_t*)(p.ws + OFF_UP);
    for (size_t e = ((size_t)blockIdx.x * 512 + threadIdx.x) * 8; e < (size_t)16384 * 1024; e += (size_t)gridDim.x * 4096) {
        { const f32x4 a = __builtin_nontemporal_load((const f32x4*)(p.down + e)), b = __builtin_nontemporal_load((const f32x4*)(p.down + e + 4));
            u32x4 w; w.x = cvt_pk_bf16(a[0], a[1]); w.y = cvt_pk_bf16(a[2], a[3]); w.z = cvt_pk_bf16(b[0], b[1]); w.w = cvt_pk_bf16(b[2], b[3]); *(u32x4*)(db + e) = w; }
        { const f32x4 a = __builtin_nontemporal_load((const f32x4*)(p.up + e)), b = __builtin_nontemporal_load((const f32x4*)(p.up + e + 4));
            u32x4 w; w.x = cvt_pk_bf16(a[0], a[1]); w.y = cvt_pk_bf16(a[2], a[3]); w.z = cvt_pk_bf16(b[0], b[1]); w.w = cvt_pk_bf16(b[2], b[3]); *(u32x4*)(ub + e) = w; }
    }
}

#define SORT16(L) do { float _h; _h = fmaxf(L[0], L[1]); L[1] = fminf(L[0], L[1]); L[0] = _h; _h = fmaxf(L[2], L[3]); L[3] = fminf(L[2], L[3]); L[2] = _h; _h = fmaxf(L[0], L[2]); L[2] = fminf(L[0], L[2]); L[0] = _h; _h = fmaxf(L[1], L[3]); L[3] = fminf(L[1], L[3]); L[1] = _h; _h = fmaxf(L[1], L[2]); L[2] = fminf(L[1], L[2]); L[1] = _h; _h = fmaxf(L[4], L[5]); L[5] = fminf(L[4], L[5]); L[4] = _h; _h = fmaxf(L[6], L[7]); L[7] = fminf(L[6], L[7]); L[6] = _h; _h = fmaxf(L[4], L[6]); L[6] = fminf(L[4], L[6]); L[4] = _h; _h = fmaxf(L[5], L[7]); L[7] = fminf(L[5], L[7]); L[5] = _h; _h = fmaxf(L[5], L[6]); L[6] = fminf(L[5], L[6]); L[5] = _h; _h = fmaxf(L[0], L[4]); L[4] = fminf(L[0], L[4]); L[0] = _h; _h = fmaxf(L[2], L[6]); L[6] = fminf(L[2], L[6]); L[2] = _h; _h = fmaxf(L[2], L[4]); L[4] = fminf(L[2], L[4]); L[2] = _h; _h = fmaxf(L[1], L[5]); L[5] = fminf(L[1], L[5]); L[1] = _h; _h = fmaxf(L[3], L[7]); L[7] = fminf(L[3], L[7]); L[3] = _h; _h = fmaxf(L[3], L[5]); L[5] = fminf(L[3], L[5]); L[3] = _h; _h = fmaxf(L[1], L[2]); L[2] = fminf(L[1], L[2]); L[1] = _h; _h = fmaxf(L[3], L[4]); L[4] = fminf(L[3], L[4]); L[3] = _h; _h = fmaxf(L[5], L[6]); L[6] = fminf(L[5], L[6]); L[5] = _h; _h = fmaxf(L[8], L[9]); L[9] = fminf(L[8], L[9]); L[8] = _h; _h = fmaxf(L[10], L[11]); L[11] = fminf(L[10], L[11]); L[10] = _h; _h = fmaxf(L[8], L[10]); L[10] = fminf(L[8], L[10]); L[8] = _h; _h = fmaxf(L[9], L[11]); L[11] = fminf(L[9], L[11]); L[9] = _h; _h = fmaxf(L[9], L[10]); L[10] = fminf(L[9], L[10]); L[9] = _h; _h = fmaxf(L[12], L[13]); L[13] = fminf(L[12], L[13]); L[12] = _h; _h = fmaxf(L[14], L[15]); L[15] = fminf(L[14], L[15]); L[14] = _h; _h = fmaxf(L[12], L[14]); L[14] = fminf(L[12], L[14]); L[12] = _h; _h = fmaxf(L[13], L[15]); L[15] = fminf(L[13], L[15]); L[13] = _h; _h = fmaxf(L[13], L[14]); L[14] = fminf(L[13], L[14]); L[13] = _h; _h = fmaxf(L[8], L[12]); L[12] = fminf(L[8], L[12]); L[8] = _h; _h = fmaxf(L[10], L[14]); L[14] = fminf(L[10], L[14]); L[10] = _h; _h = fmaxf(L[10], L[12]); L[12] = fminf(L[10], L[12]); L[10] = _h; _h = fmaxf(L[9], L[13]); L[13] = fminf(L[9], L[13]); L[9] = _h; _h = fmaxf(L[11], L[15]); L[15] = fminf(L[11], L[15]); L[11] = _h; _h = fmaxf(L[11], L[13]); L[13] = fminf(L[11], L[13]); L[11] = _h; _h = fmaxf(L[9], L[10]); L[10] = fminf(L[9], L[10]); L[9] = _h; _h = fmaxf(L[11], L[12]); L[12] = fminf(L[11], L[12]); L[11] = _h; _h = fmaxf(L[13], L[14]); L[14] = fminf(L[13], L[14]); L[13] = _h; _h = fmaxf(L[0], L[8]); L[8] = fminf(L[0], L[8]); L[0] = _h; _h = fmaxf(L[4], L[12]); L[12] = fminf(L[4], L[12]); L[4] = _h; _h = fmaxf(L[4], L[8]); L[8] = fminf(L[4], L[8]); L[4] = _h; _h = fmaxf(L[2], L[10]); L[10] = fminf(L[2], L[10]); L[2] = _h; _h = fmaxf(L[6], L[14]); L[14] = fminf(L[6], L[14]); L[6] = _h; _h = fmaxf(L[6], L[10]); L[10] = fminf(L[6], L[10]); L[6] = _h; _h = fmaxf(L[2], L[4]); L[4] = fminf(L[2], L[4]); L[2] = _h; _h = fmaxf(L[6], L[8]); L[8] = fminf(L[6], L[8]); L[6] = _h; _h = fmaxf(L[10], L[12]); L[12] = fminf(L[10], L[12]); L[10] = _h; _h = fmaxf(L[1], L[9]); L[9] = fminf(L[1], L[9]); L[1] = _h; _h = fmaxf(L[5], L[13]); L[13] = fminf(L[5], L[13]); L[5] = _h; _h = fmaxf(L[5], L[9]); L[9] = fminf(L[5], L[9]); L[5] = _h; _h = fmaxf(L[3], L[11]); L[11] = fminf(L[3], L[11]); L[3] = _h; _h = fmaxf(L[7], L[15]); L[15] = fminf(L[7], L[15]); L[7] = _h; _h = fmaxf(L[7], L[11]); L[11] = fminf(L[7], L[11]); L[7] = _h; _h = fmaxf(L[3], L[5]); L[5] = fminf(L[3], L[5]); L[3] = _h; _h = fmaxf(L[7], L[9]); L[9] = fminf(L[7], L[9]); L[7] = _h; _h = fmaxf(L[11], L[13]); L[13] = fminf(L[11], L[13]); L[11] = _h; _h = fmaxf(L[1], L[2]); L[2] = fminf(L[1], L[2]); L[1] = _h; _h = fmaxf(L[3], L[4]); L[4] = fminf(L[3], L[4]); L[3] = _h; _h = fmaxf(L[5], L[6]); L[6] = fminf(L[5], L[6]); L[5] = _h; _h = fmaxf(L[7], L[8]); L[8] = fminf(L[7], L[8]); L[7] = _h; _h = fmaxf(L[9], L[10]); L[10] = fminf(L[9], L[10]); L[9] = _h; _h = fmaxf(L[11], L[12]); L[12] = fminf(L[11], L[12]); L[11] = _h; _h = fmaxf(L[13], L[14]); L[14] = fminf(L[13], L[14]); L[13] = _h; } while (0)
#define BITONIC16(L) do { float _h; _h = fmaxf(L[0], L[8]); L[8] = fminf(L[0], L[8]); L[0] = _h; _h = fmaxf(L[1], L[9]); L[9] = fminf(L[1], L[9]); L[1] = _h; _h = fmaxf(L[2], L[10]); L[10] = fminf(L[2], L[10]); L[2] = _h; _h = fmaxf(L[3], L[11]); L[11] = fminf(L[3], L[11]); L[3] = _h; _h = fmaxf(L[4], L[12]); L[12] = fminf(L[4], L[12]); L[4] = _h; _h = fmaxf(L[5], L[13]); L[13] = fminf(L[5], L[13]); L[5] = _h; _h = fmaxf(L[6], L[14]); L[14] = fminf(L[6], L[14]); L[6] = _h; _h = fmaxf(L[7], L[15]); L[15] = fminf(L[7], L[15]); L[7] = _h; _h = fmaxf(L[0], L[4]); L[4] = fminf(L[0], L[4]); L[0] = _h; _h = fmaxf(L[1], L[5]); L[5] = fminf(L[1], L[5]); L[1] = _h; _h = fmaxf(L[2], L[6]); L[6] = fminf(L[2], L[6]); L[2] = _h; _h = fmaxf(L[3], L[7]); L[7] = fminf(L[3], L[7]); L[3] = _h; _h = fmaxf(L[8], L[12]); L[12] = fminf(L[8], L[12]); L[8] = _h; _h = fmaxf(L[9], L[13]); L[13] = fminf(L[9], L[13]); L[9] = _h; _h = fmaxf(L[10], L[14]); L[14] = fminf(L[10], L[14]); L[10] = _h; _h = fmaxf(L[11], L[15]); L[15] = fminf(L[11], L[15]); L[11] = _h; _h = fmaxf(L[0], L[2]); L[2] = fminf(L[0], L[2]); L[0] = _h; _h = fmaxf(L[1], L[3]); L[3] = fminf(L[1], L[3]); L[1] = _h; _h = fmaxf(L[4], L[6]); L[6] = fminf(L[4], L[6]); L[4] = _h; _h = fmaxf(L[5], L[7]); L[7] = fminf(L[5], L[7]); L[5] = _h; _h = fmaxf(L[8], L[10]); L[10] = fminf(L[8], L[10]); L[8] = _h; _h = fmaxf(L[9], L[11]); L[11] = fminf(L[9], L[11]); L[9] = _h; _h = fmaxf(L[12], L[14]); L[14] = fminf(L[12], L[14]); L[12] = _h; _h = fmaxf(L[13], L[15]); L[15] = fminf(L[13], L[15]); L[13] = _h; _h = fmaxf(L[0], L[1]); L[1] = fminf(L[0], L[1]); L[0] = _h; _h = fmaxf(L[2], L[3]); L[3] = fminf(L[2], L[3]); L[2] = _h; _h = fmaxf(L[4], L[5]); L[5] = fminf(L[4], L[5]); L[4] = _h; _h = fmaxf(L[6], L[7]); L[7] = fminf(L[6], L[7]); L[6] = _h; _h = fmaxf(L[8], L[9]); L[9] = fminf(L[8], L[9]); L[8] = _h; _h = fmaxf(L[10], L[11]); L[11] = fminf(L[10], L[11]); L[10] = _h; _h = fmaxf(L[12], L[13]); L[13] = fminf(L[12], L[13]); L[12] = _h; _h = fmaxf(L[14], L[15]); L[15] = fminf(L[14], L[15]); L[14] = _h; } while (0)
#define INS16(L, xin) do { float _x = (xin); _Pragma("unroll") for (int _p = 0; _p < 16; ++_p) { const float _hi = fmaxf(L[_p], _x); _x = fminf(L[_p], _x); L[_p] = _hi; } } while (0)
__device__ void phase_topk(const Params& p, unsigned char* lds) {
    const int tid = threadIdx.x, wid = tid >> 6, lane = tid & 63, r = lane & 31, hh = lane >> 5;
    const bf16_t* qp = (const bf16_t*)(p.ws + OFF_QP); const bf16_t* keysb = (const bf16_t*)(p.ws + OFF_KEYS);
    int* idxo = (int*)(p.ws + OFF_IDX); float* go = (float*)(p.ws + OFF_G);
    float* myrows = (float*)lds + wid * 32 * 129;
    const float NEG = -__builtin_inff();
    for (int tile = blockIdx.x; tile < 256; tile += gridDim.x) {
        const int tokb = tile * 64 + (wid & 1) * 32;
        float v1[16], v2[16];
#pragma unroll
        for (int j = 0; j < 16; ++j) { v1[j] = NEG; v2[j] = NEG; }
#pragma unroll 1
        for (int pass = 0; pass < 4; ++pass) {
            const int half = pass >> 1, hg = pass & 1, head = hg * 4 + (wid >> 1);
            f32x16 acc[4] = {zero16(), zero16(), zero16(), zero16()};
            const bf16_t* arow = qp + (size_t)(tokb + r) * 2048 + head * 256 + half * 128 + 8 * hh;
            const bf16_t* kb = keysb + half * 16384 + r * 128 + 8 * hh;
#pragma unroll
            for (int ks = 0; ks < 8; ++ks) { const bf16x8 a = *(const bf16x8*)(arow + 16 * ks);
#pragma unroll
                for (int nt = 0; nt < 4; ++nt) { const bf16x8 bb = *(const bf16x8*)(kb + nt * 32 * 128 + 16 * ks); acc[nt] = MFMA32(a, bb, acc[nt]); } }
#pragma unroll
            for (int nt = 0; nt < 4; ++nt)
#pragma unroll
                for (int e = 0; e < 16; ++e) { const int m = (e & 3) + 8 * (e >> 2) + 4 * hh; myrows[m * 129 + nt * 32 + r] = acc[nt][e]; }
            asm volatile("s_waitcnt lgkmcnt(0)" ::: "memory"); __builtin_amdgcn_wave_barrier();
            float L[16];
            const float* rowp = myrows + r * 129 + hh * 64;
#pragma unroll
            for (int j = 0; j < 16; ++j) L[j] = __uint_as_float((__float_as_uint(rowp[j]) & ~127u) | (unsigned)(127 - (hh * 64 + j)));
            SORT16(L);
#pragma unroll 1
            for (int g = 1; g < 4; ++g) {
                float Gp[16];
#pragma unroll
                for (int j = 0; j < 16; ++j) Gp[j] = __uint_as_float((__float_as_uint(rowp[g * 16 + j]) & ~127u) | (unsigned)(127 - (hh * 64 + g * 16 + j)));
                SORT16(Gp);
#pragma unroll
                for (int j = 0; j < 16; ++j) L[j] = fmaxf(L[j], Gp[15 - j]);
                BITONIC16(L);
            }
            {
                float O[16];
#pragma unroll
                for (int j = 0; j < 16; ++j) O[j] = __shfl_xor(L[j], 32);
#pragma unroll
                for (int j = 0; j < 16; ++j) L[j] = fmaxf(L[j], O[15 - j]);
                BITONIC16(L);
            }
            const bool mine = hh == hg;
            if (half == 0) {
#pragma unroll
                for (int j = 0; j < 16; ++j) v1[j] = mine ? L[j] : v1[j];
            } else {
#pragma unroll
                for (int j = 0; j < 16; ++j) v2[j] = mine ? L[j] : v2[j];
            }
            asm volatile("s_waitcnt lgkmcnt(0)" ::: "memory"); __builtin_amdgcn_wave_barrier();
        }
        float T[16]; int TI[16];
        int i1[16], i2[16];
#pragma unroll
        for (int j = 0; j < 16; ++j) { i1[j] = (127 - (int)(__float_as_uint(v1[j]) & 127u)) * 128; i2[j] = 127 - (int)(__float_as_uint(v2[j]) & 127u); }
#pragma unroll
        for (int j = 0; j < 16; ++j) { T[j] = v1[0] + v2[j]; TI[j] = i1[0] + i2[j]; }
#pragma unroll
        for (int a = 1; a < 16; ++a)
#pragma unroll
            for (int b = 0; b < 16; ++b)
                if ((a + 1) * (b + 1) <= 16) {
                    float s = v1[a] + v2[b]; int id = i1[a] + i2[b];
#pragma unroll
                    for (int q = (a + 1) * (b + 1) - 1; q < 16; ++q) { const bool c = s > T[q]; const float ts = c ? T[q] : s; const int ti = c ? TI[q] : id; T[q] = c ? s : T[q]; TI[q] = c ? id : TI[q]; s = ts; id = ti; }
                }
        const int token = tokb + r, head = hh * 4 + (wid >> 1);
        const float t0v = T[0]; float tot = 0.f;
#pragma unroll
        for (int j = 0; j < 16; ++j) { T[j] = __expf(T[j] - t0v); tot += T[j]; }
        const float inv = 1.0f / tot;
#pragma unroll
        for (int j = 0; j < 16; j += 4) { *(f32x4*)(go + (size_t)token * 128 + head * 16 + j) = (f32x4){T[j] * inv, T[j + 1] * inv, T[j + 2] * inv, T[j + 3] * inv};
            *(int4*)(idxo + (size_t)token * 128 + head * 16 + j) = make_int4(TI[j], TI[j + 1], TI[j + 2], TI[j + 3]); }
    }
}

__device__ void phase_peer(const Params& p, unsigned char* lds) {
    const int tid = threadIdx.x, wid = tid >> 6, lane = tid & 63, l16 = lane & 15, q4 = lane >> 4;
    const bf16_t* h2 = (const bf16_t*)(p.ws + OFF_H2); const bf16_t* db = (const bf16_t*)(p.ws + OFF_DOWN); const bf16_t* ub = (const bf16_t*)(p.ws + OFF_UP);
    const int* idxo = (const int*)(p.ws + OFF_IDX); const float* go = (const float*)(p.ws + OFF_G);
    const float* mod = (const float*)(p.ws + OFF_MOD);
    float* sga = (float*)lds + wid * 128;
    for (int tg = blockIdx.x * 8 + wid; tg < 2048; tg += gridDim.x * 8) {
        const int b = tg >> 10;
        for (int tt = 0; tt < 8; ++tt) {
            const int t = tg * 8 + tt;
            const int idA = idxo[(size_t)t * 128 + lane], idB = idxo[(size_t)t * 128 + 64 + lane];
            const float gA = go[(size_t)t * 128 + lane], gB = go[(size_t)t * 128 + 64 + lane];
            u32x4 hq[8];
#pragma unroll
            for (int i = 0; i < 8; ++i) hq[i] = *(const u32x4*)(h2 + (size_t)t * DM + i * 128 + l16 * 8);
#pragma unroll 2
            for (int s = 0; s < 32; ++s) {
                const int slot = 4 * s + q4;
                const int e = __shfl(s < 16 ? idA : idB, slot & 63);
                const bf16_t* row = db + (size_t)e * DM + l16 * 8;
                u32x4 w[8];
#pragma unroll
                for (int i = 0; i < 8; ++i) w[i] = *(const u32x4*)(row + i * 128);
                float a = 0.f;
#pragma unroll
                for (int i = 0; i < 8; ++i) {
                    a = dot2bf(w[i].x, hq[i].x, a); a = dot2bf(w[i].y, hq[i].y, a); a = dot2bf(w[i].z, hq[i].z, a); a = dot2bf(w[i].w, hq[i].w, a); }
                a += __shfl_xor(a, 8); a += __shfl_xor(a, 4); a += __shfl_xor(a, 2); a += __shfl_xor(a, 1);
                const float gg = __shfl(s < 16 ? gA : gB, slot & 63);
                if (l16 == 0) sga[slot] = gelu1(a) * gg;
            }
            asm volatile("s_waitcnt lgkmcnt(0)" ::: "memory"); __builtin_amdgcn_wave_barrier();
            float acc[16];
#pragma unroll
            for (int j = 0; j < 16; ++j) acc[j] = 0.f;
#pragma unroll 4
            for (int slot = 0; slot < 128; ++slot) {
                const int e = __builtin_amdgcn_readlane(slot < 64 ? idA : idB, slot & 63);
                const float ga = sga[slot];
                const bf16_t* row = ub + (size_t)e * DM + lane * 8;
                const u32x4 w0 = *(const u32x4*)row, w1 = *(const u32x4*)(row + 512);
                acc[0] += ga * bflo(w0.x); acc[1] += ga * bfhi(w0.x); acc[2] += ga * bflo(w0.y); acc[3] += ga * bfhi(w0.y);
                acc[4] += ga * bflo(w0.z); acc[5] += ga * bfhi(w0.z); acc[6] += ga * bflo(w0.w); acc[7] += ga * bfhi(w0.w);
                acc[8] += ga * bflo(w1.x); acc[9] += ga * bfhi(w1.x); acc[10] += ga * bflo(w1.y); acc[11] += ga * bfhi(w1.y);
                acc[12] += ga * bflo(w1.z); acc[13] += ga * bfhi(w1.z); acc[14] += ga * bflo(w1.w); acc[15] += ga * bfhi(w1.w);
            }
            asm volatile("s_waitcnt lgkmcnt(0)" ::: "memory"); __builtin_amdgcn_wave_barrier();
            float xo[16]; float ss = 0.f;
#pragma unroll
            for (int i = 0; i < 2; ++i)
#pragma unroll
                for (int j4 = 0; j4 < 2; ++j4) { const int d = i * 512 + lane * 8 + j4 * 4;
                    const f32x4 xv = *(const f32x4*)(p.out + (size_t)t * DM + d);
                    const f32x4 g2 = *(const f32x4*)(mod + b * 6144 + 5120 + d) + *(const f32x4*)(p.b_ada + 5120 + d);
#pragma unroll
                    for (int j = 0; j < 4; ++j) { const float v = xv[j] + g2[j] * acc[i * 8 + j4 * 4 + j]; xo[i * 8 + j4 * 4 + j] = v; ss += v * v; } }
            ss = wave_sum(ss);
            const float rstd = rsqrtf(ss * (1.0f / 1024.0f) + EPS);
#pragma unroll
            for (int i = 0; i < 2; ++i)
#pragma unroll
                for (int j4 = 0; j4 < 2; ++j4) { const int d = i * 512 + lane * 8 + j4 * 4;
                    const f32x4 fw = *(const f32x4*)(p.final_w + d);
                    *(f32x4*)(p.out + (size_t)t * DM + d) = (f32x4){xo[i * 8 + j4 * 4] * rstd * fw[0], xo[i * 8 + j4 * 4 + 1] * rstd * fw[1], xo[i * 8 + j4 * 4 + 2] * rstd * fw[2], xo[i * 8 + j4 * 4 + 3] * rstd * fw[3]}; }
        }
    }
}

__device__ void phase_tables8(const Params& p) {
    const int wid = threadIdx.x >> 6, lane = threadIdx.x & 63;
    const int row0 = blockIdx.x * 8 + wid, rstep = gridDim.x * 8;
    f32x4 vn[4];
    if (row0 < 32768) { const float* src0 = (row0 >= 16384 ? p.up : p.down) + (size_t)(row0 & 16383) * DM + lane * 16;
#pragma unroll
        for (int i = 0; i < 4; ++i) vn[i] = __builtin_nontemporal_load((const f32x4*)(src0 + 4 * i)); }
    for (int row = row0; row < 32768; row += rstep) {
        const bool isup = row >= 16384; const int e = row & 16383;
        f32x4 v[4]; float m = 0.f;
#pragma unroll
        for (int i = 0; i < 4; ++i) v[i] = vn[i];
        if (row + rstep < 32768) { const int rn = row + rstep; const float* srcn = (rn >= 16384 ? p.up : p.down) + (size_t)(rn & 16383) * DM + lane * 16;
#pragma unroll
            for (int i = 0; i < 4; ++i) vn[i] = __builtin_nontemporal_load((const f32x4*)(srcn + 4 * i)); }
#pragma unroll
        for (int i = 0; i < 4; ++i) { m = fmaxf(m, fmaxf(fmaxf(fabsf(v[i][0]), fabsf(v[i][1])), fmaxf(fabsf(v[i][2]), fabsf(v[i][3])))); }
#pragma unroll
        for (int o = 32; o; o >>= 1) m = fmaxf(m, __shfl_xor(m, o));
        const float sc = m > 0.f ? m * (1.0f / 224.0f) : 1.0f, inv = m > 0.f ? 224.0f / m : 0.f;
        int w[4];
#pragma unroll
        for (int i = 0; i < 4; ++i) { w[i] = __builtin_amdgcn_cvt_pk_fp8_f32(v[i][0] * inv, v[i][1] * inv, 0, false); w[i] = __builtin_amdgcn_cvt_pk_fp8_f32(v[i][2] * inv, v[i][3] * inv, w[i], true); }
        unsigned char* dst = p.ws + (isup ? OFF_UP8 : OFF_DOWN8) + (size_t)e * 1024 + lane * 16;
        *(u32x4*)dst = (u32x4){(unsigned)w[0], (unsigned)w[1], (unsigned)w[2], (unsigned)w[3]};
        if (lane == 0) ((float*)(p.ws + (isup ? OFF_SCU : OFF_SCD)))[e] = sc;
    }
}

__device__ __forceinline__ float dot2bfv(bf16x2_t a, unsigned b, float c) { return __builtin_amdgcn_fdot2_f32_bf16(a, __builtin_bit_cast(bf16x2_t, b), c, false); }
#define PEER_FMA16(ACC, W, GA) do { \
    const f32x2 _a0 = __builtin_amdgcn_cvt_pk_f32_fp8((int)(W).x, false), _a1 = __builtin_amdgcn_cvt_pk_f32_fp8((int)(W).x, true); \
    const f32x2 _b0 = __builtin_amdgcn_cvt_pk_f32_fp8((int)(W).y, false), _b1 = __builtin_amdgcn_cvt_pk_f32_fp8((int)(W).y, true); \
    const f32x2 _c0 = __builtin_amdgcn_cvt_pk_f32_fp8((int)(W).z, false), _c1 = __builtin_amdgcn_cvt_pk_f32_fp8((int)(W).z, true); \
    const f32x2 _d0 = __builtin_amdgcn_cvt_pk_f32_fp8((int)(W).w, false), _d1 = __builtin_amdgcn_cvt_pk_f32_fp8((int)(W).w, true); \
    ACC[0] = __builtin_fmaf((GA), _a0.x, ACC[0]); ACC[1] = __builtin_fmaf((GA), _a0.y, ACC[1]); ACC[2] = __builtin_fmaf((GA), _a1.x, ACC[2]); ACC[3] = __builtin_fmaf((GA), _a1.y, ACC[3]); \
    ACC[4] = __builtin_fmaf((GA), _b0.x, ACC[4]); ACC[5] = __builtin_fmaf((GA), _b0.y, ACC[5]); ACC[6] = __builtin_fmaf((GA), _b1.x, ACC[6]); ACC[7] = __builtin_fmaf((GA), _b1.y, ACC[7]); \
    ACC[8] = __builtin_fmaf((GA), _c0.x, ACC[8]); ACC[9] = __builtin_fmaf((GA), _c0.y, ACC[9]); ACC[10] = __builtin_fmaf((GA), _c1.x, ACC[10]); ACC[11] = __builtin_fmaf((GA), _c1.y, ACC[11]); \
    ACC[12] = __builtin_fmaf((GA), _d0.x, ACC[12]); ACC[13] = __builtin_fmaf((GA), _d0.y, ACC[13]); ACC[14] = __builtin_fmaf((GA), _d1.x, ACC[14]); ACC[15] = __builtin_fmaf((GA), _d1.y, ACC[15]); } while (0)
__device__ void phase_peer2(const Params& p, unsigned char* lds) {
    const int tid = threadIdx.x, wid = tid >> 6, lane = tid & 63, l16 = lane & 15, q4 = lane >> 4;
    unsigned char* wl = lds + wid * 6144;
    int* se = (int*)wl;
    float* sg = (float*)(wl + 2048);
    float* sa = (float*)(wl + 4096);
    const unsigned char* d8 = p.ws + OFF_DOWN8; const unsigned char* u8 = p.ws + OFF_UP8;
    const float* scd = (const float*)(p.ws + OFF_SCD); const float* scu = (const float*)(p.ws + OFF_SCU);
    const bf16_t* h2 = (const bf16_t*)(p.ws + OFF_H2);
    const int* idxo = (const int*)(p.ws + OFF_IDX); const float* go = (const float*)(p.ws + OFF_G);
    const float* mod = (const float*)(p.ws + OFF_MOD);
    const unsigned long long ltmask = (1ull << lane) - 1ull;
    for (int blk2 = blockIdx.x * 2; blk2 < 512; blk2 += (blk2 & 1) ? 2 * gridDim.x - 1 : 1) {
        const int blk = blk2; const int tok0 = blk * 32 + wid * 4; const int b = tok0 >> 13;
#pragma unroll
        for (int tk = 0; tk < 4; ++tk) { const size_t o = (size_t)(tok0 + tk) * 128 + lane;
            const int idA = idxo[o], idB = idxo[o + 64]; const float gA = go[o], gB = go[o + 64];
            int base = 0;
#pragma unroll
            for (int r = 0; r < 8; ++r) {
                const bool mA = (idA >> 11) == r, mB = (idB >> 11) == r; const unsigned long long kA = __ballot(mA), kB = __ballot(mB);
                if (mA) { const int pos = tk * 128 + base + __popcll(kA & ltmask); se[pos] = idA; sg[pos] = gA; }
                base += __popcll(kA);
                if (mB) { const int pos = tk * 128 + base + __popcll(kB & ltmask); se[pos] = idB; sg[pos] = gB; }
                base += __popcll(kB); } }
        u32x4 hq[4][2];
#pragma unroll
        for (int i = 0; i < 4; ++i)
#pragma unroll
            for (int j = 0; j < 2; ++j) hq[i][j] = *(const u32x4*)(h2 + (size_t)(tok0 + q4) * DM + i * 256 + l16 * 16 + j * 8);
        asm volatile("s_waitcnt lgkmcnt(0)" ::: "memory"); __builtin_amdgcn_wave_barrier();
        {
            u32x4 bufA[8], bufB[8]; float sdA[2], sdB[2];
#define PEER_DLOAD(BUF, SD, K) do { _Pragma("unroll") for (int _u = 0; _u < 2; ++_u) { const int _e = se[q4 * 128 + 2 * (K) + _u]; const unsigned char* _row = d8 + (size_t)_e * 1024 + l16 * 16; \
            _Pragma("unroll") for (int _i = 0; _i < 4; ++_i) BUF[_u * 4 + _i] = *(const u32x4*)(_row + _i * 256); SD[_u] = scd[_e]; } } while (0)
#define PEER_DCOMP(BUF, SD, K) do { _Pragma("unroll") for (int _u = 0; _u < 2; ++_u) { float _a = 0.f; \
            _Pragma("unroll") for (int _i = 0; _i < 4; ++_i) { const u32x4 _h0 = hq[_i][0], _h1 = hq[_i][1]; const u32x4 _w = BUF[_u * 4 + _i]; \
                _a = dot2bfv(__builtin_amdgcn_cvt_scalef32_pk_bf16_fp8((int)_w.x, 1.0f, false), _h0.x, _a); _a = dot2bfv(__builtin_amdgcn_cvt_scalef32_pk_bf16_fp8((int)_w.x, 1.0f, true), _h0.y, _a); \
                _a = dot2bfv(__builtin_amdgcn_cvt_scalef32_pk_bf16_fp8((int)_w.y, 1.0f, false), _h0.z, _a); _a = dot2bfv(__builtin_amdgcn_cvt_scalef32_pk_bf16_fp8((int)_w.y, 1.0f, true), _h0.w, _a); \
                _a = dot2bfv(__builtin_amdgcn_cvt_scalef32_pk_bf16_fp8((int)_w.z, 1.0f, false), _h1.x, _a); _a = dot2bfv(__builtin_amdgcn_cvt_scalef32_pk_bf16_fp8((int)_w.z, 1.0f, true), _h1.y, _a); \
                _a = dot2bfv(__builtin_amdgcn_cvt_scalef32_pk_bf16_fp8((int)_w.w, 1.0f, false), _h1.z, _a); _a = dot2bfv(__builtin_amdgcn_cvt_scalef32_pk_bf16_fp8((int)_w.w, 1.0f, true), _h1.w, _a); } \
            _a += __shfl_xor(_a, 8); _a += __shfl_xor(_a, 4); _a += __shfl_xor(_a, 2); _a += __shfl_xor(_a, 1); \
            if (l16 == 0) sa[q4 * 128 + 2 * (K) + _u] = _a * SD[_u]; } } while (0)
            PEER_DLOAD(bufA, sdA, 0);
            for (int k = 0; k < 64; k += 2) {
                PEER_DLOAD(bufB, sdB, k + 1);
                PEER_DCOMP(bufA, sdA, k);
                if (k + 2 < 64) PEER_DLOAD(bufA, sdA, k + 2);
                PEER_DCOMP(bufB, sdB, k + 1);
            }
#undef PEER_DLOAD
#undef PEER_DCOMP
            asm volatile("s_waitcnt lgkmcnt(0)" ::: "memory"); __builtin_amdgcn_wave_barrier();
#pragma unroll
            for (int j = 0; j < 8; ++j) { const int ix = lane + 64 * j; const int e = se[ix]; sg[ix] = gelu1(sa[ix]) * sg[ix] * scu[e]; }
        }
        asm volatile("s_waitcnt lgkmcnt(0)" ::: "memory"); __builtin_amdgcn_wave_barrier();
        float acc0[16], acc1[16], acc2[16], acc3[16];
#pragma unroll
        for (int j = 0; j < 16; ++j) { acc0[j] = 0.f; acc1[j] = 0.f; acc2[j] = 0.f; acc3[j] = 0.f; }
        {
            u32x4 ring[12];
#pragma unroll
            for (int j = 0; j < 12; ++j) ring[j] = *(const u32x4*)(u8 + (size_t)se[(j & 3) * 128 + (j >> 2)] * 1024 + lane * 16);
            for (int i = 0; i < 129; i += 3) {
#pragma unroll
                for (int j = 0; j < 12; ++j) {
                    const int tk = j & 3, st = i + (j >> 2);
                    if (st >= 128) break;
                    const float ga = sg[tk * 128 + st];
                    const u32x4 w = ring[j];
                    if (st + 3 < 128) ring[j] = *(const u32x4*)(u8 + (size_t)se[tk * 128 + st + 3] * 1024 + lane * 16);
                    if (tk == 0) PEER_FMA16(acc0, w, ga); else if (tk == 1) PEER_FMA16(acc1, w, ga); else if (tk == 2) PEER_FMA16(acc2, w, ga); else PEER_FMA16(acc3, w, ga);
                }
            }
        }
        asm volatile("s_waitcnt lgkmcnt(0)" ::: "memory"); __builtin_amdgcn_wave_barrier();
#define PEER_FIN(ACC, TK) do { const size_t _o = (size_t)(tok0 + (TK)) * DM + lane * 16; f32x4 _x[4]; float _ss = 0.f; \
        _Pragma("unroll") for (int _j = 0; _j < 4; ++_j) { const f32x4 _xv = *(const f32x4*)(p.out + _o + 4 * _j); const f32x4 _g2 = *(const f32x4*)(mod + b * 6144 + 5120 + lane * 16 + 4 * _j) + *(const f32x4*)(p.b_ada + 5120 + lane * 16 + 4 * _j); \
            _x[_j] = _xv + _g2 * (f32x4){ACC[4 * _j], ACC[4 * _j + 1], ACC[4 * _j + 2], ACC[4 * _j + 3]}; _ss += _x[_j][0] * _x[_j][0] + _x[_j][1] * _x[_j][1] + _x[_j][2] * _x[_j][2] + _x[_j][3] * _x[_j][3]; } \
        _ss = wave_sum(_ss); const float _rs = rsqrtf(_ss * (1.0f / 1024.0f) + EPS); \
        _Pragma("unroll") for (int _j = 0; _j < 4; ++_j) { const f32x4 _fw = *(const f32x4*)(p.final_w + lane * 16 + 4 * _j); *(f32x4*)(p.out + _o + 4 * _j) = _x[_j] * _rs * _fw; } } while (0)
        PEER_FIN(acc0, 0); PEER_FIN(acc1, 1); PEER_FIN(acc2, 2); PEER_FIN(acc3, 3);
#undef PEER_FIN
    }
}

#ifndef DBG_STAGE
#define DBG_STAGE 0
#endif
__device__ void phase_final_only(const Params& p) {
    const int wid = threadIdx.x >> 6, lane = threadIdx.x & 63;
    for (int t = blockIdx.x * 8 + wid; t < NTOK; t += gridDim.x * 8) {
        f32x4 xv[4]; float ss = 0.f;
#pragma unroll
        for (int i = 0; i < 4; ++i) { xv[i] = *(const f32x4*)(p.out + (size_t)t * DM + 256 * i + 4 * lane); ss += xv[i][0] * xv[i][0] + xv[i][1] * xv[i][1] + xv[i][2] * xv[i][2] + xv[i][3] * xv[i][3]; }
        ss = wave_sum(ss);
        const float rstd = rsqrtf(ss * (1.0f / 1024.0f) + EPS);
#pragma unroll
        for (int i = 0; i < 4; ++i) { const f32x4 fw = *(const f32x4*)(p.final_w + 256 * i + 4 * lane); *(f32x4*)(p.out + (size_t)t * DM + 256 * i + 4 * lane) = xv[i] * rstd * fw; }
    }
}

__device__ void phase_dump_bf16(const Params& p, const bf16_t* src, int ld) {
    for (size_t e = (size_t)blockIdx.x * 512 + threadIdx.x; e < (size_t)NTOK * DM; e += (size_t)gridDim.x * 512) {
        const size_t t = e >> 10, d = e & 1023; float v = __uint_as_float((unsigned)src[t * ld + d] << 16); if (!(fabsf(v) < 1e30f)) v = 1000.f; p.out[e] = v; }
}
__device__ void dbg_check_bf16(const Params& p, const bf16_t* src, size_t n, unsigned bit) {
    unsigned* flags = (unsigned*)(p.ws + OFF_IDX);
    bool bad = false;
    for (size_t e = (size_t)blockIdx.x * 512 + threadIdx.x; e < n; e += (size_t)gridDim.x * 512) { const float v = __uint_as_float((unsigned)src[e] << 16); if (!(fabsf(v) < 1e30f)) bad = true; }
    if (bad) atomicOr(flags, bit);
}
__device__ void dbg_check_f32(const Params& p, const float* src, size_t n, unsigned bit, float lim) {
    unsigned* flags = (unsigned*)(p.ws + OFF_IDX);
    bool bad = false;
    for (size_t e = (size_t)blockIdx.x * 512 + threadIdx.x; e < n; e += (size_t)gridDim.x * 512) { const float v = src[e]; if (!(fabsf(v) < lim)) bad = true; }
    if (bad) atomicOr(flags, bit);
}
__device__ void dbg_final(const Params& p) {
    const unsigned f = *(const unsigned*)(p.ws + OFF_IDX);
    for (size_t e = (size_t)blockIdx.x * 512 + threadIdx.x; e < (size_t)NTOK * DM; e += (size_t)gridDim.x * 512) p.out[e] = p.x[e] * (1.0f + (float)f);
}
#define GSYNC() xcd_barrier(xb)
__global__ void __launch_bounds__(512, 2) fwd_megakernel(Params p) {
    extern __shared__ __attribute__((aligned(16))) unsigned char lds[];
    cg::grid_group grid = cg::this_grid();
    LAS unsigned char* lds3 = (LAS unsigned char*)lds;
    const float* mod = (const float*)(p.ws + OFF_MOD);
    volatile LAS unsigned* xst = (volatile LAS unsigned*)(lds3 + LDS_BYTES - 16);
    if (threadIdx.x == 0) { xst[0] = 0u; xst[1] = 0u; }
    __syncthreads();
    const XcdBarrier xb = xcd_barrier_post((unsigned*)(p.ws + OFF_BAR), xst);
    if (p.ws == nullptr) grid.sync();
    phase0(p, lds);
#if DBG_STAGE == 6
    if (blockIdx.x == 0 && threadIdx.x == 0) *(unsigned*)(p.ws + OFF_IDX) = 0u;
#endif
    GSYNC();
    phase_norm<true>(p, p.x, p.norm1_w, 0, 1024, (bf16_t*)(p.ws + OFF_HB), lds);
    GSYNC();
#if DBG_STAGE == 3
    phase_dump_bf16(p, (const bf16_t*)(p.ws + OFF_HB), DM); return;
#endif
    { pg8::StaticOrder S; S.init(NTOK, 7168, gridDim.x, blockIdx.x); EpiProj E{(bf16_t*)(p.ws + OFF_PROJ)};
        pg8::gemm_phase(lds3, pg8::Gemm{(const bf16_t*)(p.ws + OFF_HB), (const bf16_t*)(p.ws + OFF_WINT), NTOK, 7168, 1024}, S, E); }
    GSYNC();
#if DBG_STAGE == 2
    phase_dump_bf16(p, (const bf16_t*)(p.ws + OFF_PROJ) + 1024, PW); return;
#endif
    phase_glaA(p, lds);
    GSYNC();
#if DBG_STAGE == 6
    dbg_check_bf16(p, (const bf16_t*)p.out, (size_t)NTOK * 2048, 1u);
    dbg_check_f32(p, (const float*)(p.ws + OFF_ALR), (size_t)NTOK * 16, 8u, 50.f);
    dbg_check_f32(p, (const float*)(p.ws + OFF_DECAY), (size_t)1024 * 128, 16u, 1.0001f);
#endif
    phase_scan_sgu(p, lds);
    GSYNC();
#if DBG_STAGE == 6
    dbg_check_bf16(p, (const bf16_t*)p.out, (size_t)NTOK * 2048, 2u);
#endif
#if DBG_STAGE == 4
    phase_dump_bf16(p, (const bf16_t*)(p.ws + OFF_HB), DM); return;
#endif
    phase_glaC(p, lds);
    GSYNC();
#if DBG_STAGE == 5
    phase_dump_bf16(p, (const bf16_t*)(p.ws + OFF_HB), DM); return;
#endif
#if DBG_STAGE == 6
    dbg_check_bf16(p, (const bf16_t*)(p.ws + OFF_HB), (size_t)NTOK * DM, 4u);
    GSYNC();
    dbg_final(p); return;
#endif
    { pg8::StaticOrder S; S.init(NTOK, 1024, gridDim.x, blockIdx.x); EpiX1 E{p.x, p.out, mod, p.b_ada};
        pg8::gemm_phase(lds3, pg8::Gemm{(const bf16_t*)(p.ws + OFF_HB), (const bf16_t*)(p.ws + OFF_WOUTT), NTOK, 1024, 1024}, S, E); }
    GSYNC();
#if DBG_STAGE == 1
    phase_final_only(p); return;
#endif
    phase_norm<false>(p, p.out, p.norm2_w, 3072, 4096, (bf16_t*)(p.ws + OFF_H2), lds);
    phase_tables8(p);
    GSYNC();
    { pg8::StaticOrder S; S.init(NTOK, 2048, gridDim.x, blockIdx.x); EpiQ E{(bf16_t*)(p.ws + OFF_QP)};
        pg8::gemm_phase(lds3, pg8::Gemm{(const bf16_t*)(p.ws + OFF_H2), (const bf16_t*)(p.ws + OFF_WQT), NTOK, 2048, 1024}, S, E); }
    GSYNC();
    phase_topk(p, lds);
    asm volatile("s_waitcnt vmcnt(0) lgkmcnt(0)" ::: "memory"); __syncthreads();
    phase_peer2(p, lds);
}

extern "C" void kernel_launch(void* const* d_in, const int* in_sizes, int n_in, void* d_out, int out_size, void* d_ws, size_t ws_size, hipStream_t stream) {
    static int grid_blocks = 0;
    if (!grid_blocks) {
        int dev = 0, cus = 0, per_cu = 0;
        hipGetDevice(&dev);
        hipDeviceGetAttribute(&cus, hipDeviceAttributeMultiprocessorCount, dev);
        hipFuncSetAttribute((const void*)fwd_megakernel, hipFuncAttributeMaxDynamicSharedMemorySize, LDS_BYTES);
        hipOccupancyMaxActiveBlocksPerMultiprocessor(&per_cu, (const void*)fwd_megakernel, 512, LDS_BYTES);
        if (per_cu < 1) per_cu = 1;
        grid_blocks = cus * per_cu;
        if (ws_size < WS_END) fprintf(stderr, "kernel_launch: workspace too small (%zu < %zu)\n", ws_size, (size_t)WS_END);
    }
    Params p{};
    p.x = (const float*)d_in[0]; p.c = (const float*)d_in[1]; p.w_ada = (const float*)d_in[2]; p.b_ada = (const float*)d_in[3]; p.norm1_w = (const float*)d_in[4];
    p.w_in = (const float*)d_in[5]; p.w_alpha_up = (const float*)d_in[6]; p.b_alpha = (const float*)d_in[7]; p.gla_norm_w = (const float*)d_in[8];
    p.sgu_ln_w = (const float*)d_in[9]; p.sgu_ln_b = (const float*)d_in[10]; p.sgu_w = (const float*)d_in[11]; p.sgu_b = (const float*)d_in[12];
    p.w_out = (const float*)d_in[13]; p.norm2_w = (const float*)d_in[14]; p.w_q = (const float*)d_in[15]; p.keys1 = (const float*)d_in[16]; p.keys2 = (const float*)d_in[17];
    p.down = (const float*)d_in[18]; p.up = (const float*)d_in[19]; p.final_w = (const float*)d_in[20];
    p.out = (float*)d_out; p.ws = (unsigned char*)d_ws;
    hipMemsetAsync((unsigned char*)d_ws + OFF_BAR, 0, XCD_BAR_WORDS * 4, stream);
    void* args[] = {&p};
    hipError_t e = hipLaunchCooperativeKernel((const void*)fwd_megakernel, dim3(grid_blocks), dim3(512), args, LDS_BYTES, stream);
    if (e != hipSuccess) fprintf(stderr, "cooperative launch failed: %s (grid %d)\n", hipGetErrorString(e), grid_blocks);
}
```

```cpp
#include <hip/hip_runtime.h>
#include <hip/hip_cooperative_groups.h>
#include <cstdio>
namespace cg = cooperative_groups;

#define LAS __attribute__((address_space(3)))
typedef unsigned short bf16_t;
typedef short bf16x8 __attribute__((ext_vector_type(8)));
typedef float f32x2 __attribute__((ext_vector_type(2)));
typedef float f32x4 __attribute__((ext_vector_type(4)));
typedef float f32x16 __attribute__((ext_vector_type(16)));
typedef unsigned u32x2 __attribute__((ext_vector_type(2)));
typedef unsigned u32x4 __attribute__((ext_vector_type(4)));
typedef __bf16 bf16x2_t __attribute__((ext_vector_type(2)));

constexpr int NTOK = 16384, DM = 1024, SEQ = 8192, INW = 7184, PW = 5120;
constexpr float EPS = 1e-6f;
constexpr size_t MiB = 1024 * 1024;
constexpr size_t OFF_PROJ = 0;
constexpr size_t OFF_DOWN = 0;
constexpr size_t OFF_UP = 32 * MiB;
constexpr size_t OFF_DOWN8 = 0;
constexpr size_t OFF_UP8 = 16 * MiB;
constexpr size_t OFF_SCD = 32 * MiB;
constexpr size_t OFF_SCU = 32 * MiB + 65536;
constexpr size_t OFF_H2 = 64 * MiB;
constexpr size_t OFF_QP = 96 * MiB;
constexpr size_t OFF_HB = 160 * MiB;
constexpr size_t OFF_WINT = 192 * MiB;
constexpr size_t OFF_WOUTT = 206 * MiB;
constexpr size_t OFF_WQT = 208 * MiB;
constexpr size_t OFF_KEYS = 212 * MiB;
constexpr size_t OFF_MOD = OFF_KEYS + 65536;
constexpr size_t OFF_ALR = OFF_MOD + 65536;
constexpr size_t OFF_STATS = OFF_ALR + MiB;
constexpr size_t OFF_DECAY = OFF_STATS + 131072;
constexpr size_t OFF_BAR = OFF_DECAY + 524288;
constexpr size_t OFF_IDX = 214 * MiB;
constexpr size_t OFF_G = 222 * MiB;
constexpr size_t WS_END = 230 * MiB;
constexpr int LDS_BYTES = 135168;

struct Params {
    const float *x, *c, *w_ada, *b_ada, *norm1_w, *w_in, *w_alpha_up, *b_alpha, *gla_norm_w, *sgu_ln_w, *sgu_ln_b, *sgu_w, *sgu_b, *w_out, *norm2_w, *w_q, *keys1, *keys2, *down, *up, *final_w;
    float* out; unsigned char* ws;
};

__device__ __forceinline__ unsigned cvt_pk_bf16_asm(float lo, float hi) { unsigned r; asm volatile("v_cvt_pk_bf16_f32 %0, %1, %2" : "=v"(r) : "v"(lo), "v"(hi)); return r; }
__device__ __forceinline__ unsigned cvt_pk_bf16(float lo, float hi) { f32x2 v = {lo, hi}; bf16x2_t b = __builtin_convertvector(v, bf16x2_t); return __builtin_bit_cast(unsigned, b); }
__device__ __forceinline__ float bflo(unsigned w) { return __uint_as_float(w << 16); }
__device__ __forceinline__ float bfhi(unsigned w) { return __uint_as_float(w & 0xffff0000u); }
__device__ __forceinline__ float wave_sum(float v) {
#pragma unroll
    for (int o = 32; o; o >>= 1) v += __shfl_xor(v, o);
    return v;
}
__device__ __forceinline__ float sigmoidf_(float x) { return __builtin_amdgcn_rcpf(1.0f + __expf(-x)); }
__device__ __forceinline__ f32x2 gelu_pk(f32x2 v) {
    const f32x2 av = __builtin_elementwise_abs(v), d = av * 0.2316418882f + 1.0f;
    f32x2 t; t.x = __builtin_amdgcn_rcpf(d.x); t.y = __builtin_amdgcn_rcpf(d.y);
    f32x2 q = t * 0.5307027145f + (-0.7265760135f); q = q * t + 0.7107068705f; q = q * t + (-0.142248368f); q = q * t + 0.127414796f; q = q * t;
    const f32x2 s = (v * v) * (-0.72134752044f);
    f32x2 e; e.x = __builtin_amdgcn_exp2f(s.x); e.y = __builtin_amdgcn_exp2f(s.y);
    const f32x2 m = v * (q * e), r = v - m;
    f32x2 o; o.x = v.x < 0.f ? m.x : r.x; o.y = v.y < 0.f ? m.y : r.y; return o;
}
__device__ __forceinline__ float gelu1(float v) { f32x2 r = gelu_pk((f32x2){v, v}); return r.x; }
__device__ __forceinline__ f32x16 zero16() { f32x16 z;
#pragma unroll
    for (int i = 0; i < 16; ++i) z[i] = 0.f;
    return z; }
__device__ __forceinline__ float dot2bf(unsigned a, unsigned b, float c) { return __builtin_amdgcn_fdot2_f32_bf16(__builtin_bit_cast(bf16x2_t, a), __builtin_bit_cast(bf16x2_t, b), c, false); }
#define MFMA32(a, b, c) __builtin_amdgcn_mfma_f32_32x32x16_bf16((a), (b), (c), 0, 0, 0)


#define XB_TMO      128
#define XB_XCNT(j)  (256  + 64 * (j))
#define XB_XSUB(j)  (1280 + 64 * (j))
#define XB_XGEN(j)  (2304 + 64 * (j))
#define XB_TOP      3328
#define XB_TOPGEN   3392
#define XCD_BAR_WORDS 3456
#define XB_SPIN_CAP (1u << 18)
__device__ __forceinline__ unsigned xb_ld(unsigned* p)              { return __hip_atomic_load(p, __ATOMIC_RELAXED, __HIP_MEMORY_SCOPE_AGENT); }
__device__ __forceinline__ unsigned xb_add(unsigned* p, unsigned v) { return __hip_atomic_fetch_add(p, v, __ATOMIC_RELAXED, __HIP_MEMORY_SCOPE_AGENT); }
__device__ __forceinline__ unsigned xb_xcc_id() { return (unsigned)__builtin_amdgcn_s_getreg((3 << 11) | 20) & 0xFu; }
#define XB_SPIN(cond, bar) do { unsigned _sp = 0; while (cond) { __builtin_amdgcn_s_sleep(1); \
    if ((++_sp & 255u) == 0u) { if (xb_ld(&(bar)[XB_TMO])) break; if (_sp > XB_SPIN_CAP) { atomicAdd(&(bar)[XB_TMO], 1u); break; } } } } while (0)
struct XcdBarrier { unsigned* bar; unsigned x; volatile LAS unsigned* st; };
__device__ __forceinline__ XcdBarrier xcd_barrier_post(unsigned* bar, volatile LAS unsigned* st) {
    XcdBarrier b; b.bar = bar; b.x = xb_xcc_id(); b.st = st;
    if (threadIdx.x == 0) (void)xb_add(&bar[XB_XCNT(b.x)], 1u);
    return b;
}
__device__ __forceinline__ void xcd_barrier_complete(unsigned* bar, unsigned x, unsigned& nloc, unsigned& nx) {
    const unsigned G = gridDim.x * gridDim.y * gridDim.z;
    unsigned sum, cnt, mine, sp = 0u;
    for (;;) {
        sum = 0u; cnt = 0u; mine = 0u;
#pragma unroll
        for (unsigned j = 0; j < 16; ++j) { const unsigned c = xb_ld(&bar[XB_XCNT(j)]); sum += c; cnt += (c > 0u) ? 1u : 0u; mine = (j == x) ? c : mine; }
        if (sum == G) break;
        __builtin_amdgcn_s_sleep(1);
        if ((++sp & 255u) == 0u) { if (xb_ld(&bar[XB_TMO])) break; if (sp > XB_SPIN_CAP) { atomicAdd(&bar[XB_TMO], 1u); break; } }
    }
    nloc = mine > 0u ? mine : 1u; nx = cnt > 0u ? cnt : 1u;
}
__device__ __forceinline__ void xcd_barrier(const XcdBarrier& b) {
    asm volatile("s_waitcnt vmcnt(0)" ::: "memory");
    __syncthreads();
    if (threadIdx.x == 0) {
        unsigned* bar = b.bar;
        __builtin_amdgcn_s_waitcnt(0);
        unsigned nloc = b.st[0], nx = b.st[1];
        if (nloc == 0u) { xcd_barrier_complete(bar, b.x, nloc, nx); b.st[0] = nloc; b.st[1] = nx; }
        const unsigned old = xb_add(&bar[XB_XSUB(b.x)], 1u);
        const unsigned gen = old / nloc;
        if (old + 1u == (gen + 1u) * nloc) {
            __builtin_amdgcn_fence(__ATOMIC_RELEASE, "agent");
            asm volatile("s_waitcnt vmcnt(0)" ::: "memory");
            const unsigned og = xb_add(&bar[XB_TOP], 1u);
            const unsigned tg = og / nx;
            if (og + 1u == (tg + 1u) * nx) xb_add(&bar[XB_TOPGEN], 1u);
            else XB_SPIN(xb_ld(&bar[XB_TOPGEN]) == tg, bar);
            __builtin_amdgcn_fence(__ATOMIC_ACQUIRE, "agent");
            xb_add(&bar[XB_XGEN(b.x)], 1u);
            asm volatile("s_waitcnt vmcnt(0)" ::: "memory");
        } else {
            XB_SPIN(xb_ld(&bar[XB_XGEN(b.x)]) == gen, bar);
            __builtin_amdgcn_fence(__ATOMIC_ACQUIRE, "agent");
            asm volatile("s_waitcnt vmcnt(0)" ::: "memory");
        }
    }
    __syncthreads();
}

namespace pg8 {
constexpr int BM = 256, BK = 64, HALF = 128, HTB = HALF * BK * 2, STAGE_BYTES = 8 * HTB, NXCD = 8, WGM = 8;
__host__ __device__ __forceinline__ int lds_byte(int r, int c) { const int st = (r >> 4) * 2 + (c >> 5), rr = r & 15, cc = c & 31, ob = rr * 64 + cc * 2; return st * 1024 + (ob ^ (((ob >> 9) & 1) << 5)); }
__host__ __device__ __forceinline__ void stage_rc(int b, int& R, int& C) { const int st = b / 1024, sb = b % 1024, swz = sb ^ (((sb >> 9) & 1) << 5); R = (st >> 1) * 16 + swz / 64; C = (st & 1) * 32 + (swz % 64) / 2; }
__host__ __device__ __forceinline__ int perm32(int rho) { const int n = rho >> 4, i = rho & 15; return 8 * (i >> 2) + 4 * n + (i & 3); }
struct Unit { int pm, pn; };
struct Gemm { const bf16_t* A; const bf16_t* Bt; int M, N, K; };
struct StaticOrder {
    int nM, nN, nwg, G, c;
    __device__ void init(int M, int N, int G_, int c_) { nM = M / BM; nN = N / BM; nwg = nM * nN; G = G_; c = c_; }
    __device__ bool next(int i, Unit& u) const {
        const long L = (long)i * G + c; if (L >= nwg) return false;
        int wgid = (int)L; { const int q = nwg / NXCD, r = nwg % NXCD, xcd = wgid % NXCD, off = wgid / NXCD; wgid = (xcd < r ? xcd * (q + 1) : r * (q + 1) + (xcd - r) * q) + off; }
        const int nig = WGM * nN, gid = wgid / nig, fm = gid * WGM, gsz = (nM - fm) < WGM ? (nM - fm) : WGM;
        u.pm = fm + ((wgid % nig) % gsz); u.pn = (wgid % nig) / gsz; return true;
    }
    __device__ __forceinline__ void a_ready(const Unit&) const {}
    __device__ __forceinline__ void done(const Unit&) const {}
};

template <class Epi, class Sched>
__device__ __forceinline__ void gemm_phase(LAS unsigned char* lds, const Gemm g, const Sched& S, const Epi& E) {
    const int tid = threadIdx.x, wid = __builtin_amdgcn_readfirstlane(tid >> 6), lane = tid & 63, wr = wid >> 2, wc = wid & 3, fr = lane & 15, fq = lane >> 4;
    const int K = g.K, nt = K / BK;
    unsigned voffA[2], voffB[2];
#pragma unroll
    for (int i = 0; i < 2; ++i) { int R, C; stage_rc(tid * 16 + i * 8192, R, C); const int Rb = Epi::PERM ? ((R & ~31) + perm32(R & 31)) : R;
        voffA[i] = (unsigned)(R * K + C) * 2u; voffB[i] = (unsigned)(Rb * K + C) * 2u; }
    const size_t kstep = (size_t)(BK * 2);
    const size_t hstep = (size_t)HALF * K * 2;
    const size_t tstep = 2 * hstep;
    const unsigned ldsw = (unsigned)wid * 1024u;
    const int aoff = lds_byte(wr * 64 + fr, fq * 8), boff = lds_byte(wc * 32 + fr, fq * 8);
#define PG8_SA(b, h) (((b) * 2 + (h)) * HTB)
#define PG8_SB(b, h) ((4 + (b) * 2 + (h)) * HTB)
#define PG8_STAGE(bufoff, gbase, voff) do { _Pragma("unroll") for (int _i = 0; _i < 2; ++_i) \
        __builtin_amdgcn_global_load_lds((const unsigned*)((const char*)(gbase) + (voff)[_i]), (LAS unsigned*)(lds + (bufoff) + ldsw + _i * 8192), 16, 0, 0); } while (0)
#define PG8_LDA(dst, b, h) do { _Pragma("unroll") for (int m = 0; m < 4; ++m) _Pragma("unroll") for (int k = 0; k < 2; ++k) dst[m][k] = *(const LAS bf16x8*)(lds + PG8_SA(b, h) + aoff + m * 2048 + k * 1024); } while (0)
#define PG8_LDB(dst, b, h) do { _Pragma("unroll") for (int n = 0; n < 2; ++n) _Pragma("unroll") for (int k = 0; k < 2; ++k) dst[n][k] = *(const LAS bf16x8*)(lds + PG8_SB(b, h) + boff + n * 2048 + k * 1024); } while (0)
#define PG8_MMA(ai, bj, At, Bt) do { __builtin_amdgcn_s_setprio(1); _Pragma("unroll") for (int m = 0; m < 4; ++m) _Pragma("unroll") for (int n = 0; n < 2; ++n) _Pragma("unroll") for (int k = 0; k < 2; ++k) \
        acc[ai][bj][m][n] = __builtin_amdgcn_mfma_f32_16x16x32_bf16(Bt[n][k], At[m][k], acc[ai][bj][m][n], 0, 0, 0); __builtin_amdgcn_s_setprio(0); } while (0)
#define PG8_WAIT_V(n) asm volatile("s_waitcnt vmcnt(" #n ")" ::: "memory")
#define PG8_WAIT_L(n) asm volatile("s_waitcnt lgkmcnt(" #n ")" ::: "memory")
#define PG8_BAR __builtin_amdgcn_s_barrier()
#define PG8_SCHED __builtin_amdgcn_sched_barrier(0)
    Unit cur, nxt; int ui = 0;
    if (!S.next(0, cur)) return;
    f32x4 acc[2][2][4][2];
#pragma unroll
    for (int a = 0; a < 2; ++a)
#pragma unroll
        for (int b = 0; b < 2; ++b)
#pragma unroll
            for (int m = 0; m < 4; ++m)
#pragma unroll
                for (int n = 0; n < 2; ++n) acc[a][b][m][n] = (f32x4){0.f, 0.f, 0.f, 0.f};
    bf16x8 At[4][2], B0[2][2], B1[2][2];
    const char* cA = (const char*)g.A + (size_t)cur.pm * tstep; const char* cB = (const char*)g.Bt + (size_t)cur.pn * tstep;
    S.a_ready(cur);
    PG8_STAGE(PG8_SB(0, 0), cB, voffB); PG8_STAGE(PG8_SA(0, 0), cA, voffA); PG8_STAGE(PG8_SB(0, 1), cB + hstep, voffB); PG8_STAGE(PG8_SA(0, 1), cA + hstep, voffA);
    if (wr == 1) PG8_BAR;
    PG8_WAIT_V(4); PG8_BAR;
    PG8_STAGE(PG8_SB(1, 0), cB + kstep, voffB); PG8_STAGE(PG8_SA(1, 0), cA + kstep, voffA); PG8_STAGE(PG8_SB(1, 1), cB + hstep + kstep, voffB);
    PG8_WAIT_V(6); PG8_BAR;
    for (;;) {
        const bool has_next = S.next(ui + 1, nxt);
        const char* nA = has_next ? (const char*)g.A + (size_t)nxt.pm * tstep : cA; const char* nB = has_next ? (const char*)g.Bt + (size_t)nxt.pn * tstep : cB;
        for (int t = 0; t < nt; t += 2) {
            const bool last = (t == nt - 2);
            const char* a1 = cA + (size_t)(t + 1) * kstep;
            const char* a2 = last ? nA : cA + (size_t)(t + 2) * kstep; const char* b2 = last ? nB : cB + (size_t)(t + 2) * kstep;
            const char* a3 = a2 + kstep; const char* b3 = b2 + kstep;
            if (last && has_next) S.a_ready(nxt);
            PG8_LDB(B0, 0, 0); PG8_SCHED; PG8_LDA(At, 0, 0); PG8_STAGE(PG8_SA(1, 1), a1 + hstep, voffA);
            PG8_WAIT_L(8); PG8_BAR; PG8_WAIT_L(0); PG8_MMA(0, 0, At, B0); PG8_BAR; PG8_SCHED;
            PG8_LDB(B1, 0, 1); PG8_STAGE(PG8_SB(0, 0), b2, voffB);
            PG8_BAR; PG8_WAIT_L(0); PG8_MMA(0, 1, At, B1); PG8_BAR;
            PG8_LDA(At, 0, 1); PG8_STAGE(PG8_SA(0, 0), a2, voffA);
            PG8_BAR; PG8_WAIT_L(0); PG8_MMA(1, 0, At, B0); PG8_BAR; PG8_SCHED;
            PG8_STAGE(PG8_SB(0, 1), b2 + hstep, voffB);
            PG8_WAIT_V(6); PG8_BAR; PG8_MMA(1, 1, At, B1); PG8_BAR;
            PG8_LDB(B0, 1, 0); PG8_SCHED; PG8_LDA(At, 1, 0); PG8_STAGE(PG8_SA(0, 1), a2 + hstep, voffA);
            PG8_WAIT_L(8); PG8_BAR; PG8_WAIT_L(0); PG8_MMA(0, 0, At, B0); PG8_BAR; PG8_SCHED;
            PG8_LDB(B1, 1, 1); PG8_STAGE(PG8_SB(1, 0), b3, voffB);
            PG8_BAR; PG8_WAIT_L(0); PG8_MMA(0, 1, At, B1); PG8_BAR;
            PG8_LDA(At, 1, 1); PG8_STAGE(PG8_SA(1, 0), a3, voffA);
            PG8_BAR; PG8_WAIT_L(0); PG8_MMA(1, 0, At, B0); PG8_BAR; PG8_SCHED;
            PG8_STAGE(PG8_SB(1, 1), b3 + hstep, voffB);
            PG8_WAIT_V(6); PG8_BAR; PG8_MMA(1, 1, At, B1); PG8_BAR;
        }
        E(acc, cur, wr, wc, fr, fq); S.done(cur);
        if (!has_next) break;
#pragma unroll
        for (int a = 0; a < 2; ++a)
#pragma unroll
            for (int b = 0; b < 2; ++b)
#pragma unroll
                for (int m = 0; m < 4; ++m)
#pragma unroll
                    for (int n = 0; n < 2; ++n) acc[a][b][m][n] = (f32x4){0.f, 0.f, 0.f, 0.f};
        cur = nxt; cA = nA; cB = nB; ++ui;
    }
    PG8_WAIT_V(0);
    if (wr == 0) PG8_BAR;
    PG8_BAR;
#undef PG8_SA
#undef PG8_SB
#undef PG8_STAGE
#undef PG8_LDA
#undef PG8_LDB
#undef PG8_MMA
#undef PG8_WAIT_V
#undef PG8_WAIT_L
#undef PG8_BAR
#undef PG8_SCHED
}
}
using pg8::Unit;

struct EpiProj {
    static constexpr bool PERM = true;
    bf16_t* P;
    __device__ __forceinline__ void operator()(const f32x4 (&acc)[2][2][4][2], const Unit& u, int wr, int wc, int fr, int fq) const {
        const int row0 = u.pm * 256 + wr * 64 + fr; const int pn = u.pn;
        if (pn < 8 || pn >= 24) {
            const bool act = pn >= 24;
            const int col0 = (act ? 4096 + (pn - 24) * 256 : pn * 256) + wc * 32 + 8 * fq;
#pragma unroll
            for (int ai = 0; ai < 2; ++ai)
#pragma unroll
                for (int m = 0; m < 4; ++m) { bf16_t* rowp = P + (size_t)(row0 + ai * 128 + m * 16) * PW + col0;
#pragma unroll
                    for (int bj = 0; bj < 2; ++bj) { f32x4 v0 = acc[ai][bj][m][0], v1 = acc[ai][bj][m][1];
                        if (act) { f32x2 a = gelu_pk((f32x2){v0[0], v0[1]}), b = gelu_pk((f32x2){v0[2], v0[3]}), c = gelu_pk((f32x2){v1[0], v1[1]}), d = gelu_pk((f32x2){v1[2], v1[3]});
                            v0 = (f32x4){a.x, a.y, b.x, b.y}; v1 = (f32x4){c.x, c.y, d.x, d.y}; }
                        u32x4 w; w.x = cvt_pk_bf16_asm(v0[0], v0[1]); w.y = cvt_pk_bf16_asm(v0[2], v0[3]); w.z = cvt_pk_bf16_asm(v1[0], v1[1]); w.w = cvt_pk_bf16_asm(v1[2], v1[3]);
                        *(u32x4*)(rowp + bj * 128) = w; } }
        } else {
            const bool isrg = pn < 16;
            const int col0 = (isrg ? 2048 + (pn - 8) * 128 : 3072 + (pn - 16) * 128) + wc * 32 + 8 * fq;
#pragma unroll
            for (int ai = 0; ai < 2; ++ai)
#pragma unroll
                for (int m = 0; m < 4; ++m) { bf16_t* rowp = P + (size_t)(row0 + ai * 128 + m * 16) * PW + col0;
                    float o[8];
#pragma unroll
                    for (int n = 0; n < 2; ++n) { const f32x4 a = acc[ai][0][m][n], g = acc[ai][1][m][n];
                        if (isrg) {
#pragma unroll
                            for (int j = 0; j < 4; ++j) o[n * 4 + j] = a[j] * sigmoidf_(a[j]) * sigmoidf_(g[j]);
                        } else { f32x2 x = gelu_pk((f32x2){a[0], a[1]}), y = gelu_pk((f32x2){a[2], a[3]});
                            o[n * 4 + 0] = x.x * sigmoidf_(g[0]); o[n * 4 + 1] = x.y * sigmoidf_(g[1]); o[n * 4 + 2] = y.x * sigmoidf_(g[2]); o[n * 4 + 3] = y.y * sigmoidf_(g[3]); } }
                    u32x4 w; w.x = cvt_pk_bf16_asm(o[0], o[1]); w.y = cvt_pk_bf16_asm(o[2], o[3]); w.z = cvt_pk_bf16_asm(o[4], o[5]); w.w = cvt_pk_bf16_asm(o[6], o[7]);
                    *(u32x4*)rowp = w; }
        }
    }
};
struct EpiX1 {
    static constexpr bool PERM = false;
    const float* x; float* x1; const float* mod; const float* b_ada;
    __device__ __forceinline__ void operator()(const f32x4 (&acc)[2][2][4][2], const Unit& u, int wr, int wc, int fr, int fq) const {
        const int row0 = u.pm * 256 + wr * 64 + fr, col0 = u.pn * 256 + wc * 32 + 4 * fq; const int b = u.pm >> 5;
        f32x4 gv[2][2];
#pragma unroll
        for (int bj = 0; bj < 2; ++bj)
#pragma unroll
            for (int n = 0; n < 2; ++n) gv[bj][n] = *(const f32x4*)(mod + b * 6144 + 2048 + col0 + bj * 128 + n * 16) + *(const f32x4*)(b_ada + 2048 + col0 + bj * 128 + n * 16);
#pragma unroll
        for (int ai = 0; ai < 2; ++ai)
#pragma unroll
            for (int m = 0; m < 4; ++m) { const size_t off = (size_t)(row0 + ai * 128 + m * 16) * DM + col0;
#pragma unroll
                for (int bj = 0; bj < 2; ++bj)
#pragma unroll
                    for (int n = 0; n < 2; ++n) { const f32x4 xv = *(const f32x4*)(x + off + bj * 128 + n * 16); *(f32x4*)(x1 + off + bj * 128 + n * 16) = xv + gv[bj][n] * acc[ai][bj][m][n]; } }
    }
};
struct EpiQ {
    static constexpr bool PERM = true;
    bf16_t* O;
    __device__ __forceinline__ void operator()(const f32x4 (&acc)[2][2][4][2], const Unit& u, int wr, int wc, int fr, int fq) const {
        const int row0 = u.pm * 256 + wr * 64 + fr, col0 = u.pn * 256 + wc * 32 + 8 * fq;
#pragma unroll
        for (int ai = 0; ai < 2; ++ai)
#pragma unroll
            for (int m = 0; m < 4; ++m) { bf16_t* rowp = O + (size_t)(row0 + ai * 128 + m * 16) * 2048 + col0;
#pragma unroll
                for (int bj = 0; bj < 2; ++bj) { const f32x4 v0 = acc[ai][bj][m][0], v1 = acc[ai][bj][m][1];
                    u32x4 w; w.x = cvt_pk_bf16_asm(v0[0], v0[1]); w.y = cvt_pk_bf16_asm(v0[2], v0[3]); w.z = cvt_pk_bf16_asm(v1[0], v1[1]); w.w = cvt_pk_bf16_asm(v1[2], v1[3]);
                    *(u32x4*)(rowp + bj * 128) = w; } }
    }
};

__device__ __forceinline__ int win_src_col(int n) {
    if (n < 2048) return n;
    if (n < 4096) { const int u = (n - 2048) >> 8, r = (n - 2048) & 255; return r < 128 ? 2048 + 128 * u + r : 5136 + 128 * u + (r - 128); }
    if (n < 6144) { const int u = (n - 4096) >> 8, r = (n - 4096) & 255; return r < 128 ? 3088 + 128 * u + r : 6160 + 128 * u + (r - 128); }
    return 4112 + (n - 6144);
}
__device__ void phase0(const Params& p, unsigned char* lds) {
    const int tid = threadIdx.x;
    float* mod = (float*)(p.ws + OFF_MOD);
    {
        float* ssc = (float*)lds;
        float* red = (float*)lds + 2048;
        for (int e = tid; e < 2048; e += 512) { const float cv = p.c[e]; ssc[e] = cv * sigmoidf_(cv); }
        __syncthreads();
        for (int cbk = blockIdx.x; cbk < 256; cbk += gridDim.x) {
            const int cc = tid % 24, rg = tid / 24;
            if (tid < 504) { float a0 = 0.f, a1 = 0.f;
                const float* wp = p.w_ada + cbk * 24 + cc;
#pragma unroll 1
                for (int j0 = 0; j0 < 49; j0 += 7) { float w[7];
#pragma unroll
                    for (int u = 0; u < 7; ++u) { const int k = rg + 21 * (j0 + u); w[u] = k < 1024 ? wp[(size_t)k * 6144] : 0.f; }
#pragma unroll
                    for (int u = 0; u < 7; ++u) { const int k = rg + 21 * (j0 + u); if (k < 1024) { a0 += ssc[k] * w[u]; a1 += ssc[1024 + k] * w[u]; } } }
                red[(rg * 24 + cc) * 2] = a0; red[(rg * 24 + cc) * 2 + 1] = a1; }
            __syncthreads();
            if (tid < 48) { const int c2 = tid % 24, bb = tid / 24; float s = 0.f;
                for (int g = 0; g < 21; ++g) s += red[(g * 24 + c2) * 2 + bb];
                mod[bb * 6144 + cbk * 24 + c2] = s; }
            __syncthreads();
        }
    }
    float* tile = (float*)lds;
    for (int tl = blockIdx.x; tl < 2560; tl += gridDim.x) {
        const float* W; bf16_t* Bt; int ldw, nt, kt, which;
        if (tl < 1792) { which = 0; W = p.w_in; ldw = INW; Bt = (bf16_t*)(p.ws + OFF_WINT); nt = tl >> 4; kt = tl & 15; }
        else if (tl < 2048) { which = 1; W = p.w_out; ldw = 1024; Bt = (bf16_t*)(p.ws + OFF_WOUTT); nt = (tl - 1792) >> 4; kt = tl & 15; }
        else { which = 2; W = p.w_q; ldw = 2048; Bt = (bf16_t*)(p.ws + OFF_WQT); nt = (tl - 2048) >> 4; kt = tl & 15; }
        { const int nn = tid & 63, kk0 = tid >> 6; const int n = nt * 64 + nn; const int sc = which == 0 ? win_src_col(n) : n;
#pragma unroll
            for (int i = 0; i < 8; ++i) { const int k = kk0 + 8 * i; tile[nn * 65 + k] = W[(size_t)(kt * 64 + k) * ldw + sc]; } }
        __syncthreads();
        { const int n = tid >> 3, kc = (tid & 7) * 8; const float* tp = tile + n * 65 + kc;
            u32x4 w; w.x = cvt_pk_bf16(tp[0], tp[1]); w.y = cvt_pk_bf16(tp[2], tp[3]); w.z = cvt_pk_bf16(tp[4], tp[5]); w.w = cvt_pk_bf16(tp[6], tp[7]);
            *(u32x4*)(Bt + (size_t)(nt * 64 + n) * 1024 + kt * 64 + kc) = w; }
        __syncthreads();
    }
    { bf16_t* kb = (bf16_t*)(p.ws + OFF_KEYS);
        for (int e = (blockIdx.x * 512 + tid) * 2; e < 32768; e += gridDim.x * 1024) {
            const float* src = e < 16384 ? p.keys1 + e : p.keys2 + (e - 16384);
            *(unsigned*)(kb + e) = cvt_pk_bf16(src[0], src[1]); } }
}

template <bool ALR>
__device__ void phase_norm(const Params& p, const float* xin, const float* nw, int shift_off, int scale_off, bf16_t* hout, unsigned char* lds) {
    const int tid = threadIdx.x, wid = tid >> 6, lane = tid & 63;
    const float* mod = (const float*)(p.ws + OFF_MOD);
    float* wat = (float*)lds;
    if (ALR) {
        for (int e = tid; e < 16384; e += 512) { const int d = e >> 4, r = e & 15; wat[r * 1024 + d] = p.w_in[(size_t)d * INW + 3072 + r]; }
        __syncthreads();
    }
    float* alr = (float*)(p.ws + OFF_ALR);
    for (int tg = blockIdx.x * 8 + wid; tg < 2048; tg += gridDim.x * 8) {
        const int b = tg >> 10;
        f32x4 w4[4], sc[4], sh[4];
#pragma unroll
        for (int i = 0; i < 4; ++i) { const int d = 256 * i + 4 * lane; w4[i] = *(const f32x4*)(nw + d);
            sc[i] = *(const f32x4*)(mod + b * 6144 + scale_off + d) + *(const f32x4*)(p.b_ada + scale_off + d) + 1.0f;
            sh[i] = *(const f32x4*)(mod + b * 6144 + shift_off + d) + *(const f32x4*)(p.b_ada + shift_off + d);
            w4[i] = w4[i] * sc[i]; }
        f32x4 xn[4];
#pragma unroll
        for (int i = 0; i < 4; ++i) xn[i] = *(const f32x4*)(xin + (size_t)(tg * 8) * DM + 256 * i + 4 * lane);
        for (int tt = 0; tt < 8; ++tt) {
            const int t = tg * 8 + tt;
            f32x4 xv[4]; float ss = 0.f;
#pragma unroll
            for (int i = 0; i < 4; ++i) { xv[i] = xn[i]; ss += xv[i][0] * xv[i][0] + xv[i][1] * xv[i][1] + xv[i][2] * xv[i][2] + xv[i][3] * xv[i][3]; }
            if (tt < 7) {
#pragma unroll
                for (int i = 0; i < 4; ++i) xn[i] = *(const f32x4*)(xin + (size_t)(t + 1) * DM + 256 * i + 4 * lane); }
            ss = wave_sum(ss);
            const float rstd = rsqrtf(ss * (1.0f / 1024.0f) + EPS);
#pragma unroll
            for (int i = 0; i < 4; ++i) { xv[i] = xv[i] * rstd * w4[i] + sh[i];
                u32x2 w; w.x = cvt_pk_bf16(xv[i][0], xv[i][1]); w.y = cvt_pk_bf16(xv[i][2], xv[i][3]);
                *(u32x2*)(hout + (size_t)t * DM + 256 * i + 4 * lane) = w; }
            if (ALR) {
                float ps[16];
#pragma unroll
                for (int r = 0; r < 16; ++r) { float s = 0.f;
#pragma unroll
                    for (int i = 0; i < 4; ++i) { const f32x4 wv = *(const f32x4*)(wat + r * 1024 + 256 * i + 4 * lane); s += xv[i][0] * wv[0] + xv[i][1] * wv[1] + xv[i][2] * wv[2] + xv[i][3] * wv[3]; }
                    ps[r] = s; if (r & 1) asm volatile("" ::: "memory"); }
                float t8[8], t4[4], t2[2];
                { const bool up = (lane & 32) != 0;
#pragma unroll
                  for (int j = 0; j < 8; ++j) { const float snd = up ? ps[j] : ps[j + 8], keep = up ? ps[j + 8] : ps[j]; t8[j] = keep + __shfl_xor(snd, 32); } }
                { const bool up = (lane & 16) != 0;
#pragma unroll
                  for (int j = 0; j < 4; ++j) { const float snd = up ? t8[j] : t8[j + 4], keep = up ? t8[j + 4] : t8[j]; t4[j] = keep + __shfl_xor(snd, 16); } }
                { const bool up = (lane & 8) != 0;
#pragma unroll
                  for (int j = 0; j < 2; ++j) { const float snd = up ? t4[j] : t4[j + 2], keep = up ? t4[j + 2] : t4[j]; t2[j] = keep + __shfl_xor(snd, 8); } }
                float t1;
                { const bool up = (lane & 4) != 0; const float snd = up ? t2[0] : t2[1], keep = up ? t2[1] : t2[0]; t1 = keep + __shfl_xor(snd, 4); }
                t1 += __shfl_xor(t1, 2); t1 += __shfl_xor(t1, 1);
                if ((lane & 3) == 0) alr[(size_t)t * 16 + ((lane >> 5) & 1) * 8 + ((lane >> 4) & 1) * 4 + ((lane >> 3) & 1) * 2 + ((lane >> 2) & 1)] = t1;
            }
        }
    }
}

template <bool TR>
__device__ __forceinline__ void gla_G(const Params& p, int t0, int h, float* sALR, float* sG, float* sGT) {
    const int tid = threadIdx.x;
    const float* alr = (const float*)(p.ws + OFF_ALR);
    if (tid < 256) *(f32x4*)(sALR + tid * 4) = *(const f32x4*)(alr + (size_t)t0 * 16 + tid * 4);
    const int col = tid & 127, pg = tid >> 7;
    float wup[16];
#pragma unroll
    for (int r = 0; r < 16; ++r) wup[r] = p.w_alpha_up[r * 512 + h * 128 + col];
    const float bias = p.b_alpha[h * 128 + col];
    __syncthreads();
#pragma unroll 4
    for (int pp = 0; pp < 16; ++pp) { const int pos = pg * 16 + pp;
        float z0 = bias, z1 = 0.f, z2 = 0.f, z3 = 0.f;
#pragma unroll
        for (int r4 = 0; r4 < 4; ++r4) { const f32x4 a = *(const f32x4*)(sALR + pos * 16 + r4 * 4); z0 += a[0] * wup[r4 * 4]; z1 += a[1] * wup[r4 * 4 + 1]; z2 += a[2] * wup[r4 * 4 + 2]; z3 += a[3] * wup[r4 * 4 + 3]; }
        const float z = (z0 + z1) + (z2 + z3);
        sG[pos * 128 + col] = (fminf(z, 0.f) - __logf(1.0f + __expf(-fabsf(z)))) * (1.0f / 16.0f); }
    __syncthreads();
    if (tid < 128) { float cum = 0.f;
#pragma unroll 16
        for (int pos = 0; pos < 64; ++pos) { cum += sG[pos * 128 + tid]; if (TR) sGT[tid * 65 + pos] = cum; else sG[pos * 128 + tid] = cum; } }
    __syncthreads();
}
__device__ __forceinline__ void gla_VT(const bf16_t* P, int t0, int h, bf16_t* sVT) {
    const int tid = threadIdx.x;
#pragma unroll
    for (int i = 0; i < 4; ++i) { const int task = tid + 512 * i, pos = task & 63, dg = task >> 6;
        const u32x4 w = *(const u32x4*)(P + (size_t)(t0 + pos) * PW + 1024 + h * 256 + dg * 8);
        bf16_t* d = sVT + (dg * 8) * 72 + pos;
        d[0] = (bf16_t)w.x; d[72] = (bf16_t)(w.x >> 16); d[144] = (bf16_t)w.y; d[216] = (bf16_t)(w.y >> 16);
        d[288] = (bf16_t)w.z; d[360] = (bf16_t)(w.z >> 16); d[432] = (bf16_t)w.w; d[504] = (bf16_t)(w.w >> 16); }
}

__device__ void phase_glaA(const Params& p, unsigned char* lds) {
    const int tid = threadIdx.x, wid = tid >> 6, lane = tid & 63, r = lane & 31, hh = lane >> 5;
    const bf16_t* P = (const bf16_t*)(p.ws + OFF_PROJ);
    { float* stats = (float*)(p.ws + OFF_STATS);
        const int tst0 = blockIdx.x * 8 + wid, tstep = gridDim.x * 8;
        u32x4 an = (u32x4){0u, 0u, 0u, 0u}, bn = an;
        if (tst0 < NTOK) { an = *(const u32x4*)(P + (size_t)tst0 * PW + 4096 + lane * 16); bn = *(const u32x4*)(P + (size_t)tst0 * PW + 4096 + lane * 16 + 8); }
        for (int t = tst0; t < NTOK; t += tstep) {
            const u32x4 a = an, b = bn;
            if (t + tstep < NTOK) { an = *(const u32x4*)(P + (size_t)(t + tstep) * PW + 4096 + lane * 16); bn = *(const u32x4*)(P + (size_t)(t + tstep) * PW + 4096 + lane * 16 + 8); }
            float v[16] = {bflo(a.x), bfhi(a.x), bflo(a.y), bfhi(a.y), bflo(a.z), bfhi(a.z), bflo(a.w), bfhi(a.w), bflo(b.x), bfhi(b.x), bflo(b.y), bfhi(b.y), bflo(b.z), bfhi(b.z), bflo(b.w), bfhi(b.w)};
            float s = 0.f;
#pragma unroll
            for (int i = 0; i < 16; ++i) s += v[i];
            const float mean = wave_sum(s) * (1.0f / 1024.0f);
            float q = 0.f;
#pragma unroll
            for (int i = 0; i < 16; ++i) { const float d = v[i] - mean; q += d * d; }
            q = wave_sum(q);
            if (lane == 0) *(f32x2*)(stats + (size_t)t * 2) = (f32x2){mean, rsqrtf(q * (1.0f / 1024.0f) + EPS)};
        } }
    float* sALR = (float*)lds; float* sG = (float*)(lds + 4096);
    bf16_t* sKT = (bf16_t*)(lds + 36864); bf16_t* sVT = (bf16_t*)(lds + 55296); float* sGT = (float*)(lds + 92160);
    bf16_t* KV = (bf16_t*)p.out; float* decay = (float*)(p.ws + OFF_DECAY);
    for (int item = blockIdx.x; item < 1024; item += gridDim.x) {
        const int h = item & 3, n = (item >> 2) & 127, b = item >> 9, t0 = b * SEQ + n * 64;
        gla_G<true>(p, t0, h, sALR, sG, sGT);
#pragma unroll
        for (int i = 0; i < 2; ++i) { const int task = tid + 512 * i, pos = task & 63, kg = task >> 6;
            const u32x4 w = *(const u32x4*)(P + (size_t)(t0 + pos) * PW + 512 + h * 128 + kg * 8);
            const unsigned ww[4] = {w.x, w.y, w.z, w.w};
            bf16_t* d = sKT + (kg * 8) * 72 + pos;
#pragma unroll
            for (int e = 0; e < 4; ++e) { const int kd = kg * 8 + 2 * e;
                const float f0 = __expf(sGT[kd * 65 + 63] - sGT[kd * 65 + pos]), f1 = __expf(sGT[(kd + 1) * 65 + 63] - sGT[(kd + 1) * 65 + pos]);
                const unsigned pk = cvt_pk_bf16(bflo(ww[e]) * f0, bfhi(ww[e]) * f1);
                d[(2 * e) * 72] = (bf16_t)pk; d[(2 * e + 1) * 72] = (bf16_t)(pk >> 16); } }
        gla_VT(P, t0, h, sVT);
        if (tid < 128) decay[item * 128 + tid] = __expf(sGT[tid * 65 + 63]);
        __syncthreads();
        f32x16 acc[4];
#pragma unroll
        for (int mi = 0; mi < 4; ++mi) acc[mi] = zero16();
#pragma unroll
        for (int ks = 0; ks < 4; ++ks) {
            const bf16x8 bfr = *(const bf16x8*)(sVT + (wid * 32 + r) * 72 + ks * 16 + hh * 8);
#pragma unroll
            for (int mi = 0; mi < 4; ++mi) { const bf16x8 afr = *(const bf16x8*)(sKT + (mi * 32 + r) * 72 + ks * 16 + hh * 8); acc[mi] = MFMA32(afr, bfr, acc[mi]); }
        }
        bf16_t* dst = KV + (size_t)item * 32768 + (size_t)(wid * 32 + r) * 128;
#pragma unroll
        for (int mi = 0; mi < 4; ++mi)
#pragma unroll
            for (int g = 0; g < 4; ++g) { u32x2 w; w.x = cvt_pk_bf16(acc[mi][g * 4], acc[mi][g * 4 + 1]); w.y = cvt_pk_bf16(acc[mi][g * 4 + 2], acc[mi][g * 4 + 3]);
                *(u32x2*)(dst + mi * 32 + g * 8 + hh * 4) = w; }
        __syncthreads();
    }
}

__device__ void phase_scan_sgu(const Params& p, unsigned char* lds) {
    const int tid = threadIdx.x, wid = tid >> 6, lane = tid & 63, r = lane & 31, hh = lane >> 5;
    { unsigned* KV = (unsigned*)p.out; const float* decay = (const float*)(p.ws + OFF_DECAY);
        for (int gt = blockIdx.x * 512 + tid; gt < 131072; gt += gridDim.x * 512) {
            const int bh = gt >> 14, e = gt & 16383, kd = (e * 2) & 127, b = bh >> 2, h = bh & 3;
            float s0 = 0.f, s1 = 0.f;
            for (int n0 = 0; n0 < 128; n0 += 16) {
                unsigned w[16]; f32x2 d[16];
#pragma unroll
                for (int j = 0; j < 16; ++j) { const int item = ((b * 128 + n0 + j) << 2) + h; w[j] = KV[(size_t)item * 16384 + e]; d[j] = *(const f32x2*)(decay + item * 128 + kd); }
#pragma unroll
                for (int j = 0; j < 16; ++j) { const int item = ((b * 128 + n0 + j) << 2) + h; KV[(size_t)item * 16384 + e] = cvt_pk_bf16(s0, s1);
                    s0 = s0 * d[j].x + bflo(w[j]); s1 = s1 * d[j].y + bfhi(w[j]); }
            }
        } }
    const bf16_t* P = (const bf16_t*)(p.ws + OFF_PROJ);
    const float* stats = (const float*)(p.ws + OFF_STATS);
    bf16_t* merged = (bf16_t*)(p.ws + OFF_HB);
    bf16_t* sVT = (bf16_t*)lds;
    for (int item = blockIdx.x; item < 1024; item += gridDim.x) {
        const int g = item & 7, n = (item >> 3) & 63, b = item >> 9, t0 = b * SEQ + n * 128;
#pragma unroll
        for (int i = 0; i < 4; ++i) { const int task = tid + 512 * i, j = task & 127, cg8 = task >> 7;
            const u32x4 w = *(const u32x4*)(P + (size_t)(t0 + j) * PW + 4096 + g * 128 + cg8 * 8);
            const f32x2 st = *(const f32x2*)(stats + (size_t)(t0 + j) * 2);
            const f32x4 lw0 = *(const f32x4*)(p.sgu_ln_w + g * 128 + cg8 * 8), lw1 = *(const f32x4*)(p.sgu_ln_w + g * 128 + cg8 * 8 + 4);
            const f32x4 lb0 = *(const f32x4*)(p.sgu_ln_b + g * 128 + cg8 * 8), lb1 = *(const f32x4*)(p.sgu_ln_b + g * 128 + cg8 * 8 + 4);
            const float v[8] = {bflo(w.x), bfhi(w.x), bflo(w.y), bfhi(w.y), bflo(w.z), bfhi(w.z), bflo(w.w), bfhi(w.w)};
            bf16_t* d = sVT + (cg8 * 8) * 136 + j;
#pragma unroll
            for (int e = 0; e < 8; e += 2) { const float lw_a = e < 4 ? lw0[e] : lw1[e - 4], lw_b = e < 4 ? lw0[e + 1] : lw1[e - 3], lb_a = e < 4 ? lb0[e] : lb1[e - 4], lb_b = e < 4 ? lb0[e + 1] : lb1[e - 3];
                const unsigned pk = cvt_pk_bf16((v[e] - st.x) * st.y * lw_a + lb_a, (v[e + 1] - st.x) * st.y * lw_b + lb_b);
                d[e * 136] = (bf16_t)pk; d[(e + 1) * 136] = (bf16_t)(pk >> 16); } }
        __syncthreads();
        const int ni = wid & 3, mb = (wid >> 2) * 2, irow = ni * 32 + r;
        f32x16 acc[2] = {zero16(), zero16()};
        const float* wrow = p.sgu_w + (size_t)g * 16384 + (size_t)irow * 128;
        for (int ks = 0; ks < 2 * ni + 2; ++ks) {
            const int j0 = ks * 16 + hh * 8;
            const f32x4 wa = *(const f32x4*)(wrow + j0), wb = *(const f32x4*)(wrow + j0 + 4);
            float wv[8] = {wa[0], wa[1], wa[2], wa[3], wb[0], wb[1], wb[2], wb[3]};
#pragma unroll
            for (int e = 0; e < 8; ++e) wv[e] = (j0 + e <= irow) ? wv[e] : 0.f;
            u32x4 bw; bw.x = cvt_pk_bf16(wv[0], wv[1]); bw.y = cvt_pk_bf16(wv[2], wv[3]); bw.z = cvt_pk_bf16(wv[4], wv[5]); bw.w = cvt_pk_bf16(wv[6], wv[7]);
            const bf16x8 bfr = __builtin_bit_cast(bf16x8, bw);
#pragma unroll
            for (int mi = 0; mi < 2; ++mi) { const bf16x8 afr = *(const bf16x8*)(sVT + ((mb + mi) * 32 + r) * 136 + j0); acc[mi] = MFMA32(afr, bfr, acc[mi]); }
        }
        const float bs = p.sgu_b[g * 128 + irow];
        const size_t tok = (size_t)(t0 + irow);
#pragma unroll
        for (int mi = 0; mi < 2; ++mi)
#pragma unroll
            for (int g4 = 0; g4 < 4; ++g4) { const int c = (mb + mi) * 32 + g4 * 8 + hh * 4;
                const u32x2 ug = *(const u32x2*)(P + tok * PW + 3072 + g * 128 + c);
                u32x2 o; o.x = cvt_pk_bf16(bflo(ug.x) * (acc[mi][g4 * 4] + bs), bfhi(ug.x) * (acc[mi][g4 * 4 + 1] + bs));
                o.y = cvt_pk_bf16(bflo(ug.y) * (acc[mi][g4 * 4 + 2] + bs), bfhi(ug.y) * (acc[mi][g4 * 4 + 3] + bs));
                *(u32x2*)(merged + tok * DM + g * 128 + c) = o; }
        __syncthreads();
    }
}

__device__ void phase_glaC(const Params& p, unsigned char* lds) {
    const int tid = threadIdx.x, wid = tid >> 6, lane = tid & 63, r = lane & 31, hh = lane >> 5;
    const bf16_t* P = (const bf16_t*)(p.ws + OFF_PROJ);
    float* sALR = (float*)lds; float* sG = (float*)(lds + 4096);
    bf16_t* sQD = (bf16_t*)(lds + 36864); bf16_t* sKI = (bf16_t*)(lds + 54272); bf16_t* sVT = (bf16_t*)(lds + 71680); bf16_t* sAM = (bf16_t*)(lds + 108544); float* sSS = (float*)(lds + 117760);
    const bf16_t* ST = (const bf16_t*)p.out; bf16_t* merged = (bf16_t*)(p.ws + OFF_HB);
    for (int item = blockIdx.x; item < 1024; item += gridDim.x) {
        const int h = item & 3, n = (item >> 2) & 127, b = item >> 9, t0 = b * SEQ + n * 64;
        gla_G<false>(p, t0, h, sALR, sG, nullptr);
#pragma unroll
        for (int i = 0; i < 2; ++i) { const int task = tid + 512 * i, kg = task & 15, pos = task >> 4;
            const u32x4 qw = *(const u32x4*)(P + (size_t)(t0 + pos) * PW + h * 128 + kg * 8), kw = *(const u32x4*)(P + (size_t)(t0 + pos) * PW + 512 + h * 128 + kg * 8);
            const f32x4 g0 = *(const f32x4*)(sG + pos * 128 + kg * 8), g1 = *(const f32x4*)(sG + pos * 128 + kg * 8 + 4);
            const float gv[8] = {g0[0], g0[1], g0[2], g0[3], g1[0], g1[1], g1[2], g1[3]};
            const unsigned qq[4] = {qw.x, qw.y, qw.z, qw.w}, kk[4] = {kw.x, kw.y, kw.z, kw.w};
            unsigned qo[4], ko[4];
#pragma unroll
            for (int e = 0; e < 4; ++e) { const float e0 = __expf(gv[2 * e]), e1 = __expf(gv[2 * e + 1]);
                qo[e] = cvt_pk_bf16(bflo(qq[e]) * 0.08838834764831845f * e0, bfhi(qq[e]) * 0.08838834764831845f * e1);
                ko[e] = cvt_pk_bf16(bflo(kk[e]) * __builtin_amdgcn_rcpf(e0), bfhi(kk[e]) * __builtin_amdgcn_rcpf(e1)); }
            *(u32x4*)(sQD + pos * 136 + kg * 8) = (u32x4){qo[0], qo[1], qo[2], qo[3]};
            *(u32x4*)(sKI + pos * 136 + kg * 8) = (u32x4){ko[0], ko[1], ko[2], ko[3]}; }
        gla_VT(P, t0, h, sVT);
        __syncthreads();
        if (wid < 4) { const int mj = wid >> 1, nI = wid & 1;
            f32x16 a = zero16();
            if (mj <= nI) {
#pragma unroll
                for (int ks = 0; ks < 8; ++ks) { const bf16x8 afr = *(const bf16x8*)(sKI + (mj * 32 + r) * 136 + ks * 16 + hh * 8), bfr = *(const bf16x8*)(sQD + (nI * 32 + r) * 136 + ks * 16 + hh * 8); a = MFMA32(afr, bfr, a); } }
            const int i = nI * 32 + r;
#pragma unroll
            for (int g = 0; g < 4; ++g) { const int j = mj * 32 + g * 8 + hh * 4;
                u32x2 w; w.x = cvt_pk_bf16(j <= i ? a[g * 4] : 0.f, j + 1 <= i ? a[g * 4 + 1] : 0.f); w.y = cvt_pk_bf16(j + 2 <= i ? a[g * 4 + 2] : 0.f, j + 3 <= i ? a[g * 4 + 3] : 0.f);
                *(u32x2*)(sAM + i * 72 + j) = w; } }
        __syncthreads();
        const int nI = wid & 1, mb = (wid >> 1) * 2, i = nI * 32 + r;
        f32x16 acc[2] = {zero16(), zero16()};
        const bf16_t* Sg = ST + (size_t)item * 32768;
#pragma unroll
        for (int ks = 0; ks < 8; ++ks) { const bf16x8 bfr = *(const bf16x8*)(sQD + i * 136 + ks * 16 + hh * 8);
#pragma unroll
            for (int mi = 0; mi < 2; ++mi) { const bf16x8 afr = *(const bf16x8*)(Sg + (size_t)((mb + mi) * 32 + r) * 128 + ks * 16 + hh * 8); acc[mi] = MFMA32(afr, bfr, acc[mi]); } }
        for (int ks = 0; ks < 2 * nI + 2; ++ks) { const bf16x8 bfr = *(const bf16x8*)(sAM + i * 72 + ks * 16 + hh * 8);
#pragma unroll
            for (int mi = 0; mi < 2; ++mi) { const bf16x8 afr = *(const bf16x8*)(sVT + ((mb + mi) * 32 + r) * 72 + ks * 16 + hh * 8); acc[mi] = MFMA32(afr, bfr, acc[mi]); } }
        float ss = 0.f;
#pragma unroll
        for (int mi = 0; mi < 2; ++mi)
#pragma unroll
            for (int e = 0; e < 16; ++e) ss += acc[mi][e] * acc[mi][e];
        ss += __shfl_xor(ss, 32);
        if (hh == 0) sSS[(wid >> 1) * 64 + i] = ss;
        __syncthreads();
        const float tot = sSS[i] + sSS[64 + i] + sSS[128 + i] + sSS[192 + i];
        const float rstd = rsqrtf(tot * (1.0f / 256.0f) + EPS);
        const size_t tok = (size_t)(t0 + i);
#pragma unroll
        for (int mi = 0; mi < 2; ++mi)
#pragma unroll
            for (int g4 = 0; g4 < 4; ++g4) { const int ch = h * 256 + (mb + mi) * 32 + g4 * 8 + hh * 4;
                const f32x4 nwv = *(const f32x4*)(p.gla_norm_w + ch);
                const u32x2 rg = *(const u32x2*)(P + tok * PW + 2048 + ch), mg = *(const u32x2*)(merged + tok * DM + ch);
                u32x2 o; o.x = cvt_pk_bf16(acc[mi][g4 * 4] * rstd * nwv[0] * bflo(rg.x) + bflo(mg.x), acc[mi][g4 * 4 + 1] * rstd * nwv[1] * bfhi(rg.x) + bfhi(mg.x));
                o.y = cvt_pk_bf16(acc[mi][g4 * 4 + 2] * rstd * nwv[2] * bflo(rg.y) + bflo(mg.y), acc[mi][g4 * 4 + 3] * rstd * nwv[3] * bfhi(rg.y) + bfhi(mg.y));
                *(u32x2*)(merged + tok * DM + ch) = o; }
        __syncthreads();
    }
}

__device__ void phase_tables(const Params& p) {
    bf16_t* db = (bf16_t*)(p.ws + OFF_DOWN); bf16_t* ub = (bf16_t*)(p.ws + OFF_UP);
    for (size_t e = ((size_t)blockIdx.x * 512 + threadIdx.x) * 8; e < (size_t)16384 * 1024; e += (size_t)gridDim.x * 4096) {
        { const f32x4 a = __builtin_nontemporal_load((const f32x4*)(p.down + e)), b = __builtin_nontemporal_load((const f32x4*)(p.down + e + 4));
            u32x4 w; w.x = cvt_pk_bf16(a[0], a[1]); w.y = cvt_pk_bf16(a[2], a[3]); w.z = cvt_pk_bf16(b[0], b[1]); w.w = cvt_pk_bf16(b[2], b[3]); *(u32x4*)(db + e) = w; }
        { const f32x4 a = __builtin_nontemporal_load((const f32x4*)(p.up + e)), b = __builtin_nontemporal_load((const f32x4*)(p.up + e + 4));
            u32x4 w; w.x = cvt_pk_bf16(a[0], a[1]); w.y = cvt_pk_bf16(a[2], a[3]); w.z = cvt_pk_bf16(b[0], b[1]); w.w = cvt_pk_bf16(b[2], b[3]); *(u32x4*)(ub + e) = w; }
    }
}

#define SORT16(L) do { float _h; _h = fmaxf(L[0], L[1]); L[1] = fminf(L[0], L[1]); L[0] = _h; _h = fmaxf(L[2], L[3]); L[3] = fminf(L[2], L[3]); L[2] = _h; _h = fmaxf(L[0], L[2]); L[2] = fminf(L[0], L[2]); L[0] = _h; _h = fmaxf(L[1], L[3]); L[3] = fminf(L[1], L[3]); L[1] = _h; _h = fmaxf(L[1], L[2]); L[2] = fminf(L[1], L[2]); L[1] = _h; _h = fmaxf(L[4], L[5]); L[5] = fminf(L[4], L[5]); L[4] = _h; _h = fmaxf(L[6], L[7]); L[7] = fminf(L[6], L[7]); L[6] = _h; _h = fmaxf(L[4], L[6]); L[6] = fminf(L[4], L[6]); L[4] = _h; _h = fmaxf(L[5], L[7]); L[7] = fminf(L[5], L[7]); L[5] = _h; _h = fmaxf(L[5], L[6]); L[6] = fminf(L[5], L[6]); L[5] = _h; _h = fmaxf(L[0], L[4]); L[4] = fminf(L[0], L[4]); L[0] = _h; _h = fmaxf(L[2], L[6]); L[6] = fminf(L[2], L[6]); L[2] = _h; _h = fmaxf(L[2], L[4]); L[4] = fminf(L[2], L[4]); L[2] = _h; _h = fmaxf(L[1], L[5]); L[5] = fminf(L[1], L[5]); L[1] = _h; _h = fmaxf(L[3], L[7]); L[7] = fminf(L[3], L[7]); L[3] = _h; _h = fmaxf(L[3], L[5]); L[5] = fminf(L[3], L[5]); L[3] = _h; _h = fmaxf(L[1], L[2]); L[2] = fminf(L[1], L[2]); L[1] = _h; _h = fmaxf(L[3], L[4]); L[4] = fminf(L[3], L[4]); L[3] = _h; _h = fmaxf(L[5], L[6]); L[6] = fminf(L[5], L[6]); L[5] = _h; _h = fmaxf(L[8], L[9]); L[9] = fminf(L[8], L[9]); L[8] = _h; _h = fmaxf(L[10], L[11]); L[11] = fminf(L[10], L[11]); L[10] = _h; _h = fmaxf(L[8], L[10]); L[10] = fminf(L[8], L[10]); L[8] = _h; _h = fmaxf(L[9], L[11]); L[11] = fminf(L[9], L[11]); L[9] = _h; _h = fmaxf(L[9], L[10]); L[10] = fminf(L[9], L[10]); L[9] = _h; _h = fmaxf(L[12], L[13]); L[13] = fminf(L[12], L[13]); L[12] = _h; _h = fmaxf(L[14], L[15]); L[15] = fminf(L[14], L[15]); L[14] = _h; _h = fmaxf(L[12], L[14]); L[14] = fminf(L[12], L[14]); L[12] = _h; _h = fmaxf(L[13], L[15]); L[15] = fminf(L[13], L[15]); L[13] = _h; _h = fmaxf(L[13], L[14]); L[14] = fminf(L[13], L[14]); L[13] = _h; _h = fmaxf(L[8], L[12]); L[12] = fminf(L[8], L[12]); L[8] = _h; _h = fmaxf(L[10], L[14]); L[14] = fminf(L[10], L[14]); L[10] = _h; _h = fmaxf(L[10], L[12]); L[12] = fminf(L[10], L[12]); L[10] = _h; _h = fmaxf(L[9], L[13]); L[13] = fminf(L[9], L[13]); L[9] = _h; _h = fmaxf(L[11], L[15]); L[15] = fminf(L[11], L[15]); L[11] = _h; _h = fmaxf(L[11], L[13]); L[13] = fminf(L[11], L[13]); L[11] = _h; _h = fmaxf(L[9], L[10]); L[10] = fminf(L[9], L[10]); L[9] = _h; _h = fmaxf(L[11], L[12]); L[12] = fminf(L[11], L[12]); L[11] = _h; _h = fmaxf(L[13], L[14]); L[14] = fminf(L[13], L[14]); L[13] = _h; _h = fmaxf(L[0], L[8]); L[8] = fminf(L[0], L[8]); L[0] = _h; _h = fmaxf(L[4], L[12]); L[12] = fminf(L[4], L[12]); L[4] = _h; _h = fmaxf(L[4], L[8]); L[8] = fminf(L[4], L[8]); L[4] = _h; _h = fmaxf(L[2], L[10]); L[10] = fminf(L[2], L[10]); L[2] = _h; _h = fmaxf(L[6], L[14]); L[14] = fminf(L[6], L[14]); L[6] = _h; _h = fmaxf(L[6], L[10]); L[10] = fminf(L[6], L[10]); L[6] = _h; _h = fmaxf(L[2], L[4]); L[4] = fminf(L[2], L[4]); L[2] = _h; _h = fmaxf(L[6], L[8]); L[8] = fminf(L[6], L[8]); L[6] = _h; _h = fmaxf(L[10], L[12]); L[12] = fminf(L[10], L[12]); L[10] = _h; _h = fmaxf(L[1], L[9]); L[9] = fminf(L[1], L[9]); L[1] = _h; _h = fmaxf(L[5], L[13]); L[13] = fminf(L[5], L[13]); L[5] = _h; _h = fmaxf(L[5], L[9]); L[9] = fminf(L[5], L[9]); L[5] = _h; _h = fmaxf(L[3], L[11]); L[11] = fminf(L[3], L[11]); L[3] = _h; _h = fmaxf(L[7], L[15]); L[15] = fminf(L[7], L[15]); L[7] = _h; _h = fmaxf(L[7], L[11]); L[11] = fminf(L[7], L[11]); L[7] = _h; _h = fmaxf(L[3], L[5]); L[5] = fminf(L[3], L[5]); L[3] = _h; _h = fmaxf(L[7], L[9]); L[9] = fminf(L[7], L[9]); L[7] = _h; _h = fmaxf(L[11], L[13]); L[13] = fminf(L[11], L[13]); L[11] = _h; _h = fmaxf(L[1], L[2]); L[2] = fminf(L[1], L[2]); L[1] = _h; _h = fmaxf(L[3], L[4]); L[4] = fminf(L[3], L[4]); L[3] = _h; _h = fmaxf(L[5], L[6]); L[6] = fminf(L[5], L[6]); L[5] = _h; _h = fmaxf(L[7], L[8]); L[8] = fminf(L[7], L[8]); L[7] = _h; _h = fmaxf(L[9], L[10]); L[10] = fminf(L[9], L[10]); L[9] = _h; _h = fmaxf(L[11], L[12]); L[12] = fminf(L[11], L[12]); L[11] = _h; _h = fmaxf(L[13], L[14]); L[14] = fminf(L[13], L[14]); L[13] = _h; } while (0)
#define BITONIC16(L) do { float _h; _h = fmaxf(L[0], L[8]); L[8] = fminf(L[0], L[8]); L[0] = _h; _h = fmaxf(L[1], L[9]); L[9] = fminf(L[1], L[9]); L[1] = _h; _h = fmaxf(L[2], L[10]); L[10] = fminf(L[2], L[10]); L[2] = _h; _h = fmaxf(L[3], L[11]); L[11] = fminf(L[3], L[11]); L[3] = _h; _h = fmaxf(L[4], L[12]); L[12] = fminf(L[4], L[12]); L[4] = _h; _h = fmaxf(L[5], L[13]); L[13] = fminf(L[5], L[13]); L[5] = _h; _h = fmaxf(L[6], L[14]); L[14] = fminf(L[6], L[14]); L[6] = _h; _h = fmaxf(L[7], L[15]); L[15] = fminf(L[7], L[15]); L[7] = _h; _h = fmaxf(L[0], L[4]); L[4] = fminf(L[0], L[4]); L[0] = _h; _h = fmaxf(L[1], L[5]); L[5] = fminf(L[1], L[5]); L[1] = _h; _h = fmaxf(L[2], L[6]); L[6] = fminf(L[2], L[6]); L[2] = _h; _h = fmaxf(L[3], L[7]); L[7] = fminf(L[3], L[7]); L[3] = _h; _h = fmaxf(L[8], L[12]); L[12] = fminf(L[8], L[12]); L[8] = _h; _h = fmaxf(L[9], L[13]); L[13] = fminf(L[9], L[13]); L[9] = _h; _h = fmaxf(L[10], L[14]); L[14] = fminf(L[10], L[14]); L[10] = _h; _h = fmaxf(L[11], L[15]); L[15] = fminf(L[11], L[15]); L[11] = _h; _h = fmaxf(L[0], L[2]); L[2] = fminf(L[0], L[2]); L[0] = _h; _h = fmaxf(L[1], L[3]); L[3] = fminf(L[1], L[3]); L[1] = _h; _h = fmaxf(L[4], L[6]); L[6] = fminf(L[4], L[6]); L[4] = _h; _h = fmaxf(L[5], L[7]); L[7] = fminf(L[5], L[7]); L[5] = _h; _h = fmaxf(L[8], L[10]); L[10] = fminf(L[8], L[10]); L[8] = _h; _h = fmaxf(L[9], L[11]); L[11] = fminf(L[9], L[11]); L[9] = _h; _h = fmaxf(L[12], L[14]); L[14] = fminf(L[12], L[14]); L[12] = _h; _h = fmaxf(L[13], L[15]); L[15] = fminf(L[13], L[15]); L[13] = _h; _h = fmaxf(L[0], L[1]); L[1] = fminf(L[0], L[1]); L[0] = _h; _h = fmaxf(L[2], L[3]); L[3] = fminf(L[2], L[3]); L[2] = _h; _h = fmaxf(L[4], L[5]); L[5] = fminf(L[4], L[5]); L[4] = _h; _h = fmaxf(L[6], L[7]); L[7] = fminf(L[6], L[7]); L[6] = _h; _h = fmaxf(L[8], L[9]); L[9] = fminf(L[8], L[9]); L[8] = _h; _h = fmaxf(L[10], L[11]); L[11] = fminf(L[10], L[11]); L[10] = _h; _h = fmaxf(L[12], L[13]); L[13] = fminf(L[12], L[13]); L[12] = _h; _h = fmaxf(L[14], L[15]); L[15] = fminf(L[14], L[15]); L[14] = _h; } while (0)
#define INS16(L, xin) do { float _x = (xin); _Pragma("unroll") for (int _p = 0; _p < 16; ++_p) { const float _hi = fmaxf(L[_p], _x); _x = fminf(L[_p], _x); L[_p] = _hi; } } while (0)
__device__ void phase_topk(const Params& p, unsigned char* lds) {
    const int tid = threadIdx.x, wid = tid >> 6, lane = tid & 63, r = lane & 31, hh = lane >> 5;
    const bf16_t* qp = (const bf16_t*)(p.ws + OFF_QP); const bf16_t* keysb = (const bf16_t*)(p.ws + OFF_KEYS);
    int* idxo = (int*)(p.ws + OFF_IDX); float* go = (float*)(p.ws + OFF_G);
    float* myrows = (float*)lds + wid * 32 * 129;
    const float NEG = -__builtin_inff();
    for (int tile = blockIdx.x; tile < 256; tile += gridDim.x) {
        const int tokb = tile * 64 + (wid & 1) * 32;
        float v1[16], v2[16];
#pragma unroll
        for (int j = 0; j < 16; ++j) { v1[j] = NEG; v2[j] = NEG; }
#pragma unroll 1
        for (int pass = 0; pass < 4; ++pass) {
            const int half = pass >> 1, hg = pass & 1, head = hg * 4 + (wid >> 1);
            f32x16 acc[4] = {zero16(), zero16(), zero16(), zero16()};
            const bf16_t* arow = qp + (size_t)(tokb + r) * 2048 + head * 256 + half * 128 + 8 * hh;
            const bf16_t* kb = keysb + half * 16384 + r * 128 + 8 * hh;
#pragma unroll
            for (int ks = 0; ks < 8; ++ks) { const bf16x8 a = *(const bf16x8*)(arow + 16 * ks);
#pragma unroll
                for (int nt = 0; nt < 4; ++nt) { const bf16x8 bb = *(const bf16x8*)(kb + nt * 32 * 128 + 16 * ks); acc[nt] = MFMA32(a, bb, acc[nt]); } }
#pragma unroll
            for (int nt = 0; nt < 4; ++nt)
#pragma unroll
                for (int e = 0; e < 16; ++e) { const int m = (e & 3) + 8 * (e >> 2) + 4 * hh; myrows[m * 129 + nt * 32 + r] = acc[nt][e]; }
            asm volatile("s_waitcnt lgkmcnt(0)" ::: "memory"); __builtin_amdgcn_wave_barrier();
            float L[16];
            const float* rowp = myrows + r * 129 + hh * 64;
#pragma unroll
            for (int j = 0; j < 16; ++j) L[j] = __uint_as_float((__float_as_uint(rowp[j]) & ~127u) | (unsigned)(127 - (hh * 64 + j)));
            SORT16(L);
#pragma unroll 1
            for (int g = 1; g < 4; ++g) {
                float Gp[16];
#pragma unroll
                for (int j = 0; j < 16; ++j) Gp[j] = __uint_as_float((__float_as_uint(rowp[g * 16 + j]) & ~127u) | (unsigned)(127 - (hh * 64 + g * 16 + j)));
                SORT16(Gp);
#pragma unroll
                for (int j = 0; j < 16; ++j) L[j] = fmaxf(L[j], Gp[15 - j]);
                BITONIC16(L);
            }
            {
                float O[16];
#pragma unroll
                for (int j = 0; j < 16; ++j) O[j] = __shfl_xor(L[j], 32);
#pragma unroll
                for (int j = 0; j < 16; ++j) L[j] = fmaxf(L[j], O[15 - j]);
                BITONIC16(L);
            }
            const bool mine = hh == hg;
            if (half == 0) {
#pragma unroll
                for (int j = 0; j < 16; ++j) v1[j] = mine ? L[j] : v1[j];
            } else {
#pragma unroll
                for (int j = 0; j < 16; ++j) v2[j] = mine ? L[j] : v2[j];
            }
            asm volatile("s_waitcnt lgkmcnt(0)" ::: "memory"); __builtin_amdgcn_wave_barrier();
        }
        float T[16]; int TI[16];
        int i1[16], i2[16];
#pragma unroll
        for (int j = 0; j < 16; ++j) { i1[j] = (127 - (int)(__float_as_uint(v1[j]) & 127u)) * 128; i2[j] = 127 - (int)(__float_as_uint(v2[j]) & 127u); }
#pragma unroll
        for (int j = 0; j < 16; ++j) { T[j] = v1[0] + v2[j]; TI[j] = i1[0] + i2[j]; }
#pragma unroll
        for (int a = 1; a < 16; ++a)
#pragma unroll
            for (int b = 0; b < 16; ++b)
                if ((a + 1) * (b + 1) <= 16) {
                    float s = v1[a] + v2[b]; int id = i1[a] + i2[b];
#pragma unroll
                    for (int q = (a + 1) * (b + 1) - 1; q < 16; ++q) { const bool c = s > T[q]; const float ts = c ? T[q] : s; const int ti = c ? TI[q] : id; T[q] = c ? s : T[q]; TI[q] = c ? id : TI[q]; s = ts; id = ti; }
                }
        const int token = tokb + r, head = hh * 4 + (wid >> 1);
        const float t0v = T[0]; float tot = 0.f;
#pragma unroll
        for (int j = 0; j < 16; ++j) { T[j] = __expf(T[j] - t0v); tot += T[j]; }
        const float inv = 1.0f / tot;
#pragma unroll
        for (int j = 0; j < 16; j += 4) { *(f32x4*)(go + (size_t)token * 128 + head * 16 + j) = (f32x4){T[j] * inv, T[j + 1] * inv, T[j + 2] * inv, T[j + 3] * inv};
            *(int4*)(idxo + (size_t)token * 128 + head * 16 + j) = make_int4(TI[j], TI[j + 1], TI[j + 2], TI[j + 3]); }
    }
}

__device__ void phase_peer(const Params& p, unsigned char* lds) {
    const int tid = threadIdx.x, wid = tid >> 6, lane = tid & 63, l16 = lane & 15, q4 = lane >> 4;
    const bf16_t* h2 = (const bf16_t*)(p.ws + OFF_H2); const bf16_t* db = (const bf16_t*)(p.ws + OFF_DOWN); const bf16_t* ub = (const bf16_t*)(p.ws + OFF_UP);
    const int* idxo = (const int*)(p.ws + OFF_IDX); const float* go = (const float*)(p.ws + OFF_G);
    const float* mod = (const float*)(p.ws + OFF_MOD);
    float* sga = (float*)lds + wid * 128;
    for (int tg = blockIdx.x * 8 + wid; tg < 2048; tg += gridDim.x * 8) {
        const int b = tg >> 10;
        for (int tt = 0; tt < 8; ++tt) {
            const int t = tg * 8 + tt;
            const int idA = idxo[(size_t)t * 128 + lane], idB = idxo[(size_t)t * 128 + 64 + lane];
            const float gA = go[(size_t)t * 128 + lane], gB = go[(size_t)t * 128 + 64 + lane];
            u32x4 hq[8];
#pragma unroll
            for (int i = 0; i < 8; ++i) hq[i] = *(const u32x4*)(h2 + (size_t)t * DM + i * 128 + l16 * 8);
#pragma unroll 2
            for (int s = 0; s < 32; ++s) {
                const int slot = 4 * s + q4;
                const int e = __shfl(s < 16 ? idA : idB, slot & 63);
                const bf16_t* row = db + (size_t)e * DM + l16 * 8;
                u32x4 w[8];
#pragma unroll
                for (int i = 0; i < 8; ++i) w[i] = *(const u32x4*)(row + i * 128);
                float a = 0.f;
#pragma unroll
                for (int i = 0; i < 8; ++i) {
                    a = dot2bf(w[i].x, hq[i].x, a); a = dot2bf(w[i].y, hq[i].y, a); a = dot2bf(w[i].z, hq[i].z, a); a = dot2bf(w[i].w, hq[i].w, a); }
                a += __shfl_xor(a, 8); a += __shfl_xor(a, 4); a += __shfl_xor(a, 2); a += __shfl_xor(a, 1);
                const float gg = __shfl(s < 16 ? gA : gB, slot & 63);
                if (l16 == 0) sga[slot] = gelu1(a) * gg;
            }
            asm volatile("s_waitcnt lgkmcnt(0)" ::: "memory"); __builtin_amdgcn_wave_barrier();
            float acc[16];
#pragma unroll
            for (int j = 0; j < 16; ++j) acc[j] = 0.f;
#pragma unroll 4
            for (int slot = 0; slot < 128; ++slot) {
                const int e = __builtin_amdgcn_readlane(slot < 64 ? idA : idB, slot & 63);
                const float ga = sga[slot];
                const bf16_t* row = ub + (size_t)e * DM + lane * 8;
                const u32x4 w0 = *(const u32x4*)row, w1 = *(const u32x4*)(row + 512);
                acc[0] += ga * bflo(w0.x); acc[1] += ga * bfhi(w0.x); acc[2] += ga * bflo(w0.y); acc[3] += ga * bfhi(w0.y);
                acc[4] += ga * bflo(w0.z); acc[5] += ga * bfhi(w0.z); acc[6] += ga * bflo(w0.w); acc[7] += ga * bfhi(w0.w);
                acc[8] += ga * bflo(w1.x); acc[9] += ga * bfhi(w1.x); acc[10] += ga * bflo(w1.y); acc[11] += ga * bfhi(w1.y);
                acc[12] += ga * bflo(w1.z); acc[13] += ga * bfhi(w1.z); acc[14] += ga * bflo(w1.w); acc[15] += ga * bfhi(w1.w);
            }
            asm volatile("s_waitcnt lgkmcnt(0)" ::: "memory"); __builtin_amdgcn_wave_barrier();
            float xo[16]; float ss = 0.f;
#pragma unroll
            for (int i = 0; i < 2; ++i)
#pragma unroll
                for (int j4 = 0; j4 < 2; ++j4) { const int d = i * 512 + lane * 8 + j4 * 4;
                    const f32x4 xv = *(const f32x4*)(p.out + (size_t)t * DM + d);
                    const f32x4 g2 = *(const f32x4*)(mod + b * 6144 + 5120 + d) + *(const f32x4*)(p.b_ada + 5120 + d);
#pragma unroll
                    for (int j = 0; j < 4; ++j) { const float v = xv[j] + g2[j] * acc[i * 8 + j4 * 4 + j]; xo[i * 8 + j4 * 4 + j] = v; ss += v * v; } }
            ss = wave_sum(ss);
            const float rstd = rsqrtf(ss * (1.0f / 1024.0f) + EPS);
#pragma unroll
            for (int i = 0; i < 2; ++i)
#pragma unroll
                for (int j4 = 0; j4 < 2; ++j4) { const int d = i * 512 + lane * 8 + j4 * 4;
                    const f32x4 fw = *(const f32x4*)(p.final_w + d);
                    *(f32x4*)(p.out + (size_t)t * DM + d) = (f32x4){xo[i * 8 + j4 * 4] * rstd * fw[0], xo[i * 8 + j4 * 4 + 1] * rstd * fw[1], xo[i * 8 + j4 * 4 + 2] * rstd * fw[2], xo[i * 8 + j4 * 4 + 3] * rstd * fw[3]}; }
        }
    }
}

__device__ void phase_tables8(const Params& p) {
    const int wid = threadIdx.x >> 6, lane = threadIdx.x & 63;
    const int row0 = blockIdx.x * 8 + wid, rstep = gridDim.x * 8;
    f32x4 vn[4];
    if (row0 < 32768) { const float* src0 = (row0 >= 16384 ? p.up : p.down) + (size_t)(row0 & 16383) * DM + lane * 16;
#pragma unroll
        for (int i = 0; i < 4; ++i) vn[i] = __builtin_nontemporal_load((const f32x4*)(src0 + 4 * i)); }
    for (int row = row0; row < 32768; row += rstep) {
        const bool isup = row >= 16384; const int e = row & 16383;
        f32x4 v[4]; float m = 0.f;
#pragma unroll
        for (int i = 0; i < 4; ++i) v[i] = vn[i];
        if (row + rstep < 32768) { const int rn = row + rstep; const float* srcn = (rn >= 16384 ? p.up : p.down) + (size_t)(rn & 16383) * DM + lane * 16;
#pragma unroll
            for (int i = 0; i < 4; ++i) vn[i] = __builtin_nontemporal_load((const f32x4*)(srcn + 4 * i)); }
#pragma unroll
        for (int i = 0; i < 4; ++i) { m = fmaxf(m, fmaxf(fmaxf(fabsf(v[i][0]), fabsf(v[i][1])), fmaxf(fabsf(v[i][2]), fabsf(v[i][3])))); }
#pragma unroll
        for (int o = 32; o; o >>= 1) m = fmaxf(m, __shfl_xor(m, o));
        const float qmax = isup ? 224.0f : 127.0f;
        const float sc = m > 0.f ? m / qmax : 1.0f, inv = m > 0.f ? qmax / m : 0.f;
        int w[4];
        if (isup) {
#pragma unroll
            for (int i = 0; i < 4; ++i) { w[i] = __builtin_amdgcn_cvt_pk_fp8_f32(v[i][0] * inv, v[i][1] * inv, 0, false); w[i] = __builtin_amdgcn_cvt_pk_fp8_f32(v[i][2] * inv, v[i][3] * inv, w[i], true); }
        } else {
#pragma unroll
            for (int i = 0; i < 4; ++i) { const int q0 = (int)rintf(v[i][0] * inv), q1 = (int)rintf(v[i][1] * inv), q2 = (int)rintf(v[i][2] * inv), q3 = (int)rintf(v[i][3] * inv);
                w[i] = (q0 & 255) | ((q1 & 255) << 8) | ((q2 & 255) << 16) | ((q3 & 255) << 24); }
        }
        unsigned char* dst = p.ws + (isup ? OFF_UP8 : OFF_DOWN8) + (size_t)e * 1024 + lane * 16;
        *(u32x4*)dst = (u32x4){(unsigned)w[0], (unsigned)w[1], (unsigned)w[2], (unsigned)w[3]};
        if (lane == 0) ((float*)(p.ws + (isup ? OFF_SCU : OFF_SCD)))[e] = sc;
    }
}

__device__ __forceinline__ float dot2bfv(bf16x2_t a, unsigned b, float c) { return __builtin_amdgcn_fdot2_f32_bf16(a, __builtin_bit_cast(bf16x2_t, b), c, false); }
#define PEER_FMA16(ACC, W, GA) do { \
    const f32x2 _a0 = __builtin_amdgcn_cvt_pk_f32_fp8((int)(W).x, false), _a1 = __builtin_amdgcn_cvt_pk_f32_fp8((int)(W).x, true); \
    const f32x2 _b0 = __builtin_amdgcn_cvt_pk_f32_fp8((int)(W).y, false), _b1 = __builtin_amdgcn_cvt_pk_f32_fp8((int)(W).y, true); \
    const f32x2 _c0 = __builtin_amdgcn_cvt_pk_f32_fp8((int)(W).z, false), _c1 = __builtin_amdgcn_cvt_pk_f32_fp8((int)(W).z, true); \
    const f32x2 _d0 = __builtin_amdgcn_cvt_pk_f32_fp8((int)(W).w, false), _d1 = __builtin_amdgcn_cvt_pk_f32_fp8((int)(W).w, true); \
    ACC[0] = __builtin_fmaf((GA), _a0.x, ACC[0]); ACC[1] = __builtin_fmaf((GA), _a0.y, ACC[1]); ACC[2] = __builtin_fmaf((GA), _a1.x, ACC[2]); ACC[3] = __builtin_fmaf((GA), _a1.y, ACC[3]); \
    ACC[4] = __builtin_fmaf((GA), _b0.x, ACC[4]); ACC[5] = __builtin_fmaf((GA), _b0.y, ACC[5]); ACC[6] = __builtin_fmaf((GA), _b1.x, ACC[6]); ACC[7] = __builtin_fmaf((GA), _b1.y, ACC[7]); \
    ACC[8] = __builtin_fmaf((GA), _c0.x, ACC[8]); ACC[9] = __builtin_fmaf((GA), _c0.y, ACC[9]); ACC[10] = __builtin_fmaf((GA), _c1.x, ACC[10]); ACC[11] = __builtin_fmaf((GA), _c1.y, ACC[11]); \
    ACC[12] = __builtin_fmaf((GA), _d0.x, ACC[12]); ACC[13] = __builtin_fmaf((GA), _d0.y, ACC[13]); ACC[14] = __builtin_fmaf((GA), _d1.x, ACC[14]); ACC[15] = __builtin_fmaf((GA), _d1.y, ACC[15]); } while (0)
__device__ void phase_peer2(const Params& p, unsigned char* lds) {
    const int tid = threadIdx.x, wid = tid >> 6, lane = tid & 63, l16 = lane & 15, q4 = lane >> 4;
    unsigned char* wl = lds + wid * 6144;
    int* se = (int*)wl;
    float* sg = (float*)(wl + 2048);
    float* sa = (float*)(wl + 4096);
    const unsigned char* d8 = p.ws + OFF_DOWN8; const unsigned char* u8 = p.ws + OFF_UP8;
    const float* scd = (const float*)(p.ws + OFF_SCD); const float* scu = (const float*)(p.ws + OFF_SCU);
    const bf16_t* h2 = (const bf16_t*)(p.ws + OFF_H2);
    const int* idxo = (const int*)(p.ws + OFF_IDX); const float* go = (const float*)(p.ws + OFF_G);
    const float* mod = (const float*)(p.ws + OFF_MOD);
    const unsigned long long ltmask = (1ull << lane) - 1ull;
    for (int blk2 = blockIdx.x * 2; blk2 < 512; blk2 += (blk2 & 1) ? 2 * gridDim.x - 1 : 1) {
        const int blk = blk2; const int tok0 = blk * 32 + wid * 4; const int b = tok0 >> 13;
#pragma unroll
        for (int tk = 0; tk < 4; ++tk) { const size_t o = (size_t)(tok0 + tk) * 128 + lane;
            const int idA = idxo[o], idB = idxo[o + 64]; const float gA = go[o], gB = go[o + 64];
            int base = 0;
#pragma unroll
            for (int r = 0; r < 8; ++r) {
                const bool mA = (idA >> 11) == r, mB = (idB >> 11) == r; const unsigned long long kA = __ballot(mA), kB = __ballot(mB);
                if (mA) { const int pos = tk * 128 + base + __popcll(kA & ltmask); se[pos] = idA; sg[pos] = gA; }
                base += __popcll(kA);
                if (mB) { const int pos = tk * 128 + base + __popcll(kB & ltmask); se[pos] = idB; sg[pos] = gB; }
                base += __popcll(kB); } }
        int hq8[16]; float hscale;
        {
            u32x4 hraw[4][2]; float hm = 0.f;
#pragma unroll
            for (int i = 0; i < 4; ++i)
#pragma unroll
                for (int j = 0; j < 2; ++j) { hraw[i][j] = *(const u32x4*)(h2 + (size_t)(tok0 + q4) * DM + i * 256 + l16 * 16 + j * 8);
                    const unsigned ww[4] = {hraw[i][j].x, hraw[i][j].y, hraw[i][j].z, hraw[i][j].w};
#pragma unroll
                    for (int c = 0; c < 4; ++c) hm = fmaxf(hm, fmaxf(fabsf(bflo(ww[c])), fabsf(bfhi(ww[c])))); }
            hm = fmaxf(hm, __shfl_xor(hm, 8)); hm = fmaxf(hm, __shfl_xor(hm, 4)); hm = fmaxf(hm, __shfl_xor(hm, 2)); hm = fmaxf(hm, __shfl_xor(hm, 1));
            hscale = hm > 0.f ? hm * (1.0f / 127.0f) : 1.0f; const float hinv = hm > 0.f ? 127.0f / hm : 0.f;
#pragma unroll
            for (int i = 0; i < 4; ++i)
#pragma unroll
                for (int j = 0; j < 2; ++j) { const unsigned ww[4] = {hraw[i][j].x, hraw[i][j].y, hraw[i][j].z, hraw[i][j].w};
#pragma unroll
                    for (int c2 = 0; c2 < 2; ++c2) { const int q0 = (int)rintf(bflo(ww[2 * c2]) * hinv), q1 = (int)rintf(bfhi(ww[2 * c2]) * hinv), q2 = (int)rintf(bflo(ww[2 * c2 + 1]) * hinv), q3 = (int)rintf(bfhi(ww[2 * c2 + 1]) * hinv);
                        hq8[i * 4 + j * 2 + c2] = (q0 & 255) | ((q1 & 255) << 8) | ((q2 & 255) << 16) | ((q3 & 255) << 24); } }
        }
        asm volatile("s_waitcnt lgkmcnt(0)" ::: "memory"); __builtin_amdgcn_wave_barrier();
        {
            u32x4 bufA[8], bufB[8]; float sdA[2], sdB[2];
#define PEER_DLOAD(BUF, SD, K) do { _Pragma("unroll") for (int _u = 0; _u < 2; ++_u) { const int _e = se[q4 * 128 + 2 * (K) + _u]; const unsigned char* _row = d8 + (size_t)_e * 1024 + l16 * 16; \
            _Pragma("unroll") for (int _i = 0; _i < 4; ++_i) BUF[_u * 4 + _i] = *(const u32x4*)(_row + _i * 256); SD[_u] = scd[_e]; } } while (0)
#define PEER_DCOMP(BUF, SD, K) do { _Pragma("unroll") for (int _u = 0; _u < 2; ++_u) { int _ai = 0; \
            _Pragma("unroll") for (int _i = 0; _i < 4; ++_i) { const u32x4 _w = BUF[_u * 4 + _i]; \
                _ai = __builtin_amdgcn_sdot4((int)_w.x, hq8[_i * 4], _ai, false); _ai = __builtin_amdgcn_sdot4((int)_w.y, hq8[_i * 4 + 1], _ai, false); \
                _ai = __builtin_amdgcn_sdot4((int)_w.z, hq8[_i * 4 + 2], _ai, false); _ai = __builtin_amdgcn_sdot4((int)_w.w, hq8[_i * 4 + 3], _ai, false); } \
            _ai += __shfl_xor(_ai, 8); _ai += __shfl_xor(_ai, 4); _ai += __shfl_xor(_ai, 2); _ai += __shfl_xor(_ai, 1); \
            if (l16 == 0) sa[q4 * 128 + 2 * (K) + _u] = (float)_ai * SD[_u] * hscale; } } while (0)
            PEER_DLOAD(bufA, sdA, 0);
            for (int k = 0; k < 64; k += 2) {
                PEER_DLOAD(bufB, sdB, k + 1);
                PEER_DCOMP(bufA, sdA, k);
                if (k + 2 < 64) PEER_DLOAD(bufA, sdA, k + 2);
                PEER_DCOMP(bufB, sdB, k + 1);
            }
#undef PEER_DLOAD
#undef PEER_DCOMP
            asm volatile("s_waitcnt lgkmcnt(0)" ::: "memory"); __builtin_amdgcn_wave_barrier();
#pragma unroll
            for (int j = 0; j < 8; ++j) { const int ix = lane + 64 * j; const int e = se[ix]; sg[ix] = gelu1(sa[ix]) * sg[ix] * scu[e]; }
        }
        asm volatile("s_waitcnt lgkmcnt(0)" ::: "memory"); __builtin_amdgcn_wave_barrier();
        float acc0[16], acc1[16], acc2[16], acc3[16];
#pragma unroll
        for (int j = 0; j < 16; ++j) { acc0[j] = 0.f; acc1[j] = 0.f; acc2[j] = 0.f; acc3[j] = 0.f; }
        {
            u32x4 ring[12];
#pragma unroll
            for (int j = 0; j < 12; ++j) ring[j] = *(const u32x4*)(u8 + (size_t)se[(j & 3) * 128 + (j >> 2)] * 1024 + lane * 16);
            for (int i = 0; i < 129; i += 3) {
#pragma unroll
                for (int j = 0; j < 12; ++j) {
                    const int tk = j & 3, st = i + (j >> 2);
                    if (st >= 128) break;
                    const float ga = sg[tk * 128 + st];
                    const u32x4 w = ring[j];
                    if (st + 3 < 128) ring[j] = *(const u32x4*)(u8 + (size_t)se[tk * 128 + st + 3] * 1024 + lane * 16);
                    if (tk == 0) PEER_FMA16(acc0, w, ga); else if (tk == 1) PEER_FMA16(acc1, w, ga); else if (tk == 2) PEER_FMA16(acc2, w, ga); else PEER_FMA16(acc3, w, ga);
                }
            }
        }
        asm volatile("s_waitcnt lgkmcnt(0)" ::: "memory"); __builtin_amdgcn_wave_barrier();
#define PEER_FIN(ACC, TK) do { const size_t _o = (size_t)(tok0 + (TK)) * DM + lane * 16; f32x4 _x[4]; float _ss = 0.f; \
        _Pragma("unroll") for (int _j = 0; _j < 4; ++_j) { const f32x4 _xv = *(const f32x4*)(p.out + _o + 4 * _j); const f32x4 _g2 = *(const f32x4*)(mod + b * 6144 + 5120 + lane * 16 + 4 * _j) + *(const f32x4*)(p.b_ada + 5120 + lane * 16 + 4 * _j); \
            _x[_j] = _xv + _g2 * (f32x4){ACC[4 * _j], ACC[4 * _j + 1], ACC[4 * _j + 2], ACC[4 * _j + 3]}; _ss += _x[_j][0] * _x[_j][0] + _x[_j][1] * _x[_j][1] + _x[_j][2] * _x[_j][2] + _x[_j][3] * _x[_j][3]; } \
        _ss = wave_sum(_ss); const float _rs = rsqrtf(_ss * (1.0f / 1024.0f) + EPS); \
        _Pragma("unroll") for (int _j = 0; _j < 4; ++_j) { const f32x4 _fw = *(const f32x4*)(p.final_w + lane * 16 + 4 * _j); *(f32x4*)(p.out + _o + 4 * _j) = _x[_j] * _rs * _fw; } } while (0)
        PEER_FIN(acc0, 0); PEER_FIN(acc1, 1); PEER_FIN(acc2, 2); PEER_FIN(acc3, 3);
#undef PEER_FIN
    }
}

#ifndef DBG_STAGE
#define DBG_STAGE 0
#endif
__device__ void phase_final_only(const Params& p) {
    const int wid = threadIdx.x >> 6, lane = threadIdx.x & 63;
    for (int t = blockIdx.x * 8 + wid; t < NTOK; t += gridDim.x * 8) {
        f32x4 xv[4]; float ss = 0.f;
#pragma unroll
        for (int i = 0; i < 4; ++i) { xv[i] = *(const f32x4*)(p.out + (size_t)t * DM + 256 * i + 4 * lane); ss += xv[i][0] * xv[i][0] + xv[i][1] * xv[i][1] + xv[i][2] * xv[i][2] + xv[i][3] * xv[i][3]; }
        ss = wave_sum(ss);
        const float rstd = rsqrtf(ss * (1.0f / 1024.0f) + EPS);
#pragma unroll
        for (int i = 0; i < 4; ++i) { const f32x4 fw = *(const f32x4*)(p.final_w + 256 * i + 4 * lane); *(f32x4*)(p.out + (size_t)t * DM + 256 * i + 4 * lane) = xv[i] * rstd * fw; }
    }
}

__device__ void phase_dump_bf16(const Params& p, const bf16_t* src, int ld) {
    for (size_t e = (size_t)blockIdx.x * 512 + threadIdx.x; e < (size_t)NTOK * DM; e += (size_t)gridDim.x * 512) {
        const size_t t = e >> 10, d = e & 1023; float v = __uint_as_float((unsigned)src[t * ld + d] << 16); if (!(fabsf(v) < 1e30f)) v = 1000.f; p.out[e] = v; }
}
__device__ void dbg_check_bf16(const Params& p, const bf16_t* src, size_t n, unsigned bit) {
    unsigned* flags = (unsigned*)(p.ws + OFF_IDX);
    bool bad = false;
    for (size_t e = (size_t)blockIdx.x * 512 + threadIdx.x; e < n; e += (size_t)gridDim.x * 512) { const float v = __uint_as_float((unsigned)src[e] << 16); if (!(fabsf(v) < 1e30f)) bad = true; }
    if (bad) atomicOr(flags, bit);
}
__device__ void dbg_check_f32(const Params& p, const float* src, size_t n, unsigned bit, float lim) {
    unsigned* flags = (unsigned*)(p.ws + OFF_IDX);
    bool bad = false;
    for (size_t e = (size_t)blockIdx.x * 512 + threadIdx.x; e < n; e += (size_t)gridDim.x * 512) { const float v = src[e]; if (!(fabsf(v) < lim)) bad = true; }
    if (bad) atomicOr(flags, bit);
}
__device__ void dbg_final(const Params& p) {
    const unsigned f = *(const unsigned*)(p.ws + OFF_IDX);
    for (size_t e = (size_t)blockIdx.x * 512 + threadIdx.x; e < (size_t)NTOK * DM; e += (size_t)gridDim.x * 512) p.out[e] = p.x[e] * (1.0f + (float)f);
}
#define GSYNC() xcd_barrier(xb)
__global__ void __launch_bounds__(512, 2) fwd_megakernel(Params p) {
    extern __shared__ __attribute__((aligned(16))) unsigned char lds[];
    cg::grid_group grid = cg::this_grid();
    LAS unsigned char* lds3 = (LAS unsigned char*)lds;
    const float* mod = (const float*)(p.ws + OFF_MOD);
    volatile LAS unsigned* xst = (volatile LAS unsigned*)(lds3 + LDS_BYTES - 16);
    if (threadIdx.x == 0) { xst[0] = 0u; xst[1] = 0u; }
    __syncthreads();
    const XcdBarrier xb = xcd_barrier_post((unsigned*)(p.ws + OFF_BAR), xst);
    if (p.ws == nullptr) grid.sync();
    phase0(p, lds);
#if DBG_STAGE == 6
    if (blockIdx.x == 0 && threadIdx.x == 0) *(unsigned*)(p.ws + OFF_IDX) = 0u;
#endif
    GSYNC();
    phase_norm<true>(p, p.x, p.norm1_w, 0, 1024, (bf16_t*)(p.ws + OFF_HB), lds);
    GSYNC();
#if DBG_STAGE == 3
    phase_dump_bf16(p, (const bf16_t*)(p.ws + OFF_HB), DM); return;
#endif
    { pg8::StaticOrder S; S.init(NTOK, 7168, gridDim.x, blockIdx.x); EpiProj E{(bf16_t*)(p.ws + OFF_PROJ)};
        pg8::gemm_phase(lds3, pg8::Gemm{(const bf16_t*)(p.ws + OFF_HB), (const bf16_t*)(p.ws + OFF_WINT), NTOK, 7168, 1024}, S, E); }
    GSYNC();
#if DBG_STAGE == 2
    phase_dump_bf16(p, (const bf16_t*)(p.ws + OFF_PROJ) + 1024, PW); return;
#endif
    phase_glaA(p, lds);
    GSYNC();
#if DBG_STAGE == 6
    dbg_check_bf16(p, (const bf16_t*)p.out, (size_t)NTOK * 2048, 1u);
    dbg_check_f32(p, (const float*)(p.ws + OFF_ALR), (size_t)NTOK * 16, 8u, 50.f);
    dbg_check_f32(p, (const float*)(p.ws + OFF_DECAY), (size_t)1024 * 128, 16u, 1.0001f);
#endif
    phase_scan_sgu(p, lds);
    GSYNC();
#if DBG_STAGE == 6
    dbg_check_bf16(p, (const bf16_t*)p.out, (size_t)NTOK * 2048, 2u);
#endif
#if DBG_STAGE == 4
    phase_dump_bf16(p, (const bf16_t*)(p.ws + OFF_HB), DM); return;
#endif
    phase_glaC(p, lds);
    GSYNC();
#if DBG_STAGE == 5
    phase_dump_bf16(p, (const bf16_t*)(p.ws + OFF_HB), DM); return;
#endif
#if DBG_STAGE == 6
    dbg_check_bf16(p, (const bf16_t*)(p.ws + OFF_HB), (size_t)NTOK * DM, 4u);
    GSYNC();
    dbg_final(p); return;
#endif
    { pg8::StaticOrder S; S.init(NTOK, 1024, gridDim.x, blockIdx.x); EpiX1 E{p.x, p.out, mod, p.b_ada};
        pg8::gemm_phase(lds3, pg8::Gemm{(const bf16_t*)(p.ws + OFF_HB), (const bf16_t*)(p.ws + OFF_WOUTT), NTOK, 1024, 1024}, S, E); }
    GSYNC();
#if DBG_STAGE == 1
    phase_final_only(p); return;
#endif
    phase_norm<false>(p, p.out, p.norm2_w, 3072, 4096, (bf16_t*)(p.ws + OFF_H2), lds);
    phase_tables8(p);
    GSYNC();
    { pg8::StaticOrder S; S.init(NTOK, 2048, gridDim.x, blockIdx.x); EpiQ E{(bf16_t*)(p.ws + OFF_QP)};
        pg8::gemm_phase(lds3, pg8::Gemm{(const bf16_t*)(p.ws + OFF_H2), (const bf16_t*)(p.ws + OFF_WQT), NTOK, 2048, 1024}, S, E); }
    GSYNC();
    phase_topk(p, lds);
    asm volatile("s_waitcnt vmcnt(0) lgkmcnt(0)" ::: "memory"); __syncthreads();
    phase_peer2(p, lds);
}

extern "C" void kernel_launch(void* const* d_in, const int* in_sizes, int n_in, void* d_out, int out_size, void* d_ws, size_t ws_size, hipStream_t stream) {
    static int grid_blocks = 0;
    if (!grid_blocks) {
        int dev = 0, cus = 0, per_cu = 0;
        hipGetDevice(&dev);
        hipDeviceGetAttribute(&cus, hipDeviceAttributeMultiprocessorCount, dev);
        hipFuncSetAttribute((const void*)fwd_megakernel, hipFuncAttributeMaxDynamicSharedMemorySize, LDS_BYTES);
        hipOccupancyMaxActiveBlocksPerMultiprocessor(&per_cu, (const void*)fwd_megakernel, 512, LDS_BYTES);
        per_cu = 1;
        grid_blocks = cus * per_cu;
        if (ws_size < WS_END) fprintf(stderr, "kernel_launch: workspace too small (%zu < %zu)\n", ws_size, (size_t)WS_END);
    }
    Params p{};
    p.x = (const float*)d_in[0]; p.c = (const float*)d_in[1]; p.w_ada = (const float*)d_in[2]; p.b_ada = (const float*)d_in[3]; p.norm1_w = (const float*)d_in[4];
    p.w_in = (const float*)d_in[5]; p.w_alpha_up = (const float*)d_in[6]; p.b_alpha = (const float*)d_in[7]; p.gla_norm_w = (const float*)d_in[8];
    p.sgu_ln_w = (const float*)d_in[9]; p.sgu_ln_b = (const float*)d_in[10]; p.sgu_w = (const float*)d_in[11]; p.sgu_b = (const float*)d_in[12];
    p.w_out = (const float*)d_in[13]; p.norm2_w = (const float*)d_in[14]; p.w_q = (const float*)d_in[15]; p.keys1 = (const float*)d_in[16]; p.keys2 = (const float*)d_in[17];
    p.down = (const float*)d_in[18]; p.up = (const float*)d_in[19]; p.final_w = (const float*)d_in[20];
    p.out = (float*)d_out; p.ws = (unsigned char*)d_ws;
    hipMemsetAsync((unsigned char*)d_ws + OFF_BAR, 0, XCD_BAR_WORDS * 4, stream);
    void* args[] = {&p};
    hipError_t e = hipLaunchCooperativeKernel((const void*)fwd_megakernel, dim3(grid_blocks), dim3(512), args, LDS_BYTES, stream);
    if (e != hipSuccess) fprintf(stderr, "cooperative launch failed: %s (grid %d)\n", hipGetErrorString(e), grid_blocks);
}
```

```cpp
#include <hip/hip_runtime.h>
#include <hip/hip_cooperative_groups.h>
#include <cstdio>
namespace cg = cooperative_groups;

#define LAS __attribute__((address_space(3)))
typedef unsigned short bf16_t;
typedef short bf16x8 __attribute__((ext_vector_type(8)));
typedef float f32x2 __attribute__((ext_vector_type(2)));
typedef float f32x4 __attribute__((ext_vector_type(4)));
typedef float f32x16 __attribute__((ext_vector_type(16)));
typedef unsigned u32x2 __attribute__((ext_vector_type(2)));
typedef unsigned u32x4 __attribute__((ext_vector_type(4)));
typedef __bf16 bf16x2_t __attribute__((ext_vector_type(2)));

constexpr int NTOK = 16384, DM = 1024, SEQ = 8192, INW = 7184, PW = 5120;
constexpr float EPS = 1e-6f;
constexpr size_t MiB = 1024 * 1024;
constexpr size_t OFF_PROJ = 0;
constexpr size_t OFF_DOWN = 0;
constexpr size_t OFF_UP = 32 * MiB;
constexpr size_t OFF_DOWN8 = 0;
constexpr size_t OFF_UP8 = 16 * MiB;
constexpr size_t OFF_SCD = 32 * MiB;
constexpr size_t OFF_SCU = 32 * MiB + 65536;
constexpr size_t OFF_H2 = 64 * MiB;
constexpr size_t OFF_QP = 96 * MiB;
constexpr size_t OFF_HB = 160 * MiB;
constexpr size_t OFF_WINT = 192 * MiB;
constexpr size_t OFF_WOUTT = 206 * MiB;
constexpr size_t OFF_WQT = 208 * MiB;
constexpr size_t OFF_KEYS = 212 * MiB;
constexpr size_t OFF_MOD = OFF_KEYS + 65536;
constexpr size_t OFF_ALR = OFF_MOD + 65536;
constexpr size_t OFF_STATS = OFF_ALR + MiB;
constexpr size_t OFF_DECAY = OFF_STATS + 131072;
constexpr size_t OFF_BAR = OFF_DECAY + 524288;
constexpr size_t OFF_IDX = 214 * MiB;
constexpr size_t OFF_G = 222 * MiB;
constexpr size_t WS_END = 230 * MiB;
constexpr int LDS_BYTES = 135168;

struct Params {
    const float *x, *c, *w_ada, *b_ada, *norm1_w, *w_in, *w_alpha_up, *b_alpha, *gla_norm_w, *sgu_ln_w, *sgu_ln_b, *sgu_w, *sgu_b, *w_out, *norm2_w, *w_q, *keys1, *keys2, *down, *up, *final_w;
    float* out; unsigned char* ws;
};

__device__ __forceinline__ unsigned cvt_pk_bf16_asm(float lo, float hi) { unsigned r; asm volatile("v_cvt_pk_bf16_f32 %0, %1, %2" : "=v"(r) : "v"(lo), "v"(hi)); return r; }
__device__ __forceinline__ unsigned cvt_pk_bf16(float lo, float hi) { f32x2 v = {lo, hi}; bf16x2_t b = __builtin_convertvector(v, bf16x2_t); return __builtin_bit_cast(unsigned, b); }
__device__ __forceinline__ float bflo(unsigned w) { return __uint_as_float(w << 16); }
__device__ __forceinline__ float bfhi(unsigned w) { return __uint_as_float(w & 0xffff0000u); }
__device__ __forceinline__ float wave_sum(float v) {
#pragma unroll
    for (int o = 32; o; o >>= 1) v += __shfl_xor(v, o);
    return v;
}
__device__ __forceinline__ float sigmoidf_(float x) { return __builtin_amdgcn_rcpf(1.0f + __expf(-x)); }
__device__ __forceinline__ f32x2 gelu_pk(f32x2 v) {
    const f32x2 av = __builtin_elementwise_abs(v), d = av * 0.2316418882f + 1.0f;
    f32x2 t; t.x = __builtin_amdgcn_rcpf(d.x); t.y = __builtin_amdgcn_rcpf(d.y);
    f32x2 q = t * 0.5307027145f + (-0.7265760135f); q = q * t + 0.7107068705f; q = q * t + (-0.142248368f); q = q * t + 0.127414796f; q = q * t;
    const f32x2 s = (v * v) * (-0.72134752044f);
    f32x2 e; e.x = __builtin_amdgcn_exp2f(s.x); e.y = __builtin_amdgcn_exp2f(s.y);
    const f32x2 m = v * (q * e), r = v - m;
    f32x2 o; o.x = v.x < 0.f ? m.x : r.x; o.y = v.y < 0.f ? m.y : r.y; return o;
}
__device__ __forceinline__ float gelu1(float v) { f32x2 r = gelu_pk((f32x2){v, v}); return r.x; }
__device__ __forceinline__ f32x16 zero16() { f32x16 z;
#pragma unroll
    for (int i = 0; i < 16; ++i) z[i] = 0.f;
    return z; }
__device__ __forceinline__ float dot2bf(unsigned a, unsigned b, float c) { return __builtin_amdgcn_fdot2_f32_bf16(__builtin_bit_cast(bf16x2_t, a), __builtin_bit_cast(bf16x2_t, b), c, false); }
#define MFMA32(a, b, c) __builtin_amdgcn_mfma_f32_32x32x16_bf16((a), (b), (c), 0, 0, 0)


#define XB_TMO      128
#define XB_XCNT(j)  (256  + 64 * (j))
#define XB_XSUB(j)  (1280 + 64 * (j))
#define XB_XGEN(j)  (2304 + 64 * (j))
#define XB_TOP      3328
#define XB_TOPGEN   3392
#define XCD_BAR_WORDS 3456
#define XB_SPIN_CAP (1u << 18)
__device__ __forceinline__ unsigned xb_ld(unsigned* p)              { return __hip_atomic_load(p, __ATOMIC_RELAXED, __HIP_MEMORY_SCOPE_AGENT); }
__device__ __forceinline__ unsigned xb_add(unsigned* p, unsigned v) { return __hip_atomic_fetch_add(p, v, __ATOMIC_RELAXED, __HIP_MEMORY_SCOPE_AGENT); }
__device__ __forceinline__ unsigned xb_xcc_id() { return (unsigned)__builtin_amdgcn_s_getreg((3 << 11) | 20) & 0xFu; }
#define XB_SPIN(cond, bar) do { unsigned _sp = 0; while (cond) { __builtin_amdgcn_s_sleep(1); \
    if ((++_sp & 255u) == 0u) { if (xb_ld(&(bar)[XB_TMO])) break; if (_sp > XB_SPIN_CAP) { atomicAdd(&(bar)[XB_TMO], 1u); break; } } } } while (0)
struct XcdBarrier { unsigned* bar; unsigned x; volatile LAS unsigned* st; };
__device__ __forceinline__ XcdBarrier xcd_barrier_post(unsigned* bar, volatile LAS unsigned* st) {
    XcdBarrier b; b.bar = bar; b.x = xb_xcc_id(); b.st = st;
    if (threadIdx.x == 0) (void)xb_add(&bar[XB_XCNT(b.x)], 1u);
    return b;
}
__device__ __forceinline__ void xcd_barrier_complete(unsigned* bar, unsigned x, unsigned& nloc, unsigned& nx) {
    const unsigned G = gridDim.x * gridDim.y * gridDim.z;
    unsigned sum, cnt, mine, sp = 0u;
    for (;;) {
        sum = 0u; cnt = 0u; mine = 0u;
#pragma unroll
        for (unsigned j = 0; j < 16; ++j) { const unsigned c = xb_ld(&bar[XB_XCNT(j)]); sum += c; cnt += (c > 0u) ? 1u : 0u; mine = (j == x) ? c : mine; }
        if (sum == G) break;
        __builtin_amdgcn_s_sleep(1);
        if ((++sp & 255u) == 0u) { if (xb_ld(&bar[XB_TMO])) break; if (sp > XB_SPIN_CAP) { atomicAdd(&bar[XB_TMO], 1u); break; } }
    }
    nloc = mine > 0u ? mine : 1u; nx = cnt > 0u ? cnt : 1u;
}
__device__ __forceinline__ void xcd_barrier(const XcdBarrier& b) {
    asm volatile("s_waitcnt vmcnt(0)" ::: "memory");
    __syncthreads();
    if (threadIdx.x == 0) {
        unsigned* bar = b.bar;
        __builtin_amdgcn_s_waitcnt(0);
        unsigned nloc = b.st[0], nx = b.st[1];
        if (nloc == 0u) { xcd_barrier_complete(bar, b.x, nloc, nx); b.st[0] = nloc; b.st[1] = nx; }
        const unsigned old = xb_add(&bar[XB_XSUB(b.x)], 1u);
        const unsigned gen = old / nloc;
        if (old + 1u == (gen + 1u) * nloc) {
            __builtin_amdgcn_fence(__ATOMIC_RELEASE, "agent");
            asm volatile("s_waitcnt vmcnt(0)" ::: "memory");
            const unsigned og = xb_add(&bar[XB_TOP], 1u);
            const unsigned tg = og / nx;
            if (og + 1u == (tg + 1u) * nx) xb_add(&bar[XB_TOPGEN], 1u);
            else XB_SPIN(xb_ld(&bar[XB_TOPGEN]) == tg, bar);
            __builtin_amdgcn_fence(__ATOMIC_ACQUIRE, "agent");
            xb_add(&bar[XB_XGEN(b.x)], 1u);
            asm volatile("s_waitcnt vmcnt(0)" ::: "memory");
        } else {
            XB_SPIN(xb_ld(&bar[XB_XGEN(b.x)]) == gen, bar);
            __builtin_amdgcn_fence(__ATOMIC_ACQUIRE, "agent");
            asm volatile("s_waitcnt vmcnt(0)" ::: "memory");
        }
    }
    __syncthreads();
}

namespace pg8 {
constexpr int BM = 256, BK = 64, HALF = 128, HTB = HALF * BK * 2, STAGE_BYTES = 8 * HTB, NXCD = 8, WGM = 8;
__host__ __device__ __forceinline__ int lds_byte(int r, int c) { const int st = (r >> 4) * 2 + (c >> 5), rr = r & 15, cc = c & 31, ob = rr * 64 + cc * 2; return st * 1024 + (ob ^ (((ob >> 9) & 1) << 5)); }
__host__ __device__ __forceinline__ void stage_rc(int b, int& R, int& C) { const int st = b / 1024, sb = b % 1024, swz = sb ^ (((sb >> 9) & 1) << 5); R = (st >> 1) * 16 + swz / 64; C = (st & 1) * 32 + (swz % 64) / 2; }
__host__ __device__ __forceinline__ int perm32(int rho) { const int n = rho >> 4, i = rho & 15; return 8 * (i >> 2) + 4 * n + (i & 3); }
struct Unit { int pm, pn; };
struct Gemm { const bf16_t* A; const bf16_t* Bt; int M, N, K; };
struct StaticOrder {
    int nM, nN, nwg, G, c;
    __device__ void init(int M, int N, int G_, int c_) { nM = M / BM; nN = N / BM; nwg = nM * nN; G = G_; c = c_; }
    __device__ bool next(int i, Unit& u) const {
        const long L = (long)i * G + c; if (L >= nwg) return false;
        int wgid = (int)L; { const int q = nwg / NXCD, r = nwg % NXCD, xcd = wgid % NXCD, off = wgid / NXCD; wgid = (xcd < r ? xcd * (q + 1) : r * (q + 1) + (xcd - r) * q) + off; }
        const int nig = WGM * nN, gid = wgid / nig, fm = gid * WGM, gsz = (nM - fm) < WGM ? (nM - fm) : WGM;
        u.pm = fm + ((wgid % nig) % gsz); u.pn = (wgid % nig) / gsz; return true;
    }
    __device__ __forceinline__ void a_ready(const Unit&) const {}
    __device__ __forceinline__ void done(const Unit&) const {}
};

template <class Epi, class Sched>
__device__ __forceinline__ void gemm_phase(LAS unsigned char* lds, const Gemm g, const Sched& S, const Epi& E) {
    const int tid = threadIdx.x, wid = __builtin_amdgcn_readfirstlane(tid >> 6), lane = tid & 63, wr = wid >> 2, wc = wid & 3, fr = lane & 15, fq = lane >> 4;
    const int K = g.K, nt = K / BK;
    unsigned voffA[2], voffB[2];
#pragma unroll
    for (int i = 0; i < 2; ++i) { int R, C; stage_rc(tid * 16 + i * 8192, R, C); const int Rb = Epi::PERM ? ((R & ~31) + perm32(R & 31)) : R;
        voffA[i] = (unsigned)(R * K + C) * 2u; voffB[i] = (unsigned)(Rb * K + C) * 2u; }
    const size_t kstep = (size_t)(BK * 2);
    const size_t hstep = (size_t)HALF * K * 2;
    const size_t tstep = 2 * hstep;
    const unsigned ldsw = (unsigned)wid * 1024u;
    const int aoff = lds_byte(wr * 64 + fr, fq * 8), boff = lds_byte(wc * 32 + fr, fq * 8);
#define PG8_SA(b, h) (((b) * 2 + (h)) * HTB)
#define PG8_SB(b, h) ((4 + (b) * 2 + (h)) * HTB)
#define PG8_STAGE(bufoff, gbase, voff) do { _Pragma("unroll") for (int _i = 0; _i < 2; ++_i) \
        __builtin_amdgcn_global_load_lds((const unsigned*)((const char*)(gbase) + (voff)[_i]), (LAS unsigned*)(lds + (bufoff) + ldsw + _i * 8192), 16, 0, 0); } while (0)
#define PG8_LDA(dst, b, h) do { _Pragma("unroll") for (int m = 0; m < 4; ++m) _Pragma("unroll") for (int k = 0; k < 2; ++k) dst[m][k] = *(const LAS bf16x8*)(lds + PG8_SA(b, h) + aoff + m * 2048 + k * 1024); } while (0)
#define PG8_LDB(dst, b, h) do { _Pragma("unroll") for (int n = 0; n < 2; ++n) _Pragma("unroll") for (int k = 0; k < 2; ++k) dst[n][k] = *(const LAS bf16x8*)(lds + PG8_SB(b, h) + boff + n * 2048 + k * 1024); } while (0)
#define PG8_MMA(ai, bj, At, Bt) do { __builtin_amdgcn_s_setprio(1); _Pragma("unroll") for (int m = 0; m < 4; ++m) _Pragma("unroll") for (int n = 0; n < 2; ++n) _Pragma("unroll") for (int k = 0; k < 2; ++k) \
        acc[ai][bj][m][n] = __builtin_amdgcn_mfma_f32_16x16x32_bf16(Bt[n][k], At[m][k], acc[ai][bj][m][n], 0, 0, 0); __builtin_amdgcn_s_setprio(0); } while (0)
#define PG8_WAIT_V(n) asm volatile("s_waitcnt vmcnt(" #n ")" ::: "memory")
#define PG8_WAIT_L(n) asm volatile("s_waitcnt lgkmcnt(" #n ")" ::: "memory")
#define PG8_BAR __builtin_amdgcn_s_barrier()
#define PG8_SCHED __builtin_amdgcn_sched_barrier(0)
    Unit cur, nxt; int ui = 0;
    if (!S.next(0, cur)) return;
    f32x4 acc[2][2][4][2];
#pragma unroll
    for (int a = 0; a < 2; ++a)
#pragma unroll
        for (int b = 0; b < 2; ++b)
#pragma unroll
            for (int m = 0; m < 4; ++m)
#pragma unroll
                for (int n = 0; n < 2; ++n) acc[a][b][m][n] = (f32x4){0.f, 0.f, 0.f, 0.f};
    bf16x8 At[4][2], B0[2][2], B1[2][2];
    const char* cA = (const char*)g.A + (size_t)cur.pm * tstep; const char* cB = (const char*)g.Bt + (size_t)cur.pn * tstep;
    S.a_ready(cur);
    PG8_STAGE(PG8_SB(0, 0), cB, voffB); PG8_STAGE(PG8_SA(0, 0), cA, voffA); PG8_STAGE(PG8_SB(0, 1), cB + hstep, voffB); PG8_STAGE(PG8_SA(0, 1), cA + hstep, voffA);
    if (wr == 1) PG8_BAR;
    PG8_WAIT_V(4); PG8_BAR;
    PG8_STAGE(PG8_SB(1, 0), cB + kstep, voffB); PG8_STAGE(PG8_SA(1, 0), cA + kstep, voffA); PG8_STAGE(PG8_SB(1, 1), cB + hstep + kstep, voffB);
    PG8_WAIT_V(6); PG8_BAR;
    for (;;) {
        const bool has_next = S.next(ui + 1, nxt);
        const char* nA = has_next ? (const char*)g.A + (size_t)nxt.pm * tstep : cA; const char* nB = has_next ? (const char*)g.Bt + (size_t)nxt.pn * tstep : cB;
        for (int t = 0; t < nt; t += 2) {
            const bool last = (t == nt - 2);
            const char* a1 = cA + (size_t)(t + 1) * kstep;
            const char* a2 = last ? nA : cA + (size_t)(t + 2) * kstep; const char* b2 = last ? nB : cB + (size_t)(t + 2) * kstep;
            const char* a3 = a2 + kstep; const char* b3 = b2 + kstep;
            if (last && has_next) S.a_ready(nxt);
            PG8_LDB(B0, 0, 0); PG8_SCHED; PG8_LDA(At, 0, 0); PG8_STAGE(PG8_SA(1, 1), a1 + hstep, voffA);
            PG8_WAIT_L(8); PG8_BAR; PG8_WAIT_L(0); PG8_MMA(0, 0, At, B0); PG8_BAR; PG8_SCHED;
            PG8_LDB(B1, 0, 1); PG8_STAGE(PG8_SB(0, 0), b2, voffB);
            PG8_BAR; PG8_WAIT_L(0); PG8_MMA(0, 1, At, B1); PG8_BAR;
            PG8_LDA(At, 0, 1); PG8_STAGE(PG8_SA(0, 0), a2, voffA);
            PG8_BAR; PG8_WAIT_L(0); PG8_MMA(1, 0, At, B0); PG8_BAR; PG8_SCHED;
            PG8_STAGE(PG8_SB(0, 1), b2 + hstep, voffB);
            PG8_WAIT_V(6); PG8_BAR; PG8_MMA(1, 1, At, B1); PG8_BAR;
            PG8_LDB(B0, 1, 0); PG8_SCHED; PG8_LDA(At, 1, 0); PG8_STAGE(PG8_SA(0, 1), a2 + hstep, voffA);
            PG8_WAIT_L(8); PG8_BAR; PG8_WAIT_L(0); PG8_MMA(0, 0, At, B0); PG8_BAR; PG8_SCHED;
            PG8_LDB(B1, 1, 1); PG8_STAGE(PG8_SB(1, 0), b3, voffB);
            PG8_BAR; PG8_WAIT_L(0); PG8_MMA(0, 1, At, B1); PG8_BAR;
            PG8_LDA(At, 1, 1); PG8_STAGE(PG8_SA(1, 0), a3, voffA);
            PG8_BAR; PG8_WAIT_L(0); PG8_MMA(1, 0, At, B0); PG8_BAR; PG8_SCHED;
            PG8_STAGE(PG8_SB(1, 1), b3 + hstep, voffB);
            PG8_WAIT_V(6); PG8_BAR; PG8_MMA(1, 1, At, B1); PG8_BAR;
        }
        E(acc, cur, wr, wc, fr, fq); S.done(cur);
        if (!has_next) break;
#pragma unroll
        for (int a = 0; a < 2; ++a)
#pragma unroll
            for (int b = 0; b < 2; ++b)
#pragma unroll
                for (int m = 0; m < 4; ++m)
#pragma unroll
                    for (int n = 0; n < 2; ++n) acc[a][b][m][n] = (f32x4){0.f, 0.f, 0.f, 0.f};
        cur = nxt; cA = nA; cB = nB; ++ui;
    }
    PG8_WAIT_V(0);
    if (wr == 0) PG8_BAR;
    PG8_BAR;
#undef PG8_SA
#undef PG8_SB
#undef PG8_STAGE
#undef PG8_LDA
#undef PG8_LDB
#undef PG8_MMA
#undef PG8_WAIT_V
#undef PG8_WAIT_L
#undef PG8_BAR
#undef PG8_SCHED
}
}
using pg8::Unit;

struct EpiProj {
    static constexpr bool PERM = true;
    bf16_t* P;
    __device__ __forceinline__ void operator()(const f32x4 (&acc)[2][2][4][2], const Unit& u, int wr, int wc, int fr, int fq) const {
        const int row0 = u.pm * 256 + wr * 64 + fr; const int pn = u.pn;
        if (pn < 8 || pn >= 24) {
            const bool act = pn >= 24;
            const int col0 = (act ? 4096 + (pn - 24) * 256 : pn * 256) + wc * 32 + 8 * fq;
#pragma unroll
            for (int ai = 0; ai < 2; ++ai)
#pragma unroll
                for (int m = 0; m < 4; ++m) { bf16_t* rowp = P + (size_t)(row0 + ai * 128 + m * 16) * PW + col0;
#pragma unroll
                    for (int bj = 0; bj < 2; ++bj) { f32x4 v0 = acc[ai][bj][m][0], v1 = acc[ai][bj][m][1];
                        if (act) { f32x2 a = gelu_pk((f32x2){v0[0], v0[1]}), b = gelu_pk((f32x2){v0[2], v0[3]}), c = gelu_pk((f32x2){v1[0], v1[1]}), d = gelu_pk((f32x2){v1[2], v1[3]});
                            v0 = (f32x4){a.x, a.y, b.x, b.y}; v1 = (f32x4){c.x, c.y, d.x, d.y}; }
                        u32x4 w; w.x = cvt_pk_bf16_asm(v0[0], v0[1]); w.y = cvt_pk_bf16_asm(v0[2], v0[3]); w.z = cvt_pk_bf16_asm(v1[0], v1[1]); w.w = cvt_pk_bf16_asm(v1[2], v1[3]);
                        *(u32x4*)(rowp + bj * 128) = w; } }
        } else {
            const bool isrg = pn < 16;
            const int col0 = (isrg ? 2048 + (pn - 8) * 128 : 3072 + (pn - 16) * 128) + wc * 32 + 8 * fq;
#pragma unroll
            for (int ai = 0; ai < 2; ++ai)
#pragma unroll
                for (int m = 0; m < 4; ++m) { bf16_t* rowp = P + (size_t)(row0 + ai * 128 + m * 16) * PW + col0;
                    float o[8];
#pragma unroll
                    for (int n = 0; n < 2; ++n) { const f32x4 a = acc[ai][0][m][n], g = acc[ai][1][m][n];
                        if (isrg) {
#pragma unroll
                            for (int j = 0; j < 4; ++j) o[n * 4 + j] = a[j] * sigmoidf_(a[j]) * sigmoidf_(g[j]);
                        } else { f32x2 x = gelu_pk((f32x2){a[0], a[1]}), y = gelu_pk((f32x2){a[2], a[3]});
                            o[n * 4 + 0] = x.x * sigmoidf_(g[0]); o[n * 4 + 1] = x.y * sigmoidf_(g[1]); o[n * 4 + 2] = y.x * sigmoidf_(g[2]); o[n * 4 + 3] = y.y * sigmoidf_(g[3]); } }
                    u32x4 w; w.x = cvt_pk_bf16_asm(o[0], o[1]); w.y = cvt_pk_bf16_asm(o[2], o[3]); w.z = cvt_pk_bf16_asm(o[4], o[5]); w.w = cvt_pk_bf16_asm(o[6], o[7]);
                    *(u32x4*)rowp = w; }
        }
    }
};
struct EpiX1 {
    static constexpr bool PERM = false;
    const float* x; float* x1; const float* mod; const float* b_ada;
    __device__ __forceinline__ void operator()(const f32x4 (&acc)[2][2][4][2], const Unit& u, int wr, int wc, int fr, int fq) const {
        const int row0 = u.pm * 256 + wr * 64 + fr, col0 = u.pn * 256 + wc * 32 + 4 * fq; const int b = u.pm >> 5;
        f32x4 gv[2][2];
#pragma unroll
        for (int bj = 0; bj < 2; ++bj)
#pragma unroll
            for (int n = 0; n < 2; ++n) gv[bj][n] = *(const f32x4*)(mod + b * 6144 + 2048 + col0 + bj * 128 + n * 16) + *(const f32x4*)(b_ada + 2048 + col0 + bj * 128 + n * 16);
#pragma unroll
        for (int ai = 0; ai < 2; ++ai)
#pragma unroll
            for (int m = 0; m < 4; ++m) { const size_t off = (size_t)(row0 + ai * 128 + m * 16) * DM + col0;
#pragma unroll
                for (int bj = 0; bj < 2; ++bj)
#pragma unroll
                    for (int n = 0; n < 2; ++n) { const f32x4 xv = *(const f32x4*)(x + off + bj * 128 + n * 16); *(f32x4*)(x1 + off + bj * 128 + n * 16) = xv + gv[bj][n] * acc[ai][bj][m][n]; } }
    }
};
struct EpiQ {
    static constexpr bool PERM = true;
    bf16_t* O;
    __device__ __forceinline__ void operator()(const f32x4 (&acc)[2][2][4][2], const Unit& u, int wr, int wc, int fr, int fq) const {
        const int row0 = u.pm * 256 + wr * 64 + fr, col0 = u.pn * 256 + wc * 32 + 8 * fq;
#pragma unroll
        for (int ai = 0; ai < 2; ++ai)
#pragma unroll
            for (int m = 0; m < 4; ++m) { bf16_t* rowp = O + (size_t)(row0 + ai * 128 + m * 16) * 2048 + col0;
#pragma unroll
                for (int bj = 0; bj < 2; ++bj) { const f32x4 v0 = acc[ai][bj][m][0], v1 = acc[ai][bj][m][1];
                    u32x4 w; w.x = cvt_pk_bf16_asm(v0[0], v0[1]); w.y = cvt_pk_bf16_asm(v0[2], v0[3]); w.z = cvt_pk_bf16_asm(v1[0], v1[1]); w.w = cvt_pk_bf16_asm(v1[2], v1[3]);
                    *(u32x4*)(rowp + bj * 128) = w; } }
    }
};

__device__ __forceinline__ int win_src_col(int n) {
    if (n < 2048) return n;
    if (n < 4096) { const int u = (n - 2048) >> 8, r = (n - 2048) & 255; return r < 128 ? 2048 + 128 * u + r : 5136 + 128 * u + (r - 128); }
    if (n < 6144) { const int u = (n - 4096) >> 8, r = (n - 4096) & 255; return r < 128 ? 3088 + 128 * u + r : 6160 + 128 * u + (r - 128); }
    return 4112 + (n - 6144);
}
__device__ void phase0(const Params& p, unsigned char* lds) {
    const int tid = threadIdx.x;
    float* mod = (float*)(p.ws + OFF_MOD);
    {
        float* ssc = (float*)lds;
        float* red = (float*)lds + 2048;
        for (int e = tid; e < 2048; e += 512) { const float cv = p.c[e]; ssc[e] = cv * sigmoidf_(cv); }
        __syncthreads();
        for (int cbk = blockIdx.x; cbk < 256; cbk += gridDim.x) {
            const int cc = tid % 24, rg = tid / 24;
            if (tid < 504) { float a0 = 0.f, a1 = 0.f;
                const float* wp = p.w_ada + cbk * 24 + cc;
#pragma unroll 1
                for (int j0 = 0; j0 < 49; j0 += 7) { float w[7];
#pragma unroll
                    for (int u = 0; u < 7; ++u) { const int k = rg + 21 * (j0 + u); w[u] = k < 1024 ? wp[(size_t)k * 6144] : 0.f; }
#pragma unroll
                    for (int u = 0; u < 7; ++u) { const int k = rg + 21 * (j0 + u); if (k < 1024) { a0 += ssc[k] * w[u]; a1 += ssc[1024 + k] * w[u]; } } }
                red[(rg * 24 + cc) * 2] = a0; red[(rg * 24 + cc) * 2 + 1] = a1; }
            __syncthreads();
            if (tid < 48) { const int c2 = tid % 24, bb = tid / 24; float s = 0.f;
                for (int g = 0; g < 21; ++g) s += red[(g * 24 + c2) * 2 + bb];
                mod[bb * 6144 + cbk * 24 + c2] = s; }
            __syncthreads();
        }
    }
    float* tile = (float*)lds;
    for (int tl = blockIdx.x; tl < 2560; tl += gridDim.x) {
        const float* W; bf16_t* Bt; int ldw, nt, kt, which;
        if (tl < 1792) { which = 0; W = p.w_in; ldw = INW; Bt = (bf16_t*)(p.ws + OFF_WINT); nt = tl >> 4; kt = tl & 15; }
        else if (tl < 2048) { which = 1; W = p.w_out; ldw = 1024; Bt = (bf16_t*)(p.ws + OFF_WOUTT); nt = (tl - 1792) >> 4; kt = tl & 15; }
        else { which = 2; W = p.w_q; ldw = 2048; Bt = (bf16_t*)(p.ws + OFF_WQT); nt = (tl - 2048) >> 4; kt = tl & 15; }
        { const int nn = tid & 63, kk0 = tid >> 6; const int n = nt * 64 + nn; const int sc = which == 0 ? win_src_col(n) : n;
#pragma unroll
            for (int i = 0; i < 8; ++i) { const int k = kk0 + 8 * i; tile[nn * 65 + k] = W[(size_t)(kt * 64 + k) * ldw + sc]; } }
        __syncthreads();
        { const int n = tid >> 3, kc = (tid & 7) * 8; const float* tp = tile + n * 65 + kc;
            u32x4 w; w.x = cvt_pk_bf16(tp[0], tp[1]); w.y = cvt_pk_bf16(tp[2], tp[3]); w.z = cvt_pk_bf16(tp[4], tp[5]); w.w = cvt_pk_bf16(tp[6], tp[7]);
            *(u32x4*)(Bt + (size_t)(nt * 64 + n) * 1024 + kt * 64 + kc) = w; }
        __syncthreads();
    }
    { bf16_t* kb = (bf16_t*)(p.ws + OFF_KEYS);
        for (int e = (blockIdx.x * 512 + tid) * 2; e < 32768; e += gridDim.x * 1024) {
            const float* src = e < 16384 ? p.keys1 + e : p.keys2 + (e - 16384);
            *(unsigned*)(kb + e) = cvt_pk_bf16(src[0], src[1]); } }
}

template <bool ALR>
__device__ void phase_norm(const Params& p, const float* xin, const float* nw, int shift_off, int scale_off, bf16_t* hout, unsigned char* lds) {
    const int tid = threadIdx.x, wid = tid >> 6, lane = tid & 63;
    const float* mod = (const float*)(p.ws + OFF_MOD);
    float* wat = (float*)lds;
    if (ALR) {
        for (int e = tid; e < 16384; e += 512) { const int d = e >> 4, r = e & 15; wat[r * 1024 + d] = p.w_in[(size_t)d * INW + 3072 + r]; }
        __syncthreads();
    }
    float* alr = (float*)(p.ws + OFF_ALR);
    for (int tg = blockIdx.x * 8 + wid; tg < 2048; tg += gridDim.x * 8) {
        const int b = tg >> 10;
        f32x4 w4[4], sc[4], sh[4];
#pragma unroll
        for (int i = 0; i < 4; ++i) { const int d = 256 * i + 4 * lane; w4[i] = *(const f32x4*)(nw + d);
            sc[i] = *(const f32x4*)(mod + b * 6144 + scale_off + d) + *(const f32x4*)(p.b_ada + scale_off + d) + 1.0f;
            sh[i] = *(const f32x4*)(mod + b * 6144 + shift_off + d) + *(const f32x4*)(p.b_ada + shift_off + d);
            w4[i] = w4[i] * sc[i]; }
        f32x4 xn[4];
#pragma unroll
        for (int i = 0; i < 4; ++i) xn[i] = *(const f32x4*)(xin + (size_t)(tg * 8) * DM + 256 * i + 4 * lane);
        for (int tt = 0; tt < 8; ++tt) {
            const int t = tg * 8 + tt;
            f32x4 xv[4]; float ss = 0.f;
#pragma unroll
            for (int i = 0; i < 4; ++i) { xv[i] = xn[i]; ss += xv[i][0] * xv[i][0] + xv[i][1] * xv[i][1] + xv[i][2] * xv[i][2] + xv[i][3] * xv[i][3]; }
            if (tt < 7) {
#pragma unroll
                for (int i = 0; i < 4; ++i) xn[i] = *(const f32x4*)(xin + (size_t)(t + 1) * DM + 256 * i + 4 * lane); }
            ss = wave_sum(ss);
            const float rstd = rsqrtf(ss * (1.0f / 1024.0f) + EPS);
#pragma unroll
            for (int i = 0; i < 4; ++i) { xv[i] = xv[i] * rstd * w4[i] + sh[i];
                u32x2 w; w.x = cvt_pk_bf16(xv[i][0], xv[i][1]); w.y = cvt_pk_bf16(xv[i][2], xv[i][3]);
                *(u32x2*)(hout + (size_t)t * DM + 256 * i + 4 * lane) = w; }
            if (ALR) {
                float ps[16];
#pragma unroll
                for (int r = 0; r < 16; ++r) { float s = 0.f;
#pragma unroll
                    for (int i = 0; i < 4; ++i) { const f32x4 wv = *(const f32x4*)(wat + r * 1024 + 256 * i + 4 * lane); s += xv[i][0] * wv[0] + xv[i][1] * wv[1] + xv[i][2] * wv[2] + xv[i][3] * wv[3]; }
                    ps[r] = s; if (r & 1) asm volatile("" ::: "memory"); }
                float t8[8], t4[4], t2[2];
                { const bool up = (lane & 32) != 0;
#pragma unroll
                  for (int j = 0; j < 8; ++j) { const float snd = up ? ps[j] : ps[j + 8], keep = up ? ps[j + 8] : ps[j]; t8[j] = keep + __shfl_xor(snd, 32); } }
                { const bool up = (lane & 16) != 0;
#pragma unroll
                  for (int j = 0; j < 4; ++j) { const float snd = up ? t8[j] : t8[j + 4], keep = up ? t8[j + 4] : t8[j]; t4[j] = keep + __shfl_xor(snd, 16); } }
                { const bool up = (lane & 8) != 0;
#pragma unroll
                  for (int j = 0; j < 2; ++j) { const float snd = up ? t4[j] : t4[j + 2], keep = up ? t4[j + 2] : t4[j]; t2[j] = keep + __shfl_xor(snd, 8); } }
                float t1;
                { const bool up = (lane & 4) != 0; const float snd = up ? t2[0] : t2[1], keep = up ? t2[1] : t2[0]; t1 = keep + __shfl_xor(snd, 4); }
                t1 += __shfl_xor(t1, 2); t1 += __shfl_xor(t1, 1);
                if ((lane & 3) == 0) alr[(size_t)t * 16 + ((lane >> 5) & 1) * 8 + ((lane >> 4) & 1) * 4 + ((lane >> 3) & 1) * 2 + ((lane >> 2) & 1)] = t1;
            }
        }
    }
}

template <bool TR>
__device__ __forceinline__ void gla_G(const Params& p, int t0, int h, float* sALR, float* sG, float* sGT) {
    const int tid = threadIdx.x;
    const float* alr = (const float*)(p.ws + OFF_ALR);
    if (tid < 256) *(f32x4*)(sALR + tid * 4) = *(const f32x4*)(alr + (size_t)t0 * 16 + tid * 4);
    const int col = tid & 127, pg = tid >> 7;
    float wup[16];
#pragma unroll
    for (int r = 0; r < 16; ++r) wup[r] = p.w_alpha_up[r * 512 + h * 128 + col];
    const float bias = p.b_alpha[h * 128 + col];
    __syncthreads();
#pragma unroll 4
    for (int pp = 0; pp < 16; ++pp) { const int pos = pg * 16 + pp;
        float z0 = bias, z1 = 0.f, z2 = 0.f, z3 = 0.f;
#pragma unroll
        for (int r4 = 0; r4 < 4; ++r4) { const f32x4 a = *(const f32x4*)(sALR + pos * 16 + r4 * 4); z0 += a[0] * wup[r4 * 4]; z1 += a[1] * wup[r4 * 4 + 1]; z2 += a[2] * wup[r4 * 4 + 2]; z3 += a[3] * wup[r4 * 4 + 3]; }
        const float z = (z0 + z1) + (z2 + z3);
        sG[pos * 128 + col] = (fminf(z, 0.f) - __logf(1.0f + __expf(-fabsf(z)))) * (1.0f / 16.0f); }
    __syncthreads();
    if (tid < 128) { float cum = 0.f;
#pragma unroll 16
        for (int pos = 0; pos < 64; ++pos) { cum += sG[pos * 128 + tid]; if (TR) sGT[tid * 65 + pos] = cum; else sG[pos * 128 + tid] = cum; } }
    __syncthreads();
}
__device__ __forceinline__ void gla_VT(const bf16_t* P, int t0, int h, bf16_t* sVT) {
    const int tid = threadIdx.x;
#pragma unroll
    for (int i = 0; i < 4; ++i) { const int task = tid + 512 * i, pos = task & 63, dg = task >> 6;
        const u32x4 w = *(const u32x4*)(P + (size_t)(t0 + pos) * PW + 1024 + h * 256 + dg * 8);
        bf16_t* d = sVT + (dg * 8) * 72 + pos;
        d[0] = (bf16_t)w.x; d[72] = (bf16_t)(w.x >> 16); d[144] = (bf16_t)w.y; d[216] = (bf16_t)(w.y >> 16);
        d[288] = (bf16_t)w.z; d[360] = (bf16_t)(w.z >> 16); d[432] = (bf16_t)w.w; d[504] = (bf16_t)(w.w >> 16); }
}

__device__ void phase_glaA(const Params& p, unsigned char* lds) {
    const int tid = threadIdx.x, wid = tid >> 6, lane = tid & 63, r = lane & 31, hh = lane >> 5;
    const bf16_t* P = (const bf16_t*)(p.ws + OFF_PROJ);
    { float* stats = (float*)(p.ws + OFF_STATS);
        const int tst0 = blockIdx.x * 8 + wid, tstep = gridDim.x * 8;
        u32x4 an = (u32x4){0u, 0u, 0u, 0u}, bn = an;
        if (tst0 < NTOK) { an = *(const u32x4*)(P + (size_t)tst0 * PW + 4096 + lane * 16); bn = *(const u32x4*)(P + (size_t)tst0 * PW + 4096 + lane * 16 + 8); }
        for (int t = tst0; t < NTOK; t += tstep) {
            const u32x4 a = an, b = bn;
            if (t + tstep < NTOK) { an = *(const u32x4*)(P + (size_t)(t + tstep) * PW + 4096 + lane * 16); bn = *(const u32x4*)(P + (size_t)(t + tstep) * PW + 4096 + lane * 16 + 8); }
            float v[16] = {bflo(a.x), bfhi(a.x), bflo(a.y), bfhi(a.y), bflo(a.z), bfhi(a.z), bflo(a.w), bfhi(a.w), bflo(b.x), bfhi(b.x), bflo(b.y), bfhi(b.y), bflo(b.z), bfhi(b.z), bflo(b.w), bfhi(b.w)};
            float s = 0.f;
#pragma unroll
            for (int i = 0; i < 16; ++i) s += v[i];
            const float mean = wave_sum(s) * (1.0f / 1024.0f);
            float q = 0.f;
#pragma unroll
            for (int i = 0; i < 16; ++i) { const float d = v[i] - mean; q += d * d; }
            q = wave_sum(q);
            if (lane == 0) *(f32x2*)(stats + (size_t)t * 2) = (f32x2){mean, rsqrtf(q * (1.0f / 1024.0f) + EPS)};
        } }
    float* sALR = (float*)lds; float* sG = (float*)(lds + 4096);
    bf16_t* sKT = (bf16_t*)(lds + 36864); bf16_t* sVT = (bf16_t*)(lds + 55296); float* sGT = (float*)(lds + 92160);
    bf16_t* KV = (bf16_t*)p.out; float* decay = (float*)(p.ws + OFF_DECAY);
    for (int item = blockIdx.x; item < 1024; item += gridDim.x) {
        const int h = item & 3, n = (item >> 2) & 127, b = item >> 9, t0 = b * SEQ + n * 64;
        gla_G<true>(p, t0, h, sALR, sG, sGT);
#pragma unroll
        for (int i = 0; i < 2; ++i) { const int task = tid + 512 * i, pos = task & 63, kg = task >> 6;
            const u32x4 w = *(const u32x4*)(P + (size_t)(t0 + pos) * PW + 512 + h * 128 + kg * 8);
            const unsigned ww[4] = {w.x, w.y, w.z, w.w};
            bf16_t* d = sKT + (kg * 8) * 72 + pos;
#pragma unroll
            for (int e = 0; e < 4; ++e) { const int kd = kg * 8 + 2 * e;
                const float f0 = __expf(sGT[kd * 65 + 63] - sGT[kd * 65 + pos]), f1 = __expf(sGT[(kd + 1) * 65 + 63] - sGT[(kd + 1) * 65 + pos]);
                const unsigned pk = cvt_pk_bf16(bflo(ww[e]) * f0, bfhi(ww[e]) * f1);
                d[(2 * e) * 72] = (bf16_t)pk; d[(2 * e + 1) * 72] = (bf16_t)(pk >> 16); } }
        gla_VT(P, t0, h, sVT);
        if (tid < 128) decay[item * 128 + tid] = __expf(sGT[tid * 65 + 63]);
        __syncthreads();
        f32x16 acc[4];
#pragma unroll
        for (int mi = 0; mi < 4; ++mi) acc[mi] = zero16();
#pragma unroll
        for (int ks = 0; ks < 4; ++ks) {
            const bf16x8 bfr = *(const bf16x8*)(sVT + (wid * 32 + r) * 72 + ks * 16 + hh * 8);
#pragma unroll
            for (int mi = 0; mi < 4; ++mi) { const bf16x8 afr = *(const bf16x8*)(sKT + (mi * 32 + r) * 72 + ks * 16 + hh * 8); acc[mi] = MFMA32(afr, bfr, acc[mi]); }
        }
        bf16_t* dst = KV + (size_t)item * 32768 + (size_t)(wid * 32 + r) * 128;
#pragma unroll
        for (int mi = 0; mi < 4; ++mi)
#pragma unroll
            for (int g = 0; g < 4; ++g) { u32x2 w; w.x = cvt_pk_bf16(acc[mi][g * 4], acc[mi][g * 4 + 1]); w.y = cvt_pk_bf16(acc[mi][g * 4 + 2], acc[mi][g * 4 + 3]);
                *(u32x2*)(dst + mi * 32 + g * 8 + hh * 4) = w; }
        __syncthreads();
    }
}

__device__ void phase_scan_sgu(const Params& p, unsigned char* lds) {
    const int tid = threadIdx.x, wid = tid >> 6, lane = tid & 63, r = lane & 31, hh = lane >> 5;
    { unsigned* KV = (unsigned*)p.out; const float* decay = (const float*)(p.ws + OFF_DECAY);
        for (int gt = blockIdx.x * 512 + tid; gt < 131072; gt += gridDim.x * 512) {
            const int bh = gt >> 14, e = gt & 16383, kd = (e * 2) & 127, b = bh >> 2, h = bh & 3;
            float s0 = 0.f, s1 = 0.f;
            for (int n0 = 0; n0 < 128; n0 += 16) {
                unsigned w[16]; f32x2 d[16];
#pragma unroll
                for (int j = 0; j < 16; ++j) { const int item = ((b * 128 + n0 + j) << 2) + h; w[j] = KV[(size_t)item * 16384 + e]; d[j] = *(const f32x2*)(decay + item * 128 + kd); }
#pragma unroll
                for (int j = 0; j < 16; ++j) { const int item = ((b * 128 + n0 + j) << 2) + h; KV[(size_t)item * 16384 + e] = cvt_pk_bf16(s0, s1);
                    s0 = s0 * d[j].x + bflo(w[j]); s1 = s1 * d[j].y + bfhi(w[j]); }
            }
        } }
    const bf16_t* P = (const bf16_t*)(p.ws + OFF_PROJ);
    const float* stats = (const float*)(p.ws + OFF_STATS);
    bf16_t* merged = (bf16_t*)(p.ws + OFF_HB);
    bf16_t* sVT = (bf16_t*)lds;
    for (int item = blockIdx.x; item < 1024; item += gridDim.x) {
        const int g = item & 7, n = (item >> 3) & 63, b = item >> 9, t0 = b * SEQ + n * 128;
#pragma unroll
        for (int i = 0; i < 4; ++i) { const int task = tid + 512 * i, j = task & 127, cg8 = task >> 7;
            const u32x4 w = *(const u32x4*)(P + (size_t)(t0 + j) * PW + 4096 + g * 128 + cg8 * 8);
            const f32x2 st = *(const f32x2*)(stats + (size_t)(t0 + j) * 2);
            const f32x4 lw0 = *(const f32x4*)(p.sgu_ln_w + g * 128 + cg8 * 8), lw1 = *(const f32x4*)(p.sgu_ln_w + g * 128 + cg8 * 8 + 4);
            const f32x4 lb0 = *(const f32x4*)(p.sgu_ln_b + g * 128 + cg8 * 8), lb1 = *(const f32x4*)(p.sgu_ln_b + g * 128 + cg8 * 8 + 4);
            const float v[8] = {bflo(w.x), bfhi(w.x), bflo(w.y), bfhi(w.y), bflo(w.z), bfhi(w.z), bflo(w.w), bfhi(w.w)};
            bf16_t* d = sVT + (cg8 * 8) * 136 + j;
#pragma unroll
            for (int e = 0; e < 8; e += 2) { const float lw_a = e < 4 ? lw0[e] : lw1[e - 4], lw_b = e < 4 ? lw0[e + 1] : lw1[e - 3], lb_a = e < 4 ? lb0[e] : lb1[e - 4], lb_b = e < 4 ? lb0[e + 1] : lb1[e - 3];
                const unsigned pk = cvt_pk_bf16((v[e] - st.x) * st.y * lw_a + lb_a, (v[e + 1] - st.x) * st.y * lw_b + lb_b);
                d[e * 136] = (bf16_t)pk; d[(e + 1) * 136] = (bf16_t)(pk >> 16); } }
        __syncthreads();
        const int ni = wid & 3, mb = (wid >> 2) * 2, irow = ni * 32 + r;
        f32x16 acc[2] = {zero16(), zero16()};
        const float* wrow = p.sgu_w + (size_t)g * 16384 + (size_t)irow * 128;
        for (int ks = 0; ks < 2 * ni + 2; ++ks) {
            const int j0 = ks * 16 + hh * 8;
            const f32x4 wa = *(const f32x4*)(wrow + j0), wb = *(const f32x4*)(wrow + j0 + 4);
            float wv[8] = {wa[0], wa[1], wa[2], wa[3], wb[0], wb[1], wb[2], wb[3]};
#pragma unroll
            for (int e = 0; e < 8; ++e) wv[e] = (j0 + e <= irow) ? wv[e] : 0.f;
            u32x4 bw; bw.x = cvt_pk_bf16(wv[0], wv[1]); bw.y = cvt_pk_bf16(wv[2], wv[3]); bw.z = cvt_pk_bf16(wv[4], wv[5]); bw.w = cvt_pk_bf16(wv[6], wv[7]);
            const bf16x8 bfr = __builtin_bit_cast(bf16x8, bw);
#pragma unroll
            for (int mi = 0; mi < 2; ++mi) { const bf16x8 afr = *(const bf16x8*)(sVT + ((mb + mi) * 32 + r) * 136 + j0); acc[mi] = MFMA32(afr, bfr, acc[mi]); }
        }
        const float bs = p.sgu_b[g * 128 + irow];
        bf16_t* sT = (bf16_t*)(lds + 34816);
#pragma unroll
        for (int mi = 0; mi < 2; ++mi)
#pragma unroll
            for (int g4 = 0; g4 < 4; ++g4) { const int c = (mb + mi) * 32 + g4 * 8 + hh * 4;
                u32x2 o; o.x = cvt_pk_bf16(acc[mi][g4 * 4] + bs, acc[mi][g4 * 4 + 1] + bs); o.y = cvt_pk_bf16(acc[mi][g4 * 4 + 2] + bs, acc[mi][g4 * 4 + 3] + bs);
                *(u32x2*)(sT + irow * 136 + c) = o; }
        __syncthreads();
#pragma unroll
        for (int it = 0; it < 4; ++it) { const int task = tid + 512 * it, tk = task >> 4, c8 = task & 15;
            const size_t tok = (size_t)(t0 + tk);
            const u32x4 sv = *(const u32x4*)(sT + tk * 136 + c8 * 8), ug = *(const u32x4*)(P + tok * PW + 3072 + g * 128 + c8 * 8);
            u32x4 w;
            w.x = cvt_pk_bf16(bflo(ug.x) * bflo(sv.x), bfhi(ug.x) * bfhi(sv.x)); w.y = cvt_pk_bf16(bflo(ug.y) * bflo(sv.y), bfhi(ug.y) * bfhi(sv.y));
            w.z = cvt_pk_bf16(bflo(ug.z) * bflo(sv.z), bfhi(ug.z) * bfhi(sv.z)); w.w = cvt_pk_bf16(bflo(ug.w) * bflo(sv.w), bfhi(ug.w) * bfhi(sv.w));
            *(u32x4*)(merged + tok * DM + g * 128 + c8 * 8) = w; }
        __syncthreads();
    }
}

__device__ void phase_glaC(const Params& p, unsigned char* lds) {
    const int tid = threadIdx.x, wid = tid >> 6, lane = tid & 63, r = lane & 31, hh = lane >> 5;
    const bf16_t* P = (const bf16_t*)(p.ws + OFF_PROJ);
    float* sALR = (float*)lds; float* sG = (float*)(lds + 4096);
    bf16_t* sQD = (bf16_t*)(lds + 36864); bf16_t* sKI = (bf16_t*)(lds + 54272); bf16_t* sVT = (bf16_t*)(lds + 71680); bf16_t* sAM = (bf16_t*)(lds + 108544); float* sSS = (float*)(lds + 117760);
    const bf16_t* ST = (const bf16_t*)p.out; bf16_t* merged = (bf16_t*)(p.ws + OFF_HB);
    for (int item = blockIdx.x; item < 1024; item += gridDim.x) {
        const int h = item & 3, n = (item >> 2) & 127, b = item >> 9, t0 = b * SEQ + n * 64;
        gla_G<false>(p, t0, h, sALR, sG, nullptr);
#pragma unroll
        for (int i = 0; i < 2; ++i) { const int task = tid + 512 * i, kg = task & 15, pos = task >> 4;
            const u32x4 qw = *(const u32x4*)(P + (size_t)(t0 + pos) * PW + h * 128 + kg * 8), kw = *(const u32x4*)(P + (size_t)(t0 + pos) * PW + 512 + h * 128 + kg * 8);
            const f32x4 g0 = *(const f32x4*)(sG + pos * 128 + kg * 8), g1 = *(const f32x4*)(sG + pos * 128 + kg * 8 + 4);
            const float gv[8] = {g0[0], g0[1], g0[2], g0[3], g1[0], g1[1], g1[2], g1[3]};
            const unsigned qq[4] = {qw.x, qw.y, qw.z, qw.w}, kk[4] = {kw.x, kw.y, kw.z, kw.w};
            unsigned qo[4], ko[4];
#pragma unroll
            for (int e = 0; e < 4; ++e) { const float e0 = __expf(gv[2 * e]), e1 = __expf(gv[2 * e + 1]);
                qo[e] = cvt_pk_bf16(bflo(qq[e]) * 0.08838834764831845f * e0, bfhi(qq[e]) * 0.08838834764831845f * e1);
                ko[e] = cvt_pk_bf16(bflo(kk[e]) * __builtin_amdgcn_rcpf(e0), bfhi(kk[e]) * __builtin_amdgcn_rcpf(e1)); }
            *(u32x4*)(sQD + pos * 136 + kg * 8) = (u32x4){qo[0], qo[1], qo[2], qo[3]};
            *(u32x4*)(sKI + pos * 136 + kg * 8) = (u32x4){ko[0], ko[1], ko[2], ko[3]}; }
        gla_VT(P, t0, h, sVT);
        __syncthreads();
        if (wid < 4) { const int mj = wid >> 1, nI = wid & 1;
            f32x16 a = zero16();
            if (mj <= nI) {
#pragma unroll
                for (int ks = 0; ks < 8; ++ks) { const bf16x8 afr = *(const bf16x8*)(sKI + (mj * 32 + r) * 136 + ks * 16 + hh * 8), bfr = *(const bf16x8*)(sQD + (nI * 32 + r) * 136 + ks * 16 + hh * 8); a = MFMA32(afr, bfr, a); } }
            const int i = nI * 32 + r;
#pragma unroll
            for (int g = 0; g < 4; ++g) { const int j = mj * 32 + g * 8 + hh * 4;
                u32x2 w; w.x = cvt_pk_bf16(j <= i ? a[g * 4] : 0.f, j + 1 <= i ? a[g * 4 + 1] : 0.f); w.y = cvt_pk_bf16(j + 2 <= i ? a[g * 4 + 2] : 0.f, j + 3 <= i ? a[g * 4 + 3] : 0.f);
                *(u32x2*)(sAM + i * 72 + j) = w; } }
        __syncthreads();
        const int nI = wid & 1, mb = (wid >> 1) * 2, i = nI * 32 + r;
        f32x16 acc[2] = {zero16(), zero16()};
        const bf16_t* Sg = ST + (size_t)item * 32768;
#pragma unroll
        for (int ks = 0; ks < 8; ++ks) { const bf16x8 bfr = *(const bf16x8*)(sQD + i * 136 + ks * 16 + hh * 8);
#pragma unroll
            for (int mi = 0; mi < 2; ++mi) { const bf16x8 afr = *(const bf16x8*)(Sg + (size_t)((mb + mi) * 32 + r) * 128 + ks * 16 + hh * 8); acc[mi] = MFMA32(afr, bfr, acc[mi]); } }
        for (int ks = 0; ks < 2 * nI + 2; ++ks) { const bf16x8 bfr = *(const bf16x8*)(sAM + i * 72 + ks * 16 + hh * 8);
#pragma unroll
            for (int mi = 0; mi < 2; ++mi) { const bf16x8 afr = *(const bf16x8*)(sVT + ((mb + mi) * 32 + r) * 72 + ks * 16 + hh * 8); acc[mi] = MFMA32(afr, bfr, acc[mi]); } }
        float ss = 0.f;
#pragma unroll
        for (int mi = 0; mi < 2; ++mi)
#pragma unroll
            for (int e = 0; e < 16; ++e) ss += acc[mi][e] * acc[mi][e];
        ss += __shfl_xor(ss, 32);
        if (hh == 0) sSS[(wid >> 1) * 64 + i] = ss;
        __syncthreads();
        const float tot = sSS[i] + sSS[64 + i] + sSS[128 + i] + sSS[192 + i];
        const float rstd = rsqrtf(tot * (1.0f / 256.0f) + EPS);
        bf16_t* sO = (bf16_t*)lds;
#pragma unroll
        for (int mi = 0; mi < 2; ++mi)
#pragma unroll
            for (int g4 = 0; g4 < 4; ++g4) { const int dv = (mb + mi) * 32 + g4 * 8 + hh * 4;
                u32x2 o; o.x = cvt_pk_bf16(acc[mi][g4 * 4] * rstd, acc[mi][g4 * 4 + 1] * rstd); o.y = cvt_pk_bf16(acc[mi][g4 * 4 + 2] * rstd, acc[mi][g4 * 4 + 3] * rstd);
                *(u32x2*)(sO + i * 264 + dv) = o; }
        __syncthreads();
#pragma unroll
        for (int it = 0; it < 4; ++it) { const int task = tid + 512 * it, tk = task >> 5, c8 = task & 31, ch = h * 256 + c8 * 8;
            const size_t tok = (size_t)(t0 + tk);
            const u32x4 ov = *(const u32x4*)(sO + tk * 264 + c8 * 8), rg = *(const u32x4*)(P + tok * PW + 2048 + ch), mg = *(const u32x4*)(merged + tok * DM + ch);
            const f32x4 n0 = *(const f32x4*)(p.gla_norm_w + ch), n1 = *(const f32x4*)(p.gla_norm_w + ch + 4);
            u32x4 w;
            w.x = cvt_pk_bf16(bflo(ov.x) * n0[0] * bflo(rg.x) + bflo(mg.x), bfhi(ov.x) * n0[1] * bfhi(rg.x) + bfhi(mg.x));
            w.y = cvt_pk_bf16(bflo(ov.y) * n0[2] * bflo(rg.y) + bflo(mg.y), bfhi(ov.y) * n0[3] * bfhi(rg.y) + bfhi(mg.y));
            w.z = cvt_pk_bf16(bflo(ov.z) * n1[0] * bflo(rg.z) + bflo(mg.z), bfhi(ov.z) * n1[1] * bfhi(rg.z) + bfhi(mg.z));
            w.w = cvt_pk_bf16(bflo(ov.w) * n1[2] * bflo(rg.w) + bflo(mg.w), bfhi(ov.w) * n1[3] * bfhi(rg.w) + bfhi(mg.w));
            *(u32x4*)(merged + tok * DM + ch) = w; }
        __syncthreads();
    }
}

__device__ void phase_tables(const Params& p) {
    bf16_t* db = (bf16_t*)(p.ws + OFF_DOWN); bf16_t* ub = (bf16_t*)(p.ws + OFF_UP);
    for (size_t e = ((size_t)blockIdx.x * 512 + threadIdx.x) * 8; e < (size_t)16384 * 1024; e += (size_t)gridDim.x * 4096) {
        { const f32x4 a = __builtin_nontemporal_load((const f32x4*)(p.down + e)), b = __builtin_nontemporal_load((const f32x4*)(p.down + e + 4));
            u32x4 w; w.x = cvt_pk_bf16(a[0], a[1]); w.y = cvt_pk_bf16(a[2], a[3]); w.z = cvt_pk_bf16(b[0], b[1]); w.w = cvt_pk_bf16(b[2], b[3]); *(u32x4*)(db + e) = w; }
        { const f32x4 a = __builtin_nontemporal_load((const f32x4*)(p.up + e)), b = __builtin_nontemporal_load((const f32x4*)(p.up + e + 4));
            u32x4 w; w.x = cvt_pk_bf16(a[0], a[1]); w.y = cvt_pk_bf16(a[2], a[3]); w.z = cvt_pk_bf16(b[0], b[1]); w.w = cvt_pk_bf16(b[2], b[3]); *(u32x4*)(ub + e) = w; }
    }
}

#define SORT16(L) do { float _h; _h = fmaxf(L[0], L[1]); L[1] = fminf(L[0], L[1]); L[0] = _h; _h = fmaxf(L[2], L[3]); L[3] = fminf(L[2], L[3]); L[2] = _h; _h = fmaxf(L[0], L[2]); L[2] = fminf(L[0], L[2]); L[0] = _h; _h = fmaxf(L[1], L[3]); L[3] = fminf(L[1], L[3]); L[1] = _h; _h = fmaxf(L[1], L[2]); L[2] = fminf(L[1], L[2]); L[1] = _h; _h = fmaxf(L[4], L[5]); L[5] = fminf(L[4], L[5]); L[4] = _h; _h = fmaxf(L[6], L[7]); L[7] = fminf(L[6], L[7]); L[6] = _h; _h = fmaxf(L[4], L[6]); L[6] = fminf(L[4], L[6]); L[4] = _h; _h = fmaxf(L[5], L[7]); L[7] = fminf(L[5], L[7]); L[5] = _h; _h = fmaxf(L[5], L[6]); L[6] = fminf(L[5], L[6]); L[5] = _h; _h = fmaxf(L[0], L[4]); L[4] = fminf(L[0], L[4]); L[0] = _h; _h = fmaxf(L[2], L[6]); L[6] = fminf(L[2], L[6]); L[2] = _h; _h = fmaxf(L[2], L[4]); L[4] = fminf(L[2], L[4]); L[2] = _h; _h = fmaxf(L[1], L[5]); L[5] = fminf(L[1], L[5]); L[1] = _h; _h = fmaxf(L[3], L[7]); L[7] = fminf(L[3], L[7]); L[3] = _h; _h = fmaxf(L[3], L[5]); L[5] = fminf(L[3], L[5]); L[3] = _h; _h = fmaxf(L[1], L[2]); L[2] = fminf(L[1], L[2]); L[1] = _h; _h = fmaxf(L[3], L[4]); L[4] = fminf(L[3], L[4]); L[3] = _h; _h = fmaxf(L[5], L[6]); L[6] = fminf(L[5], L[6]); L[5] = _h; _h = fmaxf(L[8], L[9]); L[9] = fminf(L[8], L[9]); L[8] = _h; _h = fmaxf(L[10], L[11]); L[11] = fminf(L[10], L[11]); L[10] = _h; _h = fmaxf(L[8], L[10]); L[10] = fminf(L[8], L[10]); L[8] = _h; _h = fmaxf(L[9], L[11]); L[11] = fminf(L[9], L[11]); L[9] = _h; _h = fmaxf(L[9], L[10]); L[10] = fminf(L[9], L[10]); L[9] = _h; _h = fmaxf(L[12], L[13]); L[13] = fminf(L[12], L[13]); L[12] = _h; _h = fmaxf(L[14], L[15]); L[15] = fminf(L[14], L[15]); L[14] = _h; _h = fmaxf(L[12], L[14]); L[14] = fminf(L[12], L[14]); L[12] = _h; _h = fmaxf(L[13], L[15]); L[15] = fminf(L[13], L[15]); L[13] = _h; _h = fmaxf(L[13], L[14]); L[14] = fminf(L[13], L[14]); L[13] = _h; _h = fmaxf(L[8], L[12]); L[12] = fminf(L[8], L[12]); L[8] = _h; _h = fmaxf(L[10], L[14]); L[14] = fminf(L[10], L[14]); L[10] = _h; _h = fmaxf(L[10], L[12]); L[12] = fminf(L[10], L[12]); L[10] = _h; _h = fmaxf(L[9], L[13]); L[13] = fminf(L[9], L[13]); L[9] = _h; _h = fmaxf(L[11], L[15]); L[15] = fminf(L[11], L[15]); L[11] = _h; _h = fmaxf(L[11], L[13]); L[13] = fminf(L[11], L[13]); L[11] = _h; _h = fmaxf(L[9], L[10]); L[10] = fminf(L[9], L[10]); L[9] = _h; _h = fmaxf(L[11], L[12]); L[12] = fminf(L[11], L[12]); L[11] = _h; _h = fmaxf(L[13], L[14]); L[14] = fminf(L[13], L[14]); L[13] = _h; _h = fmaxf(L[0], L[8]); L[8] = fminf(L[0], L[8]); L[0] = _h; _h = fmaxf(L[4], L[12]); L[12] = fminf(L[4], L[12]); L[4] = _h; _h = fmaxf(L[4], L[8]); L[8] = fminf(L[4], L[8]); L[4] = _h; _h = fmaxf(L[2], L[10]); L[10] = fminf(L[2], L[10]); L[2] = _h; _h = fmaxf(L[6], L[14]); L[14] = fminf(L[6], L[14]); L[6] = _h; _h = fmaxf(L[6], L[10]); L[10] = fminf(L[6], L[10]); L[6] = _h; _h = fmaxf(L[2], L[4]); L[4] = fminf(L[2], L[4]); L[2] = _h; _h = fmaxf(L[6], L[8]); L[8] = fminf(L[6], L[8]); L[6] = _h; _h = fmaxf(L[10], L[12]); L[12] = fminf(L[10], L[12]); L[10] = _h; _h = fmaxf(L[1], L[9]); L[9] = fminf(L[1], L[9]); L[1] = _h; _h = fmaxf(L[5], L[13]); L[13] = fminf(L[5], L[13]); L[5] = _h; _h = fmaxf(L[5], L[9]); L[9] = fminf(L[5], L[9]); L[5] = _h; _h = fmaxf(L[3], L[11]); L[11] = fminf(L[3], L[11]); L[3] = _h; _h = fmaxf(L[7], L[15]); L[15] = fminf(L[7], L[15]); L[7] = _h; _h = fmaxf(L[7], L[11]); L[11] = fminf(L[7], L[11]); L[7] = _h; _h = fmaxf(L[3], L[5]); L[5] = fminf(L[3], L[5]); L[3] = _h; _h = fmaxf(L[7], L[9]); L[9] = fminf(L[7], L[9]); L[7] = _h; _h = fmaxf(L[11], L[13]); L[13] = fminf(L[11], L[13]); L[11] = _h; _h = fmaxf(L[1], L[2]); L[2] = fminf(L[1], L[2]); L[1] = _h; _h = fmaxf(L[3], L[4]); L[4] = fminf(L[3], L[4]); L[3] = _h; _h = fmaxf(L[5], L[6]); L[6] = fminf(L[5], L[6]); L[5] = _h; _h = fmaxf(L[7], L[8]); L[8] = fminf(L[7], L[8]); L[7] = _h; _h = fmaxf(L[9], L[10]); L[10] = fminf(L[9], L[10]); L[9] = _h; _h = fmaxf(L[11], L[12]); L[12] = fminf(L[11], L[12]); L[11] = _h; _h = fmaxf(L[13], L[14]); L[14] = fminf(L[13], L[14]); L[13] = _h; } while (0)
#define BITONIC16(L) do { float _h; _h = fmaxf(L[0], L[8]); L[8] = fminf(L[0], L[8]); L[0] = _h; _h = fmaxf(L[1], L[9]); L[9] = fminf(L[1], L[9]); L[1] = _h; _h = fmaxf(L[2], L[10]); L[10] = fminf(L[2], L[10]); L[2] = _h; _h = fmaxf(L[3], L[11]); L[11] = fminf(L[3], L[11]); L[3] = _h; _h = fmaxf(L[4], L[12]); L[12] = fminf(L[4], L[12]); L[4] = _h; _h = fmaxf(L[5], L[13]); L[13] = fminf(L[5], L[13]); L[5] = _h; _h = fmaxf(L[6], L[14]); L[14] = fminf(L[6], L[14]); L[6] = _h; _h = fmaxf(L[7], L[15]); L[15] = fminf(L[7], L[15]); L[7] = _h; _h = fmaxf(L[0], L[4]); L[4] = fminf(L[0], L[4]); L[0] = _h; _h = fmaxf(L[1], L[5]); L[5] = fminf(L[1], L[5]); L[1] = _h; _h = fmaxf(L[2], L[6]); L[6] = fminf(L[2], L[6]); L[2] = _h; _h = fmaxf(L[3], L[7]); L[7] = fminf(L[3], L[7]); L[3] = _h; _h = fmaxf(L[8], L[12]); L[12] = fminf(L[8], L[12]); L[8] = _h; _h = fmaxf(L[9], L[13]); L[13] = fminf(L[9], L[13]); L[9] = _h; _h = fmaxf(L[10], L[14]); L[14] = fminf(L[10], L[14]); L[10] = _h; _h = fmaxf(L[11], L[15]); L[15] = fminf(L[11], L[15]); L[11] = _h; _h = fmaxf(L[0], L[2]); L[2] = fminf(L[0], L[2]); L[0] = _h; _h = fmaxf(L[1], L[3]); L[3] = fminf(L[1], L[3]); L[1] = _h; _h = fmaxf(L[4], L[6]); L[6] = fminf(L[4], L[6]); L[4] = _h; _h = fmaxf(L[5], L[7]); L[7] = fminf(L[5], L[7]); L[5] = _h; _h = fmaxf(L[8], L[10]); L[10] = fminf(L[8], L[10]); L[8] = _h; _h = fmaxf(L[9], L[11]); L[11] = fminf(L[9], L[11]); L[9] = _h; _h = fmaxf(L[12], L[14]); L[14] = fminf(L[12], L[14]); L[12] = _h; _h = fmaxf(L[13], L[15]); L[15] = fminf(L[13], L[15]); L[13] = _h; _h = fmaxf(L[0], L[1]); L[1] = fminf(L[0], L[1]); L[0] = _h; _h = fmaxf(L[2], L[3]); L[3] = fminf(L[2], L[3]); L[2] = _h; _h = fmaxf(L[4], L[5]); L[5] = fminf(L[4], L[5]); L[4] = _h; _h = fmaxf(L[6], L[7]); L[7] = fminf(L[6], L[7]); L[6] = _h; _h = fmaxf(L[8], L[9]); L[9] = fminf(L[8], L[9]); L[8] = _h; _h = fmaxf(L[10], L[11]); L[11] = fminf(L[10], L[11]); L[10] = _h; _h = fmaxf(L[12], L[13]); L[13] = fminf(L[12], L[13]); L[12] = _h; _h = fmaxf(L[14], L[15]); L[15] = fminf(L[14], L[15]); L[14] = _h; } while (0)
#define INS16(L, xin) do { float _x = (xin); _Pragma("unroll") for (int _p = 0; _p < 16; ++_p) { const float _hi = fmaxf(L[_p], _x); _x = fminf(L[_p], _x); L[_p] = _hi; } } while (0)
__device__ void phase_topk(const Params& p, unsigned char* lds) {
    const int tid = threadIdx.x, wid = tid >> 6, lane = tid & 63, r = lane & 31, hh = lane >> 5;
    const bf16_t* qp = (const bf16_t*)(p.ws + OFF_QP); const bf16_t* keysb = (const bf16_t*)(p.ws + OFF_KEYS);
    int* idxo = (int*)(p.ws + OFF_IDX); float* go = (float*)(p.ws + OFF_G);
    float* myrows = (float*)lds + wid * 32 * 129;
    const float NEG = -__builtin_inff();
    for (int tile = blockIdx.x; tile < 256; tile += gridDim.x) {
        const int tokb = tile * 64 + (wid & 1) * 32;
        float v1[16], v2[16];
#pragma unroll
        for (int j = 0; j < 16; ++j) { v1[j] = NEG; v2[j] = NEG; }
#pragma unroll 1
        for (int pass = 0; pass < 4; ++pass) {
            const int half = pass >> 1, hg = pass & 1, head = hg * 4 + (wid >> 1);
            f32x16 acc[4] = {zero16(), zero16(), zero16(), zero16()};
            const bf16_t* arow = qp + (size_t)(tokb + r) * 2048 + head * 256 + half * 128 + 8 * hh;
            const bf16_t* kb = keysb + half * 16384 + r * 128 + 8 * hh;
#pragma unroll
            for (int ks = 0; ks < 8; ++ks) { const bf16x8 a = *(const bf16x8*)(arow + 16 * ks);
#pragma unroll
                for (int nt = 0; nt < 4; ++nt) { const bf16x8 bb = *(const bf16x8*)(kb + nt * 32 * 128 + 16 * ks); acc[nt] = MFMA32(a, bb, acc[nt]); } }
#pragma unroll
            for (int nt = 0; nt < 4; ++nt)
#pragma unroll
                for (int e = 0; e < 16; ++e) { const int m = (e & 3) + 8 * (e >> 2) + 4 * hh; myrows[m * 129 + nt * 32 + r] = acc[nt][e]; }
            asm volatile("s_waitcnt lgkmcnt(0)" ::: "memory"); __builtin_amdgcn_wave_barrier();
            float L[16];
            const float* rowp = myrows + r * 129 + hh * 64;
#pragma unroll
            for (int j = 0; j < 16; ++j) L[j] = __uint_as_float((__float_as_uint(rowp[j]) & ~127u) | (unsigned)(127 - (hh * 64 + j)));
            SORT16(L);
#pragma unroll 1
            for (int g = 1; g < 4; ++g) {
                float Gp[16];
#pragma unroll
                for (int j = 0; j < 16; ++j) Gp[j] = __uint_as_float((__float_as_uint(rowp[g * 16 + j]) & ~127u) | (unsigned)(127 - (hh * 64 + g * 16 + j)));
                SORT16(Gp);
#pragma unroll
                for (int j = 0; j < 16; ++j) L[j] = fmaxf(L[j], Gp[15 - j]);
                BITONIC16(L);
            }
            {
                float O[16];
#pragma unroll
                for (int j = 0; j < 16; ++j) O[j] = __shfl_xor(L[j], 32);
#pragma unroll
                for (int j = 0; j < 16; ++j) L[j] = fmaxf(L[j], O[15 - j]);
                BITONIC16(L);
            }
            const bool mine = hh == hg;
            if (half == 0) {
#pragma unroll
                for (int j = 0; j < 16; ++j) v1[j] = mine ? L[j] : v1[j];
            } else {
#pragma unroll
                for (int j = 0; j < 16; ++j) v2[j] = mine ? L[j] : v2[j];
            }
            asm volatile("s_waitcnt lgkmcnt(0)" ::: "memory"); __builtin_amdgcn_wave_barrier();
        }
        float T[16]; int TI[16];
        int i1[16], i2[16];
#pragma unroll
        for (int j = 0; j < 16; ++j) { i1[j] = (127 - (int)(__float_as_uint(v1[j]) & 127u)) * 128; i2[j] = 127 - (int)(__float_as_uint(v2[j]) & 127u); }
#pragma unroll
        for (int j = 0; j < 16; ++j) { T[j] = v1[0] + v2[j]; TI[j] = i1[0] + i2[j]; }
#pragma unroll
        for (int a = 1; a < 16; ++a)
#pragma unroll
            for (int b = 0; b < 16; ++b)
                if ((a + 1) * (b + 1) <= 16) {
                    float s = v1[a] + v2[b]; int id = i1[a] + i2[b];
#pragma unroll
                    for (int q = (a + 1) * (b + 1) - 1; q < 16; ++q) { const bool c = s > T[q]; const float ts = c ? T[q] : s; const int ti = c ? TI[q] : id; T[q] = c ? s : T[q]; TI[q] = c ? id : TI[q]; s = ts; id = ti; }
                }
        const int token = tokb + r, head = hh * 4 + (wid >> 1);
        const float t0v = T[0]; float tot = 0.f;
#pragma unroll
        for (int j = 0; j < 16; ++j) { T[j] = __expf(T[j] - t0v); tot += T[j]; }
        const float inv = 1.0f / tot;
#pragma unroll
        for (int j = 0; j < 16; j += 4) { *(f32x4*)(go + (size_t)token * 128 + head * 16 + j) = (f32x4){T[j] * inv, T[j + 1] * inv, T[j + 2] * inv, T[j + 3] * inv};
            *(int4*)(idxo + (size_t)token * 128 + head * 16 + j) = make_int4(TI[j], TI[j + 1], TI[j + 2], TI[j + 3]); }
    }
}

__device__ void phase_peer(const Params& p, unsigned char* lds) {
    const int tid = threadIdx.x, wid = tid >> 6, lane = tid & 63, l16 = lane & 15, q4 = lane >> 4;
    const bf16_t* h2 = (const bf16_t*)(p.ws + OFF_H2); const bf16_t* db = (const bf16_t*)(p.ws + OFF_DOWN); const bf16_t* ub = (const bf16_t*)(p.ws + OFF_UP);
    const int* idxo = (const int*)(p.ws + OFF_IDX); const float* go = (const float*)(p.ws + OFF_G);
    const float* mod = (const float*)(p.ws + OFF_MOD);
    float* sga = (float*)lds + wid * 128;
    for (int tg = blockIdx.x * 8 + wid; tg < 2048; tg += gridDim.x * 8) {
        const int b = tg >> 10;
        for (int tt = 0; tt < 8; ++tt) {
            const int t = tg * 8 + tt;
            const int idA = idxo[(size_t)t * 128 + lane], idB = idxo[(size_t)t * 128 + 64 + lane];
            const float gA = go[(size_t)t * 128 + lane], gB = go[(size_t)t * 128 + 64 + lane];
            u32x4 hq[8];
#pragma unroll
            for (int i = 0; i < 8; ++i) hq[i] = *(const u32x4*)(h2 + (size_t)t * DM + i * 128 + l16 * 8);
#pragma unroll 2
            for (int s = 0; s < 32; ++s) {
                const int slot = 4 * s + q4;
                const int e = __shfl(s < 16 ? idA : idB, slot & 63);
                const bf16_t* row = db + (size_t)e * DM + l16 * 8;
                u32x4 w[8];
#pragma unroll
                for (int i = 0; i < 8; ++i) w[i] = *(const u32x4*)(row + i * 128);
                float a = 0.f;
#pragma unroll
                for (int i = 0; i < 8; ++i) {
                    a = dot2bf(w[i].x, hq[i].x, a); a = dot2bf(w[i].y, hq[i].y, a); a = dot2bf(w[i].z, hq[i].z, a); a = dot2bf(w[i].w, hq[i].w, a); }
                a += __shfl_xor(a, 8); a += __shfl_xor(a, 4); a += __shfl_xor(a, 2); a += __shfl_xor(a, 1);
                const float gg = __shfl(s < 16 ? gA : gB, slot & 63);
                if (l16 == 0) sga[slot] = gelu1(a) * gg;
            }
            asm volatile("s_waitcnt lgkmcnt(0)" ::: "memory"); __builtin_amdgcn_wave_barrier();
            float acc[16];
#pragma unroll
            for (int j = 0; j < 16; ++j) acc[j] = 0.f;
#pragma unroll 4
            for (int slot = 0; slot < 128; ++slot) {
                const int e = __builtin_amdgcn_readlane(slot < 64 ? idA : idB, slot & 63);
                const float ga = sga[slot];
                const bf16_t* row = ub + (size_t)e * DM + lane * 8;
                const u32x4 w0 = *(const u32x4*)row, w1 = *(const u32x4*)(row + 512);
                acc[0] += ga * bflo(w0.x); acc[1] += ga * bfhi(w0.x); acc[2] += ga * bflo(w0.y); acc[3] += ga * bfhi(w0.y);
                acc[4] += ga * bflo(w0.z); acc[5] += ga * bfhi(w0.z); acc[6] += ga * bflo(w0.w); acc[7] += ga * bfhi(w0.w);
                acc[8] += ga * bflo(w1.x); acc[9] += ga * bfhi(w1.x); acc[10] += ga * bflo(w1.y); acc[11] += ga * bfhi(w1.y);
                acc[12] += ga * bflo(w1.z); acc[13] += ga * bfhi(w1.z); acc[14] += ga * bflo(w1.w); acc[15] += ga * bfhi(w1.w);
            }
            asm volatile("s_waitcnt lgkmcnt(0)" ::: "memory"); __builtin_amdgcn_wave_barrier();
            float xo[16]; float ss = 0.f;
#pragma unroll
            for (int i = 0; i < 2; ++i)
#pragma unroll
                for (int j4 = 0; j4 < 2; ++j4) { const int d = i * 512 + lane * 8 + j4 * 4;
                    const f32x4 xv = *(const f32x4*)(p.out + (size_t)t * DM + d);
                    const f32x4 g2 = *(const f32x4*)(mod + b * 6144 + 5120 + d) + *(const f32x4*)(p.b_ada + 5120 + d);
#pragma unroll
                    for (int j = 0; j < 4; ++j) { const float v = xv[j] + g2[j] * acc[i * 8 + j4 * 4 + j]; xo[i * 8 + j4 * 4 + j] = v; ss += v * v; } }
            ss = wave_sum(ss);
            const float rstd = rsqrtf(ss * (1.0f / 1024.0f) + EPS);
#pragma unroll
            for (int i = 0; i < 2; ++i)
#pragma unroll
                for (int j4 = 0; j4 < 2; ++j4) { const int d = i * 512 + lane * 8 + j4 * 4;
                    const f32x4 fw = *(const f32x4*)(p.final_w + d);
                    *(f32x4*)(p.out + (size_t)t * DM + d) = (f32x4){xo[i * 8 + j4 * 4] * rstd * fw[0], xo[i * 8 + j4 * 4 + 1] * rstd * fw[1], xo[i * 8 + j4 * 4 + 2] * rstd * fw[2], xo[i * 8 + j4 * 4 + 3] * rstd * fw[3]}; }
        }
    }
}

__device__ void phase_tables8(const Params& p) {
    const int wid = threadIdx.x >> 6, lane = threadIdx.x & 63;
    const int row0 = blockIdx.x * 8 + wid, rstep = gridDim.x * 8;
    f32x4 vn[4];
    if (row0 < 32768) { const float* src0 = (row0 >= 16384 ? p.up : p.down) + (size_t)(row0 & 16383) * DM + lane * 16;
#pragma unroll
        for (int i = 0; i < 4; ++i) vn[i] = __builtin_nontemporal_load((const f32x4*)(src0 + 4 * i)); }
    for (int row = row0; row < 32768; row += rstep) {
        const bool isup = row >= 16384; const int e = row & 16383;
        f32x4 v[4]; float m = 0.f;
#pragma unroll
        for (int i = 0; i < 4; ++i) v[i] = vn[i];
        if (row + rstep < 32768) { const int rn = row + rstep; const float* srcn = (rn >= 16384 ? p.up : p.down) + (size_t)(rn & 16383) * DM + lane * 16;
#pragma unroll
            for (int i = 0; i < 4; ++i) vn[i] = __builtin_nontemporal_load((const f32x4*)(srcn + 4 * i)); }
#pragma unroll
        for (int i = 0; i < 4; ++i) { m = fmaxf(m, fmaxf(fmaxf(fabsf(v[i][0]), fabsf(v[i][1])), fmaxf(fabsf(v[i][2]), fabsf(v[i][3])))); }
#pragma unroll
        for (int o = 32; o; o >>= 1) m = fmaxf(m, __shfl_xor(m, o));
        const float qmax = isup ? 224.0f : 127.0f;
        const float sc = m > 0.f ? m / qmax : 1.0f, inv = m > 0.f ? qmax / m : 0.f;
        int w[4];
        if (isup) {
#pragma unroll
            for (int i = 0; i < 4; ++i) { w[i] = __builtin_amdgcn_cvt_pk_fp8_f32(v[i][0] * inv, v[i][1] * inv, 0, false); w[i] = __builtin_amdgcn_cvt_pk_fp8_f32(v[i][2] * inv, v[i][3] * inv, w[i], true); }
        } else {
#pragma unroll
            for (int i = 0; i < 4; ++i) { const int q0 = (int)rintf(v[i][0] * inv), q1 = (int)rintf(v[i][1] * inv), q2 = (int)rintf(v[i][2] * inv), q3 = (int)rintf(v[i][3] * inv);
                w[i] = (q0 & 255) | ((q1 & 255) << 8) | ((q2 & 255) << 16) | ((q3 & 255) << 24); }
        }
        unsigned char* dst = p.ws + (isup ? OFF_UP8 : OFF_DOWN8) + (size_t)e * 1024 + lane * 16;
        *(u32x4*)dst = (u32x4){(unsigned)w[0], (unsigned)w[1], (unsigned)w[2], (unsigned)w[3]};
        if (lane == 0) ((float*)(p.ws + (isup ? OFF_SCU : OFF_SCD)))[e] = sc;
    }
}

__device__ __forceinline__ float dot2bfv(bf16x2_t a, unsigned b, float c) { return __builtin_amdgcn_fdot2_f32_bf16(a, __builtin_bit_cast(bf16x2_t, b), c, false); }
#define PEER_FMA16(ACC, W, GA) do { \
    const f32x2 _a0 = __builtin_amdgcn_cvt_pk_f32_fp8((int)(W).x, false), _a1 = __builtin_amdgcn_cvt_pk_f32_fp8((int)(W).x, true); \
    const f32x2 _b0 = __builtin_amdgcn_cvt_pk_f32_fp8((int)(W).y, false), _b1 = __builtin_amdgcn_cvt_pk_f32_fp8((int)(W).y, true); \
    const f32x2 _c0 = __builtin_amdgcn_cvt_pk_f32_fp8((int)(W).z, false), _c1 = __builtin_amdgcn_cvt_pk_f32_fp8((int)(W).z, true); \
    const f32x2 _d0 = __builtin_amdgcn_cvt_pk_f32_fp8((int)(W).w, false), _d1 = __builtin_amdgcn_cvt_pk_f32_fp8((int)(W).w, true); \
    ACC[0] = __builtin_fmaf((GA), _a0.x, ACC[0]); ACC[1] = __builtin_fmaf((GA), _a0.y, ACC[1]); ACC[2] = __builtin_fmaf((GA), _a1.x, ACC[2]); ACC[3] = __builtin_fmaf((GA), _a1.y, ACC[3]); \
    ACC[4] = __builtin_fmaf((GA), _b0.x, ACC[4]); ACC[5] = __builtin_fmaf((GA), _b0.y, ACC[5]); ACC[6] = __builtin_fmaf((GA), _b1.x, ACC[6]); ACC[7] = __builtin_fmaf((GA), _b1.y, ACC[7]); \
    ACC[8] = __builtin_fmaf((GA), _c0.x, ACC[8]); ACC[9] = __builtin_fmaf((GA), _c0.y, ACC[9]); ACC[10] = __builtin_fmaf((GA), _c1.x, ACC[10]); ACC[11] = __builtin_fmaf((GA), _c1.y, ACC[11]); \
    ACC[12] = __builtin_fmaf((GA), _d0.x, ACC[12]); ACC[13] = __builtin_fmaf((GA), _d0.y, ACC[13]); ACC[14] = __builtin_fmaf((GA), _d1.x, ACC[14]); ACC[15] = __builtin_fmaf((GA), _d1.y, ACC[15]); } while (0)
__device__ void phase_peer2(const Params& p, unsigned char* lds) {
    const int tid = threadIdx.x, wid = tid >> 6, lane = tid & 63, l16 = lane & 15, q4 = lane >> 4;
    unsigned char* wl = lds + wid * 6144;
    int* se = (int*)wl;
    float* sg = (float*)(wl + 2048);
    float* sa = (float*)(wl + 4096);
    const unsigned char* d8 = p.ws + OFF_DOWN8; const unsigned char* u8 = p.ws + OFF_UP8;
    const float* scd = (const float*)(p.ws + OFF_SCD); const float* scu = (const float*)(p.ws + OFF_SCU);
    const bf16_t* h2 = (const bf16_t*)(p.ws + OFF_H2);
    const int* idxo = (const int*)(p.ws + OFF_IDX); const float* go = (const float*)(p.ws + OFF_G);
    const float* mod = (const float*)(p.ws + OFF_MOD);
    const unsigned long long ltmask = (1ull << lane) - 1ull;
    for (int blk2 = blockIdx.x * 2; blk2 < 512; blk2 += (blk2 & 1) ? 2 * gridDim.x - 1 : 1) {
        const int blk = blk2; const int tok0 = blk * 32 + wid * 4; const int b = tok0 >> 13;
#pragma unroll
        for (int tk = 0; tk < 4; ++tk) { const size_t o = (size_t)(tok0 + tk) * 128 + lane;
            const int idA = idxo[o], idB = idxo[o + 64]; const float gA = go[o], gB = go[o + 64];
            int base = 0;
#pragma unroll
            for (int r = 0; r < 8; ++r) {
                const bool mA = (idA >> 11) == r, mB = (idB >> 11) == r; const unsigned long long kA = __ballot(mA), kB = __ballot(mB);
                if (mA) { const int pos = tk * 128 + base + __popcll(kA & ltmask); se[pos] = idA; sg[pos] = gA; }
                base += __popcll(kA);
                if (mB) { const int pos = tk * 128 + base + __popcll(kB & ltmask); se[pos] = idB; sg[pos] = gB; }
                base += __popcll(kB); } }
        int hq8[16]; float hscale;
        {
            u32x4 hraw[4][2]; float hm = 0.f;
#pragma unroll
            for (int i = 0; i < 4; ++i)
#pragma unroll
                for (int j = 0; j < 2; ++j) { hraw[i][j] = *(const u32x4*)(h2 + (size_t)(tok0 + q4) * DM + i * 256 + l16 * 16 + j * 8);
                    const unsigned ww[4] = {hraw[i][j].x, hraw[i][j].y, hraw[i][j].z, hraw[i][j].w};
#pragma unroll
                    for (int c = 0; c < 4; ++c) hm = fmaxf(hm, fmaxf(fabsf(bflo(ww[c])), fabsf(bfhi(ww[c])))); }
            hm = fmaxf(hm, __shfl_xor(hm, 8)); hm = fmaxf(hm, __shfl_xor(hm, 4)); hm = fmaxf(hm, __shfl_xor(hm, 2)); hm = fmaxf(hm, __shfl_xor(hm, 1));
            hscale = hm > 0.f ? hm * (1.0f / 127.0f) : 1.0f; const float hinv = hm > 0.f ? 127.0f / hm : 0.f;
#pragma unroll
            for (int i = 0; i < 4; ++i)
#pragma unroll
                for (int j = 0; j < 2; ++j) { const unsigned ww[4] = {hraw[i][j].x, hraw[i][j].y, hraw[i][j].z, hraw[i][j].w};
#pragma unroll
                    for (int c2 = 0; c2 < 2; ++c2) { const int q0 = (int)rintf(bflo(ww[2 * c2]) * hinv), q1 = (int)rintf(bfhi(ww[2 * c2]) * hinv), q2 = (int)rintf(bflo(ww[2 * c2 + 1]) * hinv), q3 = (int)rintf(bfhi(ww[2 * c2 + 1]) * hinv);
                        hq8[i * 4 + j * 2 + c2] = (q0 & 255) | ((q1 & 255) << 8) | ((q2 & 255) << 16) | ((q3 & 255) << 24); } }
        }
        asm volatile("s_waitcnt lgkmcnt(0)" ::: "memory"); __builtin_amdgcn_wave_barrier();
        {
            u32x4 bufA[8], bufB[8]; float sdA[2], sdB[2];
#define PEER_DLOAD(BUF, SD, K) do { _Pragma("unroll") for (int _u = 0; _u < 2; ++_u) { const int _e = se[q4 * 128 + 2 * (K) + _u]; const unsigned char* _row = d8 + (size_t)_e * 1024 + l16 * 16; \
            _Pragma("unroll") for (int _i = 0; _i < 4; ++_i) BUF[_u * 4 + _i] = *(const u32x4*)(_row + _i * 256); SD[_u] = scd[_e]; } } while (0)
#define PEER_DCOMP(BUF, SD, K) do { _Pragma("unroll") for (int _u = 0; _u < 2; ++_u) { int _ai = 0; \
            _Pragma("unroll") for (int _i = 0; _i < 4; ++_i) { const u32x4 _w = BUF[_u * 4 + _i]; \
                _ai = __builtin_amdgcn_sdot4((int)_w.x, hq8[_i * 4], _ai, false); _ai = __builtin_amdgcn_sdot4((int)_w.y, hq8[_i * 4 + 1], _ai, false); \
                _ai = __builtin_amdgcn_sdot4((int)_w.z, hq8[_i * 4 + 2], _ai, false); _ai = __builtin_amdgcn_sdot4((int)_w.w, hq8[_i * 4 + 3], _ai, false); } \
            _ai += __shfl_xor(_ai, 8); _ai += __shfl_xor(_ai, 4); _ai += __shfl_xor(_ai, 2); _ai += __shfl_xor(_ai, 1); \
            if (l16 == 0) sa[q4 * 128 + 2 * (K) + _u] = (float)_ai * SD[_u] * hscale; } } while (0)
            PEER_DLOAD(bufA, sdA, 0);
            for (int k = 0; k < 64; k += 2) {
                PEER_DLOAD(bufB, sdB, k + 1);
                PEER_DCOMP(bufA, sdA, k);
                if (k + 2 < 64) PEER_DLOAD(bufA, sdA, k + 2);
                PEER_DCOMP(bufB, sdB, k + 1);
            }
#undef PEER_DLOAD
#undef PEER_DCOMP
            asm volatile("s_waitcnt lgkmcnt(0)" ::: "memory"); __builtin_amdgcn_wave_barrier();
#pragma unroll
            for (int j = 0; j < 8; ++j) { const int ix = lane + 64 * j; const int e = se[ix]; sg[ix] = gelu1(sa[ix]) * sg[ix] * scu[e]; }
        }
        asm volatile("s_waitcnt lgkmcnt(0)" ::: "memory"); __builtin_amdgcn_wave_barrier();
        float acc0[16], acc1[16], acc2[16], acc3[16];
#pragma unroll
        for (int j = 0; j < 16; ++j) { acc0[j] = 0.f; acc1[j] = 0.f; acc2[j] = 0.f; acc3[j] = 0.f; }
        {
            u32x4 ring[12];
#pragma unroll
            for (int j = 0; j < 12; ++j) ring[j] = *(const u32x4*)(u8 + (size_t)se[(j & 3) * 128 + (j >> 2)] * 1024 + lane * 16);
            for (int i = 0; i < 129; i += 3) {
#pragma unroll
                for (int j = 0; j < 12; ++j) {
                    const int tk = j & 3, st = i + (j >> 2);
                    if (st >= 128) break;
                    const float ga = sg[tk * 128 + st];
                    const u32x4 w = ring[j];
                    if (st + 3 < 128) ring[j] = *(const u32x4*)(u8 + (size_t)se[tk * 128 + st + 3] * 1024 + lane * 16);
                    if (tk == 0) PEER_FMA16(acc0, w, ga); else if (tk == 1) PEER_FMA16(acc1, w, ga); else if (tk == 2) PEER_FMA16(acc2, w, ga); else PEER_FMA16(acc3, w, ga);
                }
            }
        }
        asm volatile("s_waitcnt lgkmcnt(0)" ::: "memory"); __builtin_amdgcn_wave_barrier();
#define PEER_FIN(ACC, TK) do { const size_t _o = (size_t)(tok0 + (TK)) * DM + lane * 16; f32x4 _x[4]; float _ss = 0.f; \
        _Pragma("unroll") for (int _j = 0; _j < 4; ++_j) { const f32x4 _xv = *(const f32x4*)(p.out + _o + 4 * _j); const f32x4 _g2 = *(const f32x4*)(mod + b * 6144 + 5120 + lane * 16 + 4 * _j) + *(const f32x4*)(p.b_ada + 5120 + lane * 16 + 4 * _j); \
            _x[_j] = _xv + _g2 * (f32x4){ACC[4 * _j], ACC[4 * _j + 1], ACC[4 * _j + 2], ACC[4 * _j + 3]}; _ss += _x[_j][0] * _x[_j][0] + _x[_j][1] * _x[_j][1] + _x[_j][2] * _x[_j][2] + _x[_j][3] * _x[_j][3]; } \
        _ss = wave_sum(_ss); const float _rs = rsqrtf(_ss * (1.0f / 1024.0f) + EPS); \
        _Pragma("unroll") for (int _j = 0; _j < 4; ++_j) { const f32x4 _fw = *(const f32x4*)(p.final_w + lane * 16 + 4 * _j); *(f32x4*)(p.out + _o + 4 * _j) = _x[_j] * _rs * _fw; } } while (0)
        PEER_FIN(acc0, 0); PEER_FIN(acc1, 1); PEER_FIN(acc2, 2); PEER_FIN(acc3, 3);
#undef PEER_FIN
    }
}

#ifndef DBG_STAGE
#define DBG_STAGE 0
#endif
__device__ void phase_final_only(const Params& p) {
    const int wid = threadIdx.x >> 6, lane = threadIdx.x & 63;
    for (int t = blockIdx.x * 8 + wid; t < NTOK; t += gridDim.x * 8) {
        f32x4 xv[4]; float ss = 0.f;
#pragma unroll
        for (int i = 0; i < 4; ++i) { xv[i] = *(const f32x4*)(p.out + (size_t)t * DM + 256 * i + 4 * lane); ss += xv[i][0] * xv[i][0] + xv[i][1] * xv[i][1] + xv[i][2] * xv[i][2] + xv[i][3] * xv[i][3]; }
        ss = wave_sum(ss);
        const float rstd = rsqrtf(ss * (1.0f / 1024.0f) + EPS);
#pragma unroll
        for (int i = 0; i < 4; ++i) { const f32x4 fw = *(const f32x4*)(p.final_w + 256 * i + 4 * lane); *(f32x4*)(p.out + (size_t)t * DM + 256 * i + 4 * lane) = xv[i] * rstd * fw; }
    }
}

__device__ void phase_dump_bf16(const Params& p, const bf16_t* src, int ld) {
    for (size_t e = (size_t)blockIdx.x * 512 + threadIdx.x; e < (size_t)NTOK * DM; e += (size_t)gridDim.x * 512) {
        const size_t t = e >> 10, d = e & 1023; float v = __uint_as_float((unsigned)src[t * ld + d] << 16); if (!(fabsf(v) < 1e30f)) v = 1000.f; p.out[e] = v; }
}
__device__ void dbg_check_bf16(const Params& p, const bf16_t* src, size_t n, unsigned bit) {
    unsigned* flags = (unsigned*)(p.ws + OFF_IDX);
    bool bad = false;
    for (size_t e = (size_t)blockIdx.x * 512 + threadIdx.x; e < n; e += (size_t)gridDim.x * 512) { const float v = __uint_as_float((unsigned)src[e] << 16); if (!(fabsf(v) < 1e30f)) bad = true; }
    if (bad) atomicOr(flags, bit);
}
__device__ void dbg_check_f32(const Params& p, const float* src, size_t n, unsigned bit, float lim) {
    unsigned* flags = (unsigned*)(p.ws + OFF_IDX);
    bool bad = false;
    for (size_t e = (size_t)blockIdx.x * 512 + threadIdx.x; e < n; e += (size_t)gridDim.x * 512) { const float v = src[e]; if (!(fabsf(v) < lim)) bad = true; }
    if (bad) atomicOr(flags, bit);
}
__device__ void dbg_final(const Params& p) {
    const unsigned f = *(const unsigned*)(p.ws + OFF_IDX);
    for (size_t e = (size_t)blockIdx.x * 512 + threadIdx.x; e < (size_t)NTOK * DM; e += (size_t)gridDim.x * 512) p.out[e] = p.x[e] * (1.0f + (float)f);
}
#define GSYNC() xcd_barrier(xb)
__global__ void __launch_bounds__(512, 2) fwd_megakernel(Params p) {
    extern __shared__ __attribute__((aligned(16))) unsigned char lds[];
    cg::grid_group grid = cg::this_grid();
    LAS unsigned char* lds3 = (LAS unsigned char*)lds;
    const float* mod = (const float*)(p.ws + OFF_MOD);
    volatile LAS unsigned* xst = (volatile LAS unsigned*)(lds3 + LDS_BYTES - 16);
    if (threadIdx.x == 0) { xst[0] = 0u; xst[1] = 0u; }
    __syncthreads();
    const XcdBarrier xb = xcd_barrier_post((unsigned*)(p.ws + OFF_BAR), xst);
    if (p.ws == nullptr) grid.sync();
    phase0(p, lds);
#if DBG_STAGE == 6
    if (blockIdx.x == 0 && threadIdx.x == 0) *(unsigned*)(p.ws + OFF_IDX) = 0u;
#endif
    GSYNC();
    phase_norm<true>(p, p.x, p.norm1_w, 0, 1024, (bf16_t*)(p.ws + OFF_HB), lds);
    GSYNC();
#if DBG_STAGE == 3
    phase_dump_bf16(p, (const bf16_t*)(p.ws + OFF_HB), DM); return;
#endif
    { pg8::StaticOrder S; S.init(NTOK, 7168, gridDim.x, blockIdx.x); EpiProj E{(bf16_t*)(p.ws + OFF_PROJ)};
        pg8::gemm_phase(lds3, pg8::Gemm{(const bf16_t*)(p.ws + OFF_HB), (const bf16_t*)(p.ws + OFF_WINT), NTOK, 7168, 1024}, S, E); }
    GSYNC();
#if DBG_STAGE == 2
    phase_dump_bf16(p, (const bf16_t*)(p.ws + OFF_PROJ) + 1024, PW); return;
#endif
    phase_glaA(p, lds);
    GSYNC();
#if DBG_STAGE == 6
    dbg_check_bf16(p, (const bf16_t*)p.out, (size_t)NTOK * 2048, 1u);
    dbg_check_f32(p, (const float*)(p.ws + OFF_ALR), (size_t)NTOK * 16, 8u, 50.f);
    dbg_check_f32(p, (const float*)(p.ws + OFF_DECAY), (size_t)1024 * 128, 16u, 1.0001f);
#endif
    phase_scan_sgu(p, lds);
    GSYNC();
#if DBG_STAGE == 6
    dbg_check_bf16(p, (const bf16_t*)p.out, (size_t)NTOK * 2048, 2u);
#endif
#if DBG_STAGE == 4
    phase_dump_bf16(p, (const bf16_t*)(p.ws + OFF_HB), DM); return;
#endif
    phase_glaC(p, lds);
    GSYNC();
#if DBG_STAGE == 5
    phase_dump_bf16(p, (const bf16_t*)(p.ws + OFF_HB), DM); return;
#endif
#if DBG_STAGE == 6
    dbg_check_bf16(p, (const bf16_t*)(p.ws + OFF_HB), (size_t)NTOK * DM, 4u);
    GSYNC();
    dbg_final(p); return;
#endif
    { pg8::StaticOrder S; S.init(NTOK, 1024, gridDim.x, blockIdx.x); EpiX1 E{p.x, p.out, mod, p.b_ada};
        pg8::gemm_phase(lds3, pg8::Gemm{(const bf16_t*)(p.ws + OFF_HB), (const bf16_t*)(p.ws + OFF_WOUTT), NTOK, 1024, 1024}, S, E); }
    GSYNC();
#if DBG_STAGE == 1
    phase_final_only(p); return;
#endif
    phase_norm<false>(p, p.out, p.norm2_w, 3072, 4096, (bf16_t*)(p.ws + OFF_H2), lds);
    phase_tables8(p);
    GSYNC();
    { pg8::StaticOrder S; S.init(NTOK, 2048, gridDim.x, blockIdx.x); EpiQ E{(bf16_t*)(p.ws + OFF_QP)};
        pg8::gemm_phase(lds3, pg8::Gemm{(const bf16_t*)(p.ws + OFF_H2), (const bf16_t*)(p.ws + OFF_WQT), NTOK, 2048, 1024}, S, E); }
    GSYNC();
    phase_topk(p, lds);
    asm volatile("s_waitcnt vmcnt(0) lgkmcnt(0)" ::: "memory"); __syncthreads();
    phase_peer2(p, lds);
}

extern "C" void kernel_launch(void* const* d_in, const int* in_sizes, int n_in, void* d_out, int out_size, void* d_ws, size_t ws_size, hipStream_t stream) {
    static int grid_blocks = 0;
    if (!grid_blocks) {
        int dev = 0, cus = 0, per_cu = 0;
        hipGetDevice(&dev);
        hipDeviceGetAttribute(&cus, hipDeviceAttributeMultiprocessorCount, dev);
        hipFuncSetAttribute((const void*)fwd_megakernel, hipFuncAttributeMaxDynamicSharedMemorySize, LDS_BYTES);
        hipOccupancyMaxActiveBlocksPerMultiprocessor(&per_cu, (const void*)fwd_megakernel, 512, LDS_BYTES);
        per_cu = 1;
        grid_blocks = cus * per_cu;
        if (ws_size < WS_END) fprintf(stderr, "kernel_launch: workspace too small (%zu < %zu)\n", ws_size, (size_t)WS_END);
    }
    Params p{};
    p.x = (const float*)d_in[0]; p.c = (const float*)d_in[1]; p.w_ada = (const float*)d_in[2]; p.b_ada = (const float*)d_in[3]; p.norm1_w = (const float*)d_in[4];
    p.w_in = (const float*)d_in[5]; p.w_alpha_up = (const float*)d_in[6]; p.b_alpha = (const float*)d_in[7]; p.gla_norm_w = (const float*)d_in[8];
    p.sgu_ln_w = (const float*)d_in[9]; p.sgu_ln_b = (const float*)d_in[10]; p.sgu_w = (const float*)d_in[11]; p.sgu_b = (const float*)d_in[12];
    p.w_out = (const float*)d_in[13]; p.norm2_w = (const float*)d_in[14]; p.w_q = (const float*)d_in[15]; p.keys1 = (const float*)d_in[16]; p.keys2 = (const float*)d_in[17];
    p.down = (const float*)d_in[18]; p.up = (const float*)d_in[19]; p.final_w = (const float*)d_in[20];
    p.out = (float*)d_out; p.ws = (unsigned char*)d_ws;
    hipMemsetAsync((unsigned char*)d_ws + OFF_BAR, 0, XCD_BAR_WORDS * 4, stream);
    void* args[] = {&p};
    hipError_t e = hipLaunchCooperativeKernel((const void*)fwd_megakernel, dim3(grid_blocks), dim3(512), args, LDS_BYTES, stream);
    if (e != hipSuccess) fprintf(stderr, "cooperative launch failed: %s (grid %d)\n", hipGetErrorString(e), grid_blocks);
}
```

```cpp
#include <hip/hip_runtime.h>
#include <hip/hip_cooperative_groups.h>
#include <cstdio>
namespace cg = cooperative_groups;

#define LAS __attribute__((address_space(3)))
typedef unsigned short bf16_t;
typedef short bf16x8 __attribute__((ext_vector_type(8)));
typedef float f32x2 __attribute__((ext_vector_type(2)));
typedef float f32x4 __attribute__((ext_vector_type(4)));
typedef float f32x16 __attribute__((ext_vector_type(16)));
typedef unsigned u32x2 __attribute__((ext_vector_type(2)));
typedef unsigned u32x4 __attribute__((ext_vector_type(4)));
typedef __bf16 bf16x2_t __attribute__((ext_vector_type(2)));

constexpr int NTOK = 16384, DM = 1024, SEQ = 8192, INW = 7184, PW = 5120;
constexpr float EPS = 1e-6f;
constexpr size_t MiB = 1024 * 1024;
constexpr size_t OFF_PROJ = 0;
constexpr size_t OFF_DOWN = 0;
constexpr size_t OFF_UP = 32 * MiB;
constexpr size_t OFF_DOWN8 = 0;
constexpr size_t OFF_UP8 = 16 * MiB;
constexpr size_t OFF_SCD = 32 * MiB;
constexpr size_t OFF_SCU = 32 * MiB + 65536;
constexpr size_t OFF_H2 = 64 * MiB;
constexpr size_t OFF_QP = 96 * MiB;
constexpr size_t OFF_HB = 160 * MiB;
constexpr size_t OFF_WINT = 192 * MiB;
constexpr size_t OFF_WOUTT = 206 * MiB;
constexpr size_t OFF_WQT = 208 * MiB;
constexpr size_t OFF_KEYS = 212 * MiB;
constexpr size_t OFF_MOD = OFF_KEYS + 65536;
constexpr size_t OFF_ALR = OFF_MOD + 65536;
constexpr size_t OFF_STATS = OFF_ALR + MiB;
constexpr size_t OFF_DECAY = OFF_STATS + 131072;
constexpr size_t OFF_BAR = OFF_DECAY + 524288;
constexpr size_t OFF_IDX = 214 * MiB;
constexpr size_t OFF_G = 222 * MiB;
constexpr size_t WS_END = 230 * MiB;
constexpr int LDS_BYTES = 135168;

struct Params {
    const float *x, *c, *w_ada, *b_ada, *norm1_w, *w_in, *w_alpha_up, *b_alpha, *gla_norm_w, *sgu_ln_w, *sgu_ln_b, *sgu_w, *sgu_b, *w_out, *norm2_w, *w_q, *keys1, *keys2, *down, *up, *final_w;
    float* out; unsigned char* ws;
};

__device__ __forceinline__ unsigned cvt_pk_bf16_asm(float lo, float hi) { unsigned r; asm volatile("v_cvt_pk_bf16_f32 %0, %1, %2" : "=v"(r) : "v"(lo), "v"(hi)); return r; }
__device__ __forceinline__ unsigned cvt_pk_bf16(float lo, float hi) { f32x2 v = {lo, hi}; bf16x2_t b = __builtin_convertvector(v, bf16x2_t); return __builtin_bit_cast(unsigned, b); }
__device__ __forceinline__ float bflo(unsigned w) { return __uint_as_float(w << 16); }
__device__ __forceinline__ float bfhi(unsigned w) { return __uint_as_float(w & 0xffff0000u); }
__device__ __forceinline__ float wave_sum(float v) {
#pragma unroll
    for (int o = 32; o; o >>= 1) v += __shfl_xor(v, o);
    return v;
}
__device__ __forceinline__ float sigmoidf_(float x) { return __builtin_amdgcn_rcpf(1.0f + __expf(-x)); }
__device__ __forceinline__ f32x2 gelu_pk(f32x2 v) {
    const f32x2 av = __builtin_elementwise_abs(v), d = av * 0.2316418882f + 1.0f;
    f32x2 t; t.x = __builtin_amdgcn_rcpf(d.x); t.y = __builtin_amdgcn_rcpf(d.y);
    f32x2 q = t * 0.5307027145f + (-0.7265760135f); q = q * t + 0.7107068705f; q = q * t + (-0.142248368f); q = q * t + 0.127414796f; q = q * t;
    const f32x2 s = (v * v) * (-0.72134752044f);
    f32x2 e; e.x = __builtin_amdgcn_exp2f(s.x); e.y = __builtin_amdgcn_exp2f(s.y);
    const f32x2 m = v * (q * e), r = v - m;
    f32x2 o; o.x = v.x < 0.f ? m.x : r.x; o.y = v.y < 0.f ? m.y : r.y; return o;
}
__device__ __forceinline__ float gelu1(float v) { f32x2 r = gelu_pk((f32x2){v, v}); return r.x; }
__device__ __forceinline__ f32x16 zero16() { f32x16 z;
#pragma unroll
    for (int i = 0; i < 16; ++i) z[i] = 0.f;
    return z; }
__device__ __forceinline__ float dot2bf(unsigned a, unsigned b, float c) { return __builtin_amdgcn_fdot2_f32_bf16(__builtin_bit_cast(bf16x2_t, a), __builtin_bit_cast(bf16x2_t, b), c, false); }
#define MFMA32(a, b, c) __builtin_amdgcn_mfma_f32_32x32x16_bf16((a), (b), (c), 0, 0, 0)


#define XB_TMO      128
#define XB_XCNT(j)  (256  + 64 * (j))
#define XB_XSUB(j)  (1280 + 64 * (j))
#define XB_XGEN(j)  (2304 + 64 * (j))
#define XB_TOP      3328
#define XB_TOPGEN   3392
#define XCD_BAR_WORDS 3456
#define XB_SPIN_CAP (1u << 18)
__device__ __forceinline__ unsigned xb_ld(unsigned* p)              { return __hip_atomic_load(p, __ATOMIC_RELAXED, __HIP_MEMORY_SCOPE_AGENT); }
__device__ __forceinline__ unsigned xb_add(unsigned* p, unsigned v) { return __hip_atomic_fetch_add(p, v, __ATOMIC_RELAXED, __HIP_MEMORY_SCOPE_AGENT); }
__device__ __forceinline__ unsigned xb_xcc_id() { return (unsigned)__builtin_amdgcn_s_getreg((3 << 11) | 20) & 0xFu; }
#define XB_SPIN(cond, bar) do { unsigned _sp = 0; while (cond) { __builtin_amdgcn_s_sleep(1); \
    if ((++_sp & 255u) == 0u) { if (xb_ld(&(bar)[XB_TMO])) break; if (_sp > XB_SPIN_CAP) { atomicAdd(&(bar)[XB_TMO], 1u); break; } } } } while (0)
struct XcdBarrier { unsigned* bar; unsigned x; volatile LAS unsigned* st; };
__device__ __forceinline__ XcdBarrier xcd_barrier_post(unsigned* bar, volatile LAS unsigned* st) {
    XcdBarrier b; b.bar = bar; b.x = xb_xcc_id(); b.st = st;
    if (threadIdx.x == 0) (void)xb_add(&bar[XB_XCNT(b.x)], 1u);
    return b;
}
__device__ __forceinline__ void xcd_barrier_complete(unsigned* bar, unsigned x, unsigned& nloc, unsigned& nx) {
    const unsigned G = gridDim.x * gridDim.y * gridDim.z;
    unsigned sum, cnt, mine, sp = 0u;
    for (;;) {
        sum = 0u; cnt = 0u; mine = 0u;
#pragma unroll
        for (unsigned j = 0; j < 16; ++j) { const unsigned c = xb_ld(&bar[XB_XCNT(j)]); sum += c; cnt += (c > 0u) ? 1u : 0u; mine = (j == x) ? c : mine; }
        if (sum == G) break;
        __builtin_amdgcn_s_sleep(1);
        if ((++sp & 255u) == 0u) { if (xb_ld(&bar[XB_TMO])) break; if (sp > XB_SPIN_CAP) { atomicAdd(&bar[XB_TMO], 1u); break; } }
    }
    nloc = mine > 0u ? mine : 1u; nx = cnt > 0u ? cnt : 1u;
}
__device__ __forceinline__ void xcd_barrier(const XcdBarrier& b) {
    asm volatile("s_waitcnt vmcnt(0)" ::: "memory");
    __syncthreads();
    if (threadIdx.x == 0) {
        unsigned* bar = b.bar;
        __builtin_amdgcn_s_waitcnt(0);
        unsigned nloc = b.st[0], nx = b.st[1];
        if (nloc == 0u) { xcd_barrier_complete(bar, b.x, nloc, nx); b.st[0] = nloc; b.st[1] = nx; }
        const unsigned old = xb_add(&bar[XB_XSUB(b.x)], 1u);
        const unsigned gen = old / nloc;
        if (old + 1u == (gen + 1u) * nloc) {
            __builtin_amdgcn_fence(__ATOMIC_RELEASE, "agent");
            asm volatile("s_waitcnt vmcnt(0)" ::: "memory");
            const unsigned og = xb_add(&bar[XB_TOP], 1u);
            const unsigned tg = og / nx;
            if (og + 1u == (tg + 1u) * nx) xb_add(&bar[XB_TOPGEN], 1u);
            else XB_SPIN(xb_ld(&bar[XB_TOPGEN]) == tg, bar);
            __builtin_amdgcn_fence(__ATOMIC_ACQUIRE, "agent");
            xb_add(&bar[XB_XGEN(b.x)], 1u);
            asm volatile("s_waitcnt vmcnt(0)" ::: "memory");
        } else {
            XB_SPIN(xb_ld(&bar[XB_XGEN(b.x)]) == gen, bar);
            __builtin_amdgcn_fence(__ATOMIC_ACQUIRE, "agent");
            asm volatile("s_waitcnt vmcnt(0)" ::: "memory");
        }
    }
    __syncthreads();
}

namespace pg8 {
constexpr int BM = 256, BK = 64, HALF = 128, HTB = HALF * BK * 2, STAGE_BYTES = 8 * HTB, NXCD = 8, WGM = 8;
__host__ __device__ __forceinline__ int lds_byte(int r, int c) { const int st = (r >> 4) * 2 + (c >> 5), rr = r & 15, cc = c & 31, ob = rr * 64 + cc * 2; return st * 1024 + (ob ^ (((ob >> 9) & 1) << 5)); }
__host__ __device__ __forceinline__ void stage_rc(int b, int& R, int& C) { const int st = b / 1024, sb = b % 1024, swz = sb ^ (((sb >> 9) & 1) << 5); R = (st >> 1) * 16 + swz / 64; C = (st & 1) * 32 + (swz % 64) / 2; }
__host__ __device__ __forceinline__ int perm32(int rho) { const int n = rho >> 4, i = rho & 15; return 8 * (i >> 2) + 4 * n + (i & 3); }
struct Unit { int pm, pn; };
struct Gemm { const bf16_t* A; const bf16_t* Bt; int M, N, K; };
struct StaticOrder {
    int nM, nN, nwg, G, c;
    __device__ void init(int M, int N, int G_, int c_) { nM = M / BM; nN = N / BM; nwg = nM * nN; G = G_; c = c_; }
    __device__ bool next(int i, Unit& u) const {
        const long L = (long)i * G + c; if (L >= nwg) return false;
        int wgid = (int)L; { const int q = nwg / NXCD, r = nwg % NXCD, xcd = wgid % NXCD, off = wgid / NXCD; wgid = (xcd < r ? xcd * (q + 1) : r * (q + 1) + (xcd - r) * q) + off; }
        const int nig = WGM * nN, gid = wgid / nig, fm = gid * WGM, gsz = (nM - fm) < WGM ? (nM - fm) : WGM;
        u.pm = fm + ((wgid % nig) % gsz); u.pn = (wgid % nig) / gsz; return true;
    }
    __device__ __forceinline__ void a_ready(const Unit&) const {}
    __device__ __forceinline__ void done(const Unit&) const {}
};

template <class Epi, class Sched>
__device__ __forceinline__ void gemm_phase(LAS unsigned char* lds, const Gemm g, const Sched& S, const Epi& E) {
    const int tid = threadIdx.x, wid = __builtin_amdgcn_readfirstlane(tid >> 6), lane = tid & 63, wr = wid >> 2, wc = wid & 3, fr = lane & 15, fq = lane >> 4;
    const int K = g.K, nt = K / BK;
    unsigned voffA[2], voffB[2];
#pragma unroll
    for (int i = 0; i < 2; ++i) { int R, C; stage_rc(tid * 16 + i * 8192, R, C); const int Rb = Epi::PERM ? ((R & ~31) + perm32(R & 31)) : R;
        voffA[i] = (unsigned)(R * K + C) * 2u; voffB[i] = (unsigned)(Rb * K + C) * 2u; }
    const size_t kstep = (size_t)(BK * 2);
    const size_t hstep = (size_t)HALF * K * 2;
    const size_t tstep = 2 * hstep;
    const unsigned ldsw = (unsigned)wid * 1024u;
    const int aoff = lds_byte(wr * 64 + fr, fq * 8), boff = lds_byte(wc * 32 + fr, fq * 8);
#define PG8_SA(b, h) (((b) * 2 + (h)) * HTB)
#define PG8_SB(b, h) ((4 + (b) * 2 + (h)) * HTB)
#define PG8_STAGE(bufoff, gbase, voff) do { _Pragma("unroll") for (int _i = 0; _i < 2; ++_i) \
        __builtin_amdgcn_global_load_lds((const unsigned*)((const char*)(gbase) + (voff)[_i]), (LAS unsigned*)(lds + (bufoff) + ldsw + _i * 8192), 16, 0, 0); } while (0)
#define PG8_LDA(dst, b, h) do { _Pragma("unroll") for (int m = 0; m < 4; ++m) _Pragma("unroll") for (int k = 0; k < 2; ++k) dst[m][k] = *(const LAS bf16x8*)(lds + PG8_SA(b, h) + aoff + m * 2048 + k * 1024); } while (0)
#define PG8_LDB(dst, b, h) do { _Pragma("unroll") for (int n = 0; n < 2; ++n) _Pragma("unroll") for (int k = 0; k < 2; ++k) dst[n][k] = *(const LAS bf16x8*)(lds + PG8_SB(b, h) + boff + n * 2048 + k * 1024); } while (0)
#define PG8_MMA(ai, bj, At, Bt) do { __builtin_amdgcn_s_setprio(1); _Pragma("unroll") for (int m = 0; m < 4; ++m) _Pragma("unroll") for (int n = 0; n < 2; ++n) _Pragma("unroll") for (int k = 0; k < 2; ++k) \
        acc[ai][bj][m][n] = __builtin_amdgcn_mfma_f32_16x16x32_bf16(Bt[n][k], At[m][k], acc[ai][bj][m][n], 0, 0, 0); __builtin_amdgcn_s_setprio(0); } while (0)
#define PG8_WAIT_V(n) asm volatile("s_waitcnt vmcnt(" #n ")" ::: "memory")
#define PG8_WAIT_L(n) asm volatile("s_waitcnt lgkmcnt(" #n ")" ::: "memory")
#define PG8_BAR __builtin_amdgcn_s_barrier()
#define PG8_SCHED __builtin_amdgcn_sched_barrier(0)
    Unit cur, nxt; int ui = 0;
    if (!S.next(0, cur)) return;
    f32x4 acc[2][2][4][2];
#pragma unroll
    for (int a = 0; a < 2; ++a)
#pragma unroll
        for (int b = 0; b < 2; ++b)
#pragma unroll
            for (int m = 0; m < 4; ++m)
#pragma unroll
                for (int n = 0; n < 2; ++n) acc[a][b][m][n] = (f32x4){0.f, 0.f, 0.f, 0.f};
    bf16x8 At[4][2], B0[2][2], B1[2][2];
    const char* cA = (const char*)g.A + (size_t)cur.pm * tstep; const char* cB = (const char*)g.Bt + (size_t)cur.pn * tstep;
    S.a_ready(cur);
    PG8_STAGE(PG8_SB(0, 0), cB, voffB); PG8_STAGE(PG8_SA(0, 0), cA, voffA); PG8_STAGE(PG8_SB(0, 1), cB + hstep, voffB); PG8_STAGE(PG8_SA(0, 1), cA + hstep, voffA);
    if (wr == 1) PG8_BAR;
    PG8_WAIT_V(4); PG8_BAR;
    PG8_STAGE(PG8_SB(1, 0), cB + kstep, voffB); PG8_STAGE(PG8_SA(1, 0), cA + kstep, voffA); PG8_STAGE(PG8_SB(1, 1), cB + hstep + kstep, voffB);
    PG8_WAIT_V(6); PG8_BAR;
    for (;;) {
        const bool has_next = S.next(ui + 1, nxt);
        const char* nA = has_next ? (const char*)g.A + (size_t)nxt.pm * tstep : cA; const char* nB = has_next ? (const char*)g.Bt + (size_t)nxt.pn * tstep : cB;
        for (int t = 0; t < nt; t += 2) {
            const bool last = (t == nt - 2);
            const char* a1 = cA + (size_t)(t + 1) * kstep;
            const char* a2 = last ? nA : cA + (size_t)(t + 2) * kstep; const char* b2 = last ? nB : cB + (size_t)(t + 2) * kstep;
            const char* a3 = a2 + kstep; const char* b3 = b2 + kstep;
            if (last && has_next) S.a_ready(nxt);
            PG8_LDB(B0, 0, 0); PG8_SCHED; PG8_LDA(At, 0, 0); PG8_STAGE(PG8_SA(1, 1), a1 + hstep, voffA);
            PG8_WAIT_L(8); PG8_BAR; PG8_WAIT_L(0); PG8_MMA(0, 0, At, B0); PG8_BAR; PG8_SCHED;
            PG8_LDB(B1, 0, 1); PG8_STAGE(PG8_SB(0, 0), b2, voffB);
            PG8_BAR; PG8_WAIT_L(0); PG8_MMA(0, 1, At, B1); PG8_BAR;
            PG8_LDA(At, 0, 1); PG8_STAGE(PG8_SA(0, 0), a2, voffA);
            PG8_BAR; PG8_WAIT_L(0); PG8_MMA(1, 0, At, B0); PG8_BAR; PG8_SCHED;
            PG8_STAGE(PG8_SB(0, 1), b2 + hstep, voffB);
            PG8_WAIT_V(6); PG8_BAR; PG8_MMA(1, 1, At, B1); PG8_BAR;
            PG8_LDB(B0, 1, 0); PG8_SCHED; PG8_LDA(At, 1, 0); PG8_STAGE(PG8_SA(0, 1), a2 + hstep, voffA);
            PG8_WAIT_L(8); PG8_BAR; PG8_WAIT_L(0); PG8_MMA(0, 0, At, B0); PG8_BAR; PG8_SCHED;
            PG8_LDB(B1, 1, 1); PG8_STAGE(PG8_SB(1, 0), b3, voffB);
            PG8_BAR; PG8_WAIT_L(0); PG8_MMA(0, 1, At, B1); PG8_BAR;
            PG8_LDA(At, 1, 1); PG8_STAGE(PG8_SA(1, 0), a3, voffA);
            PG8_BAR; PG8_WAIT_L(0); PG8_MMA(1, 0, At, B0); PG8_BAR; PG8_SCHED;
            PG8_STAGE(PG8_SB(1, 1), b3 + hstep, voffB);
            PG8_WAIT_V(6); PG8_BAR; PG8_MMA(1, 1, At, B1); PG8_BAR;
        }
        E(acc, cur, wr, wc, fr, fq); S.done(cur);
        if (!has_next) break;
#pragma unroll
        for (int a = 0; a < 2; ++a)
#pragma unroll
            for (int b = 0; b < 2; ++b)
#pragma unroll
                for (int m = 0; m < 4; ++m)
#pragma unroll
                    for (int n = 0; n < 2; ++n) acc[a][b][m][n] = (f32x4){0.f, 0.f, 0.f, 0.f};
        cur = nxt; cA = nA; cB = nB; ++ui;
    }
    PG8_WAIT_V(0);
    if (wr == 0) PG8_BAR;
    PG8_BAR;
#undef PG8_SA
#undef PG8_SB
#undef PG8_STAGE
#undef PG8_LDA
#undef PG8_LDB
#undef PG8_MMA
#undef PG8_WAIT_V
#undef PG8_WAIT_L
#undef PG8_BAR
#undef PG8_SCHED
}
}
using pg8::Unit;

struct EpiProj {
    static constexpr bool PERM = true;
    bf16_t* P;
    __device__ __forceinline__ void operator()(const f32x4 (&acc)[2][2][4][2], const Unit& u, int wr, int wc, int fr, int fq) const {
        const int row0 = u.pm * 256 + wr * 64 + fr; const int pn = u.pn;
        if (pn < 8 || pn >= 24) {
            const bool act = pn >= 24;
            const int col0 = (act ? 4096 + (pn - 24) * 256 : pn * 256) + wc * 32 + 8 * fq;
#pragma unroll
            for (int ai = 0; ai < 2; ++ai)
#pragma unroll
                for (int m = 0; m < 4; ++m) { bf16_t* rowp = P + (size_t)(row0 + ai * 128 + m * 16) * PW + col0;
#pragma unroll
                    for (int bj = 0; bj < 2; ++bj) { f32x4 v0 = acc[ai][bj][m][0], v1 = acc[ai][bj][m][1];
                        if (act) { f32x2 a = gelu_pk((f32x2){v0[0], v0[1]}), b = gelu_pk((f32x2){v0[2], v0[3]}), c = gelu_pk((f32x2){v1[0], v1[1]}), d = gelu_pk((f32x2){v1[2], v1[3]});
                            v0 = (f32x4){a.x, a.y, b.x, b.y}; v1 = (f32x4){c.x, c.y, d.x, d.y}; }
                        u32x4 w; w.x = cvt_pk_bf16_asm(v0[0], v0[1]); w.y = cvt_pk_bf16_asm(v0[2], v0[3]); w.z = cvt_pk_bf16_asm(v1[0], v1[1]); w.w = cvt_pk_bf16_asm(v1[2], v1[3]);
                        *(u32x4*)(rowp + bj * 128) = w; } }
        } else {
            const bool isrg = pn < 16;
            const int col0 = (isrg ? 2048 + (pn - 8) * 128 : 3072 + (pn - 16) * 128) + wc * 32 + 8 * fq;
#pragma unroll
            for (int ai = 0; ai < 2; ++ai)
#pragma unroll
                for (int m = 0; m < 4; ++m) { bf16_t* rowp = P + (size_t)(row0 + ai * 128 + m * 16) * PW + col0;
                    float o[8];
#pragma unroll
                    for (int n = 0; n < 2; ++n) { const f32x4 a = acc[ai][0][m][n], g = acc[ai][1][m][n];
                        if (isrg) {
#pragma unroll
                            for (int j = 0; j < 4; ++j) o[n * 4 + j] = a[j] * sigmoidf_(a[j]) * sigmoidf_(g[j]);
                        } else { f32x2 x = gelu_pk((f32x2){a[0], a[1]}), y = gelu_pk((f32x2){a[2], a[3]});
                            o[n * 4 + 0] = x.x * sigmoidf_(g[0]); o[n * 4 + 1] = x.y * sigmoidf_(g[1]); o[n * 4 + 2] = y.x * sigmoidf_(g[2]); o[n * 4 + 3] = y.y * sigmoidf_(g[3]); } }
                    u32x4 w; w.x = cvt_pk_bf16_asm(o[0], o[1]); w.y = cvt_pk_bf16_asm(o[2], o[3]); w.z = cvt_pk_bf16_asm(o[4], o[5]); w.w = cvt_pk_bf16_asm(o[6], o[7]);
                    *(u32x4*)rowp = w; }
        }
    }
};
struct EpiX1 {
    static constexpr bool PERM = false;
    const float* x; float* x1; const float* mod; const float* b_ada;
    __device__ __forceinline__ void operator()(const f32x4 (&acc)[2][2][4][2], const Unit& u, int wr, int wc, int fr, int fq) const {
        const int row0 = u.pm * 256 + wr * 64 + fr, col0 = u.pn * 256 + wc * 32 + 4 * fq; const int b = u.pm >> 5;
        f32x4 gv[2][2];
#pragma unroll
        for (int bj = 0; bj < 2; ++bj)
#pragma unroll
            for (int n = 0; n < 2; ++n) gv[bj][n] = *(const f32x4*)(mod + b * 6144 + 2048 + col0 + bj * 128 + n * 16) + *(const f32x4*)(b_ada + 2048 + col0 + bj * 128 + n * 16);
#pragma unroll
        for (int ai = 0; ai < 2; ++ai)
#pragma unroll
            for (int m = 0; m < 4; ++m) { const size_t off = (size_t)(row0 + ai * 128 + m * 16) * DM + col0;
#pragma unroll
                for (int bj = 0; bj < 2; ++bj)
#pragma unroll
                    for (int n = 0; n < 2; ++n) { const f32x4 xv = *(const f32x4*)(x + off + bj * 128 + n * 16); *(f32x4*)(x1 + off + bj * 128 + n * 16) = xv + gv[bj][n] * acc[ai][bj][m][n]; } }
    }
};
struct EpiQ {
    static constexpr bool PERM = true;
    bf16_t* O;
    __device__ __forceinline__ void operator()(const f32x4 (&acc)[2][2][4][2], const Unit& u, int wr, int wc, int fr, int fq) const {
        const int row0 = u.pm * 256 + wr * 64 + fr, col0 = u.pn * 256 + wc * 32 + 8 * fq;
#pragma unroll
        for (int ai = 0; ai < 2; ++ai)
#pragma unroll
            for (int m = 0; m < 4; ++m) { bf16_t* rowp = O + (size_t)(row0 + ai * 128 + m * 16) * 2048 + col0;
#pragma unroll
                for (int bj = 0; bj < 2; ++bj) { const f32x4 v0 = acc[ai][bj][m][0], v1 = acc[ai][bj][m][1];
                    u32x4 w; w.x = cvt_pk_bf16_asm(v0[0], v0[1]); w.y = cvt_pk_bf16_asm(v0[2], v0[3]); w.z = cvt_pk_bf16_asm(v1[0], v1[1]); w.w = cvt_pk_bf16_asm(v1[2], v1[3]);
                    *(u32x4*)(rowp + bj * 128) = w; } }
    }
};

__device__ __forceinline__ int win_src_col(int n) {
    if (n < 2048) return n;
    if (n < 4096) { const int u = (n - 2048) >> 8, r = (n - 2048) & 255; return r < 128 ? 2048 + 128 * u + r : 5136 + 128 * u + (r - 128); }
    if (n < 6144) { const int u = (n - 4096) >> 8, r = (n - 4096) & 255; return r < 128 ? 3088 + 128 * u + r : 6160 + 128 * u + (r - 128); }
    return 4112 + (n - 6144);
}
__device__ void phase0(const Params& p, unsigned char* lds) {
    const int tid = threadIdx.x;
    float* mod = (float*)(p.ws + OFF_MOD);
    {
        float* ssc = (float*)lds;
        float* red = (float*)lds + 2048;
        for (int e = tid; e < 2048; e += 512) { const float cv = p.c[e]; ssc[e] = cv * sigmoidf_(cv); }
        __syncthreads();
        for (int cbk = blockIdx.x; cbk < 256; cbk += gridDim.x) {
            const int cc = tid % 24, rg = tid / 24;
            if (tid < 504) { float a0 = 0.f, a1 = 0.f;
                const float* wp = p.w_ada + cbk * 24 + cc;
#pragma unroll 1
                for (int j0 = 0; j0 < 49; j0 += 7) { float w[7];
#pragma unroll
                    for (int u = 0; u < 7; ++u) { const int k = rg + 21 * (j0 + u); w[u] = k < 1024 ? wp[(size_t)k * 6144] : 0.f; }
#pragma unroll
                    for (int u = 0; u < 7; ++u) { const int k = rg + 21 * (j0 + u); if (k < 1024) { a0 += ssc[k] * w[u]; a1 += ssc[1024 + k] * w[u]; } } }
                red[(rg * 24 + cc) * 2] = a0; red[(rg * 24 + cc) * 2 + 1] = a1; }
            __syncthreads();
            if (tid < 48) { const int c2 = tid % 24, bb = tid / 24; float s = 0.f;
                for (int g = 0; g < 21; ++g) s += red[(g * 24 + c2) * 2 + bb];
                mod[bb * 6144 + cbk * 24 + c2] = s; }
            __syncthreads();
        }
    }
    float* tile = (float*)lds;
    for (int tl = blockIdx.x; tl < 2560; tl += gridDim.x) {
        const float* W; bf16_t* Bt; int ldw, nt, kt, which;
        if (tl < 1792) { which = 0; W = p.w_in; ldw = INW; Bt = (bf16_t*)(p.ws + OFF_WINT); nt = tl >> 4; kt = tl & 15; }
        else if (tl < 2048) { which = 1; W = p.w_out; ldw = 1024; Bt = (bf16_t*)(p.ws + OFF_WOUTT); nt = (tl - 1792) >> 4; kt = tl & 15; }
        else { which = 2; W = p.w_q; ldw = 2048; Bt = (bf16_t*)(p.ws + OFF_WQT); nt = (tl - 2048) >> 4; kt = tl & 15; }
        { const int nn = tid & 63, kk0 = tid >> 6; const int n = nt * 64 + nn; const int sc = which == 0 ? win_src_col(n) : n;
#pragma unroll
            for (int i = 0; i < 8; ++i) { const int k = kk0 + 8 * i; tile[nn * 65 + k] = W[(size_t)(kt * 64 + k) * ldw + sc]; } }
        __syncthreads();
        { const int n = tid >> 3, kc = (tid & 7) * 8; const float* tp = tile + n * 65 + kc;
            u32x4 w; w.x = cvt_pk_bf16(tp[0], tp[1]); w.y = cvt_pk_bf16(tp[2], tp[3]); w.z = cvt_pk_bf16(tp[4], tp[5]); w.w = cvt_pk_bf16(tp[6], tp[7]);
            *(u32x4*)(Bt + (size_t)(nt * 64 + n) * 1024 + kt * 64 + kc) = w; }
        __syncthreads();
    }
    { bf16_t* kb = (bf16_t*)(p.ws + OFF_KEYS);
        for (int e = (blockIdx.x * 512 + tid) * 2; e < 32768; e += gridDim.x * 1024) {
            const float* src = e < 16384 ? p.keys1 + e : p.keys2 + (e - 16384);
            *(unsigned*)(kb + e) = cvt_pk_bf16(src[0], src[1]); } }
}

template <bool ALR>
__device__ void phase_norm(const Params& p, const float* xin, const float* nw, int shift_off, int scale_off, bf16_t* hout, unsigned char* lds) {
    const int tid = threadIdx.x, wid = tid >> 6, lane = tid & 63;
    const float* mod = (const float*)(p.ws + OFF_MOD);
    float* wat = (float*)lds;
    if (ALR) {
        for (int e = tid; e < 16384; e += 512) { const int d = e >> 4, r = e & 15; wat[r * 1024 + d] = p.w_in[(size_t)d * INW + 3072 + r]; }
        __syncthreads();
    }
    float* alr = (float*)(p.ws + OFF_ALR);
    for (int tg = blockIdx.x * 8 + wid; tg < 2048; tg += gridDim.x * 8) {
        const int b = tg >> 10;
        f32x4 w4[4], sc[4], sh[4];
#pragma unroll
        for (int i = 0; i < 4; ++i) { const int d = 256 * i + 4 * lane; w4[i] = *(const f32x4*)(nw + d);
            sc[i] = *(const f32x4*)(mod + b * 6144 + scale_off + d) + *(const f32x4*)(p.b_ada + scale_off + d) + 1.0f;
            sh[i] = *(const f32x4*)(mod + b * 6144 + shift_off + d) + *(const f32x4*)(p.b_ada + shift_off + d);
            w4[i] = w4[i] * sc[i]; }
        f32x4 xn[4];
#pragma unroll
        for (int i = 0; i < 4; ++i) xn[i] = *(const f32x4*)(xin + (size_t)(tg * 8) * DM + 256 * i + 4 * lane);
        for (int tt = 0; tt < 8; ++tt) {
            const int t = tg * 8 + tt;
            f32x4 xv[4]; float ss = 0.f;
#pragma unroll
            for (int i = 0; i < 4; ++i) { xv[i] = xn[i]; ss += xv[i][0] * xv[i][0] + xv[i][1] * xv[i][1] + xv[i][2] * xv[i][2] + xv[i][3] * xv[i][3]; }
            if (tt < 7) {
#pragma unroll
                for (int i = 0; i < 4; ++i) xn[i] = *(const f32x4*)(xin + (size_t)(t + 1) * DM + 256 * i + 4 * lane); }
            ss = wave_sum(ss);
            const float rstd = rsqrtf(ss * (1.0f / 1024.0f) + EPS);
#pragma unroll
            for (int i = 0; i < 4; ++i) { xv[i] = xv[i] * rstd * w4[i] + sh[i];
                u32x2 w; w.x = cvt_pk_bf16(xv[i][0], xv[i][1]); w.y = cvt_pk_bf16(xv[i][2], xv[i][3]);
                *(u32x2*)(hout + (size_t)t * DM + 256 * i + 4 * lane) = w; }
            if (ALR) {
                float ps[16];
#pragma unroll
                for (int r = 0; r < 16; ++r) { float s = 0.f;
#pragma unroll
                    for (int i = 0; i < 4; ++i) { const f32x4 wv = *(const f32x4*)(wat + r * 1024 + 256 * i + 4 * lane); s += xv[i][0] * wv[0] + xv[i][1] * wv[1] + xv[i][2] * wv[2] + xv[i][3] * wv[3]; }
                    ps[r] = s; if (r & 1) asm volatile("" ::: "memory"); }
                float t8[8], t4[4], t2[2];
                { const bool up = (lane & 32) != 0;
#pragma unroll
                  for (int j = 0; j < 8; ++j) { const float snd = up ? ps[j] : ps[j + 8], keep = up ? ps[j + 8] : ps[j]; t8[j] = keep + __shfl_xor(snd, 32); } }
                { const bool up = (lane & 16) != 0;
#pragma unroll
                  for (int j = 0; j < 4; ++j) { const float snd = up ? t8[j] : t8[j + 4], keep = up ? t8[j + 4] : t8[j]; t4[j] = keep + __shfl_xor(snd, 16); } }
                { const bool up = (lane & 8) != 0;
#pragma unroll
                  for (int j = 0; j < 2; ++j) { const float snd = up ? t4[j] : t4[j + 2], keep = up ? t4[j + 2] : t4[j]; t2[j] = keep + __shfl_xor(snd, 8); } }
                float t1;
                { const bool up = (lane & 4) != 0; const float snd = up ? t2[0] : t2[1], keep = up ? t2[1] : t2[0]; t1 = keep + __shfl_xor(snd, 4); }
                t1 += __shfl_xor(t1, 2); t1 += __shfl_xor(t1, 1);
                if ((lane & 3) == 0) alr[(size_t)t * 16 + ((lane >> 5) & 1) * 8 + ((lane >> 4) & 1) * 4 + ((lane >> 3) & 1) * 2 + ((lane >> 2) & 1)] = t1;
            }
        }
    }
}

template <bool TR>
__device__ __forceinline__ void gla_G(const Params& p, int t0, int h, float* sALR, float* sG, float* sGT) {
    const int tid = threadIdx.x;
    const float* alr = (const float*)(p.ws + OFF_ALR);
    if (tid < 256) *(f32x4*)(sALR + tid * 4) = *(const f32x4*)(alr + (size_t)t0 * 16 + tid * 4);
    const int col = tid & 127, pg = tid >> 7;
    float wup[16];
#pragma unroll
    for (int r = 0; r < 16; ++r) wup[r] = p.w_alpha_up[r * 512 + h * 128 + col];
    const float bias = p.b_alpha[h * 128 + col];
    __syncthreads();
#pragma unroll 4
    for (int pp = 0; pp < 16; ++pp) { const int pos = pg * 16 + pp;
        float z0 = bias, z1 = 0.f, z2 = 0.f, z3 = 0.f;
#pragma unroll
        for (int r4 = 0; r4 < 4; ++r4) { const f32x4 a = *(const f32x4*)(sALR + pos * 16 + r4 * 4); z0 += a[0] * wup[r4 * 4]; z1 += a[1] * wup[r4 * 4 + 1]; z2 += a[2] * wup[r4 * 4 + 2]; z3 += a[3] * wup[r4 * 4 + 3]; }
        const float z = (z0 + z1) + (z2 + z3);
        sG[pos * 128 + col] = (fminf(z, 0.f) - __logf(1.0f + __expf(-fabsf(z)))) * (1.0f / 16.0f); }
    __syncthreads();
    if (tid < 128) { float cum = 0.f;
#pragma unroll 16
        for (int pos = 0; pos < 64; ++pos) { cum += sG[pos * 128 + tid]; if (TR) sGT[tid * 65 + pos] = cum; else sG[pos * 128 + tid] = cum; } }
    __syncthreads();
}
__device__ __forceinline__ void gla_VT(const bf16_t* P, int t0, int h, bf16_t* sVT) {
    const int tid = threadIdx.x;
#pragma unroll
    for (int i = 0; i < 4; ++i) { const int task = tid + 512 * i, pos = task & 63, dg = task >> 6;
        const u32x4 w = *(const u32x4*)(P + (size_t)(t0 + pos) * PW + 1024 + h * 256 + dg * 8);
        bf16_t* d = sVT + (dg * 8) * 72 + pos;
        d[0] = (bf16_t)w.x; d[72] = (bf16_t)(w.x >> 16); d[144] = (bf16_t)w.y; d[216] = (bf16_t)(w.y >> 16);
        d[288] = (bf16_t)w.z; d[360] = (bf16_t)(w.z >> 16); d[432] = (bf16_t)w.w; d[504] = (bf16_t)(w.w >> 16); }
}

__device__ void phase_glaA(const Params& p, unsigned char* lds) {
    const int tid = threadIdx.x, wid = tid >> 6, lane = tid & 63, r = lane & 31, hh = lane >> 5;
    const bf16_t* P = (const bf16_t*)(p.ws + OFF_PROJ);
    { float* stats = (float*)(p.ws + OFF_STATS);
        const int tst0 = blockIdx.x * 8 + wid, tstep = gridDim.x * 8;
        u32x4 an = (u32x4){0u, 0u, 0u, 0u}, bn = an;
        if (tst0 < NTOK) { an = *(const u32x4*)(P + (size_t)tst0 * PW + 4096 + lane * 16); bn = *(const u32x4*)(P + (size_t)tst0 * PW + 4096 + lane * 16 + 8); }
        for (int t = tst0; t < NTOK; t += tstep) {
            const u32x4 a = an, b = bn;
            if (t + tstep < NTOK) { an = *(const u32x4*)(P + (size_t)(t + tstep) * PW + 4096 + lane * 16); bn = *(const u32x4*)(P + (size_t)(t + tstep) * PW + 4096 + lane * 16 + 8); }
            float v[16] = {bflo(a.x), bfhi(a.x), bflo(a.y), bfhi(a.y), bflo(a.z), bfhi(a.z), bflo(a.w), bfhi(a.w), bflo(b.x), bfhi(b.x), bflo(b.y), bfhi(b.y), bflo(b.z), bfhi(b.z), bflo(b.w), bfhi(b.w)};
            float s = 0.f;
#pragma unroll
            for (int i = 0; i < 16; ++i) s += v[i];
            const float mean = wave_sum(s) * (1.0f / 1024.0f);
            float q = 0.f;
#pragma unroll
            for (int i = 0; i < 16; ++i) { const float d = v[i] - mean; q += d * d; }
            q = wave_sum(q);
            if (lane == 0) *(f32x2*)(stats + (size_t)t * 2) = (f32x2){mean, rsqrtf(q * (1.0f / 1024.0f) + EPS)};
        } }
    float* sALR = (float*)lds; float* sG = (float*)(lds + 4096);
    bf16_t* sKT = (bf16_t*)(lds + 36864); bf16_t* sVT = (bf16_t*)(lds + 55296); float* sGT = (float*)(lds + 92160);
    bf16_t* KV = (bf16_t*)p.out; float* decay = (float*)(p.ws + OFF_DECAY);
    for (int item = blockIdx.x; item < 1024; item += gridDim.x) {
        const int h = item & 3, n = (item >> 2) & 127, b = item >> 9, t0 = b * SEQ + n * 64;
        gla_G<true>(p, t0, h, sALR, sG, sGT);
#pragma unroll
        for (int i = 0; i < 2; ++i) { const int task = tid + 512 * i, pos = task & 63, kg = task >> 6;
            const u32x4 w = *(const u32x4*)(P + (size_t)(t0 + pos) * PW + 512 + h * 128 + kg * 8);
            const unsigned ww[4] = {w.x, w.y, w.z, w.w};
            bf16_t* d = sKT + (kg * 8) * 72 + pos;
#pragma unroll
            for (int e = 0; e < 4; ++e) { const int kd = kg * 8 + 2 * e;
                const float f0 = __expf(sGT[kd * 65 + 63] - sGT[kd * 65 + pos]), f1 = __expf(sGT[(kd + 1) * 65 + 63] - sGT[(kd + 1) * 65 + pos]);
                const unsigned pk = cvt_pk_bf16(bflo(ww[e]) * f0, bfhi(ww[e]) * f1);
                d[(2 * e) * 72] = (bf16_t)pk; d[(2 * e + 1) * 72] = (bf16_t)(pk >> 16); } }
        gla_VT(P, t0, h, sVT);
        if (tid < 128) decay[item * 128 + tid] = __expf(sGT[tid * 65 + 63]);
        __syncthreads();
        f32x16 acc[4];
#pragma unroll
        for (int mi = 0; mi < 4; ++mi) acc[mi] = zero16();
#pragma unroll
        for (int ks = 0; ks < 4; ++ks) {
            const bf16x8 bfr = *(const bf16x8*)(sVT + (wid * 32 + r) * 72 + ks * 16 + hh * 8);
#pragma unroll
            for (int mi = 0; mi < 4; ++mi) { const bf16x8 afr = *(const bf16x8*)(sKT + (mi * 32 + r) * 72 + ks * 16 + hh * 8); acc[mi] = MFMA32(afr, bfr, acc[mi]); }
        }
        bf16_t* dst = KV + (size_t)item * 32768 + (size_t)(wid * 32 + r) * 128;
#pragma unroll
        for (int mi = 0; mi < 4; ++mi)
#pragma unroll
            for (int g = 0; g < 4; ++g) { u32x2 w; w.x = cvt_pk_bf16(acc[mi][g * 4], acc[mi][g * 4 + 1]); w.y = cvt_pk_bf16(acc[mi][g * 4 + 2], acc[mi][g * 4 + 3]);
                *(u32x2*)(dst + mi * 32 + g * 8 + hh * 4) = w; }
        __syncthreads();
    }
}

__device__ void phase_scan_sgu(const Params& p, unsigned char* lds) {
    const int tid = threadIdx.x, wid = tid >> 6, lane = tid & 63, r = lane & 31, hh = lane >> 5;
    { unsigned* KV = (unsigned*)p.out; const float* decay = (const float*)(p.ws + OFF_DECAY);
        for (int gt = blockIdx.x * 512 + tid; gt < 131072; gt += gridDim.x * 512) {
            const int bh = gt >> 14, e = gt & 16383, kd = (e * 2) & 127, b = bh >> 2, h = bh & 3;
            float s0 = 0.f, s1 = 0.f;
            for (int n0 = 0; n0 < 128; n0 += 16) {
                unsigned w[16]; f32x2 d[16];
#pragma unroll
                for (int j = 0; j < 16; ++j) { const int item = ((b * 128 + n0 + j) << 2) + h; w[j] = KV[(size_t)item * 16384 + e]; d[j] = *(const f32x2*)(decay + item * 128 + kd); }
#pragma unroll
                for (int j = 0; j < 16; ++j) { const int item = ((b * 128 + n0 + j) << 2) + h; KV[(size_t)item * 16384 + e] = cvt_pk_bf16(s0, s1);
                    s0 = s0 * d[j].x + bflo(w[j]); s1 = s1 * d[j].y + bfhi(w[j]); }
            }
        } }
    const bf16_t* P = (const bf16_t*)(p.ws + OFF_PROJ);
    const float* stats = (const float*)(p.ws + OFF_STATS);
    bf16_t* merged = (bf16_t*)(p.ws + OFF_HB);
    bf16_t* sVT = (bf16_t*)lds;
    for (int item = blockIdx.x; item < 1024; item += gridDim.x) {
        const int g = item & 7, n = (item >> 3) & 63, b = item >> 9, t0 = b * SEQ + n * 128;
#pragma unroll
        for (int i = 0; i < 4; ++i) { const int task = tid + 512 * i, j = task & 127, cg8 = task >> 7;
            const u32x4 w = *(const u32x4*)(P + (size_t)(t0 + j) * PW + 4096 + g * 128 + cg8 * 8);
            const f32x2 st = *(const f32x2*)(stats + (size_t)(t0 + j) * 2);
            const f32x4 lw0 = *(const f32x4*)(p.sgu_ln_w + g * 128 + cg8 * 8), lw1 = *(const f32x4*)(p.sgu_ln_w + g * 128 + cg8 * 8 + 4);
            const f32x4 lb0 = *(const f32x4*)(p.sgu_ln_b + g * 128 + cg8 * 8), lb1 = *(const f32x4*)(p.sgu_ln_b + g * 128 + cg8 * 8 + 4);
            const float v[8] = {bflo(w.x), bfhi(w.x), bflo(w.y), bfhi(w.y), bflo(w.z), bfhi(w.z), bflo(w.w), bfhi(w.w)};
            bf16_t* d = sVT + (cg8 * 8) * 136 + j;
#pragma unroll
            for (int e = 0; e < 8; e += 2) { const float lw_a = e < 4 ? lw0[e] : lw1[e - 4], lw_b = e < 4 ? lw0[e + 1] : lw1[e - 3], lb_a = e < 4 ? lb0[e] : lb1[e - 4], lb_b = e < 4 ? lb0[e + 1] : lb1[e - 3];
                const unsigned pk = cvt_pk_bf16((v[e] - st.x) * st.y * lw_a + lb_a, (v[e + 1] - st.x) * st.y * lw_b + lb_b);
                d[e * 136] = (bf16_t)pk; d[(e + 1) * 136] = (bf16_t)(pk >> 16); } }
        __syncthreads();
        const int ni = wid & 3, mb = (wid >> 2) * 2, irow = ni * 32 + r;
        f32x16 acc[2] = {zero16(), zero16()};
        const float* wrow = p.sgu_w + (size_t)g * 16384 + (size_t)irow * 128;
        for (int ks = 0; ks < 2 * ni + 2; ++ks) {
            const int j0 = ks * 16 + hh * 8;
            const f32x4 wa = *(const f32x4*)(wrow + j0), wb = *(const f32x4*)(wrow + j0 + 4);
            float wv[8] = {wa[0], wa[1], wa[2], wa[3], wb[0], wb[1], wb[2], wb[3]};
#pragma unroll
            for (int e = 0; e < 8; ++e) wv[e] = (j0 + e <= irow) ? wv[e] : 0.f;
            u32x4 bw; bw.x = cvt_pk_bf16(wv[0], wv[1]); bw.y = cvt_pk_bf16(wv[2], wv[3]); bw.z = cvt_pk_bf16(wv[4], wv[5]); bw.w = cvt_pk_bf16(wv[6], wv[7]);
            const bf16x8 bfr = __builtin_bit_cast(bf16x8, bw);
#pragma unroll
            for (int mi = 0; mi < 2; ++mi) { const bf16x8 afr = *(const bf16x8*)(sVT + ((mb + mi) * 32 + r) * 136 + j0); acc[mi] = MFMA32(afr, bfr, acc[mi]); }
        }
        const float bs = p.sgu_b[g * 128 + irow];
        bf16_t* sT = (bf16_t*)(lds + 34816);
#pragma unroll
        for (int mi = 0; mi < 2; ++mi)
#pragma unroll
            for (int g4 = 0; g4 < 4; ++g4) { const int c = (mb + mi) * 32 + g4 * 8 + hh * 4;
                u32x2 o; o.x = cvt_pk_bf16(acc[mi][g4 * 4] + bs, acc[mi][g4 * 4 + 1] + bs); o.y = cvt_pk_bf16(acc[mi][g4 * 4 + 2] + bs, acc[mi][g4 * 4 + 3] + bs);
                *(u32x2*)(sT + irow * 136 + c) = o; }
        __syncthreads();
#pragma unroll
        for (int it = 0; it < 4; ++it) { const int task = tid + 512 * it, tk = task >> 4, c8 = task & 15;
            const size_t tok = (size_t)(t0 + tk);
            const u32x4 sv = *(const u32x4*)(sT + tk * 136 + c8 * 8), ug = *(const u32x4*)(P + tok * PW + 3072 + g * 128 + c8 * 8);
            u32x4 w;
            w.x = cvt_pk_bf16(bflo(ug.x) * bflo(sv.x), bfhi(ug.x) * bfhi(sv.x)); w.y = cvt_pk_bf16(bflo(ug.y) * bflo(sv.y), bfhi(ug.y) * bfhi(sv.y));
            w.z = cvt_pk_bf16(bflo(ug.z) * bflo(sv.z), bfhi(ug.z) * bfhi(sv.z)); w.w = cvt_pk_bf16(bflo(ug.w) * bflo(sv.w), bfhi(ug.w) * bfhi(sv.w));
            *(u32x4*)(merged + tok * DM + g * 128 + c8 * 8) = w; }
        __syncthreads();
    }
}

__device__ void phase_glaC(const Params& p, unsigned char* lds) {
    const int tid = threadIdx.x, wid = tid >> 6, lane = tid & 63, r = lane & 31, hh = lane >> 5;
    const bf16_t* P = (const bf16_t*)(p.ws + OFF_PROJ);
    float* sALR = (float*)lds; float* sG = (float*)(lds + 4096);
    bf16_t* sQD = (bf16_t*)(lds + 36864); bf16_t* sKI = (bf16_t*)(lds + 54272); bf16_t* sVT = (bf16_t*)(lds + 71680); bf16_t* sAM = (bf16_t*)(lds + 108544); float* sSS = (float*)(lds + 117760);
    const bf16_t* ST = (const bf16_t*)p.out; bf16_t* merged = (bf16_t*)(p.ws + OFF_HB);
    for (int item = blockIdx.x; item < 1024; item += gridDim.x) {
        const int h = item & 3, n = (item >> 2) & 127, b = item >> 9, t0 = b * SEQ + n * 64;
        gla_G<false>(p, t0, h, sALR, sG, nullptr);
#pragma unroll
        for (int i = 0; i < 2; ++i) { const int task = tid + 512 * i, kg = task & 15, pos = task >> 4;
            const u32x4 qw = *(const u32x4*)(P + (size_t)(t0 + pos) * PW + h * 128 + kg * 8), kw = *(const u32x4*)(P + (size_t)(t0 + pos) * PW + 512 + h * 128 + kg * 8);
            const f32x4 g0 = *(const f32x4*)(sG + pos * 128 + kg * 8), g1 = *(const f32x4*)(sG + pos * 128 + kg * 8 + 4);
            const float gv[8] = {g0[0], g0[1], g0[2], g0[3], g1[0], g1[1], g1[2], g1[3]};
            const unsigned qq[4] = {qw.x, qw.y, qw.z, qw.w}, kk[4] = {kw.x, kw.y, kw.z, kw.w};
            unsigned qo[4], ko[4];
#pragma unroll
            for (int e = 0; e < 4; ++e) { const float e0 = __expf(gv[2 * e]), e1 = __expf(gv[2 * e + 1]);
                qo[e] = cvt_pk_bf16(bflo(qq[e]) * 0.08838834764831845f * e0, bfhi(qq[e]) * 0.08838834764831845f * e1);
                ko[e] = cvt_pk_bf16(bflo(kk[e]) * __builtin_amdgcn_rcpf(e0), bfhi(kk[e]) * __builtin_amdgcn_rcpf(e1)); }
            *(u32x4*)(sQD + pos * 136 + kg * 8) = (u32x4){qo[0], qo[1], qo[2], qo[3]};
            *(u32x4*)(sKI + pos * 136 + kg * 8) = (u32x4){ko[0], ko[1], ko[2], ko[3]}; }
        gla_VT(P, t0, h, sVT);
        __syncthreads();
        if (wid < 4) { const int mj = wid >> 1, nI = wid & 1;
            f32x16 a = zero16();
            if (mj <= nI) {
#pragma unroll
                for (int ks = 0; ks < 8; ++ks) { const bf16x8 afr = *(const bf16x8*)(sKI + (mj * 32 + r) * 136 + ks * 16 + hh * 8), bfr = *(const bf16x8*)(sQD + (nI * 32 + r) * 136 + ks * 16 + hh * 8); a = MFMA32(afr, bfr, a); } }
            const int i = nI * 32 + r;
#pragma unroll
            for (int g = 0; g < 4; ++g) { const int j = mj * 32 + g * 8 + hh * 4;
                u32x2 w; w.x = cvt_pk_bf16(j <= i ? a[g * 4] : 0.f, j + 1 <= i ? a[g * 4 + 1] : 0.f); w.y = cvt_pk_bf16(j + 2 <= i ? a[g * 4 + 2] : 0.f, j + 3 <= i ? a[g * 4 + 3] : 0.f);
                *(u32x2*)(sAM + i * 72 + j) = w; } }
        __syncthreads();
        const int nI = wid & 1, mb = (wid >> 1) * 2, i = nI * 32 + r;
        f32x16 acc[2] = {zero16(), zero16()};
        const bf16_t* Sg = ST + (size_t)item * 32768;
#pragma unroll
        for (int ks = 0; ks < 8; ++ks) { const bf16x8 bfr = *(const bf16x8*)(sQD + i * 136 + ks * 16 + hh * 8);
#pragma unroll
            for (int mi = 0; mi < 2; ++mi) { const bf16x8 afr = *(const bf16x8*)(Sg + (size_t)((mb + mi) * 32 + r) * 128 + ks * 16 + hh * 8); acc[mi] = MFMA32(afr, bfr, acc[mi]); } }
        for (int ks = 0; ks < 2 * nI + 2; ++ks) { const bf16x8 bfr = *(const bf16x8*)(sAM + i * 72 + ks * 16 + hh * 8);
#pragma unroll
            for (int mi = 0; mi < 2; ++mi) { const bf16x8 afr = *(const bf16x8*)(sVT + ((mb + mi) * 32 + r) * 72 + ks * 16 + hh * 8); acc[mi] = MFMA32(afr, bfr, acc[mi]); } }
        float ss = 0.f;
#pragma unroll
        for (int mi = 0; mi < 2; ++mi)
#pragma unroll
            for (int e = 0; e < 16; ++e) ss += acc[mi][e] * acc[mi][e];
        ss += __shfl_xor(ss, 32);
        if (hh == 0) sSS[(wid >> 1) * 64 + i] = ss;
        __syncthreads();
        const float tot = sSS[i] + sSS[64 + i] + sSS[128 + i] + sSS[192 + i];
        const float rstd = rsqrtf(tot * (1.0f / 256.0f) + EPS);
        bf16_t* sO = (bf16_t*)lds;
#pragma unroll
        for (int mi = 0; mi < 2; ++mi)
#pragma unroll
            for (int g4 = 0; g4 < 4; ++g4) { const int dv = (mb + mi) * 32 + g4 * 8 + hh * 4;
                u32x2 o; o.x = cvt_pk_bf16(acc[mi][g4 * 4] * rstd, acc[mi][g4 * 4 + 1] * rstd); o.y = cvt_pk_bf16(acc[mi][g4 * 4 + 2] * rstd, acc[mi][g4 * 4 + 3] * rstd);
                *(u32x2*)(sO + i * 264 + dv) = o; }
        __syncthreads();
#pragma unroll
        for (int it = 0; it < 4; ++it) { const int task = tid + 512 * it, tk = task >> 5, c8 = task & 31, ch = h * 256 + c8 * 8;
            const size_t tok = (size_t)(t0 + tk);
            const u32x4 ov = *(const u32x4*)(sO + tk * 264 + c8 * 8), rg = *(const u32x4*)(P + tok * PW + 2048 + ch), mg = *(const u32x4*)(merged + tok * DM + ch);
            const f32x4 n0 = *(const f32x4*)(p.gla_norm_w + ch), n1 = *(const f32x4*)(p.gla_norm_w + ch + 4);
            u32x4 w;
            w.x = cvt_pk_bf16(bflo(ov.x) * n0[0] * bflo(rg.x) + bflo(mg.x), bfhi(ov.x) * n0[1] * bfhi(rg.x) + bfhi(mg.x));
            w.y = cvt_pk_bf16(bflo(ov.y) * n0[2] * bflo(rg.y) + bflo(mg.y), bfhi(ov.y) * n0[3] * bfhi(rg.y) + bfhi(mg.y));
            w.z = cvt_pk_bf16(bflo(ov.z) * n1[0] * bflo(rg.z) + bflo(mg.z), bfhi(ov.z) * n1[1] * bfhi(rg.z) + bfhi(mg.z));
            w.w = cvt_pk_bf16(bflo(ov.w) * n1[2] * bflo(rg.w) + bflo(mg.w), bfhi(ov.w) * n1[3] * bfhi(rg.w) + bfhi(mg.w));
            *(u32x4*)(merged + tok * DM + ch) = w; }
        __syncthreads();
    }
}

__device__ void phase_tables(const Params& p) {
    bf16_t* db = (bf16_t*)(p.ws + OFF_DOWN); bf16_t* ub = (bf16_t*)(p.ws + OFF_UP);
    for (size_t e = ((size_t)blockIdx.x * 512 + threadIdx.x) * 8; e < (size_t)16384 * 1024; e += (size_t)gridDim.x * 4096) {
        { const f32x4 a = __builtin_nontemporal_load((const f32x4*)(p.down + e)), b = __builtin_nontemporal_load((const f32x4*)(p.down + e + 4));
            u32x4 w; w.x = cvt_pk_bf16(a[0], a[1]); w.y = cvt_pk_bf16(a[2], a[3]); w.z = cvt_pk_bf16(b[0], b[1]); w.w = cvt_pk_bf16(b[2], b[3]); *(u32x4*)(db + e) = w; }
        { const f32x4 a = __builtin_nontemporal_load((const f32x4*)(p.up + e)), b = __builtin_nontemporal_load((const f32x4*)(p.up + e + 4));
            u32x4 w; w.x = cvt_pk_bf16(a[0], a[1]); w.y = cvt_pk_bf16(a[2], a[3]); w.z = cvt_pk_bf16(b[0], b[1]); w.w = cvt_pk_bf16(b[2], b[3]); *(u32x4*)(ub + e) = w; }
    }
}

#define SORT16(L) do { float _h; _h = fmaxf(L[0], L[1]); L[1] = fminf(L[0], L[1]); L[0] = _h; _h = fmaxf(L[2], L[3]); L[3] = fminf(L[2], L[3]); L[2] = _h; _h = fmaxf(L[0], L[2]); L[2] = fminf(L[0], L[2]); L[0] = _h; _h = fmaxf(L[1], L[3]); L[3] = fminf(L[1], L[3]); L[1] = _h; _h = fmaxf(L[1], L[2]); L[2] = fminf(L[1], L[2]); L[1] = _h; _h = fmaxf(L[4], L[5]); L[5] = fminf(L[4], L[5]); L[4] = _h; _h = fmaxf(L[6], L[7]); L[7] = fminf(L[6], L[7]); L[6] = _h; _h = fmaxf(L[4], L[6]); L[6] = fminf(L[4], L[6]); L[4] = _h; _h = fmaxf(L[5], L[7]); L[7] = fminf(L[5], L[7]); L[5] = _h; _h = fmaxf(L[5], L[6]); L[6] = fminf(L[5], L[6]); L[5] = _h; _h = fmaxf(L[0], L[4]); L[4] = fminf(L[0], L[4]); L[0] = _h; _h = fmaxf(L[2], L[6]); L[6] = fminf(L[2], L[6]); L[2] = _h; _h = fmaxf(L[2], L[4]); L[4] = fminf(L[2], L[4]); L[2] = _h; _h = fmaxf(L[1], L[5]); L[5] = fminf(L[1], L[5]); L[1] = _h; _h = fmaxf(L[3], L[7]); L[7] = fminf(L[3], L[7]); L[3] = _h; _h = fmaxf(L[3], L[5]); L[5] = fminf(L[3], L[5]); L[3] = _h; _h = fmaxf(L[1], L[2]); L[2] = fminf(L[1], L[2]); L[1] = _h; _h = fmaxf(L[3], L[4]); L[4] = fminf(L[3], L[4]); L[3] = _h; _h = fmaxf(L[5], L[6]); L[6] = fminf(L[5], L[6]); L[5] = _h; _h = fmaxf(L[8], L[9]); L[9] = fminf(L[8], L[9]); L[8] = _h; _h = fmaxf(L[10], L[11]); L[11] = fminf(L[10], L[11]); L[10] = _h; _h = fmaxf(L[8], L[10]); L[10] = fminf(L[8], L[10]); L[8] = _h; _h = fmaxf(L[9], L[11]); L[11] = fminf(L[9], L[11]); L[9] = _h; _h = fmaxf(L[9], L[10]); L[10] = fminf(L[9], L[10]); L[9] = _h; _h = fmaxf(L[12], L[13]); L[13] = fminf(L[12], L[13]); L[12] = _h; _h = fmaxf(L[14], L[15]); L[15] = fminf(L[14], L[15]); L[14] = _h; _h = fmaxf(L[12], L[14]); L[14] = fminf(L[12], L[14]); L[12] = _h; _h = fmaxf(L[13], L[15]); L[15] = fminf(L[13], L[15]); L[13] = _h; _h = fmaxf(L[13], L[14]); L[14] = fminf(L[13], L[14]); L[13] = _h; _h = fmaxf(L[8], L[12]); L[12] = fminf(L[8], L[12]); L[8] = _h; _h = fmaxf(L[10], L[14]); L[14] = fminf(L[10], L[14]); L[10] = _h; _h = fmaxf(L[10], L[12]); L[12] = fminf(L[10], L[12]); L[10] = _h; _h = fmaxf(L[9], L[13]); L[13] = fminf(L[9], L[13]); L[9] = _h; _h = fmaxf(L[11], L[15]); L[15] = fminf(L[11], L[15]); L[11] = _h; _h = fmaxf(L[11], L[13]); L[13] = fminf(L[11], L[13]); L[11] = _h; _h = fmaxf(L[9], L[10]); L[10] = fminf(L[9], L[10]); L[9] = _h; _h = fmaxf(L[11], L[12]); L[12] = fminf(L[11], L[12]); L[11] = _h; _h = fmaxf(L[13], L[14]); L[14] = fminf(L[13], L[14]); L[13] = _h; _h = fmaxf(L[0], L[8]); L[8] = fminf(L[0], L[8]); L[0] = _h; _h = fmaxf(L[4], L[12]); L[12] = fminf(L[4], L[12]); L[4] = _h; _h = fmaxf(L[4], L[8]); L[8] = fminf(L[4], L[8]); L[4] = _h; _h = fmaxf(L[2], L[10]); L[10] = fminf(L[2], L[10]); L[2] = _h; _h = fmaxf(L[6], L[14]); L[14] = fminf(L[6], L[14]); L[6] = _h; _h = fmaxf(L[6], L[10]); L[10] = fminf(L[6], L[10]); L[6] = _h; _h = fmaxf(L[2], L[4]); L[4] = fminf(L[2], L[4]); L[2] = _h; _h = fmaxf(L[6], L[8]); L[8] = fminf(L[6], L[8]); L[6] = _h; _h = fmaxf(L[10], L[12]); L[12] = fminf(L[10], L[12]); L[10] = _h; _h = fmaxf(L[1], L[9]); L[9] = fminf(L[1], L[9]); L[1] = _h; _h = fmaxf(L[5], L[13]); L[13] = fminf(L[5], L[13]); L[5] = _h; _h = fmaxf(L[5], L[9]); L[9] = fminf(L[5], L[9]); L[5] = _h; _h = fmaxf(L[3], L[11]); L[11] = fminf(L[3], L[11]); L[3] = _h; _h = fmaxf(L[7], L[15]); L[15] = fminf(L[7], L[15]); L[7] = _h; _h = fmaxf(L[7], L[11]); L[11] = fminf(L[7], L[11]); L[7] = _h; _h = fmaxf(L[3], L[5]); L[5] = fminf(L[3], L[5]); L[3] = _h; _h = fmaxf(L[7], L[9]); L[9] = fminf(L[7], L[9]); L[7] = _h; _h = fmaxf(L[11], L[13]); L[13] = fminf(L[11], L[13]); L[11] = _h; _h = fmaxf(L[1], L[2]); L[2] = fminf(L[1], L[2]); L[1] = _h; _h = fmaxf(L[3], L[4]); L[4] = fminf(L[3], L[4]); L[3] = _h; _h = fmaxf(L[5], L[6]); L[6] = fminf(L[5], L[6]); L[5] = _h; _h = fmaxf(L[7], L[8]); L[8] = fminf(L[7], L[8]); L[7] = _h; _h = fmaxf(L[9], L[10]); L[10] = fminf(L[9], L[10]); L[9] = _h; _h = fmaxf(L[11], L[12]); L[12] = fminf(L[11], L[12]); L[11] = _h; _h = fmaxf(L[13], L[14]); L[14] = fminf(L[13], L[14]); L[13] = _h; } while (0)
#define BITONIC16(L) do { float _h; _h = fmaxf(L[0], L[8]); L[8] = fminf(L[0], L[8]); L[0] = _h; _h = fmaxf(L[1], L[9]); L[9] = fminf(L[1], L[9]); L[1] = _h; _h = fmaxf(L[2], L[10]); L[10] = fminf(L[2], L[10]); L[2] = _h; _h = fmaxf(L[3], L[11]); L[11] = fminf(L[3], L[11]); L[3] = _h; _h = fmaxf(L[4], L[12]); L[12] = fminf(L[4], L[12]); L[4] = _h; _h = fmaxf(L[5], L[13]); L[13] = fminf(L[5], L[13]); L[5] = _h; _h = fmaxf(L[6], L[14]); L[14] = fminf(L[6], L[14]); L[6] = _h; _h = fmaxf(L[7], L[15]); L[15] = fminf(L[7], L[15]); L[7] = _h; _h = fmaxf(L[0], L[4]); L[4] = fminf(L[0], L[4]); L[0] = _h; _h = fmaxf(L[1], L[5]); L[5] = fminf(L[1], L[5]); L[1] = _h; _h = fmaxf(L[2], L[6]); L[6] = fminf(L[2], L[6]); L[2] = _h; _h = fmaxf(L[3], L[7]); L[7] = fminf(L[3], L[7]); L[3] = _h; _h = fmaxf(L[8], L[12]); L[12] = fminf(L[8], L[12]); L[8] = _h; _h = fmaxf(L[9], L[13]); L[13] = fminf(L[9], L[13]); L[9] = _h; _h = fmaxf(L[10], L[14]); L[14] = fminf(L[10], L[14]); L[10] = _h; _h = fmaxf(L[11], L[15]); L[15] = fminf(L[11], L[15]); L[11] = _h; _h = fmaxf(L[0], L[2]); L[2] = fminf(L[0], L[2]); L[0] = _h; _h = fmaxf(L[1], L[3]); L[3] = fminf(L[1], L[3]); L[1] = _h; _h = fmaxf(L[4], L[6]); L[6] = fminf(L[4], L[6]); L[4] = _h; _h = fmaxf(L[5], L[7]); L[7] = fminf(L[5], L[7]); L[5] = _h; _h = fmaxf(L[8], L[10]); L[10] = fminf(L[8], L[10]); L[8] = _h; _h = fmaxf(L[9], L[11]); L[11] = fminf(L[9], L[11]); L[9] = _h; _h = fmaxf(L[12], L[14]); L[14] = fminf(L[12], L[14]); L[12] = _h; _h = fmaxf(L[13], L[15]); L[15] = fminf(L[13], L[15]); L[13] = _h; _h = fmaxf(L[0], L[1]); L[1] = fminf(L[0], L[1]); L[0] = _h; _h = fmaxf(L[2], L[3]); L[3] = fminf(L[2], L[3]); L[2] = _h; _h = fmaxf(L[4], L[5]); L[5] = fminf(L[4], L[5]); L[4] = _h; _h = fmaxf(L[6], L[7]); L[7] = fminf(L[6], L[7]); L[6] = _h; _h = fmaxf(L[8], L[9]); L[9] = fminf(L[8], L[9]); L[8] = _h; _h = fmaxf(L[10], L[11]); L[11] = fminf(L[10], L[11]); L[10] = _h; _h = fmaxf(L[12], L[13]); L[13] = fminf(L[12], L[13]); L[12] = _h; _h = fmaxf(L[14], L[15]); L[15] = fminf(L[14], L[15]); L[14] = _h; } while (0)
#define INS16(L, xin) do { float _x = (xin); _Pragma("unroll") for (int _p = 0; _p < 16; ++_p) { const float _hi = fmaxf(L[_p], _x); _x = fminf(L[_p], _x); L[_p] = _hi; } } while (0)
__device__ void phase_topk(const Params& p, unsigned char* lds) {
    const int tid = threadIdx.x, wid = tid >> 6, lane = tid & 63, r = lane & 31, hh = lane >> 5;
    const bf16_t* qp = (const bf16_t*)(p.ws + OFF_QP); const bf16_t* keysb = (const bf16_t*)(p.ws + OFF_KEYS);
    int* idxo = (int*)(p.ws + OFF_IDX); float* go = (float*)(p.ws + OFF_G);
    float* myrows = (float*)lds + wid * 32 * 129;
    const float NEG = -__builtin_inff();
    for (int tile = blockIdx.x; tile < 256; tile += gridDim.x) {
        const int tokb = tile * 64 + (wid & 1) * 32;
        float v1[16], v2[16];
#pragma unroll
        for (int j = 0; j < 16; ++j) { v1[j] = NEG; v2[j] = NEG; }
#pragma unroll 1
        for (int pass = 0; pass < 4; ++pass) {
            const int half = pass >> 1, hg = pass & 1, head = hg * 4 + (wid >> 1);
            f32x16 acc[4] = {zero16(), zero16(), zero16(), zero16()};
            const bf16_t* arow = qp + (size_t)(tokb + r) * 2048 + head * 256 + half * 128 + 8 * hh;
            const bf16_t* kb = keysb + half * 16384 + r * 128 + 8 * hh;
#pragma unroll
            for (int ks = 0; ks < 8; ++ks) { const bf16x8 a = *(const bf16x8*)(arow + 16 * ks);
#pragma unroll
                for (int nt = 0; nt < 4; ++nt) { const bf16x8 bb = *(const bf16x8*)(kb + nt * 32 * 128 + 16 * ks); acc[nt] = MFMA32(a, bb, acc[nt]); } }
#pragma unroll
            for (int nt = 0; nt < 4; ++nt)
#pragma unroll
                for (int e = 0; e < 16; ++e) { const int m = (e & 3) + 8 * (e >> 2) + 4 * hh; myrows[m * 129 + nt * 32 + r] = acc[nt][e]; }
            asm volatile("s_waitcnt lgkmcnt(0)" ::: "memory"); __builtin_amdgcn_wave_barrier();
            float L[16];
            const float* rowp = myrows + r * 129 + hh * 64;
#pragma unroll
            for (int j = 0; j < 16; ++j) L[j] = __uint_as_float((__float_as_uint(rowp[j]) & ~127u) | (unsigned)(127 - (hh * 64 + j)));
            SORT16(L);
#pragma unroll 1
            for (int g = 1; g < 4; ++g) {
                float Gp[16];
#pragma unroll
                for (int j = 0; j < 16; ++j) Gp[j] = __uint_as_float((__float_as_uint(rowp[g * 16 + j]) & ~127u) | (unsigned)(127 - (hh * 64 + g * 16 + j)));
                SORT16(Gp);
#pragma unroll
                for (int j = 0; j < 16; ++j) L[j] = fmaxf(L[j], Gp[15 - j]);
                BITONIC16(L);
            }
            {
                float O[16];
#pragma unroll
                for (int j = 0; j < 16; ++j) O[j] = __shfl_xor(L[j], 32);
#pragma unroll
                for (int j = 0; j < 16; ++j) L[j] = fmaxf(L[j], O[15 - j]);
                BITONIC16(L);
            }
            const bool mine = hh == hg;
            if (half == 0) {
#pragma unroll
                for (int j = 0; j < 16; ++j) v1[j] = mine ? L[j] : v1[j];
            } else {
#pragma unroll
                for (int j = 0; j < 16; ++j) v2[j] = mine ? L[j] : v2[j];
            }
            asm volatile("s_waitcnt lgkmcnt(0)" ::: "memory"); __builtin_amdgcn_wave_barrier();
        }
        float T[16]; int TI[16];
        int i1[16], i2[16];
#pragma unroll
        for (int j = 0; j < 16; ++j) { i1[j] = (127 - (int)(__float_as_uint(v1[j]) & 127u)) * 128; i2[j] = 127 - (int)(__float_as_uint(v2[j]) & 127u); }
#pragma unroll
        for (int j = 0; j < 16; ++j) { T[j] = v1[0] + v2[j]; TI[j] = i1[0] + i2[j]; }
#pragma unroll
        for (int a = 1; a < 16; ++a)
#pragma unroll
            for (int b = 0; b < 16; ++b)
                if ((a + 1) * (b + 1) <= 16) {
                    float s = v1[a] + v2[b]; int id = i1[a] + i2[b];
#pragma unroll
                    for (int q = (a + 1) * (b + 1) - 1; q < 16; ++q) { const bool c = s > T[q]; const float ts = c ? T[q] : s; const int ti = c ? TI[q] : id; T[q] = c ? s : T[q]; TI[q] = c ? id : TI[q]; s = ts; id = ti; }
                }
        const int token = tokb + r, head = hh * 4 + (wid >> 1);
        const float t0v = T[0]; float tot = 0.f;
#pragma unroll
        for (int j = 0; j < 16; ++j) { T[j] = __expf(T[j] - t0v); tot += T[j]; }
        const float inv = 1.0f / tot;
#pragma unroll
        for (int j = 0; j < 16; j += 4) { *(f32x4*)(go + (size_t)token * 128 + head * 16 + j) = (f32x4){T[j] * inv, T[j + 1] * inv, T[j + 2] * inv, T[j + 3] * inv};
            *(int4*)(idxo + (size_t)token * 128 + head * 16 + j) = make_int4(TI[j], TI[j + 1], TI[j + 2], TI[j + 3]); }
    }
}

__device__ void phase_peer(const Params& p, unsigned char* lds) {
    const int tid = threadIdx.x, wid = tid >> 6, lane = tid & 63, l16 = lane & 15, q4 = lane >> 4;
    const bf16_t* h2 = (const bf16_t*)(p.ws + OFF_H2); const bf16_t* db = (const bf16_t*)(p.ws + OFF_DOWN); const bf16_t* ub = (const bf16_t*)(p.ws + OFF_UP);
    const int* idxo = (const int*)(p.ws + OFF_IDX); const float* go = (const float*)(p.ws + OFF_G);
    const float* mod = (const float*)(p.ws + OFF_MOD);
    float* sga = (float*)lds + wid * 128;
    for (int tg = blockIdx.x * 8 + wid; tg < 2048; tg += gridDim.x * 8) {
        const int b = tg >> 10;
        for (int tt = 0; tt < 8; ++tt) {
            const int t = tg * 8 + tt;
            const int idA = idxo[(size_t)t * 128 + lane], idB = idxo[(size_t)t * 128 + 64 + lane];
            const float gA = go[(size_t)t * 128 + lane], gB = go[(size_t)t * 128 + 64 + lane];
            u32x4 hq[8];
#pragma unroll
            for (int i = 0; i < 8; ++i) hq[i] = *(const u32x4*)(h2 + (size_t)t * DM + i * 128 + l16 * 8);
#pragma unroll 2
            for (int s = 0; s < 32; ++s) {
                const int slot = 4 * s + q4;
                const int e = __shfl(s < 16 ? idA : idB, slot & 63);
                const bf16_t* row = db + (size_t)e * DM + l16 * 8;
                u32x4 w[8];
#pragma unroll
                for (int i = 0; i < 8; ++i) w[i] = *(const u32x4*)(row + i * 128);
                float a = 0.f;
#pragma unroll
                for (int i = 0; i < 8; ++i) {
                    a = dot2bf(w[i].x, hq[i].x, a); a = dot2bf(w[i].y, hq[i].y, a); a = dot2bf(w[i].z, hq[i].z, a); a = dot2bf(w[i].w, hq[i].w, a); }
                a += __shfl_xor(a, 8); a += __shfl_xor(a, 4); a += __shfl_xor(a, 2); a += __shfl_xor(a, 1);
                const float gg = __shfl(s < 16 ? gA : gB, slot & 63);
                if (l16 == 0) sga[slot] = gelu1(a) * gg;
            }
            asm volatile("s_waitcnt lgkmcnt(0)" ::: "memory"); __builtin_amdgcn_wave_barrier();
            float acc[16];
#pragma unroll
            for (int j = 0; j < 16; ++j) acc[j] = 0.f;
#pragma unroll 4
            for (int slot = 0; slot < 128; ++slot) {
                const int e = __builtin_amdgcn_readlane(slot < 64 ? idA : idB, slot & 63);
                const float ga = sga[slot];
                const bf16_t* row = ub + (size_t)e * DM + lane * 8;
                const u32x4 w0 = *(const u32x4*)row, w1 = *(const u32x4*)(row + 512);
                acc[0] += ga * bflo(w0.x); acc[1] += ga * bfhi(w0.x); acc[2] += ga * bflo(w0.y); acc[3] += ga * bfhi(w0.y);
                acc[4] += ga * bflo(w0.z); acc[5] += ga * bfhi(w0.z); acc[6] += ga * bflo(w0.w); acc[7] += ga * bfhi(w0.w);
                acc[8] += ga * bflo(w1.x); acc[9] += ga * bfhi(w1.x); acc[10] += ga * bflo(w1.y); acc[11] += ga * bfhi(w1.y);
                acc[12] += ga * bflo(w1.z); acc[13] += ga * bfhi(w1.z); acc[14] += ga * bflo(w1.w); acc[15] += ga * bfhi(w1.w);
            }
            asm volatile("s_waitcnt lgkmcnt(0)" ::: "memory"); __builtin_amdgcn_wave_barrier();
            float xo[16]; float ss = 0.f;
#pragma unroll
            for (int i = 0; i < 2; ++i)
#pragma unroll
                for (int j4 = 0; j4 < 2; ++j4) { const int d = i * 512 + lane * 8 + j4 * 4;
                    const f32x4 xv = *(const f32x4*)(p.out + (size_t)t * DM + d);
                    const f32x4 g2 = *(const f32x4*)(mod + b * 6144 + 5120 + d) + *(const f32x4*)(p.b_ada + 5120 + d);
#pragma unroll
                    for (int j = 0; j < 4; ++j) { const float v = xv[j] + g2[j] * acc[i * 8 + j4 * 4 + j]; xo[i * 8 + j4 * 4 + j] = v; ss += v * v; } }
            ss = wave_sum(ss);
            const float rstd = rsqrtf(ss * (1.0f / 1024.0f) + EPS);
#pragma unroll
            for (int i = 0; i < 2; ++i)
#pragma unroll
                for (int j4 = 0; j4 < 2; ++j4) { const int d = i * 512 + lane * 8 + j4 * 4;
                    const f32x4 fw = *(const f32x4*)(p.final_w + d);
                    *(f32x4*)(p.out + (size_t)t * DM + d) = (f32x4){xo[i * 8 + j4 * 4] * rstd * fw[0], xo[i * 8 + j4 * 4 + 1] * rstd * fw[1], xo[i * 8 + j4 * 4 + 2] * rstd * fw[2], xo[i * 8 + j4 * 4 + 3] * rstd * fw[3]}; }
        }
    }
}

__device__ void phase_tables8(const Params& p) {
    const int wid = threadIdx.x >> 6, lane = threadIdx.x & 63;
    const int row0 = blockIdx.x * 8 + wid, rstep = gridDim.x * 8;
    f32x4 vn[4];
    if (row0 < 32768) { const float* src0 = (row0 >= 16384 ? p.up : p.down) + (size_t)(row0 & 16383) * DM + lane * 16;
#pragma unroll
        for (int i = 0; i < 4; ++i) vn[i] = __builtin_nontemporal_load((const f32x4*)(src0 + 4 * i)); }
    for (int row = row0; row < 32768; row += rstep) {
        const bool isup = row >= 16384; const int e = row & 16383;
        f32x4 v[4]; float m = 0.f;
#pragma unroll
        for (int i = 0; i < 4; ++i) v[i] = vn[i];
        if (row + rstep < 32768) { const int rn = row + rstep; const float* srcn = (rn >= 16384 ? p.up : p.down) + (size_t)(rn & 16383) * DM + lane * 16;
#pragma unroll
            for (int i = 0; i < 4; ++i) vn[i] = __builtin_nontemporal_load((const f32x4*)(srcn + 4 * i)); }
#pragma unroll
        for (int i = 0; i < 4; ++i) { m = fmaxf(m, fmaxf(fmaxf(fabsf(v[i][0]), fabsf(v[i][1])), fmaxf(fabsf(v[i][2]), fabsf(v[i][3])))); }
#pragma unroll
        for (int o = 32; o; o >>= 1) m = fmaxf(m, __shfl_xor(m, o));
        const float qmax = isup ? 224.0f : 127.0f;
        const float sc = m > 0.f ? m / qmax : 1.0f, inv = m > 0.f ? qmax / m : 0.f;
        int w[4];
        if (isup) {
#pragma unroll
            for (int i = 0; i < 4; ++i) { w[i] = __builtin_amdgcn_cvt_pk_fp8_f32(v[i][0] * inv, v[i][1] * inv, 0, false); w[i] = __builtin_amdgcn_cvt_pk_fp8_f32(v[i][2] * inv, v[i][3] * inv, w[i], true); }
        } else {
#pragma unroll
            for (int i = 0; i < 4; ++i) { const int q0 = (int)rintf(v[i][0] * inv), q1 = (int)rintf(v[i][1] * inv), q2 = (int)rintf(v[i][2] * inv), q3 = (int)rintf(v[i][3] * inv);
                w[i] = (q0 & 255) | ((q1 & 255) << 8) | ((q2 & 255) << 16) | ((q3 & 255) << 24); }
        }
        unsigned char* dst = p.ws + (isup ? OFF_UP8 : OFF_DOWN8) + (size_t)e * 1024 + lane * 16;
        *(u32x4*)dst = (u32x4){(unsigned)w[0], (unsigned)w[1], (unsigned)w[2], (unsigned)w[3]};
        if (lane == 0) ((float*)(p.ws + (isup ? OFF_SCU : OFF_SCD)))[e] = sc;
    }
}

__device__ __forceinline__ float dot2bfv(bf16x2_t a, unsigned b, float c) { return __builtin_amdgcn_fdot2_f32_bf16(a, __builtin_bit_cast(bf16x2_t, b), c, false); }
#define PEER_FMA16(ACC, W, GA) do { \
    const f32x2 _a0 = __builtin_amdgcn_cvt_pk_f32_fp8((int)(W).x, false), _a1 = __builtin_amdgcn_cvt_pk_f32_fp8((int)(W).x, true); \
    const f32x2 _b0 = __builtin_amdgcn_cvt_pk_f32_fp8((int)(W).y, false), _b1 = __builtin_amdgcn_cvt_pk_f32_fp8((int)(W).y, true); \
    const f32x2 _c0 = __builtin_amdgcn_cvt_pk_f32_fp8((int)(W).z, false), _c1 = __builtin_amdgcn_cvt_pk_f32_fp8((int)(W).z, true); \
    const f32x2 _d0 = __builtin_amdgcn_cvt_pk_f32_fp8((int)(W).w, false), _d1 = __builtin_amdgcn_cvt_pk_f32_fp8((int)(W).w, true); \
    ACC[0] = __builtin_fmaf((GA), _a0.x, ACC[0]); ACC[1] = __builtin_fmaf((GA), _a0.y, ACC[1]); ACC[2] = __builtin_fmaf((GA), _a1.x, ACC[2]); ACC[3] = __builtin_fmaf((GA), _a1.y, ACC[3]); \
    ACC[4] = __builtin_fmaf((GA), _b0.x, ACC[4]); ACC[5] = __builtin_fmaf((GA), _b0.y, ACC[5]); ACC[6] = __builtin_fmaf((GA), _b1.x, ACC[6]); ACC[7] = __builtin_fmaf((GA), _b1.y, ACC[7]); \
    ACC[8] = __builtin_fmaf((GA), _c0.x, ACC[8]); ACC[9] = __builtin_fmaf((GA), _c0.y, ACC[9]); ACC[10] = __builtin_fmaf((GA), _c1.x, ACC[10]); ACC[11] = __builtin_fmaf((GA), _c1.y, ACC[11]); \
    ACC[12] = __builtin_fmaf((GA), _d0.x, ACC[12]); ACC[13] = __builtin_fmaf((GA), _d0.y, ACC[13]); ACC[14] = __builtin_fmaf((GA), _d1.x, ACC[14]); ACC[15] = __builtin_fmaf((GA), _d1.y, ACC[15]); } while (0)
__device__ void phase_peer2(const Params& p, unsigned char* lds) {
    const int tid = threadIdx.x, wid = tid >> 6, lane = tid & 63, l16 = lane & 15, q4 = lane >> 4;
    unsigned char* wl = lds + wid * 6144;
    int* se = (int*)wl;
    float* sg = (float*)(wl + 2048);
    float* sa = (float*)(wl + 4096);
    const unsigned char* d8 = p.ws + OFF_DOWN8; const unsigned char* u8 = p.ws + OFF_UP8;
    const float* scd = (const float*)(p.ws + OFF_SCD); const float* scu = (const float*)(p.ws + OFF_SCU);
    const bf16_t* h2 = (const bf16_t*)(p.ws + OFF_H2);
    const int* idxo = (const int*)(p.ws + OFF_IDX); const float* go = (const float*)(p.ws + OFF_G);
    const float* mod = (const float*)(p.ws + OFF_MOD);
    const unsigned long long ltmask = (1ull << lane) - 1ull;
    for (int blk2 = blockIdx.x * 2; blk2 < 512; blk2 += (blk2 & 1) ? 2 * gridDim.x - 1 : 1) {
        const int blk = blk2; const int tok0 = blk * 32 + wid * 4; const int b = tok0 >> 13;
#pragma unroll
        for (int tk = 0; tk < 4; ++tk) { const size_t o = (size_t)(tok0 + tk) * 128 + lane;
            const int idA = idxo[o], idB = idxo[o + 64]; const float gA = go[o], gB = go[o + 64];
            int base = 0;
#pragma unroll
            for (int r = 0; r < 8; ++r) {
                const bool mA = (idA >> 11) == r, mB = (idB >> 11) == r; const unsigned long long kA = __ballot(mA), kB = __ballot(mB);
                if (mA) { const int pos = tk * 128 + base + __popcll(kA & ltmask); se[pos] = idA; sg[pos] = gA; }
                base += __popcll(kA);
                if (mB) { const int pos = tk * 128 + base + __popcll(kB & ltmask); se[pos] = idB; sg[pos] = gB; }
                base += __popcll(kB); } }
        int hq8[16]; float hscale;
        {
            u32x4 hraw[4][2]; float hm = 0.f;
#pragma unroll
            for (int i = 0; i < 4; ++i)
#pragma unroll
                for (int j = 0; j < 2; ++j) { hraw[i][j] = *(const u32x4*)(h2 + (size_t)(tok0 + q4) * DM + i * 256 + l16 * 16 + j * 8);
                    const unsigned ww[4] = {hraw[i][j].x, hraw[i][j].y, hraw[i][j].z, hraw[i][j].w};
#pragma unroll
                    for (int c = 0; c < 4; ++c) hm = fmaxf(hm, fmaxf(fabsf(bflo(ww[c])), fabsf(bfhi(ww[c])))); }
            hm = fmaxf(hm, __shfl_xor(hm, 8)); hm = fmaxf(hm, __shfl_xor(hm, 4)); hm = fmaxf(hm, __shfl_xor(hm, 2)); hm = fmaxf(hm, __shfl_xor(hm, 1));
            hscale = hm > 0.f ? hm * (1.0f / 127.0f) : 1.0f; const float hinv = hm > 0.f ? 127.0f / hm : 0.f;
#pragma unroll
            for (int i = 0; i < 4; ++i)
#pragma unroll
                for (int j = 0; j < 2; ++j) { const unsigned ww[4] = {hraw[i][j].x, hraw[i][j].y, hraw[i][j].z, hraw[i][j].w};
#pragma unroll
                    for (int c2 = 0; c2 < 2; ++c2) { const int q0 = (int)rintf(bflo(ww[2 * c2]) * hinv), q1 = (int)rintf(bfhi(ww[2 * c2]) * hinv), q2 = (int)rintf(bflo(ww[2 * c2 + 1]) * hinv), q3 = (int)rintf(bfhi(ww[2 * c2 + 1]) * hinv);
                        hq8[i * 4 + j * 2 + c2] = (q0 & 255) | ((q1 & 255) << 8) | ((q2 & 255) << 16) | ((q3 & 255) << 24); } }
        }
        asm volatile("s_waitcnt lgkmcnt(0)" ::: "memory"); __builtin_amdgcn_wave_barrier();
        {
            u32x4 bufA[8], bufB[8], bufC[8]; float sdA[2], sdB[2], sdC[2];
#define PEER_DLOAD(BUF, SD, K) do { _Pragma("unroll") for (int _u = 0; _u < 2; ++_u) { const int _e = se[q4 * 128 + 2 * (K) + _u]; const unsigned char* _row = d8 + (size_t)_e * 1024 + l16 * 16; \
            _Pragma("unroll") for (int _i = 0; _i < 4; ++_i) BUF[_u * 4 + _i] = *(const u32x4*)(_row + _i * 256); SD[_u] = scd[_e]; } } while (0)
#define PEER_DCOMP(BUF, SD, K) do { _Pragma("unroll") for (int _u = 0; _u < 2; ++_u) { int _ai = 0; \
            _Pragma("unroll") for (int _i = 0; _i < 4; ++_i) { const u32x4 _w = BUF[_u * 4 + _i]; \
                _ai = __builtin_amdgcn_sdot4((int)_w.x, hq8[_i * 4], _ai, false); _ai = __builtin_amdgcn_sdot4((int)_w.y, hq8[_i * 4 + 1], _ai, false); \
                _ai = __builtin_amdgcn_sdot4((int)_w.z, hq8[_i * 4 + 2], _ai, false); _ai = __builtin_amdgcn_sdot4((int)_w.w, hq8[_i * 4 + 3], _ai, false); } \
            _ai += __shfl_xor(_ai, 8); _ai += __shfl_xor(_ai, 4); _ai += __shfl_xor(_ai, 2); _ai += __shfl_xor(_ai, 1); \
            if (l16 == 0) sa[q4 * 128 + 2 * (K) + _u] = (float)_ai * SD[_u] * hscale; } } while (0)
            PEER_DLOAD(bufA, sdA, 0); PEER_DLOAD(bufB, sdB, 1);
            for (int k = 0; k < 63; k += 3) {
                PEER_DLOAD(bufC, sdC, k + 2);
                PEER_DCOMP(bufA, sdA, k);
                PEER_DLOAD(bufA, sdA, k + 3);
                PEER_DCOMP(bufB, sdB, k + 1);
                if (k + 4 < 64) PEER_DLOAD(bufB, sdB, k + 4);
                PEER_DCOMP(bufC, sdC, k + 2);
            }
            PEER_DCOMP(bufA, sdA, 63);
#undef PEER_DLOAD
#undef PEER_DCOMP
            asm volatile("s_waitcnt lgkmcnt(0)" ::: "memory"); __builtin_amdgcn_wave_barrier();
#pragma unroll
            for (int j = 0; j < 8; ++j) { const int ix = lane + 64 * j; const int e = se[ix]; sg[ix] = gelu1(sa[ix]) * sg[ix] * scu[e]; }
        }
        asm volatile("s_waitcnt lgkmcnt(0)" ::: "memory"); __builtin_amdgcn_wave_barrier();
        float acc0[16], acc1[16], acc2[16], acc3[16];
#pragma unroll
        for (int j = 0; j < 16; ++j) { acc0[j] = 0.f; acc1[j] = 0.f; acc2[j] = 0.f; acc3[j] = 0.f; }
        {
            constexpr int RD = 6;
            u32x4 ring[4 * RD];
#pragma unroll
            for (int j = 0; j < 4 * RD; ++j) ring[j] = *(const u32x4*)(u8 + (size_t)se[(j & 3) * 128 + (j >> 2)] * 1024 + lane * 16);
            for (int i = 0; i < 128; i += RD) {
#pragma unroll
                for (int j = 0; j < 4 * RD; ++j) {
                    const int tk = j & 3, st = i + (j >> 2);
                    if (st >= 128) break;
                    const float ga = sg[tk * 128 + st];
                    const u32x4 w = ring[j];
                    if (st + RD < 128) ring[j] = *(const u32x4*)(u8 + (size_t)se[tk * 128 + st + RD] * 1024 + lane * 16);
                    if (tk == 0) PEER_FMA16(acc0, w, ga); else if (tk == 1) PEER_FMA16(acc1, w, ga); else if (tk == 2) PEER_FMA16(acc2, w, ga); else PEER_FMA16(acc3, w, ga);
                }
            }
        }
        asm volatile("s_waitcnt lgkmcnt(0)" ::: "memory"); __builtin_amdgcn_wave_barrier();
#define PEER_FIN(ACC, TK) do { const size_t _o = (size_t)(tok0 + (TK)) * DM + lane * 16; f32x4 _x[4]; float _ss = 0.f; \
        _Pragma("unroll") for (int _j = 0; _j < 4; ++_j) { const f32x4 _xv = *(const f32x4*)(p.out + _o + 4 * _j); const f32x4 _g2 = *(const f32x4*)(mod + b * 6144 + 5120 + lane * 16 + 4 * _j) + *(const f32x4*)(p.b_ada + 5120 + lane * 16 + 4 * _j); \
            _x[_j] = _xv + _g2 * (f32x4){ACC[4 * _j], ACC[4 * _j + 1], ACC[4 * _j + 2], ACC[4 * _j + 3]}; _ss += _x[_j][0] * _x[_j][0] + _x[_j][1] * _x[_j][1] + _x[_j][2] * _x[_j][2] + _x[_j][3] * _x[_j][3]; } \
        _ss = wave_sum(_ss); const float _rs = rsqrtf(_ss * (1.0f / 1024.0f) + EPS); \
        _Pragma("unroll") for (int _j = 0; _j < 4; ++_j) { const f32x4 _fw = *(const f32x4*)(p.final_w + lane * 16 + 4 * _j); *(f32x4*)(p.out + _o + 4 * _j) = _x[_j] * _rs * _fw; } } while (0)
        PEER_FIN(acc0, 0); PEER_FIN(acc1, 1); PEER_FIN(acc2, 2); PEER_FIN(acc3, 3);
#undef PEER_FIN
    }
}

#ifndef DBG_STAGE
#define DBG_STAGE 0
#endif
__device__ void phase_final_only(const Params& p) {
    const int wid = threadIdx.x >> 6, lane = threadIdx.x & 63;
    for (int t = blockIdx.x * 8 + wid; t < NTOK; t += gridDim.x * 8) {
        f32x4 xv[4]; float ss = 0.f;
#pragma unroll
        for (int i = 0; i < 4; ++i) { xv[i] = *(const f32x4*)(p.out + (size_t)t * DM + 256 * i + 4 * lane); ss += xv[i][0] * xv[i][0] + xv[i][1] * xv[i][1] + xv[i][2] * xv[i][2] + xv[i][3] * xv[i][3]; }
        ss = wave_sum(ss);
        const float rstd = rsqrtf(ss * (1.0f / 1024.0f) + EPS);
#pragma unroll
        for (int i = 0; i < 4; ++i) { const f32x4 fw = *(const f32x4*)(p.final_w + 256 * i + 4 * lane); *(f32x4*)(p.out + (size_t)t * DM + 256 * i + 4 * lane) = xv[i] * rstd * fw; }
    }
}

__device__ void phase_dump_bf16(const Params& p, const bf16_t* src, int ld) {
    for (size_t e = (size_t)blockIdx.x * 512 + threadIdx.x; e < (size_t)NTOK * DM; e += (size_t)gridDim.x * 512) {
        const size_t t = e >> 10, d = e & 1023; float v = __uint_as_float((unsigned)src[t * ld + d] << 16); if (!(fabsf(v) < 1e30f)) v = 1000.f; p.out[e] = v; }
}
__device__ void dbg_check_bf16(const Params& p, const bf16_t* src, size_t n, unsigned bit) {
    unsigned* flags = (unsigned*)(p.ws + OFF_IDX);
    bool bad = false;
    for (size_t e = (size_t)blockIdx.x * 512 + threadIdx.x; e < n; e += (size_t)gridDim.x * 512) { const float v = __uint_as_float((unsigned)src[e] << 16); if (!(fabsf(v) < 1e30f)) bad = true; }
    if (bad) atomicOr(flags, bit);
}
__device__ void dbg_check_f32(const Params& p, const float* src, size_t n, unsigned bit, float lim) {
    unsigned* flags = (unsigned*)(p.ws + OFF_IDX);
    bool bad = false;
    for (size_t e = (size_t)blockIdx.x * 512 + threadIdx.x; e < n; e += (size_t)gridDim.x * 512) { const float v = src[e]; if (!(fabsf(v) < lim)) bad = true; }
    if (bad) atomicOr(flags, bit);
}
__device__ void dbg_final(const Params& p) {
    const unsigned f = *(const unsigned*)(p.ws + OFF_IDX);
    for (size_t e = (size_t)blockIdx.x * 512 + threadIdx.x; e < (size_t)NTOK * DM; e += (size_t)gridDim.x * 512) p.out[e] = p.x[e] * (1.0f + (float)f);
}
#define GSYNC() xcd_barrier(xb)
__global__ void __launch_bounds__(512, 2) fwd_megakernel(Params p) {
    extern __shared__ __attribute__((aligned(16))) unsigned char lds[];
    cg::grid_group grid = cg::this_grid();
    LAS unsigned char* lds3 = (LAS unsigned char*)lds;
    const float* mod = (const float*)(p.ws + OFF_MOD);
    volatile LAS unsigned* xst = (volatile LAS unsigned*)(lds3 + LDS_BYTES - 16);
    if (threadIdx.x == 0) { xst[0] = 0u; xst[1] = 0u; }
    __syncthreads();
    const XcdBarrier xb = xcd_barrier_post((unsigned*)(p.ws + OFF_BAR), xst);
    if (p.ws == nullptr) grid.sync();
    phase0(p, lds);
#if DBG_STAGE == 6
    if (blockIdx.x == 0 && threadIdx.x == 0) *(unsigned*)(p.ws + OFF_IDX) = 0u;
#endif
    GSYNC();
    phase_norm<true>(p, p.x, p.norm1_w, 0, 1024, (bf16_t*)(p.ws + OFF_HB), lds);
    GSYNC();
#if DBG_STAGE == 3
    phase_dump_bf16(p, (const bf16_t*)(p.ws + OFF_HB), DM); return;
#endif
    { pg8::StaticOrder S; S.init(NTOK, 7168, gridDim.x, blockIdx.x); EpiProj E{(bf16_t*)(p.ws + OFF_PROJ)};
        pg8::gemm_phase(lds3, pg8::Gemm{(const bf16_t*)(p.ws + OFF_HB), (const bf16_t*)(p.ws + OFF_WINT), NTOK, 7168, 1024}, S, E); }
    GSYNC();
#if DBG_STAGE == 2
    phase_dump_bf16(p, (const bf16_t*)(p.ws + OFF_PROJ) + 1024, PW); return;
#endif
    phase_glaA(p, lds);
    GSYNC();
#if DBG_STAGE == 6
    dbg_check_bf16(p, (const bf16_t*)p.out, (size_t)NTOK * 2048, 1u);
    dbg_check_f32(p, (const float*)(p.ws + OFF_ALR), (size_t)NTOK * 16, 8u, 50.f);
    dbg_check_f32(p, (const float*)(p.ws + OFF_DECAY), (size_t)1024 * 128, 16u, 1.0001f);
#endif
    phase_scan_sgu(p, lds);
    GSYNC();
#if DBG_STAGE == 6
    dbg_check_bf16(p, (const bf16_t*)p.out, (size_t)NTOK * 2048, 2u);
#endif
#if DBG_STAGE == 4
    phase_dump_bf16(p, (const bf16_t*)(p.ws + OFF_HB), DM); return;
#endif
    phase_glaC(p, lds);
    GSYNC();
#if DBG_STAGE == 5
    phase_dump_bf16(p, (const bf16_t*)(p.ws + OFF_HB), DM); return;
#endif
#if DBG_STAGE == 6
    dbg_check_bf16(p, (const bf16_t*)(p.ws + OFF_HB), (size_t)NTOK * DM, 4u);
    GSYNC();
    dbg_final(p); return;
#endif
    { pg8::StaticOrder S; S.init(NTOK, 1024, gridDim.x, blockIdx.x); EpiX1 E{p.x, p.out, mod, p.b_ada};
        pg8::gemm_phase(lds3, pg8::Gemm{(const bf16_t*)(p.ws + OFF_HB), (const bf16_t*)(p.ws + OFF_WOUTT), NTOK, 1024, 1024}, S, E); }
    GSYNC();
#if DBG_STAGE == 1
    phase_final_only(p); return;
#endif
    phase_norm<false>(p, p.out, p.norm2_w, 3072, 4096, (bf16_t*)(p.ws + OFF_H2), lds);
    phase_tables8(p);
    GSYNC();
    { pg8::StaticOrder S; S.init(NTOK, 2048, gridDim.x, blockIdx.x); EpiQ E{(bf16_t*)(p.ws + OFF_QP)};
        pg8::gemm_phase(lds3, pg8::Gemm{(const bf16_t*)(p.ws + OFF_H2), (const bf16_t*)(p.ws + OFF_WQT), NTOK, 2048, 1024}, S, E); }
    GSYNC();
    phase_topk(p, lds);
    asm volatile("s_waitcnt vmcnt(0) lgkmcnt(0)" ::: "memory"); __syncthreads();
    phase_peer2(p, lds);
}

extern "C" void kernel_launch(void* const* d_in, const int* in_sizes, int n_in, void* d_out, int out_size, void* d_ws, size_t ws_size, hipStream_t stream) {
    static int grid_blocks = 0;
    if (!grid_blocks) {
        int dev = 0, cus = 0, per_cu = 0;
        hipGetDevice(&dev);
        hipDeviceGetAttribute(&cus, hipDeviceAttributeMultiprocessorCount, dev);
        hipFuncSetAttribute((const void*)fwd_megakernel, hipFuncAttributeMaxDynamicSharedMemorySize, LDS_BYTES);
        hipOccupancyMaxActiveBlocksPerMultiprocessor(&per_cu, (const void*)fwd_megakernel, 512, LDS_BYTES);
        per_cu = 1;
        grid_blocks = cus * per_cu;
        if (ws_size < WS_END) fprintf(stderr, "kernel_launch: workspace too small (%zu < %zu)\n", ws_size, (size_t)WS_END);
    }
    Params p{};
    p.x = (const float*)d_in[0]; p.c = (const float*)d_in[1]; p.w_ada = (const float*)d_in[2]; p.b_ada = (const float*)d_in[3]; p.norm1_w = (const float*)d_in[4];
    p.w_in = (const float*)d_in[5]; p.w_alpha_up = (const float*)d_in[6]; p.b_alpha = (const float*)d_in[7]; p.gla_norm_w = (const float*)d_in[8];
    p.sgu_ln_w = (const float*)d_in[9]; p.sgu_ln_b = (const float*)d_in[10]; p.sgu_w = (const float*)d_in[11]; p.sgu_b = (const float*)d_in[12];
    p.w_out = (const float*)d_in[13]; p.norm2_w = (const float*)d_in[14]; p.w_q = (const float*)d_in[15]; p.keys1 = (const float*)d_in[16]; p.keys2 = (const float*)d_in[17];
    p.down = (const float*)d_in[18]; p.up = (const float*)d_in[19]; p.final_w = (const float*)d_in[20];
    p.out = (float*)d_out; p.ws = (unsigned char*)d_ws;
    hipMemsetAsync((unsigned char*)d_ws + OFF_BAR, 0, XCD_BAR_WORDS * 4, stream);
    void* args[] = {&p};
    hipError_t e = hipLaunchCooperativeKernel((const void*)fwd_megakernel, dim3(grid_blocks), dim3(512), args, LDS_BYTES, stream);
    if (e != hipSuccess) fprintf(stderr, "cooperative launch failed: %s (grid %d)\n", hipGetErrorString(e), grid_blocks);
}
```
